# Optimizing an MI355X kernel written in HIP

```python
import math
import jax
import jax.numpy as jnp
from jax import lax
import numpy as np

D_MODEL = 2048
BATCH = 2
SEQ = 16384
DEPTH = 4

GRID_W = 64
CTX_LEN = 256

MIX_WIDTH = D_MODEL
S5_WIDTH = MIX_WIDTH // 2
S5_GROUP = 16
S5_GROUPS = S5_WIDTH // S5_GROUP
S5_STATE = 64
FNET_WIDTH = MIX_WIDTH - S5_WIDTH
FNET_GROUPS = 4
FNET_GROUP = FNET_WIDTH // FNET_GROUPS

HEAD_DIM = 128
N_HEADS = D_MODEL // HEAD_DIM
N_KV_HEADS = N_HEADS // 4
Q_WIDTH = N_HEADS * HEAD_DIM
KV_WIDTH = N_KV_HEADS * HEAD_DIM
ROPE_THETA = 10000.0
ATTN_BLOCK = 128
QK_NORM_EPS = 1e-6

N_EXPERTS = 16
EXPERT_FF = D_MODEL // 2
EC_CAPACITY = 2

LN_EPS = 1e-6
N_MOD = 6
ALPHA = (2 * DEPTH) ** 0.25
BETA = (8 * DEPTH) ** -0.25
F32 = jnp.float32

kernel_name = 'hybrid_s5_fourier_gqa_ecmoe_dit'


def _layer_norm(x, gain=None, bias=None):
    xf = x.astype(F32)
    mu = jnp.mean(xf, axis=-1, keepdims=True)
    var = jnp.mean(jnp.square(xf - mu), axis=-1, keepdims=True)
    y = (xf - mu) * lax.rsqrt(var + LN_EPS)
    if gain is not None:
        y = y * gain.astype(F32) + bias.astype(F32)
    return y.astype(x.dtype)


def _rms_norm(x, gain):
    xf = x.astype(F32)
    y = xf * lax.rsqrt(jnp.mean(jnp.square(xf), axis=-1, keepdims=True) + QK_NORM_EPS)
    return (y * gain.astype(F32)).astype(x.dtype)


def _adaln(cond, w, b):
    m = jax.nn.silu(cond) @ w + b
    return jnp.split(m[..., None, :], N_MOD, axis=-1)


def _modulate(x, shift, scale):
    return _layer_norm(x) * (1 + scale) + shift


def _s5_discretize(lam_re, lam_im, log_step, b_re, b_im):
    lam = lax.complex(lam_re.astype(F32), lam_im.astype(F32))
    step = jnp.exp(log_step.astype(F32))[:, None]
    lam_bar = jnp.exp(lam * step)
    b = lax.complex(b_re.astype(F32), b_im.astype(F32))
    b_bar = ((lam_bar - 1.0) / lam)[..., None] * b
    return lam_bar, b_bar


def _recurrence_combine(left, right):
    a_l, b_l = left
    a_r, b_r = right
    return a_l * a_r, a_r * b_l + b_r


def _s5_scan(u, lam_bar, b_bar, h0, reverse):
    bu = lax.complex(jnp.einsum('blgc,gpc->blgp', u, jnp.real(b_bar)),
                     jnp.einsum('blgc,gpc->blgp', u, jnp.imag(b_bar)))
    if h0 is not None:
        edge = u.shape[1] - 1 if reverse else 0
        bu = bu.at[:, edge].add(lam_bar * h0)
    a = jnp.broadcast_to(lam_bar, (1, u.shape[1]) + lam_bar.shape)
    _, h = lax.associative_scan(_recurrence_combine, (a, bu), reverse=reverse, axis=1)
    return h


def _s5_readout(h, c_re, c_im):
    return (jnp.einsum('blgp,gcp->blgc', jnp.real(h), c_re.astype(F32))
            - jnp.einsum('blgp,gcp->blgc', jnp.imag(h), c_im.astype(F32)))


def _fourier_groups(f, w, b):
    bsz, length = f.shape[:2]
    fg = f.astype(F32).reshape(bsz, length, FNET_GROUPS, FNET_GROUP)
    mixed = jnp.real(jnp.fft.fft2(fg, axes=(1, 3), norm='ortho')).astype(f.dtype)
    return (jnp.einsum('blgc,gce->blge', mixed, w) + b).reshape(bsz, length, FNET_WIDTH)


def _s5_fourier_mixer(u_ctx, u_lat, w_in, w_out, lam_re, lam_im, log_step, b_re, b_im,
                      c_re, c_im, d_skip, w_glu, b_glu, fnet_w, fnet_b, need_ctx):
    z_lat = u_lat @ w_in
    z_ctx = u_ctx @ (w_in if need_ctx else w_in[:, :S5_WIDTH])

    def groups(z):
        return z[..., :S5_WIDTH].astype(F32).reshape(z.shape[:2] + (S5_GROUPS, S5_GROUP))

    a_lat, a_ctx = groups(z_lat), groups(z_ctx)
    d_g = d_skip.astype(F32).reshape(S5_GROUPS, S5_GROUP)
    y_lat = a_lat * d_g
    y_ctx = a_ctx * d_g if need_ctx else None
    for direction, reverse in enumerate((False, True)):
        lam_bar, b_bar = _s5_discretize(lam_re[direction], lam_im[direction], log_step[direction],
                                        b_re[direction], b_im[direction])
        h_ctx = _s5_scan(a_ctx, lam_bar, b_bar, None, reverse)
        h_ctx_final = h_ctx[:, 0] if reverse else h_ctx[:, -1]
        h_lat = _s5_scan(a_lat, lam_bar, b_bar, h_ctx_final, reverse)
        y_lat = y_lat + _s5_readout(h_lat, c_re[direction], c_im[direction])
        if need_ctx:
            y_ctx = y_ctx + _s5_readout(h_ctx, c_re[direction], c_im[direction])

    def merge(y, z):
        bsz, length = z.shape[:2]
        g = jax.nn.gelu(y.reshape(bsz, length, S5_WIDTH).astype(z.dtype))
        s5_out = g * jax.nn.sigmoid(g @ w_glu + b_glu)
        four_out = _fourier_groups(z[..., S5_WIDTH:], fnet_w, fnet_b)
        return jnp.concatenate([s5_out, four_out], axis=-1) @ w_out

    o_lat = merge(y_lat, z_lat)
    o_ctx = merge(y_ctx, z_ctx) if need_ctx else None
    return o_ctx, o_lat


def _axial_rope_tables(length):
    rows = length // GRID_W
    row = jnp.repeat(jnp.arange(rows, dtype=F32), GRID_W)
    col = jnp.tile(jnp.arange(GRID_W, dtype=F32), rows)
    n_freq = HEAD_DIM // 4
    inv_freq = ROPE_THETA ** (-jnp.arange(n_freq, dtype=F32) / n_freq)
    ang_r = row[:, None] * inv_freq
    ang_c = col[:, None] * inv_freq
    return jnp.cos(ang_r), jnp.sin(ang_r), jnp.cos(ang_c), jnp.sin(ang_c)


def _rotate(x, cos, sin):
    x1, x2 = jnp.split(x, 2, axis=-1)
    cos = cos[None, :, None, :]
    sin = sin[None, :, None, :]
    return jnp.concatenate([x1 * cos - x2 * sin, x2 * cos + x1 * sin], axis=-1)


def _apply_axial_rope(x, tables):
    cos_r, sin_r, cos_c, sin_c = tables
    xr, xc = jnp.split(x.astype(F32), 2, axis=-1)
    return jnp.concatenate([_rotate(xr, cos_r, sin_r), _rotate(xc, cos_c, sin_c)], axis=-1).astype(x.dtype)


def _attend(q, k, v):
    bsz, lq = q.shape[:2]
    n_blk = lq // ATTN_BLOCK
    group = N_HEADS // N_KV_HEADS
    qb = q.reshape(bsz, n_blk, ATTN_BLOCK, N_KV_HEADS, group, HEAD_DIM).swapaxes(0, 1)
    kf = k.astype(F32)
    scale = HEAD_DIM ** -0.5

    def block(q_blk):
        s = jnp.einsum('bqkgd,bskd->bkgqs', q_blk.astype(F32), kf) * scale
        p = jax.nn.softmax(s, axis=-1).astype(v.dtype)
        return jnp.einsum('bkgqs,bskd->bqkgd', p, v)

    o = lax.map(block, qb)
    return o.swapaxes(0, 1).reshape(bsz, lq, Q_WIDTH)


def _gqa_mixer(u_ctx, u_lat, w_qkv, q_gain, k_gain, w_o, need_ctx):
    def heads(z, n):
        return z.reshape(z.shape[:2] + (n, HEAD_DIM))

    z_lat = u_lat @ w_qkv
    tables = _axial_rope_tables(u_lat.shape[1])
    q_l = _apply_axial_rope(_rms_norm(heads(z_lat[..., :Q_WIDTH], N_HEADS), q_gain), tables)
    k_l = _apply_axial_rope(_rms_norm(heads(z_lat[..., Q_WIDTH:Q_WIDTH + KV_WIDTH], N_KV_HEADS), k_gain), tables)
    v_l = heads(z_lat[..., Q_WIDTH + KV_WIDTH:], N_KV_HEADS)

    z_ctx = u_ctx @ (w_qkv if need_ctx else w_qkv[:, Q_WIDTH:])
    kv_ctx = z_ctx[..., -2 * KV_WIDTH:]
    k_c = _rms_norm(heads(kv_ctx[..., :KV_WIDTH], N_KV_HEADS), k_gain)
    v_c = heads(kv_ctx[..., KV_WIDTH:], N_KV_HEADS)

    keys = jnp.concatenate([k_c, k_l], axis=1)
    vals = jnp.concatenate([v_c, v_l], axis=1)
    o_lat = _attend(q_l, keys, vals) @ w_o
    o_ctx = None
    if need_ctx:
        q_c = _rms_norm(heads(z_ctx[..., :Q_WIDTH], N_HEADS), q_gain)
        o_ctx = _attend(q_c, k_c, v_c) @ w_o
    return o_ctx, o_lat


def _expert_choice_ffn(h, w_router, w_gate, w_up, w_down):
    bsz, n_tok, _ = h.shape
    capacity = EC_CAPACITY * n_tok // N_EXPERTS
    affinity = jax.nn.softmax(h.astype(F32) @ w_router.astype(F32), axis=-1)
    gate, idx = lax.top_k(jnp.swapaxes(affinity, 1, 2), capacity)
    bidx = jnp.arange(bsz)[:, None, None]
    xe = h[bidx, idx]
    hid = jax.nn.silu(jnp.einsum('becd,edf->becf', xe, w_gate)) * jnp.einsum('becd,edf->becf', xe, w_up)
    ye = jnp.einsum('becf,efd->becd', hid, w_down) * gate[..., None].astype(h.dtype)
    return jnp.zeros_like(h).at[bidx, idx].add(ye)


def setup_inputs(seed: int = 0) -> dict:
    key = jax.random.key(seed)
    keys = iter(jax.random.split(key, 40))

    def normal(shape, scale):
        return jax.random.normal(next(keys), shape, F32) * scale

    d = D_MODEL
    n_even = (DEPTH + 1) // 2
    n_odd = DEPTH // 2
    lam_im_base = math.pi * jnp.arange(S5_STATE, dtype=F32)
    qkv_scale = jnp.concatenate([jnp.full((Q_WIDTH + KV_WIDTH,), d ** -0.5, F32),
                                 jnp.full((KV_WIDTH,), BETA * d ** -0.5, F32)])
    return {
        'x': normal((BATCH, SEQ, d), 1.0),
        'c': normal((BATCH, d), 1.0),
        'ctx': normal((BATCH, CTX_LEN, d), 1.0),
        'c_ctx': normal((d,), 1.0),
        'mod_w': normal((DEPTH, d, N_MOD * d), 0.5 * d ** -0.5),
        'mod_b': normal((DEPTH, N_MOD * d), 0.01),
        'ln_mix_g': 1.0 + normal((DEPTH, d), 0.05),
        'ln_mix_b': normal((DEPTH, d), 0.02),
        'ln_ffn_g': 1.0 + normal((DEPTH, d), 0.05),
        'ln_ffn_b': normal((DEPTH, d), 0.02),
        's5f_w_in': normal((n_even, d, MIX_WIDTH), d ** -0.5),
        's5f_w_out': normal((n_even, MIX_WIDTH, d), BETA * MIX_WIDTH ** -0.5),
        's5_lam_re': -0.5 + normal((n_even, 2, S5_GROUPS, S5_STATE), 0.02),
        's5_lam_im': lam_im_base + normal((n_even, 2, S5_GROUPS, S5_STATE), 0.01),
        's5_log_step': jax.random.uniform(next(keys), (n_even, 2, S5_GROUPS), dtype=F32,
                                          minval=math.log(1e-3), maxval=math.log(1e-1)),
        's5_b_re': normal((n_even, 2, S5_GROUPS, S5_STATE, S5_GROUP), (2 * S5_GROUP) ** -0.5),
        's5_b_im': normal((n_even, 2, S5_GROUPS, S5_STATE, S5_GROUP), (2 * S5_GROUP) ** -0.5),
        's5_c_re': normal((n_even, 2, S5_GROUPS, S5_GROUP, S5_STATE), S5_STATE ** -0.5),
        's5_c_im': normal((n_even, 2, S5_GROUPS, S5_GROUP, S5_STATE), S5_STATE ** -0.5),
        's5_d': normal((n_even, S5_WIDTH), 0.5),
        's5_w_glu': normal((n_even, S5_WIDTH, S5_WIDTH), S5_WIDTH ** -0.5),
        's5_b_glu': normal((n_even, S5_WIDTH), 0.01),
        'fnet_w': normal((n_even, FNET_GROUPS, FNET_GROUP, FNET_GROUP), FNET_GROUP ** -0.5),
        'fnet_b': normal((n_even, FNET_GROUPS, FNET_GROUP), 0.01),
        'attn_w_qkv': normal((n_odd, d, Q_WIDTH + 2 * KV_WIDTH), 1.0) * qkv_scale,
        'attn_q_gain': 1.0 + normal((n_odd, HEAD_DIM), 0.05),
        'attn_k_gain': 1.0 + normal((n_odd, HEAD_DIM), 0.05),
        'attn_w_o': normal((n_odd, Q_WIDTH, d), BETA * Q_WIDTH ** -0.5),
        'moe_w_router': normal((DEPTH, d, N_EXPERTS), d ** -0.5),
        'moe_w_gate': normal((DEPTH, N_EXPERTS, d, EXPERT_FF), d ** -0.5),
        'moe_w_up': normal((DEPTH, N_EXPERTS, d, EXPERT_FF), d ** -0.5),
        'moe_w_down': normal((DEPTH, N_EXPERTS, EXPERT_FF, d), BETA * EXPERT_FF ** -0.5),
    }


def reference(x, c, ctx, c_ctx, mod_w, mod_b, ln_mix_g, ln_mix_b, ln_ffn_g, ln_ffn_b,
              s5f_w_in, s5f_w_out, s5_lam_re, s5_lam_im, s5_log_step, s5_b_re, s5_b_im,
              s5_c_re, s5_c_im, s5_d, s5_w_glu, s5_b_glu, fnet_w, fnet_b,
              attn_w_qkv, attn_q_gain, attn_k_gain, attn_w_o,
              moe_w_router, moe_w_gate, moe_w_up, moe_w_down):
    for layer in range(DEPTH):
        need_ctx = layer < DEPTH - 1
        sh1, sc1, g1, sh2, sc2, g2 = _adaln(c, mod_w[layer], mod_b[layer])
        csh1, csc1, cg1, csh2, csc2, cg2 = _adaln(c_ctx, mod_w[layer], mod_b[layer])
        u_lat = _modulate(x, sh1, sc1)
        u_ctx = _modulate(ctx, csh1, csc1)
        j = layer // 2
        if layer % 2 == 0:
            o_ctx, o_lat = _s5_fourier_mixer(u_ctx, u_lat, s5f_w_in[j], s5f_w_out[j], s5_lam_re[j], s5_lam_im[j],
                                             s5_log_step[j], s5_b_re[j], s5_b_im[j], s5_c_re[j], s5_c_im[j],
                                             s5_d[j], s5_w_glu[j], s5_b_glu[j], fnet_w[j], fnet_b[j], need_ctx)
        else:
            o_ctx, o_lat = _gqa_mixer(u_ctx, u_lat, attn_w_qkv[j], attn_q_gain[j], attn_k_gain[j],
                                      attn_w_o[j], need_ctx)
        x = _layer_norm(ALPHA * x + g1 * o_lat, ln_mix_g[layer], ln_mix_b[layer])
        f_lat = _expert_choice_ffn(_modulate(x, sh2, sc2), moe_w_router[layer], moe_w_gate[layer],
                                   moe_w_up[layer], moe_w_down[layer])
        x = _layer_norm(ALPHA * x + g2 * f_lat, ln_ffn_g[layer], ln_ffn_b[layer])
        if need_ctx:
            ctx = _layer_norm(ALPHA * ctx + cg1 * o_ctx, ln_mix_g[layer], ln_mix_b[layer])
            f_ctx = _expert_choice_ffn(_modulate(ctx, csh2, csc2), moe_w_router[layer], moe_w_gate[layer],
                                       moe_w_up[layer], moe_w_down[layer])
            ctx = _layer_norm(ALPHA * ctx + cg2 * f_ctx, ln_ffn_g[layer], ln_ffn_b[layer])
    return x
```

```cpp
#include <hip/hip_runtime.h>
#include <cstdio>
#include <cstdint>

#define GAS __attribute__((address_space(1)))
#define LAS __attribute__((address_space(3)))
typedef unsigned short bf16_t;
typedef short bf16x8 __attribute__((ext_vector_type(8)));
typedef short s16x4 __attribute__((ext_vector_type(4)));
typedef float f32x4 __attribute__((ext_vector_type(4)));
typedef float f32x2 __attribute__((ext_vector_type(2)));
typedef float f32x16 __attribute__((ext_vector_type(16)));
typedef unsigned u32x4 __attribute__((ext_vector_type(4)));
typedef unsigned u32x2 __attribute__((ext_vector_type(2)));

constexpr int DM = 2048, NBATCH = 2, SEQ = 16384, CTX = 256, DEPTH = 4;
constexpr int RPB = SEQ + CTX;
constexpr int NR = NBATCH * RPB;
constexpr int NRT = NR / 256;
constexpr int NEXP = 16, EFF = 1024, CAP_L = 2048, CAP_C = 32;
constexpr int MOE_ROWS = NEXP * 4096 + NEXP * 256;
constexpr int MOE_RT = MOE_ROWS / 256;
constexpr int S5G = 64, S5P = 64, S5C = 16, S5T = 32;
constexpr int NCH = NR / S5T;
constexpr int NCHP = 1280;
constexpr int A3K = 768;
constexpr float LN_EPS = 1e-6f, QK_EPS = 1e-6f;
constexpr float ALPHA = 1.681792830507429f;
constexpr int NTHREADS = 512, NWAVES = 8;

constexpr size_t A256(size_t x) { return (x + 255) / 256 * 256; }
constexpr size_t O_CTL = 0, CTL_BYTES = 1u << 20;
constexpr size_t O_MOD = O_CTL + CTL_BYTES;
constexpr size_t O_TRIG = O_MOD + A256((size_t)4 * 3 * 6 * DM * 4);
constexpr size_t O_FA = O_TRIG + 256 * 32 * 8;
constexpr size_t O_FC = O_FA + 256 * 256 * 2;
constexpr size_t O_F256 = O_FC + (size_t)128 * 256 * 256 * 2;
constexpr size_t O_POW = O_F256 + 512 * 256 * 2;
constexpr size_t O_BBAR = O_POW + A256((size_t)2 * 2 * 64 * 64 * 33 * 8);
constexpr size_t O_KF = O_BBAR + (size_t)2 * 2 * 64 * 64 * 16 * 8;
constexpr size_t O_WIN = O_KF + (size_t)2 * 2 * 64 * 32 * 256 * 4;
constexpr size_t O_WOUT = O_WIN + (size_t)2 * DM * DM * 2;
constexpr size_t O_WGLU = O_WOUT + (size_t)2 * DM * DM * 2;
constexpr size_t O_FNM = O_WGLU + (size_t)2 * 1024 * 1024 * 2;
constexpr size_t O_BT1 = O_FNM + (size_t)2 * 4 * 256 * 512 * 2;
constexpr size_t O_BT3 = O_BT1 + (size_t)2 * 64 * 256 * 512 * 2;
constexpr size_t O_WQKV = O_BT3 + (size_t)2 * 64 * 512 * 768 * 2;
constexpr size_t O_WO = O_WQKV + (size_t)2 * 3072 * DM * 2;
constexpr size_t O_WGU = O_WO + (size_t)2 * DM * DM * 2;
constexpr size_t O_WD = O_WGU + (size_t)NEXP * 2048 * DM * 2;
constexpr size_t O_XC = O_WD + (size_t)NEXP * DM * EFF * 2;
constexpr size_t O_AFF = O_XC + (size_t)512 * DM * 4;
constexpr size_t O_SEL = O_AFF + (size_t)NR * 16 * 4;
constexpr size_t O_IDX = O_SEL + (size_t)NR * 16 * 4;
constexpr size_t O_U = O_IDX + A256((size_t)MOE_ROWS * 4);
constexpr size_t O_H2 = O_U + (size_t)NR * DM * 2;
constexpr size_t O_O = O_H2 + (size_t)NR * DM * 2;
constexpr size_t O_S = O_O + (size_t)NR * DM * 2;
constexpr size_t O_A3 = O_S;
constexpr size_t O_SUM = O_A3 + (size_t)S5G * NCHP * A3K * 2;
constexpr size_t O_ZF = O_SUM + (size_t)S5G * NCHP * 256 * 4;
constexpr size_t O_T1 = O_ZF + (size_t)NR * 1024 * 2;
constexpr size_t O_T1C = O_T1 + (size_t)2048 * 128 * 128 * 2 + 256;
constexpr size_t O_BT2 = O_T1C + (size_t)2048 * 256 * 2;
constexpr size_t O_PQ = O_BT2 + (size_t)128 * 2048 * 256 * 2;
constexpr size_t O_G = O_PQ + (size_t)NR * DM * 2;
constexpr size_t O_CAT = O_G + (size_t)NR * 1024 * 2;
constexpr size_t O_EVEN_END = O_CAT + (size_t)NR * DM * 2;
constexpr size_t O_Z = O_S;
constexpr size_t O_AO = O_Z + (size_t)NR * 3072 * 2;
constexpr size_t O_ODD_END = O_AO + (size_t)NR * DM * 2;
constexpr size_t O_XE = O_S;
constexpr size_t O_HID = O_XE + (size_t)MOE_ROWS * DM * 2;
constexpr size_t O_YE = O_HID + (size_t)MOE_ROWS * EFF * 2;
constexpr size_t O_MOE_END = O_YE + (size_t)MOE_ROWS * DM * 2;
constexpr size_t WS_NEED = O_EVEN_END > O_MOE_END ? (O_EVEN_END > O_ODD_END ? O_EVEN_END : O_ODD_END) : (O_MOE_END > O_ODD_END ? O_MOE_END : O_ODD_END);
static_assert(WS_NEED < (size_t)2300 * 1024 * 1024, "workspace budget");
constexpr int CW_BAR = 4096;
constexpr int CW_DIAG = 16384;

constexpr int RING_BYTES = 131072;
constexpr int MISC_OFF = RING_BYTES;
constexpr int EPI_OFF = RING_BYTES + 256;
constexpr int LDS_BYTES = 163840;

#define LDS_WAIT() asm volatile("s_waitcnt lgkmcnt(0)" ::: "memory")
#define VM_WAIT() asm volatile("s_waitcnt vmcnt(0)" ::: "memory")
__device__ __forceinline__ float bf2f(unsigned b) { return __uint_as_float(b << 16); }
__device__ __forceinline__ unsigned f2bf(float f) { unsigned u = __float_as_uint(f); return (u + 0x7fffu + ((u >> 16) & 1u)) >> 16; }
__device__ __forceinline__ unsigned cvt_pk_bf16(float lo, float hi) { unsigned r; asm volatile("v_cvt_pk_bf16_f32 %0, %1, %2" : "=v"(r) : "v"(lo), "v"(hi)); return r; }
template <int CTRL> __device__ __forceinline__ float dpp_mov(float v) { return __int_as_float(__builtin_amdgcn_update_dpp(0, __float_as_int(v), CTRL, 0xf, 0xf, true)); }
__device__ __forceinline__ float row16_sum(float v) {
    v += dpp_mov<0xB1>(v);
    v += dpp_mov<0x4E>(v);
    v += dpp_mov<0x141>(v);
    v += dpp_mov<0x140>(v);
    return v;
}
__device__ __forceinline__ float wave_sum(float v) {
    v = row16_sum(v);
    { auto rr = __builtin_amdgcn_permlane16_swap(__float_as_uint(v), __float_as_uint(v), false, false); v = __uint_as_float(rr[0]) + __uint_as_float(rr[1]); }
    { auto rr = __builtin_amdgcn_permlane32_swap(__float_as_uint(v), __float_as_uint(v), false, false); v = __uint_as_float(rr[0]) + __uint_as_float(rr[1]); }
    return v;
}
__device__ __forceinline__ float wave_max(float v) {
    v = fmaxf(v, dpp_mov<0xB1>(v)); v = fmaxf(v, dpp_mov<0x4E>(v)); v = fmaxf(v, dpp_mov<0x141>(v)); v = fmaxf(v, dpp_mov<0x140>(v));
    { auto rr = __builtin_amdgcn_permlane16_swap(__float_as_uint(v), __float_as_uint(v), false, false); v = fmaxf(__uint_as_float(rr[0]), __uint_as_float(rr[1])); }
    { auto rr = __builtin_amdgcn_permlane32_swap(__float_as_uint(v), __float_as_uint(v), false, false); v = fmaxf(__uint_as_float(rr[0]), __uint_as_float(rr[1])); }
    return v;
}
__device__ __forceinline__ float sigmoid_fast(float x) { return __builtin_amdgcn_rcpf(1.f + __builtin_amdgcn_exp2f(-1.4426950408889634f * x)); }
__device__ __forceinline__ float silu_f(float x) { return x / (1.f + __expf(-x)); }
__device__ __forceinline__ float gelu_tanh(float x) {
    const float u = 0.7978845608028654f * (x + 0.044715f * x * x * x);
    const float t = 1.f - 2.f * sigmoid_fast(-2.f * u);
    return 0.5f * x * (1.f + t);
}

#define XB_TMO      128
#define XB_XCNT(j)  (256  + 64 * (j))
#define XB_XSUB(j)  (1280 + 64 * (j))
#define XB_XGEN(j)  (2304 + 64 * (j))
#define XB_TOP      3328
#define XB_TOPGEN   3392
#define XCD_BAR_WORDS 3456
#define XB_SPIN_CAP (1u << 18)

__device__ __forceinline__ unsigned xb_ld(unsigned* p)              { return __hip_atomic_load(p, __ATOMIC_RELAXED, __HIP_MEMORY_SCOPE_AGENT); }
__device__ __forceinline__ unsigned xb_add(unsigned* p, unsigned v) { return __hip_atomic_fetch_add(p, v, __ATOMIC_RELAXED, __HIP_MEMORY_SCOPE_AGENT); }
__device__ __forceinline__ unsigned xb_xcc_id() { return (unsigned)__builtin_amdgcn_s_getreg((3 << 11) | 20) & 0xFu; }
#define XB_SPIN(cond, bar) do { unsigned _sp = 0; while (cond) { __builtin_amdgcn_s_sleep(1); \
    if ((++_sp & 255u) == 0u) { if (xb_ld(&(bar)[XB_TMO])) break; if (_sp > XB_SPIN_CAP) { atomicAdd(&(bar)[XB_TMO], 1u); break; } } } } while (0)

struct XcdBarrier { unsigned* bar; unsigned x; volatile LAS unsigned* st; };

__device__ __forceinline__ XcdBarrier xcd_barrier_post(unsigned* bar, volatile LAS unsigned* st) {
    XcdBarrier b; b.bar = bar; b.x = xb_xcc_id(); b.st = st;
    if (threadIdx.x == 0) (void)xb_add(&bar[XB_XCNT(b.x)], 1u);
    return b;
}
__device__ __forceinline__ void xcd_barrier_complete(unsigned* bar, unsigned x, unsigned& nloc, unsigned& nx) {
    const unsigned G = gridDim.x * gridDim.y * gridDim.z;
    unsigned sum, cnt, mine, sp = 0u;
    for (;;) {
        sum = 0u; cnt = 0u; mine = 0u;
#pragma unroll
        for (unsigned j = 0; j < 16; ++j) { const unsigned c = xb_ld(&bar[XB_XCNT(j)]); sum += c; cnt += (c > 0u) ? 1u : 0u; mine = (j == x) ? c : mine; }
        if (sum == G) break;
        __builtin_amdgcn_s_sleep(1);
        if ((++sp & 255u) == 0u) { if (xb_ld(&bar[XB_TMO])) break; if (sp > XB_SPIN_CAP) { atomicAdd(&bar[XB_TMO], 1u); break; } }
    }
    nloc = mine > 0u ? mine : 1u; nx = cnt > 0u ? cnt : 1u;
}
__device__ __forceinline__ void xcd_barrier(const XcdBarrier& b) {
    asm volatile("s_waitcnt vmcnt(0)" ::: "memory");
    __syncthreads();
    if (threadIdx.x == 0) {
        unsigned* bar = b.bar;
        __builtin_amdgcn_s_waitcnt(0);
        unsigned nloc = b.st[0], nx = b.st[1];
        if (nloc == 0u) { xcd_barrier_complete(bar, b.x, nloc, nx); b.st[0] = nloc; b.st[1] = nx; }
        const unsigned old = xb_add(&bar[XB_XSUB(b.x)], 1u);
        const unsigned gen = old / nloc;
        if (old + 1u == (gen + 1u) * nloc) {
            __builtin_amdgcn_fence(__ATOMIC_RELEASE, "agent");
            asm volatile("s_waitcnt vmcnt(0)" ::: "memory");
            const unsigned og = xb_add(&bar[XB_TOP], 1u);
            const unsigned tg = og / nx;
            if (og + 1u == (tg + 1u) * nx) xb_add(&bar[XB_TOPGEN], 1u);
            else XB_SPIN(xb_ld(&bar[XB_TOPGEN]) == tg, bar);
            __builtin_amdgcn_fence(__ATOMIC_ACQUIRE, "agent");
            xb_add(&bar[XB_XGEN(b.x)], 1u);
            asm volatile("s_waitcnt vmcnt(0)" ::: "memory");
        } else {
            XB_SPIN(xb_ld(&bar[XB_XGEN(b.x)]) == gen, bar);
            __builtin_amdgcn_fence(__ATOMIC_ACQUIRE, "agent");
            asm volatile("s_waitcnt vmcnt(0)" ::: "memory");
        }
    }
    __syncthreads();
}
namespace pg8 {
constexpr int BM = 256, BK = 64, HALF = 128, HTB = HALF * BK * 2, STAGE_BYTES = 8 * HTB, NXCD = 8, WGM = 8;
__host__ __device__ __forceinline__ int lds_byte(int r, int c) { const int st = (r >> 4) * 2 + (c >> 5), rr = r & 15, cc = c & 31, ob = rr * 64 + cc * 2; return st * 1024 + (ob ^ (((ob >> 9) & 1) << 5)); }
__host__ __device__ __forceinline__ void stage_rc(int b, int& R, int& C) { const int st = b / 1024, sb = b % 1024, swz = sb ^ (((sb >> 9) & 1) << 5); R = (st >> 1) * 16 + swz / 64; C = (st & 1) * 32 + (swz % 64) / 2; }
__host__ __device__ __forceinline__ int perm32(int rho) { const int n = rho >> 4, i = rho & 15; return 8 * (i >> 2) + 4 * n + (i & 3); }

struct Unit { int pm, pn; };
struct Sched {
    int nM, nN, nwg, G, c;
    __device__ __forceinline__ void init(int nM_, int nN_, int G_, int c_) { nM = nM_; nN = nN_; nwg = nM * nN; G = G_; c = c_; }
    int head = 0, headM0 = 0;
    __device__ __forceinline__ bool next(int i, Unit& u) const {
        long L = (long)i * G + c;
        if (L < head) { u.pm = headM0 + (int)L / nN; u.pn = (int)L % nN; return true; }
        L -= head; if (L >= nwg) return false;
        int wgid = (int)L; { const int q = nwg / NXCD, r = nwg % NXCD, xcd = wgid % NXCD, off = wgid / NXCD; wgid = (xcd < r ? xcd * (q + 1) : r * (q + 1) + (xcd - r) * q) + off; }
        const int nig = WGM * nN, gid = wgid / nig, fm = gid * WGM, gsz = (nM - fm) < WGM ? (nM - fm) : WGM;
        u.pm = fm + ((wgid % nig) % gsz); u.pn = (wgid % nig) / gsz; return true;
    }
};
typedef f32x4 Acc[2][2][4][2];
#define PG8_NO_GATHER __device__ __forceinline__ int arow(const Unit&, int) const { return 0; }
#define PG8_NO_LITE static constexpr bool LITE = false; __device__ __forceinline__ bool lite(const Unit&) const { return false; }

template <class Op>
__device__ __forceinline__ void gemm_phase(LAS unsigned char* lds, const Op& op, const Sched& S, int tid) {
    asm volatile("" : "+v"(tid));
    const int wid = __builtin_amdgcn_readfirstlane(tid >> 6), lane = tid & 63, wr = wid >> 2, wc = wid & 3, fr = lane & 15, fq = lane >> 4;
    const int K = op.K, nt = K / BK, lda = op.lda, ldb = op.ldb;
    unsigned voffA[2], voffB[2]; int RA[2];
#pragma unroll
    for (int i = 0; i < 2; ++i) { int R, C; stage_rc(tid * 16 + i * 8192, R, C); const int Rb = Op::PERM ? ((R & ~31) + perm32(R & 31)) : R; RA[i] = R;
        voffA[i] = Op::GATHER ? (unsigned)C * 2u : (unsigned)(R * lda + C) * 2u; voffB[i] = (unsigned)(Rb * ldb + C) * 2u; }
    unsigned ga[2][2], gn[2][2];
#define PG8_GROWS(G, U) do { _Pragma("unroll") for (int _h = 0; _h < 2; ++_h) _Pragma("unroll") for (int _i = 0; _i < 2; ++_i) G[_h][_i] = (unsigned)op.arow(U, _h * HALF + RA[_i]) * (unsigned)(lda * 2); } while (0)
    const size_t kstep = (size_t)(BK * 2);
    const size_t hstepA = (size_t)HALF * lda * 2, hstepB = (size_t)HALF * ldb * 2;
    const unsigned ldsw = (unsigned)wid * 1024u;
    const int aoff = lds_byte(wr * 64 + fr, fq * 8), boff = lds_byte(wc * 32 + fr, fq * 8);
#define PG8_SA(b, h) (((b) * 2 + (h)) * HTB)
#define PG8_SB(b, h) ((4 + (b) * 2 + (h)) * HTB)
#define PG8_STAGE(bufoff, gbase, voff) do { _Pragma("unroll") for (int _i = 0; _i < 2; ++_i) \
        __builtin_amdgcn_global_load_lds((const unsigned*)((const char*)(gbase) + (voff)[_i]), (LAS unsigned*)(lds + (bufoff) + ldsw + _i * 8192), 16, 0, 0); } while (0)
#define PG8_STAGE_A(bufoff, sel, h, kb) do { _Pragma("unroll") for (int _i = 0; _i < 2; ++_i) { const char* _p; \
        if constexpr (Op::GATHER) _p = (const char*)op.A + (kb) + (size_t)(((sel) ? gn[h][_i] : ga[h][_i]) + voffA[_i]); \
        else _p = ((sel) ? nA : cA) + (size_t)(h) * hstepA + (kb) + voffA[_i]; \
        __builtin_amdgcn_global_load_lds((const unsigned*)_p, (LAS unsigned*)(lds + (bufoff) + ldsw + _i * 8192), 16, 0, 0); } } while (0)
#define PG8_LDA(dst, b, h) do { _Pragma("unroll") for (int m = 0; m < 4; ++m) _Pragma("unroll") for (int k = 0; k < 2; ++k) dst[m][k] = *(const LAS bf16x8*)(lds + PG8_SA(b, h) + aoff + m * 2048 + k * 1024); } while (0)
#define PG8_LDB(dst, b, h) do { _Pragma("unroll") for (int n = 0; n < 2; ++n) _Pragma("unroll") for (int k = 0; k < 2; ++k) dst[n][k] = *(const LAS bf16x8*)(lds + PG8_SB(b, h) + boff + n * 2048 + k * 1024); } while (0)
#define PG8_MMA(ai, bj, At, Bt) do { if (Op::LITE && lite && ((ai) == 1 || wr == 1)) break; __builtin_amdgcn_s_setprio(1); _Pragma("unroll") for (int m = 0; m < 4; ++m) _Pragma("unroll") for (int n = 0; n < 2; ++n) _Pragma("unroll") for (int k = 0; k < 2; ++k) \
        acc[ai][bj][m][n] = __builtin_amdgcn_mfma_f32_16x16x32_bf16(Bt[n][k], At[m][k], acc[ai][bj][m][n], 0, 0, 0); __builtin_amdgcn_s_setprio(0); } while (0)
#define PG8_WAIT_V(n) asm volatile("s_waitcnt vmcnt(" #n ")" ::: "memory")
#define PG8_WAIT_L(n) asm volatile("s_waitcnt lgkmcnt(" #n ")" ::: "memory")
#define PG8_BAR __builtin_amdgcn_s_barrier()
#define PG8_SCHED __builtin_amdgcn_sched_barrier(0)
    Unit cur, nxt; int ui = 0;
    if (!S.next(0, cur)) return;
    bool lite = Op::LITE ? op.lite(cur) : false;
    Acc acc;
#pragma unroll
    for (int a = 0; a < 2; ++a)
#pragma unroll
        for (int b = 0; b < 2; ++b)
#pragma unroll
            for (int m = 0; m < 4; ++m)
#pragma unroll
                for (int n = 0; n < 2; ++n) acc[a][b][m][n] = (f32x4){0.f, 0.f, 0.f, 0.f};
    bf16x8 At[4][2], B0[2][2], B1[2][2];
    const char* cA = (const char*)op.A + op.aoff(cur); const char* cB = (const char*)op.Bt + op.boff(cur); const char* nA = cA;
    if constexpr (Op::GATHER) { PG8_GROWS(ga, cur); if (S.next(1, nxt)) PG8_GROWS(gn, nxt); else PG8_GROWS(gn, cur);
        asm volatile("" :: "v"(ga[0][0]), "v"(ga[0][1]), "v"(ga[1][0]), "v"(ga[1][1]), "v"(gn[0][0]), "v"(gn[0][1]), "v"(gn[1][0]), "v"(gn[1][1])); }
    PG8_STAGE(PG8_SB(0, 0), cB, voffB); PG8_STAGE(PG8_SB(0, 1), cB + hstepB, voffB); PG8_STAGE_A(PG8_SA(0, 0), false, 0, 0); PG8_STAGE_A(PG8_SA(0, 1), false, 1, 0);
    if (wr == 1) PG8_BAR;
    PG8_WAIT_V(2); PG8_BAR;
    PG8_STAGE(PG8_SB(1, 0), cB + kstep, voffB); PG8_STAGE_A(PG8_SA(1, 0), false, 0, kstep); PG8_STAGE(PG8_SB(1, 1), cB + hstepB + kstep, voffB);
    PG8_WAIT_V(6); PG8_BAR;
    for (;;) {
        const bool has_next = S.next(ui + 1, nxt);
        nA = has_next ? (const char*)op.A + op.aoff(nxt) : cA; const char* nB = has_next ? (const char*)op.Bt + op.boff(nxt) : cB;
        for (int t = 0; t < nt; t += 2) {
            const bool last = (t == nt - 2), seln = last && has_next;
            const size_t k1 = (size_t)(t + 1) * kstep, k2 = last ? 0 : (size_t)(t + 2) * kstep, k3 = k2 + kstep;
            const char* b2 = last ? nB : cB + (size_t)(t + 2) * kstep; const char* b3 = b2 + kstep;
            PG8_LDB(B0, 0, 0); PG8_LDB(B1, 0, 1); PG8_SCHED; PG8_LDA(At, 0, 0); PG8_STAGE_A(PG8_SA(1, 1), false, 1, k1);
            PG8_WAIT_V(8); PG8_WAIT_L(0); PG8_BAR; PG8_MMA(0, 0, At, B0); PG8_MMA(0, 1, At, B1); PG8_BAR; PG8_SCHED;
            PG8_LDA(At, 0, 1); PG8_STAGE(PG8_SB(0, 0), b2, voffB); PG8_STAGE(PG8_SB(0, 1), b2 + hstepB, voffB); PG8_STAGE_A(PG8_SA(0, 0), seln, 0, k2);
            PG8_WAIT_V(8); PG8_WAIT_L(0); PG8_BAR; PG8_MMA(1, 0, At, B0); PG8_MMA(1, 1, At, B1); PG8_BAR; PG8_SCHED;
            PG8_LDB(B0, 1, 0); PG8_LDB(B1, 1, 1); PG8_SCHED; PG8_LDA(At, 1, 0); PG8_STAGE_A(PG8_SA(0, 1), seln, 1, k2);
            PG8_WAIT_V(8); PG8_WAIT_L(0); PG8_BAR; PG8_MMA(0, 0, At, B0); PG8_MMA(0, 1, At, B1); PG8_BAR; PG8_SCHED;
            PG8_LDA(At, 1, 1); PG8_STAGE(PG8_SB(1, 0), b3, voffB); PG8_STAGE(PG8_SB(1, 1), b3 + hstepB, voffB); PG8_STAGE_A(PG8_SA(1, 0), seln, 0, k3);
            PG8_WAIT_V(8); PG8_WAIT_L(0); PG8_BAR; PG8_MMA(1, 0, At, B0); PG8_MMA(1, 1, At, B1); PG8_BAR; PG8_SCHED;
        }
        if (wr == 0) PG8_BAR;
        op(acc, cur, wr, wc, fr, fq);
        if (!has_next) break;
#pragma unroll
        for (int a = 0; a < 2; ++a)
#pragma unroll
            for (int b = 0; b < 2; ++b)
#pragma unroll
                for (int m = 0; m < 4; ++m)
#pragma unroll
                    for (int n = 0; n < 2; ++n) acc[a][b][m][n] = (f32x4){0.f, 0.f, 0.f, 0.f};
        cur = nxt; cA = nA; cB = nB; ++ui; lite = Op::LITE ? op.lite(cur) : false;
        if constexpr (Op::GATHER) {
#pragma unroll
            for (int _h = 0; _h < 2; ++_h)
#pragma unroll
                for (int _i = 0; _i < 2; ++_i) ga[_h][_i] = gn[_h][_i];
            Unit n2; if (S.next(ui + 1, n2)) PG8_GROWS(gn, n2);
            asm volatile("" :: "v"(gn[0][0]), "v"(gn[0][1]), "v"(gn[1][0]), "v"(gn[1][1]));
        }
        if (wr == 1) PG8_BAR;
    }
    PG8_WAIT_V(0);
    PG8_BAR;
#undef PG8_SA
#undef PG8_SB
#undef PG8_STAGE
#undef PG8_STAGE_A
#undef PG8_GROWS
#undef PG8_LDA
#undef PG8_LDB
#undef PG8_MMA
#undef PG8_WAIT_V
#undef PG8_WAIT_L
#undef PG8_BAR
#undef PG8_SCHED
}

__device__ __forceinline__ u32x4 pack8(const f32x4 a, const f32x4 b) { u32x4 w; w.x = cvt_pk_bf16(a[0], a[1]); w.y = cvt_pk_bf16(a[2], a[3]); w.z = cvt_pk_bf16(b[0], b[1]); w.w = cvt_pk_bf16(b[2], b[3]); return w; }
__device__ __forceinline__ int moe_expert(int pm) { return pm < 256 ? (pm >> 4) : (pm - 256); }

template <bool MOE> struct OpStore {
    static constexpr bool PERM = true, GATHER = false; PG8_NO_GATHER static constexpr bool LITE = MOE; __device__ __forceinline__ bool lite(const Unit& u) const { return MOE && u.pm >= 256; }
    const bf16_t* A; const bf16_t* Bt; int lda, ldb, K; bf16_t* out; int ldc; const float* bias;
    __device__ __forceinline__ size_t aoff(const Unit& u) const { return (size_t)u.pm * 256 * lda * 2; }
    __device__ __forceinline__ size_t boff(const Unit& u) const { return MOE ? ((size_t)moe_expert(u.pm) * 2048 + (size_t)u.pn * 256) * ldb * 2 : (size_t)u.pn * 256 * ldb * 2; }
    __device__ __forceinline__ void operator()(const Acc& acc, const Unit& u, int wr, int wc, int fr, int fq) const {
        const int row0 = u.pm * 256 + wr * 64 + fr, col0 = u.pn * 256 + wc * 32 + 8 * fq;
#pragma unroll
        for (int ai = 0; ai < 2; ++ai)
#pragma unroll
            for (int m = 0; m < 4; ++m) { bf16_t* rowp = out + (size_t)(row0 + ai * 128 + m * 16) * ldc + col0;
#pragma unroll
                for (int bj = 0; bj < 2; ++bj) { f32x4 v0 = acc[ai][bj][m][0], v1 = acc[ai][bj][m][1];
                    if (bias) { v0 += *(const f32x4*)(bias + col0 + bj * 128); v1 += *(const f32x4*)(bias + col0 + bj * 128 + 4); }
                    *(u32x4*)(rowp + bj * 128) = pack8(v0, v1); } }
    }
};
struct OpWin {
    static constexpr bool PERM = true, GATHER = false; PG8_NO_GATHER PG8_NO_LITE
    const bf16_t* A; const bf16_t* Bt; int lda, ldb, K; bf16_t* a3; bf16_t* zf;
    __device__ __forceinline__ size_t aoff(const Unit& u) const { return (size_t)u.pm * 256 * lda * 2; }
    __device__ __forceinline__ size_t boff(const Unit& u) const { return (size_t)u.pn * 256 * ldb * 2; }
    __device__ __forceinline__ void operator()(const Acc& acc, const Unit& u, int wr, int wc, int fr, int fq) const {
        const int row0 = u.pm * 256 + wr * 64 + fr, col0 = u.pn * 256 + wc * 32 + 8 * fq;
#pragma unroll
        for (int ai = 0; ai < 2; ++ai)
#pragma unroll
            for (int m = 0; m < 4; ++m) { const int row = row0 + ai * 128 + m * 16;
#pragma unroll
                for (int bj = 0; bj < 2; ++bj) { const int c = col0 + bj * 128; const u32x4 w = pack8(acc[ai][bj][m][0], acc[ai][bj][m][1]);
                    if (u.pn < 4) { const int g = c >> 4; *(u32x4*)(a3 + ((size_t)(g * NCHP + (row >> 5)) * A3K + (row & 31) * 16 + (c & 15))) = w; }
                    else *(u32x4*)(zf + (size_t)row * 1024 + (c - 1024)) = w; } }
    }
};
struct OpL1 {
    static constexpr bool PERM = false, GATHER = false; PG8_NO_GATHER PG8_NO_LITE
    const bf16_t* A; const bf16_t* Bt; int lda, ldb, K; float* sum;
    __device__ __forceinline__ size_t aoff(const Unit& u) const { const int g = u.pm / 5, rt = u.pm % 5; return (size_t)(g * NCHP + rt * 256) * A3K * 2; }
    __device__ __forceinline__ size_t boff(const Unit& u) const { return (size_t)(u.pm / 5) * 256 * 512 * 2; }
    __device__ __forceinline__ void operator()(const Acc& acc, const Unit& u, int wr, int wc, int fr, int fq) const {
        const int g = u.pm / 5, rt = u.pm % 5, row0 = rt * 256 + wr * 64 + fr, col0 = wc * 32 + 4 * fq;
#pragma unroll
        for (int ai = 0; ai < 2; ++ai)
#pragma unroll
            for (int m = 0; m < 4; ++m) { float* rowp = sum + ((size_t)(g * NCHP + row0 + ai * 128 + m * 16)) * 256 + col0;
#pragma unroll
                for (int bj = 0; bj < 2; ++bj)
#pragma unroll
                    for (int n = 0; n < 2; ++n) *(f32x4*)(rowp + bj * 128 + n * 16) = acc[ai][bj][m][n]; }
    }
};
struct OpL3 {
    static constexpr bool PERM = true, GATHER = false; PG8_NO_GATHER PG8_NO_LITE
    const bf16_t* A; const bf16_t* Bt; int lda, ldb, K; bf16_t* gout;
    __device__ __forceinline__ size_t aoff(const Unit& u) const { const int g = u.pm / 5, rt = u.pm % 5; return (size_t)(g * NCHP + rt * 256) * A3K * 2; }
    __device__ __forceinline__ size_t boff(const Unit& u) const { return ((size_t)(u.pm / 5) * 512 + (size_t)u.pn * 256) * A3K * 2; }
    __device__ __forceinline__ void operator()(const Acc& acc, const Unit& u, int wr, int wc, int fr, int fq) const {
        const int g = u.pm / 5, rt = u.pm % 5, row0 = rt * 256 + wr * 64 + fr, col0 = u.pn * 256 + wc * 32 + 8 * fq;
#pragma unroll
        for (int ai = 0; ai < 2; ++ai)
#pragma unroll
            for (int m = 0; m < 4; ++m) { const int chunk = row0 + ai * 128 + m * 16;
                if (chunk < NCH) {
#pragma unroll
                    for (int bj = 0; bj < 2; ++bj) { const int c = col0 + bj * 128, t = c >> 4, co = c & 15; f32x4 v0 = acc[ai][bj][m][0], v1 = acc[ai][bj][m][1];
#pragma unroll
                        for (int i = 0; i < 4; ++i) { v0[i] = gelu_tanh(v0[i]); v1[i] = gelu_tanh(v1[i]); }
                        *(u32x4*)(gout + ((size_t)(chunk * 32 + t)) * 1024 + g * 16 + co) = pack8(v0, v1); } } }
    }
};
struct OpGlu {
    static constexpr bool PERM = true, GATHER = false; PG8_NO_GATHER PG8_NO_LITE
    const bf16_t* A; const bf16_t* Bt; int lda, ldb, K; const float* bias; bf16_t* cat;
    __device__ __forceinline__ size_t aoff(const Unit& u) const { return (size_t)u.pm * 256 * lda * 2; }
    __device__ __forceinline__ size_t boff(const Unit& u) const { return (size_t)u.pn * 256 * ldb * 2; }
    __device__ __forceinline__ void operator()(const Acc& acc, const Unit& u, int wr, int wc, int fr, int fq) const {
        const int row0 = u.pm * 256 + wr * 64 + fr, col0 = u.pn * 256 + wc * 32 + 8 * fq;
#pragma unroll
        for (int ai = 0; ai < 2; ++ai)
#pragma unroll
            for (int m = 0; m < 4; ++m) { const int row = row0 + ai * 128 + m * 16;
#pragma unroll
                for (int bj = 0; bj < 2; ++bj) { const int c = col0 + bj * 128;
                    const f32x4 b0 = *(const f32x4*)(bias + c), b1 = *(const f32x4*)(bias + c + 4);
                    const u32x4 gw = *(const u32x4*)(A + (size_t)row * 1024 + c);
                    f32x4 g0, g1; g0[0] = bf2f(gw.x & 0xffffu); g0[1] = bf2f(gw.x >> 16); g0[2] = bf2f(gw.y & 0xffffu); g0[3] = bf2f(gw.y >> 16);
                    g1[0] = bf2f(gw.z & 0xffffu); g1[1] = bf2f(gw.z >> 16); g1[2] = bf2f(gw.w & 0xffffu); g1[3] = bf2f(gw.w >> 16);
                    f32x4 v0 = acc[ai][bj][m][0] + b0, v1 = acc[ai][bj][m][1] + b1;
#pragma unroll
                    for (int i = 0; i < 4; ++i) { v0[i] = g0[i] * sigmoid_fast(v0[i]); v1[i] = g1[i] * sigmoid_fast(v1[i]); }
                    *(u32x4*)(cat + (size_t)row * 2048 + c) = pack8(v0, v1); } }
    }
};
struct OpFftA {
    static constexpr bool PERM = true, GATHER = false; PG8_NO_GATHER PG8_NO_LITE
    const bf16_t* A; const bf16_t* Bt; int lda, ldb, K; bf16_t* bt2;
    __device__ __forceinline__ size_t aoff(const Unit&) const { return 0; }
    __device__ __forceinline__ size_t boff(const Unit& u) const { return (size_t)u.pn * 256 * 128 * 2; }
    __device__ __forceinline__ void operator()(const Acc& acc, const Unit& u, int wr, int wc, int fr, int fq) const {
        const int l2b = wc * 32 + 8 * fq;
#pragma unroll
        for (int ai = 0; ai < 2; ++ai)
#pragma unroll
            for (int m = 0; m < 4; ++m) { const int k1 = wr * 64 + m * 16 + fr;
#pragma unroll
                for (int bj = 0; bj < 2; ++bj) { const int col = 2 * u.pn + bj;
                    *(u32x4*)(bt2 + ((size_t)(k1 * 2048 + col)) * 256 + ai * 128 + l2b) = pack8(acc[ai][bj][m][0], acc[ai][bj][m][1]); } }
    }
};
struct OpFftC {
    static constexpr bool PERM = true, GATHER = false; PG8_NO_GATHER PG8_NO_LITE
    const bf16_t* A; const bf16_t* Bt; int lda, ldb, K; bf16_t* pq;
    __device__ __forceinline__ size_t aoff(const Unit& u) const { return (size_t)(u.pn >> 3) * 256 * 256 * 2; }
    __device__ __forceinline__ size_t boff(const Unit& u) const { return (size_t)u.pn * 256 * 256 * 2; }
    __device__ __forceinline__ void operator()(const Acc& acc, const Unit& u, int wr, int wc, int fr, int fq) const {
        const int k1 = u.pn >> 3;
#pragma unroll
        for (int ai = 0; ai < 2; ++ai)
#pragma unroll
            for (int m = 0; m < 4; ++m) { const int k2 = wr * 64 + m * 16 + fr, k = k1 + 128 * k2;
#pragma unroll
                for (int bj = 0; bj < 2; ++bj) { const int colb = (u.pn & 7) * 256 + bj * 128 + wc * 32 + 8 * fq, b = colb >> 10, ch = colb & 1023, g = ch >> 8, c = ch & 255;
                    *(u32x4*)(pq + ((size_t)(b * RPB + CTX + k)) * 2048 + g * 512 + ai * 256 + c) = pack8(acc[ai][bj][m][0], acc[ai][bj][m][1]); } }
    }
};
struct OpCtxDft {
    static constexpr bool PERM = true, GATHER = false; PG8_NO_GATHER PG8_NO_LITE
    const bf16_t* A; const bf16_t* Bt; int lda, ldb, K; bf16_t* pq;
    __device__ __forceinline__ size_t aoff(const Unit& u) const { return (size_t)u.pm * 256 * 256 * 2; }
    __device__ __forceinline__ size_t boff(const Unit& u) const { return (size_t)u.pn * 256 * 256 * 2; }
    __device__ __forceinline__ void operator()(const Acc& acc, const Unit& u, int wr, int wc, int fr, int fq) const {
#pragma unroll
        for (int ai = 0; ai < 2; ++ai)
#pragma unroll
            for (int m = 0; m < 4; ++m) { const int k = ai * 128 + wr * 64 + m * 16 + fr;
#pragma unroll
                for (int bj = 0; bj < 2; ++bj) { const int colb = u.pn * 256 + bj * 128 + wc * 32 + 8 * fq, b = colb >> 10, ch = colb & 1023, g = ch >> 8, c = ch & 255;
                    *(u32x4*)(pq + ((size_t)(b * RPB + k)) * 2048 + g * 512 + u.pm * 256 + c) = pack8(acc[ai][bj][m][0], acc[ai][bj][m][1]); } }
    }
};
struct OpFnet {
    static constexpr bool PERM = true, GATHER = false; PG8_NO_GATHER PG8_NO_LITE
    const bf16_t* A; const bf16_t* Bt; int lda, ldb, K; const float* bias; bf16_t* cat;
    __device__ __forceinline__ size_t aoff(const Unit& u) const { return (size_t)u.pm * 256 * lda * 2 + (size_t)u.pn * 512 * 2; }
    __device__ __forceinline__ size_t boff(const Unit& u) const { return (size_t)u.pn * 256 * 512 * 2; }
    __device__ __forceinline__ void operator()(const Acc& acc, const Unit& u, int wr, int wc, int fr, int fq) const {
        const int row0 = u.pm * 256 + wr * 64 + fr, col0 = u.pn * 256 + wc * 32 + 8 * fq;
#pragma unroll
        for (int ai = 0; ai < 2; ++ai)
#pragma unroll
            for (int m = 0; m < 4; ++m) { const int row = row0 + ai * 128 + m * 16;
#pragma unroll
                for (int bj = 0; bj < 2; ++bj) { const int c = col0 + bj * 128;
                    const f32x4 v0 = acc[ai][bj][m][0] + *(const f32x4*)(bias + c), v1 = acc[ai][bj][m][1] + *(const f32x4*)(bias + c + 4);
                    *(u32x4*)(cat + (size_t)row * 2048 + 1024 + c) = pack8(v0, v1); } }
    }
};
struct OpM1 {
    static constexpr bool PERM = true, GATHER = true, LITE = true; __device__ __forceinline__ bool lite(const Unit& u) const { return u.pm >= 256; }
    const bf16_t* A; const bf16_t* Bt; int lda, ldb, K; bf16_t* hid; const int* idx;
    __device__ __forceinline__ size_t aoff(const Unit&) const { return 0; }
    __device__ __forceinline__ int arow(const Unit& u, int r) const { const int m = u.pm * 256 + r; const bool ok = m < NEXP * 4096 || ((m - NEXP * 4096) & 255) < 2 * CAP_C; return ok ? idx[m] : 0; }
    __device__ __forceinline__ size_t boff(const Unit& u) const { return ((size_t)moe_expert(u.pm) * 2048 + (size_t)u.pn * 256) * ldb * 2; }
    __device__ __forceinline__ void operator()(const Acc& acc, const Unit& u, int wr, int wc, int fr, int fq) const {
        const int row0 = u.pm * 256 + wr * 64 + fr, f0 = u.pn * 128 + wc * 16 + 4 * fq;
#pragma unroll
        for (int ai = 0; ai < 2; ++ai)
#pragma unroll
            for (int m = 0; m < 4; ++m) { bf16_t* rowp = hid + (size_t)(row0 + ai * 128 + m * 16) * EFF + f0;
#pragma unroll
                for (int bj = 0; bj < 2; ++bj) { const f32x4 gt = acc[ai][bj][m][0], up = acc[ai][bj][m][1]; f32x4 h;
#pragma unroll
                    for (int i = 0; i < 4; ++i) h[i] = gt[i] * sigmoid_fast(gt[i]) * up[i];
                    u32x2 w; w.x = cvt_pk_bf16(h[0], h[1]); w.y = cvt_pk_bf16(h[2], h[3]);
                    *(u32x2*)(rowp + bj * 64) = w; } }
    }
};
}
namespace att {
constexpr int D = 128, NW = 8, QBLK = 32, KVBLK = 64;
constexpr float SCALE = 0.088388347648318440f;
constexpr float THR = 8.f;
constexpr int LDQ = 3072, LDK = 3072, LDO = 2048;
constexpr size_t SHM_V = KVBLK * D * 2, SHM_K = KVBLK * D * 2, SHM_ATTN = 2 * SHM_V + 2 * SHM_K + NW * 64 * 4;
#define KSWZ(row, colB) ((row) * 256 + ((colB) ^ (((row) & 7) << 4)))
#define SBAR() __builtin_amdgcn_sched_barrier(0)
__device__ __forceinline__ int crow(int r, int hi) { return (r & 3) + 8 * (r >> 2) + 4 * hi; }
__device__ __forceinline__ unsigned cvtpk(float lo, float hi) { unsigned r; asm volatile("v_cvt_pk_bf16_f32 %0, %1, %2" : "=v"(r) : "v"(lo), "v"(hi)); return r; }

__device__ __forceinline__ void partialSM(f32x16& p0, f32x16& p1, float& m_reg, float& mn, float& alpha) {
  constexpr float C = SCALE * 1.4426950408889634f;
  float pmax = p0[0]; for (int r = 1; r < 16; ++r) pmax = fmaxf(pmax, p0[r]); for (int r = 0; r < 16; ++r) pmax = fmaxf(pmax, p1[r]);
  { auto rr = __builtin_amdgcn_permlane32_swap(__float_as_uint(pmax), __float_as_uint(pmax), false, false);
    pmax = fmaxf(__uint_as_float(rr[0]), __uint_as_float(rr[1])); }
  if (__builtin_expect(__all(pmax - m_reg <= THR / SCALE), 1)) { mn = m_reg; alpha = 1.f; }
  else { mn = fmaxf(m_reg, pmax); alpha = __builtin_amdgcn_exp2f((m_reg - mn) * C); m_reg = mn; }
  float mnC = -mn * C;
  for (int r = 0; r < 16; ++r) p0[r] = fmaf(p0[r], C, mnC); for (int r = 0; r < 16; ++r) p1[r] = fmaf(p1[r], C, mnC);
  for (int r = 0; r < 16; ++r) p0[r] = __builtin_amdgcn_exp2f(p0[r]);
}
__device__ __forceinline__ void partialSM_fix(f32x16& p0, f32x16& p1) {
  for (int r = 0; r < 16; ++r) p0[r] = __builtin_amdgcn_exp2f(p0[r]);
}
__device__ __forceinline__ void finishSM(f32x16& p0, f32x16& p1, float alpha, float& l_reg, bf16x8& pa0, bf16x8& pa1, bf16x8& pa2, bf16x8& pa3) {
  for (int r = 0; r < 16; ++r) p1[r] = __builtin_amdgcn_exp2f(p1[r]);
  float ps = 0; for (int r = 0; r < 16; ++r) ps += p0[r]; for (int r = 0; r < 16; ++r) ps += p1[r];
  { auto rr = __builtin_amdgcn_permlane32_swap(__float_as_uint(ps), __float_as_uint(ps), false, false);
    ps = __uint_as_float(rr[0]) + __uint_as_float(rr[1]); }
  l_reg = l_reg * alpha + ps;
#define PK4(P, BASE, OUT) do { unsigned a0 = cvtpk(P[BASE + 0], P[BASE + 1]), a1 = cvtpk(P[BASE + 2], P[BASE + 3]);   \
    unsigned b0 = cvtpk(P[BASE + 4], P[BASE + 5]), b1 = cvtpk(P[BASE + 6], P[BASE + 7]);                              \
    auto r0 = __builtin_amdgcn_permlane32_swap(a0, b0, false, false); auto r1 = __builtin_amdgcn_permlane32_swap(a1, b1, false, false); \
    u32x4 w = {r0[0], r1[0], r0[1], r1[1]}; OUT = *reinterpret_cast<bf16x8*>(&w); } while (0)
  PK4(p0, 0, pa0); PK4(p0, 8, pa1); PK4(p1, 0, pa2); PK4(p1, 8, pa3);
#undef PK4
}
__device__ __forceinline__ void partialSM_fix2(f32x16& p0, float& l_reg) {
  for (int r = 0; r < 16; ++r) { p0[r] = __builtin_amdgcn_exp2f(p0[r]); l_reg += p0[r]; }
}
__device__ __forceinline__ void finishSM2(f32x16& p0, f32x16& p1, float& l_reg, bf16x8& pa0, bf16x8& pa1, bf16x8& pa2, bf16x8& pa3) {
#define PK4(P, BASE, OUT) do { unsigned a0 = cvtpk(P[BASE + 0], P[BASE + 1]), a1 = cvtpk(P[BASE + 2], P[BASE + 3]);   \
    unsigned b0 = cvtpk(P[BASE + 4], P[BASE + 5]), b1 = cvtpk(P[BASE + 6], P[BASE + 7]);                              \
    u32x4 w = {a0, a1, b0, b1}; OUT = *reinterpret_cast<bf16x8*>(&w); } while (0)
  PK4(p0, 0, pa0); PK4(p0, 8, pa1);
  for (int r = 0; r < 8; ++r) { p1[r] = __builtin_amdgcn_exp2f(p1[r]); l_reg += p1[r]; }
  PK4(p1, 0, pa2);
  for (int r = 8; r < 16; ++r) { p1[r] = __builtin_amdgcn_exp2f(p1[r]); l_reg += p1[r]; }
  PK4(p1, 8, pa3);
#undef PK4
}
__device__ __forceinline__ void qkt(f32x16& p0, f32x16& p1, const bf16_t* Ks, const bf16x8* qr, int r32, int hi) {
  p0 = f32x16{}; p1 = f32x16{};
  for (int d0 = 0; d0 < 8; ++d0) { int cb = (d0 * 16 + hi * 8) * 2;
    bf16x8 b0 = *reinterpret_cast<const bf16x8*>((const char*)Ks + KSWZ(r32, cb));
    bf16x8 b1 = *reinterpret_cast<const bf16x8*>((const char*)Ks + KSWZ(32 + r32, cb));
    p0 = __builtin_amdgcn_mfma_f32_32x32x16_bf16(b0, qr[d0], p0, 0, 0, 0);
    p1 = __builtin_amdgcn_mfma_f32_32x32x16_bf16(b1, qr[d0], p1, 0, 0, 0); }
}
__device__ __forceinline__ int v_st(int k, int c) { const int kk = (k & ~0xC) | ((k & 4) << 1) | ((k & 8) >> 1); return ((kk >> 3) * 4 + (c >> 5)) * 512 + ((kk & 7) * 32 + (c & 31)) * 2; }
__device__ __forceinline__ int v_rd_base(int lane) { return ((lane & 3) << 3) | (((lane >> 2) & 3) << 6) | (((lane >> 4) & 1) << 5) | (((lane >> 5) & 1) << 8); }
constexpr int v_rd_off(int d0, int ks, int half) { return d0 * 512 + ks * 4096 + half * 2048; }
template <int OFF> __device__ __forceinline__ s16x4 tr_read(int vb) {
  s16x4 r; asm volatile("ds_read_b64_tr_b16 %0, %1 offset:%2" : "=&v"(r) : "v"(vb), "i"(OFF) : "memory"); return r;
}
template <int D0> __device__ __forceinline__ void pv_one(f32x16& od, int vb, bf16x8 pa0, bf16x8 pa1, bf16x8 pa2, bf16x8 pa3) {
  const s16x4 l0 = tr_read<v_rd_off(D0, 0, 0)>(vb), h0 = tr_read<v_rd_off(D0, 0, 1)>(vb), l1 = tr_read<v_rd_off(D0, 1, 0)>(vb), h1 = tr_read<v_rd_off(D0, 1, 1)>(vb);
  const s16x4 l2 = tr_read<v_rd_off(D0, 2, 0)>(vb), h2 = tr_read<v_rd_off(D0, 2, 1)>(vb), l3 = tr_read<v_rd_off(D0, 3, 0)>(vb), h3 = tr_read<v_rd_off(D0, 3, 1)>(vb);
  asm volatile("s_waitcnt lgkmcnt(0)" ::: "memory"); SBAR();
#define PK(L, H) (bf16x8){L[0], L[1], L[2], L[3], H[0], H[1], H[2], H[3]}
  od = __builtin_amdgcn_mfma_f32_32x32x16_bf16(pa0, PK(l0, h0), od, 0, 0, 0);
  od = __builtin_amdgcn_mfma_f32_32x32x16_bf16(pa1, PK(l1, h1), od, 0, 0, 0);
  od = __builtin_amdgcn_mfma_f32_32x32x16_bf16(pa2, PK(l2, h2), od, 0, 0, 0);
  od = __builtin_amdgcn_mfma_f32_32x32x16_bf16(pa3, PK(l3, h3), od, 0, 0, 0);
#undef PK
}
__device__ __forceinline__ void pv_d0(f32x16* o, int vb, bf16x8 pa0, bf16x8 pa1, bf16x8 pa2, bf16x8 pa3) {
  pv_one<0>(o[0], vb, pa0, pa1, pa2, pa3); pv_one<1>(o[1], vb, pa0, pa1, pa2, pa3); pv_one<2>(o[2], vb, pa0, pa1, pa2, pa3); pv_one<3>(o[3], vb, pa0, pa1, pa2, pa3);
}
template <bool FIXM>
__device__ __forceinline__ void attn_dense_body(const bf16_t* __restrict__ Qb, const bf16_t* __restrict__ Kh, const bf16_t* __restrict__ Vh,
                                                bf16_t* __restrict__ Ob, int seq, char* lds, int tid, float mfixC) {
  asm volatile("" : "+v"(tid));
  const int wid = tid >> 6, lane = tid & 63, r32 = lane & 31, hi = lane >> 5;
  bf16_t* V_lds = (bf16_t*)lds; bf16_t* K_lds = (bf16_t*)(lds + 2 * SHM_V);
  float* ws = (float*)(lds + 2 * SHM_V + 2 * SHM_K) + wid * 64; float* li_l = ws; float* al_l = ws + 32;
  float m_reg = -1e30f, l_reg = 0; f32x16 o[4] = {}; bf16x8 qr[8];
  const bf16_t* Qw = Qb + (long)(wid * QBLK + r32) * LDQ + hi * 8;
#pragma unroll
  for (int d0 = 0; d0 < 8; ++d0) qr[d0] = *reinterpret_cast<const bf16x8*>(Qw + d0 * 16);
  const int sr = tid >> 4, sc = (tid & 15) * 8, vst0 = v_st(sr, sc), vst1 = v_st(32 + sr, sc);
  const int vb0 = (int)(uintptr_t)V_lds + v_rd_base(lane);
  struct { bf16x8 vs0, vs1, ks0, ks1; } sr_[2];
#define SLOAD(i, k0) do { sr_[i].vs0 = *reinterpret_cast<const bf16x8*>(&Vh[(long)((k0) + sr) * LDK + sc]); sr_[i].vs1 = *reinterpret_cast<const bf16x8*>(&Vh[(long)((k0) + 32 + sr) * LDK + sc]); \
    sr_[i].ks0 = *reinterpret_cast<const bf16x8*>(&Kh[(long)((k0) + sr) * LDK + sc]); sr_[i].ks1 = *reinterpret_cast<const bf16x8*>(&Kh[(long)((k0) + 32 + sr) * LDK + sc]); } while (0)
#define SWRITE(b, i) do { *(bf16x8*)((char*)V_lds + (b) * SHM_V + vst0) = sr_[i].vs0;          \
    *(bf16x8*)((char*)V_lds + (b) * SHM_V + vst1) = sr_[i].vs1; int kc = sc * 2;               \
    *(bf16x8*)((char*)K_lds + (b) * SHM_K + KSWZ(sr, kc)) = sr_[i].ks0;                       \
    *(bf16x8*)((char*)K_lds + (b) * SHM_K + KSWZ(32 + sr, kc)) = sr_[i].ks1; } while (0)
#define SWAIT() asm volatile("s_waitcnt vmcnt(4)" ::: "memory")
#define PSM(P0, P1, MN, AL) do { if constexpr (FIXM) { SBAR(); partialSM_fix(P0, P1); AL = 1.f; SBAR(); } else partialSM(P0, P1, m_reg, MN, AL); } while (0)
#define RESC(a) do { if constexpr (!FIXM) if (__any((a) < 1.f)) { if (hi == 0) al_l[r32] = (a); asm volatile("s_waitcnt lgkmcnt(0)" ::: "memory"); \
    for (int d = 0; d < 4; ++d) for (int r = 0; r < 16; ++r) o[d][r] *= al_l[crow(r, hi)]; } } while (0)
  f32x16 pA0, pA1, pB0, pB1; float mnA, mnB, alA, alB; bf16x8 pa0, pa1, pa2, pa3; const int NT = seq / KVBLK;
  constexpr int SE = 0, SO = 1;
  SLOAD(SE, 0); asm volatile("s_waitcnt vmcnt(0)" ::: "memory"); SWRITE(0, SE); __syncthreads();
  qkt(pA0, pA1, K_lds, qr, r32, hi); PSM(pA0, pA1, mnA, alA);
  SLOAD(SO, KVBLK); SLOAD(SE, 2 * KVBLK);
  SWAIT(); SWRITE(1, SO); __syncthreads();
  for (int j = 1; j + 1 < NT; j += 2) {
    SBAR(); qkt(pB0, pB1, (bf16_t*)((char*)K_lds + SHM_K), qr, r32, hi);
    finishSM(pA0, pA1, alA, l_reg, pa0, pa1, pa2, pa3); SBAR();
    SLOAD(SO, (j + 2) * KVBLK); SBAR();
    pv_d0(o, vb0, pa0, pa1, pa2, pa3); PSM(pB0, pB1, mnB, alB);
    __syncthreads(); SWAIT(); SWRITE(0, SE);
    RESC(alB); __syncthreads();
    SBAR(); qkt(pA0, pA1, K_lds, qr, r32, hi);
    finishSM(pB0, pB1, alB, l_reg, pa0, pa1, pa2, pa3); SBAR();
    SLOAD(SE, (j + 3 < NT ? j + 3 : NT - 1) * KVBLK); SBAR();
    pv_d0(o, vb0 + (int)SHM_V, pa0, pa1, pa2, pa3); PSM(pA0, pA1, mnA, alA);
    __syncthreads(); SWAIT(); SWRITE(1, SO);
    RESC(alA); __syncthreads();
  }
  SBAR(); qkt(pB0, pB1, (bf16_t*)((char*)K_lds + SHM_K), qr, r32, hi);
  finishSM(pA0, pA1, alA, l_reg, pa0, pa1, pa2, pa3); SBAR();
  pv_d0(o, vb0, pa0, pa1, pa2, pa3); PSM(pB0, pB1, mnB, alB);
  __syncthreads(); RESC(alB);
  finishSM(pB0, pB1, alB, l_reg, pa0, pa1, pa2, pa3); SBAR();
  pv_d0(o, vb0 + (int)SHM_V, pa0, pa1, pa2, pa3);
  if (hi == 0) li_l[r32] = l_reg; asm volatile("s_waitcnt lgkmcnt(0)" ::: "memory");
  float rli[16];
#pragma unroll
  for (int r = 0; r < 16; ++r) rli[r] = __builtin_amdgcn_rcpf(li_l[crow(r, hi)]);
  bf16_t* Ow = Ob + (long)(wid * QBLK) * LDO;
#pragma unroll
  for (int r = 0; r < 16; ++r) { int orow = crow(r, hi);
    for (int d0 = 0; d0 < 4; ++d0) Ow[(long)orow * LDO + d0 * 32 + r32] = (bf16_t)f2bf(o[d0][r] * rli[r]); }
  asm volatile("s_waitcnt vmcnt(0) lgkmcnt(0)" ::: "memory"); __syncthreads();
#undef SLOAD
#undef SWRITE
#undef SWAIT
#undef RESC
#undef PSM
}

template <int NT>
__device__ __forceinline__ void attn_ring3_body(const bf16_t* __restrict__ Qb, const bf16_t* __restrict__ Kh, const bf16_t* __restrict__ Vh, bf16_t* __restrict__ Ob, char* lds, int tid) {
  static_assert(NT >= 8, "ring body: at least 8 key tiles");
  asm volatile("" : "+v"(tid));
  const int wid = tid >> 6, lane = tid & 63, r32 = lane & 31, hi = lane >> 5;
  constexpr int VB = (int)SHM_V, KB = (int)SHM_K;
  bf16_t* K_lds = (bf16_t*)lds; bf16_t* V_lds = (bf16_t*)(lds + 3 * KB);
  float* ws = (float*)(lds + 3 * VB + 3 * KB) + wid * 64; float* li_l = ws;
  float l_reg = 0; f32x16 o[4] = {}; bf16x8 qr[8];
  const bf16_t* Qw = Qb + (long)(wid * QBLK + r32) * LDQ + hi * 8;
#pragma unroll
  for (int d0 = 0; d0 < 8; ++d0) qr[d0] = *reinterpret_cast<const bf16x8*>(Qw + d0 * 16);
  const int sr = tid >> 4, sc = (tid & 15) * 8, srp = (sr & ~0xC) | ((sr & 4) << 1) | ((sr & 8) >> 1), vst0 = v_st(srp, sc), vst1 = v_st(32 + srp, sc);
  const int vb0 = (int)(uintptr_t)V_lds + v_rd_base(lane);
  struct { bf16x8 vs0, vs1, ks0, ks1; } sr_[2];
#define SLOAD(i, t) do { const long k0_ = (long)((t) < NT ? (t) : NT - 1) * KVBLK; sr_[i].vs0 = *reinterpret_cast<const bf16x8*>(&Vh[(k0_ + sr) * LDK + sc]); sr_[i].vs1 = *reinterpret_cast<const bf16x8*>(&Vh[(k0_ + 32 + sr) * LDK + sc]); \
    sr_[i].ks0 = *reinterpret_cast<const bf16x8*>(&Kh[(k0_ + sr) * LDK + sc]); sr_[i].ks1 = *reinterpret_cast<const bf16x8*>(&Kh[(k0_ + 32 + sr) * LDK + sc]); } while (0)
#define SWRITE(b, i) do { *(bf16x8*)((char*)V_lds + (b) * VB + vst0) = sr_[i].vs0; *(bf16x8*)((char*)V_lds + (b) * VB + vst1) = sr_[i].vs1; const int kc = sc * 2; \
    *(bf16x8*)((char*)K_lds + (b) * KB + KSWZ(sr, kc)) = sr_[i].ks0; *(bf16x8*)((char*)K_lds + (b) * KB + KSWZ(32 + sr, kc)) = sr_[i].ks1; } while (0)
#define SWAIT() asm volatile("s_waitcnt vmcnt(4)" ::: "memory")
  f32x16 pA0, pA1, pB0, pB1; bf16x8 pa0, pa1, pa2, pa3;
  unsigned ca0, ca1, cb0, cb1; bf16x8 ka0, ka1, kb0, kb1; s16x4 va[4];
#define KRD(D0, B0, B1) do { B0 = *reinterpret_cast<const bf16x8*>(Kp + KSWZ(r32, ((D0) * 16 + hi * 8) * 2)); B1 = *reinterpret_cast<const bf16x8*>(Kp + KSWZ(32 + r32, ((D0) * 16 + hi * 8) * 2)); } while (0)
#define MQ(ACC, KF, D0) ACC = __builtin_amdgcn_mfma_f32_32x32x16_bf16(KF, qr[D0], ACC, 0, 0, 0)
#define EX(P, R) P[R] = __builtin_amdgcn_exp2f(P[R])
#define AD(P, R) l_reg += P[R]
#define CV(P, I, A, B) do { A = cvtpk(P[I], P[(I) + 1]); B = cvtpk(P[(I) + 2], P[(I) + 3]); } while (0)
#define PM(OUT) do { u32x4 w_ = {ca0, ca1, cb0, cb1}; OUT = *reinterpret_cast<bf16x8*>(&w_); } while (0)
#define RV(ARR, I, D0, KS) do { ARR[I] = tr_read<v_rd_off(D0, KS, 0)>(vbp); ARR[(I) + 1] = tr_read<v_rd_off(D0, KS, 1)>(vbp); } while (0)
#define PKV(L, H) (bf16x8){L[0], L[1], L[2], L[3], H[0], H[1], H[2], H[3]}
#define MP(D0, PA, ARR, I) o[D0] = __builtin_amdgcn_mfma_f32_32x32x16_bf16(PKV(ARR[I], ARR[(I) + 1]), PA, o[D0], 0, 0, 0)
#define WL(N) do { asm volatile("s_waitcnt lgkmcnt(" #N ")" ::: "memory"); SBAR(); } while (0)
#define TROW(t) ((long)((t) < NT ? (t) : NT - 1) * KVBLK)
#define SLV0(i, t) sr_[i].vs0 = *reinterpret_cast<const bf16x8*>(&Vh[(TROW(t) + sr) * LDK + sc])
#define SLV1(i, t) sr_[i].vs1 = *reinterpret_cast<const bf16x8*>(&Vh[(TROW(t) + 32 + sr) * LDK + sc])
#define SLK0(i, t) sr_[i].ks0 = *reinterpret_cast<const bf16x8*>(&Kh[(TROW(t) + sr) * LDK + sc])
#define SLK1(i, t) sr_[i].ks1 = *reinterpret_cast<const bf16x8*>(&Kh[(TROW(t) + 32 + sr) * LDK + sc])
#define SWV0(b, i) *(bf16x8*)((char*)V_lds + (b) * VB + vst0) = sr_[i].vs0
#define SWV1(b, i) *(bf16x8*)((char*)V_lds + (b) * VB + vst1) = sr_[i].vs1
#define SWK0(b, i) *(bf16x8*)((char*)K_lds + (b) * KB + KSWZ(sr, sc * 2)) = sr_[i].ks0
#define SWK1(b, i) *(bf16x8*)((char*)K_lds + (b) * KB + KSWZ(32 + sr, sc * 2)) = sr_[i].ks1
#define STEP(J, Q0, Q1, P0, P1, BQ, BP, BW, SL, SW) do { const char* Kp = (const char*)K_lds + (BQ) * KB; const int vbp = vb0 + (BP) * VB; SBAR(); \
    KRD(0, ka0, ka1); Q0 = f32x16{}; Q1 = f32x16{};        \
    MQ(Q0, ka0, 0); KRD(1, kb0, kb1); EX(P1, 0); CV(P0, 0, ca0, ca1); SBAR(); \
    MQ(Q1, ka1, 0); EX(P1, 1); AD(P1, 0); CV(P0, 4, cb0, cb1); PM(pa0); SBAR(); \
    MQ(Q0, kb0, 1); KRD(2, ka0, ka1); EX(P1, 2); AD(P1, 1); CV(P0, 8, ca0, ca1); SBAR(); \
    MQ(Q1, kb1, 1); EX(P1, 3); AD(P1, 2); CV(P0, 12, cb0, cb1); PM(pa1); SBAR(); \
    MQ(Q0, ka0, 2); KRD(3, kb0, kb1); EX(P1, 4); AD(P1, 3); SBAR(); \
    MQ(Q1, ka1, 2); EX(P1, 5); AD(P1, 4); SLV0(SL, (J) + 2); SBAR(); \
    MQ(Q0, kb0, 3); KRD(4, ka0, ka1); EX(P1, 6); AD(P1, 5); SBAR(); \
    MQ(Q1, kb1, 3); EX(P1, 7); AD(P1, 6); SLV1(SL, (J) + 2); SBAR(); \
    MQ(Q0, ka0, 4); KRD(5, kb0, kb1); EX(P1, 8); AD(P1, 7); CV(P1, 0, ca0, ca1); SBAR(); \
    MQ(Q1, ka1, 4); EX(P1, 9); AD(P1, 8); CV(P1, 4, cb0, cb1); PM(pa2); SBAR(); \
    MQ(Q0, kb0, 5); KRD(6, ka0, ka1); EX(P1, 10); AD(P1, 9); SBAR(); \
    MQ(Q1, kb1, 5); EX(P1, 11); AD(P1, 10); SLK0(SL, (J) + 2); SBAR(); \
    MQ(Q0, ka0, 6); KRD(7, kb0, kb1); EX(P1, 12); AD(P1, 11); SBAR(); \
    MQ(Q1, ka1, 6); EX(P1, 13); AD(P1, 12); CV(P1, 8, ca0, ca1); SLK1(SL, (J) + 2); SBAR(); \
    MQ(Q0, kb0, 7); EX(P1, 14); AD(P1, 13); SBAR(); RV(va, 0, 0, 0); RV(va, 2, 1, 0); SBAR(); \
    MQ(Q1, kb1, 7); EX(P1, 15); AD(P1, 14); SBAR(); \
    WL(2); MP(0, pa0, va, 0); RV(va, 0, 0, 1); AD(P1, 15); CV(P1, 12, cb0, cb1); PM(pa3); EX(Q0, 0); SBAR(); \
    WL(2); MP(1, pa0, va, 2); RV(va, 2, 1, 1); EX(Q0, 1); AD(Q0, 0); SBAR(); \
    WL(2); MP(0, pa1, va, 0); RV(va, 0, 0, 2); EX(Q0, 2); AD(Q0, 1); SBAR(); \
    WL(2); MP(1, pa1, va, 2); RV(va, 2, 1, 2); EX(Q0, 3); AD(Q0, 2); SBAR(); \
    WL(2); MP(0, pa2, va, 0); RV(va, 0, 0, 3); EX(Q0, 4); AD(Q0, 3); SBAR(); \
    WL(2); MP(1, pa2, va, 2); RV(va, 2, 1, 3); EX(Q0, 5); AD(Q0, 4); SBAR(); \
    WL(2); MP(0, pa3, va, 0); RV(va, 0, 2, 0); EX(Q0, 6); AD(Q0, 5); SBAR(); \
    WL(2); MP(1, pa3, va, 2); RV(va, 2, 3, 0); EX(Q0, 7); AD(Q0, 6); SBAR(); \
    WL(2); MP(2, pa0, va, 0); RV(va, 0, 2, 1); EX(Q0, 8); AD(Q0, 7); SBAR(); \
    WL(2); MP(3, pa0, va, 2); RV(va, 2, 3, 1); EX(Q0, 9); AD(Q0, 8); SBAR(); \
    WL(2); MP(2, pa1, va, 0); RV(va, 0, 2, 2); EX(Q0, 10); AD(Q0, 9); SBAR(); \
    WL(2); MP(3, pa1, va, 2); RV(va, 2, 3, 2); EX(Q0, 11); AD(Q0, 10); SBAR(); \
    WL(2); MP(2, pa2, va, 0); RV(va, 0, 2, 3); SWAIT(); SWV0(BW, SW); EX(Q0, 12); AD(Q0, 11); SBAR(); \
    WL(3); MP(3, pa2, va, 2); RV(va, 2, 3, 3); SWV1(BW, SW); EX(Q0, 13); AD(Q0, 12); SBAR(); \
    WL(4); MP(2, pa3, va, 0); SWK0(BW, SW); EX(Q0, 14); AD(Q0, 13); SBAR(); \
    WL(2); MP(3, pa3, va, 2); SWK1(BW, SW); EX(Q0, 15); AD(Q0, 14); AD(Q0, 15); SBAR(); \
    __syncthreads(); } while (0)
  SLOAD(0, 0); asm volatile("s_waitcnt vmcnt(0)" ::: "memory"); SWRITE(0, 0); SLOAD(1, 1); SLOAD(0, 2); __syncthreads();
  qkt(pA0, pA1, K_lds, qr, r32, hi); partialSM_fix2(pA0, l_reg); SWAIT(); SWRITE(1, 1); __syncthreads();
  int jb = 1;
  for (; jb + 5 < NT; jb += 6) {
    STEP(jb,     pB0, pB1, pA0, pA1, 1, 0, 2, 1, 0);
    STEP(jb + 1, pA0, pA1, pB0, pB1, 2, 1, 0, 0, 1);
    STEP(jb + 2, pB0, pB1, pA0, pA1, 0, 2, 1, 1, 0);
    STEP(jb + 3, pA0, pA1, pB0, pB1, 1, 0, 2, 0, 1);
    STEP(jb + 4, pB0, pB1, pA0, pA1, 2, 1, 0, 1, 0);
    STEP(jb + 5, pA0, pA1, pB0, pB1, 0, 2, 1, 0, 1);
  }
  constexpr int REM = (NT - 1) % 6;
  if constexpr (REM > 0) STEP(jb,     pB0, pB1, pA0, pA1, 1, 0, 2, 1, 0);
  if constexpr (REM > 1) STEP(jb + 1, pA0, pA1, pB0, pB1, 2, 1, 0, 0, 1);
  if constexpr (REM > 2) STEP(jb + 2, pB0, pB1, pA0, pA1, 0, 2, 1, 1, 0);
  if constexpr (REM > 3) STEP(jb + 3, pA0, pA1, pB0, pB1, 1, 0, 2, 0, 1);
  if constexpr (REM > 4) STEP(jb + 4, pB0, pB1, pA0, pA1, 2, 1, 0, 1, 0);
  if constexpr ((NT - 1) & 1) finishSM2(pB0, pB1, l_reg, pa0, pa1, pa2, pa3); else finishSM2(pA0, pA1, l_reg, pa0, pa1, pa2, pa3);
  { auto rr = __builtin_amdgcn_permlane32_swap(__float_as_uint(l_reg), __float_as_uint(l_reg), false, false); l_reg = __uint_as_float(rr[0]) + __uint_as_float(rr[1]); }
  { const int vbp = vb0 + ((NT - 1) % 3) * VB; SBAR(); RV(va, 0, 0, 0); RV(va, 2, 1, 0); SBAR();
    WL(2); MP(0, pa0, va, 0); RV(va, 0, 0, 1); SBAR();
    WL(2); MP(1, pa0, va, 2); RV(va, 2, 1, 1); SBAR();
    WL(2); MP(0, pa1, va, 0); RV(va, 0, 0, 2); SBAR();
    WL(2); MP(1, pa1, va, 2); RV(va, 2, 1, 2); SBAR();
    WL(2); MP(0, pa2, va, 0); RV(va, 0, 0, 3); SBAR();
    WL(2); MP(1, pa2, va, 2); RV(va, 2, 1, 3); SBAR();
    WL(2); MP(0, pa3, va, 0); RV(va, 0, 2, 0); SBAR();
    WL(2); MP(1, pa3, va, 2); RV(va, 2, 3, 0); SBAR();
    WL(2); MP(2, pa0, va, 0); RV(va, 0, 2, 1); SBAR();
    WL(2); MP(3, pa0, va, 2); RV(va, 2, 3, 1); SBAR();
    WL(2); MP(2, pa1, va, 0); RV(va, 0, 2, 2); SBAR();
    WL(2); MP(3, pa1, va, 2); RV(va, 2, 3, 2); SBAR();
    WL(2); MP(2, pa2, va, 0); RV(va, 0, 2, 3); SBAR();
    WL(2); MP(3, pa2, va, 2); RV(va, 2, 3, 3); SBAR();
    WL(2); MP(2, pa3, va, 0); SBAR();
    WL(0); MP(3, pa3, va, 2); SBAR();
  }
  { const float rl = __builtin_amdgcn_rcpf(l_reg); bf16_t* Orow = Ob + (long)(wid * QBLK + r32) * LDO + hi * 8;
#pragma unroll
    for (int D0 = 0; D0 < 4; ++D0) {
#pragma unroll
      for (int gp = 0; gp < 2; ++gp) { const int k = D0 * 4 + 2 * gp;
        unsigned ax = cvtpk(o[D0][8 * gp + 0] * rl, o[D0][8 * gp + 1] * rl), ay = cvtpk(o[D0][8 * gp + 2] * rl, o[D0][8 * gp + 3] * rl);
        unsigned bx = cvtpk(o[D0][8 * gp + 4] * rl, o[D0][8 * gp + 5] * rl), by = cvtpk(o[D0][8 * gp + 6] * rl, o[D0][8 * gp + 7] * rl);
        auto sx = __builtin_amdgcn_permlane32_swap(ax, bx, false, false); auto sy = __builtin_amdgcn_permlane32_swap(ay, by, false, false);
        *(u32x4*)(Orow + 8 * k) = (u32x4){sx[0], sy[0], sx[1], sy[1]}; } } }
  asm volatile("s_waitcnt vmcnt(0) lgkmcnt(0)" ::: "memory"); __syncthreads();
#undef STEP
#undef TROW
#undef SLV0
#undef SLV1
#undef SLK0
#undef SLK1
#undef SWV0
#undef SWV1
#undef SWK0
#undef SWK1
#undef KRD
#undef MQ
#undef EX
#undef AD
#undef CV
#undef PM
#undef RV
#undef PKV
#undef MP
#undef WL
#undef SLOAD
#undef SWRITE
#undef SWAIT
}
}
struct Args { const float* in[32]; float* out; unsigned char* ws; int ph_lo, ph_hi, li, pad; };
constexpr int PTR_OFF = RING_BYTES + 512;
struct Ctx { LAS unsigned char* ldsb; unsigned char* ws;
    __device__ __forceinline__ const float* inp(int i) const { const u32x2 v = *(const LAS u32x2*)(ldsb + PTR_OFF + 8 * i);
        const unsigned long long p = ((unsigned long long)(unsigned)__builtin_amdgcn_readfirstlane((int)v.y) << 32) | (unsigned)__builtin_amdgcn_readfirstlane((int)v.x);
        return (const float*)(const GAS float*)p; }
    __device__ __forceinline__ float* outp() const { return (float*)inp(32); } };
enum { IN_X = 0, IN_C, IN_CTX, IN_CCTX, IN_MODW, IN_MODB, IN_LNMG, IN_LNMB, IN_LNFG, IN_LNFB, IN_WIN, IN_WOUT, IN_LAMRE, IN_LAMIM, IN_LOGSTEP, IN_BRE, IN_BIM, IN_CRE, IN_CIM,
       IN_S5D, IN_WGLU, IN_BGLU, IN_FNETW, IN_FNETB, IN_WQKV, IN_QGAIN, IN_KGAIN, IN_WO, IN_ROUTER, IN_WGATE, IN_WUP, IN_WDOWN };

struct RowV { f32x4 v[8]; };
__device__ __forceinline__ void row_load_f32(RowV& r, const float* p, int lane) {
#pragma unroll
    for (int j = 0; j < 8; ++j) r.v[j] = *(const f32x4*)(p + 4 * lane + 256 * j);
}
__device__ __forceinline__ void row_store_f32(const RowV& r, float* p, int lane) {
#pragma unroll
    for (int j = 0; j < 8; ++j) *(f32x4*)(p + 4 * lane + 256 * j) = r.v[j];
}
__device__ __forceinline__ void row_store_f32_nt(const RowV& r, float* p, int lane) {
#pragma unroll
    for (int j = 0; j < 8; ++j) __builtin_nontemporal_store(r.v[j], (f32x4*)(p + 4 * lane + 256 * j));
}
__device__ __forceinline__ void row_load_bf16(RowV& r, const bf16_t* p, int lane) {
#pragma unroll
    for (int j = 0; j < 8; ++j) { const u32x2 w = *(const u32x2*)(p + 4 * lane + 256 * j);
        r.v[j] = (f32x4){bf2f(w.x & 0xffffu), bf2f(w.x >> 16), bf2f(w.y & 0xffffu), bf2f(w.y >> 16)}; }
}
__device__ __forceinline__ void row_store_bf16(const RowV& r, bf16_t* p, int lane) {
#pragma unroll
    for (int j = 0; j < 8; ++j) { u32x2 w; w.x = cvt_pk_bf16(r.v[j][0], r.v[j][1]); w.y = cvt_pk_bf16(r.v[j][2], r.v[j][3]); *(u32x2*)(p + 4 * lane + 256 * j) = w; }
}
__device__ __forceinline__ void row_normalize(RowV& r) {
    float s = 0.f;
#pragma unroll
    for (int j = 0; j < 8; ++j) s += (r.v[j][0] + r.v[j][1]) + (r.v[j][2] + r.v[j][3]);
    const float mean = wave_sum(s) * (1.f / DM); float q = 0.f;
#pragma unroll
    for (int j = 0; j < 8; ++j) { r.v[j] = r.v[j] - mean; q += (r.v[j][0] * r.v[j][0] + r.v[j][1] * r.v[j][1]) + (r.v[j][2] * r.v[j][2] + r.v[j][3] * r.v[j][3]); }
    const float rstd = 1.f / sqrtf(wave_sum(q) * (1.f / DM) + LN_EPS);
#pragma unroll
    for (int j = 0; j < 8; ++j) r.v[j] = r.v[j] * rstd;
}
__device__ __forceinline__ void row_modulate(RowV& r, const float* shift, const float* scale, int lane) {
#pragma unroll
    for (int j = 0; j < 8; ++j) { const f32x4 sc = *(const f32x4*)(scale + 4 * lane + 256 * j), sh = *(const f32x4*)(shift + 4 * lane + 256 * j); r.v[j] = r.v[j] * (sc + 1.f) + sh; }
}
__device__ __forceinline__ void row_affine(RowV& r, const float* gain, const float* bias, int lane) {
#pragma unroll
    for (int j = 0; j < 8; ++j) { const f32x4 g = *(const f32x4*)(gain + 4 * lane + 256 * j), b = *(const f32x4*)(bias + 4 * lane + 256 * j); r.v[j] = r.v[j] * g + b; }
}
__device__ __forceinline__ void row_decode(int r, int& b, bool& isctx, int& idx) { b = r / RPB; const int t = r - b * RPB; isctx = t < CTX; idx = isctx ? t : t - CTX; }
__device__ __forceinline__ const float* mod_ptr(const unsigned char* ws, int layer, int which, int k) { return (const float*)(ws + O_MOD) + ((size_t)((layer * 3 + which) * 6 + k)) * DM; }

template <int MODE>
__device__ __forceinline__ void transpose_item(const float* W, int K, int N, bf16_t* WT, LAS float* scrf, int item, int lane) {
    LAS unsigned* scr = (LAS unsigned*)scrf;
    const int nblk = N / 64, kb = item / nblk, nb = item % nblk, k0 = 64 * kb, n0 = 64 * nb;
    const float* src = W + (size_t)k0 * N + n0 + lane;
    float v[64];
#pragma unroll
    for (int i = 0; i < 64; ++i) v[i] = src[(size_t)i * N];
#pragma unroll
    for (int i = 0; i < 32; ++i) scr[lane * 33 + i] = cvt_pk_bf16(v[2 * i], v[2 * i + 1]);
    LDS_WAIT(); asm volatile("" ::: "memory");
    const int c = lane & 7;
#pragma unroll
    for (int jj = 0; jj < 8; ++jj) { const int n = (lane >> 3) + 8 * jj; const LAS unsigned* s = scr + n * 33 + 4 * c;
        u32x4 o; o.x = s[0]; o.y = s[1]; o.z = s[2]; o.w = s[3];
        const int nn = n0 + n; const int orow = MODE == 0 ? nn : (8 * (nn >> 2) + (nn & 3) + (MODE == 2 ? 4 : 0));
        *(u32x4*)(WT + (size_t)orow * K + k0 + 8 * c) = o; }
    LDS_WAIT(); asm volatile("" ::: "memory");
}

__device__ __forceinline__ void p0_prologue(const Ctx& a, LAS unsigned char* lds, int tid, int lane, int wave) {
    unsigned char* ws = a.ws;
    LAS float* scr = (LAS float*)(lds + wave * 16384);
    const int gw = blockIdx.x * NWAVES + wave, NGW = gridDim.x * NWAVES;
    constexpr int I_SQ = 32 * 32, I_GLU = 16 * 16, I_QKV = 32 * 48;
    constexpr int PER_J = 2 * I_SQ + I_GLU + I_QKV + I_SQ;
    for (int it = gw; it < 2 * PER_J; it += NGW) {
        const int j = it / PER_J; int r = it % PER_J;
        if (r < I_SQ) { transpose_item<0>(a.inp(IN_WIN) + (size_t)j * DM * DM, DM, DM, (bf16_t*)(ws + O_WIN) + (size_t)j * DM * DM, scr, r, lane); continue; } r -= I_SQ;
        if (r < I_SQ) { transpose_item<0>(a.inp(IN_WOUT) + (size_t)j * DM * DM, DM, DM, (bf16_t*)(ws + O_WOUT) + (size_t)j * DM * DM, scr, r, lane); continue; } r -= I_SQ;
        if (r < I_GLU) { transpose_item<0>(a.inp(IN_WGLU) + (size_t)j * 1024 * 1024, 1024, 1024, (bf16_t*)(ws + O_WGLU) + (size_t)j * 1024 * 1024, scr, r, lane); continue; } r -= I_GLU;
        if (r < I_QKV) { transpose_item<0>(a.inp(IN_WQKV) + (size_t)j * DM * 3072, DM, 3072, (bf16_t*)(ws + O_WQKV) + (size_t)j * 3072 * DM, scr, r, lane); continue; } r -= I_QKV;
        transpose_item<0>(a.inp(IN_WO) + (size_t)j * DM * DM, DM, DM, (bf16_t*)(ws + O_WO) + (size_t)j * DM * DM, scr, r, lane);
    }
    __syncthreads();
    {
        LAS float* sl = (LAS float*)lds;
        LAS float* red = (LAS float*)(lds + 32768);
        for (int i = tid; i < 3 * DM; i += NTHREADS) { const int w = i / DM, k = i % DM; const float cv = w < 2 ? a.inp(IN_C)[w * DM + k] : a.inp(IN_CCTX)[k]; sl[i] = silu_f(cv); }
        __syncthreads();
        for (int wi = blockIdx.x; wi < 256; wi += gridDim.x) {
            const int layer = wi >> 6, col0 = (wi & 63) * 192;
            const float* W = a.inp(IN_MODW) + (size_t)layer * DM * 12288 + col0 + lane;
            float acc[3][3];
#pragma unroll
            for (int q = 0; q < 3; ++q)
#pragma unroll
                for (int r = 0; r < 3; ++r) acc[q][r] = 0.f;
#pragma unroll 16
            for (int k = wave * 256; k < wave * 256 + 256; ++k) {
                const float s0 = sl[k], s1 = sl[DM + k], s2 = sl[2 * DM + k];
#pragma unroll
                for (int q = 0; q < 3; ++q) { const float w = W[(size_t)k * 12288 + 64 * q]; acc[q][0] += w * s0; acc[q][1] += w * s1; acc[q][2] += w * s2; }
            }
#pragma unroll
            for (int q = 0; q < 3; ++q)
#pragma unroll
                for (int r = 0; r < 3; ++r) red[(wave * 9 + q * 3 + r) * 64 + lane] = acc[q][r];
            __syncthreads();
            for (int i = tid; i < 576; i += NTHREADS) { const int qr = i / 64, l = i % 64, q = qr / 3, r = qr % 3; float s = 0.f;
#pragma unroll
                for (int w = 0; w < 8; ++w) s += red[(w * 9 + qr) * 64 + l];
                const int n = col0 + 64 * q + l;
                ((float*)(ws + O_MOD))[((size_t)(layer * 3 + r)) * 12288 + n] = s + a.inp(IN_MODB)[layer * 12288 + n]; }
            __syncthreads();
        }
    }
    const int gt = blockIdx.x * NTHREADS + tid, NGT = gridDim.x * NTHREADS;
    const double INV_PI = 0.31830988618379067153776752674503;
    for (int i = gt; i < 256 * 32; i += NGT) { const int pos = i >> 5, f = i & 31; const float invf = (float)exp(-(double)f * (9.210340371976182736071965818737 / 32.0)); const float ang = (float)pos * invf;
        ((f32x2*)(ws + O_TRIG))[i] = (f32x2){(float)cospi((double)ang * INV_PI), (float)sinpi((double)ang * INV_PI)}; }
    for (int i = gt; i < 256 * 256; i += NGT) { const int r = i >> 8, k = i & 255;
        { float v = 0.f; if (k < 128) { float ss, cc; sincospif((float)(((r & 127) * k) & 127) * (1.f / 64.f), &ss, &cc); v = (r < 128 ? cc : -ss) * (1.f / 128.f); }
          ((bf16_t*)(ws + O_FA))[i] = (bf16_t)f2bf(v); }
    }
    for (int i8 = gt; i8 < 128 * 256 * 32; i8 += NGT) {
        const int k1 = i8 >> 13, r = (i8 >> 5) & 255, kc = (i8 & 31) * 8, k2 = r & 127; float v[8];
#pragma unroll
        for (int q = 0; q < 8; ++q) { const int k = kc + q, l2 = k & 127; float ss, cc; sincospif((float)((l2 * (k1 + 128 * k2)) & 16383) * (1.f / 8192.f), &ss, &cc);
            v[q] = r < 128 ? (k < 128 ? cc : ss) : (k < 128 ? ss : -cc); }
        u32x4 o; o.x = cvt_pk_bf16(v[0], v[1]); o.y = cvt_pk_bf16(v[2], v[3]); o.z = cvt_pk_bf16(v[4], v[5]); o.w = cvt_pk_bf16(v[6], v[7]);
        *(u32x4*)((bf16_t*)(ws + O_FC) + (size_t)i8 * 8) = o; }
    for (int i = gt; i < 512 * 256; i += NGT) { const int r = i >> 8, l = i & 255, k = r & 255; float ss, cc; sincospif((float)((k * l) & 255) * (1.f / 128.f), &ss, &cc);
        ((bf16_t*)(ws + O_F256))[i] = (bf16_t)f2bf((r < 256 ? cc : ss) * (1.f / 16.f)); }
    for (int i = gt; i < 2 * 2 * 64 * 64 * 33; i += NGT) { const int jdgp = i / 33, n = i - jdgp * 33;
        const double step = exp((double)a.inp(IN_LOGSTEP)[jdgp >> 6]), ar = (double)a.inp(IN_LAMRE)[jdgp] * step, ai = (double)a.inp(IN_LAMIM)[jdgp] * step * INV_PI;
        const double mag = exp(ar * n); ((f32x2*)(ws + O_POW))[i] = (f32x2){(float)(mag * cospi(ai * n)), (float)(mag * sinpi(ai * n))}; }
    for (int i = gt; i < 2 * 2 * 64 * 64 * 16; i += NGT) { const int jdgp = i >> 4;
        const double lre = a.inp(IN_LAMRE)[jdgp], lim = a.inp(IN_LAMIM)[jdgp], step = exp((double)a.inp(IN_LOGSTEP)[jdgp >> 6]);
        const double mag = exp(lre * step), ang = lim * step * INV_PI, br = mag * cospi(ang) - 1.0, bi = mag * sinpi(ang), den = lre * lre + lim * lim;
        const double qr = (br * lre + bi * lim) / den, qi = (bi * lre - br * lim) / den;
        const double xr = a.inp(IN_BRE)[i], xi = a.inp(IN_BIM)[i]; ((f32x2*)(ws + O_BBAR))[i] = (f32x2){(float)(qr * xr - qi * xi), (float)(qr * xi + qi * xr)}; }
    {
        __syncthreads();
        LAS float* ct = (LAS float*)lds; LAS float* st = ct + 256;
        if (tid < 256) { float ss, cc; sincospif((float)tid * (1.f / 128.f), &ss, &cc); ct[tid] = cc * (1.f / 16.f); st[tid] = -ss * (1.f / 16.f); }
        __syncthreads();
        for (int i = gt; i < 2 * 4 * 64 * 256; i += NGT) { const int e = i & 255, kb = (i >> 8) & 63, jg = i >> 14, c0 = (kb & 31) * 8; const LAS float* tb = kb < 32 ? ct : st;
            const float* w = a.inp(IN_FNETW) + (size_t)jg * 65536 + e; float s[8];
#pragma unroll
            for (int q = 0; q < 8; ++q) s[q] = 0.f;
#pragma unroll 4
            for (int m = 0; m < 256; ++m) { const float wv = w[m * 256];
#pragma unroll
                for (int q = 0; q < 8; ++q) s[q] += tb[(m * (c0 + q)) & 255] * wv; }
            u32x4 o; o.x = cvt_pk_bf16(s[0], s[1]); o.y = cvt_pk_bf16(s[2], s[3]); o.z = cvt_pk_bf16(s[4], s[5]); o.w = cvt_pk_bf16(s[6], s[7]);
            *(u32x4*)((bf16_t*)(ws + O_FNM) + ((size_t)jg * 256 + e) * 512 + kb * 8) = o; }
        __syncthreads();
    }
    if (gt < 128) ((bf16_t*)(ws + O_T1))[(size_t)2048 * 128 * 128 + gt] = 0;
}

__device__ __forceinline__ void p1_kf(const Ctx& a, LAS unsigned char* lds, int tid) {
    unsigned char* ws = a.ws;
    LAS f32x2* pw = (LAS f32x2*)lds;
    LAS f32x2* bb = pw + 64 * 33;
    LAS f32x2* cc = bb + 64 * 16;
    for (int jdg = blockIdx.x; jdg < 256; jdg += gridDim.x) {
        for (int i = tid; i < 64 * 33; i += NTHREADS) pw[i] = ((const f32x2*)(ws + O_POW))[(size_t)jdg * 64 * 33 + i];
        for (int i = tid; i < 64 * 16; i += NTHREADS) bb[i] = ((const f32x2*)(ws + O_BBAR))[(size_t)jdg * 64 * 16 + i];
        for (int i = tid; i < 16 * 64; i += NTHREADS) cc[(i >> 6) * 65 + (i & 63)] = (f32x2){a.inp(IN_CRE)[(size_t)jdg * 1024 + i], a.inp(IN_CIM)[(size_t)jdg * 1024 + i]};
        __syncthreads();
        const int tau = tid >> 4, co = tid & 15; float s[16];
#pragma unroll
        for (int ci = 0; ci < 16; ++ci) s[ci] = 0.f;
        for (int p = 0; p < 64; ++p) { const f32x2 w = pw[p * 33 + tau], c = cc[co * 65 + p]; const float xr = c.x * w.x - c.y * w.y, xi = c.x * w.y + c.y * w.x;
#pragma unroll
            for (int ci = 0; ci < 16; ++ci) { const f32x2 b = bb[p * 16 + ci]; s[ci] += xr * b.x - xi * b.y; } }
        float* out = (float*)(ws + O_KF) + ((size_t)jdg * 32 + tau) * 256 + co * 16;
#pragma unroll
        for (int q = 0; q < 4; ++q) *(f32x4*)(out + 4 * q) = (f32x4){s[4 * q], s[4 * q + 1], s[4 * q + 2], s[4 * q + 3]};
        __syncthreads();
    }
}
__device__ __forceinline__ u32x4 p2_bt1_item(const Ctx& a, int i) {
    unsigned char* ws = a.ws; const f32x2* POW = (const f32x2*)(ws + O_POW); const f32x2* BB = (const f32x2*)(ws + O_BBAR);
    const int k8 = i & 63, rr = (i >> 6) & 255, jg = i >> 14, j = jg >> 6, g = jg & 63;
    const int typ = rr >> 6, p = rr & 63, d = typ >> 1, t = k8 >> 1, ci0 = (k8 & 1) * 8, n = d == 0 ? (31 - t) : t;
    const size_t jdgp = ((size_t)((j * 2 + d) * 64 + g)) * 64 + p; const f32x2 w = POW[jdgp * 33 + n]; float v[8];
#pragma unroll
    for (int c = 0; c < 8; ++c) { const f32x2 b = BB[jdgp * 16 + ci0 + c]; v[c] = (typ & 1) ? (w.x * b.y + w.y * b.x) : (w.x * b.x - w.y * b.y); }
    u32x4 o; o.x = cvt_pk_bf16(v[0], v[1]); o.y = cvt_pk_bf16(v[2], v[3]); o.z = cvt_pk_bf16(v[4], v[5]); o.w = cvt_pk_bf16(v[6], v[7]); return o;
}
__device__ __forceinline__ u32x4 p2_bt3_item(const Ctx& a, int i) {
    unsigned char* ws = a.ws; const f32x2* POW = (const f32x2*)(ws + O_POW); const float* KF = (const float*)(ws + O_KF);
    const int k8 = i % 96, rr = (i / 96) & 511, jg = i / (96 * 512), j = jg >> 6, g = jg & 63;
    const int t = rr >> 4, co = rr & 15; float v[8];
    if (k8 < 64) { const int s = k8 >> 1, ci0 = (k8 & 1) * 8;
        f32x4 f0 = (f32x4){0.f, 0.f, 0.f, 0.f}, f1 = f0;
        if (s <= t) { const f32x4* p = (const f32x4*)(KF + ((((size_t)(j * 2 + 0) * 64 + g) * 32 + (t - s)) * 16 + co) * 16 + ci0); f0 += p[0]; f1 += p[1]; }
        if (s >= t) { const f32x4* p = (const f32x4*)(KF + ((((size_t)(j * 2 + 1) * 64 + g) * 32 + (s - t)) * 16 + co) * 16 + ci0); f0 += p[0]; f1 += p[1]; }
#pragma unroll
        for (int c = 0; c < 4; ++c) { v[c] = f0[c]; v[4 + c] = f1[c]; }
        if (s == t && (co >> 3) == (k8 & 1)) { const float dsk = a.inp(IN_S5D)[j * 1024 + g * 16 + co];
#pragma unroll
            for (int c = 0; c < 8; ++c) v[c] += (ci0 + c == co) ? dsk : 0.f; }
    } else { const int q0 = (k8 - 64) * 8, typ = q0 >> 6, d = typ >> 1, n = d == 0 ? (t + 1) : (32 - t);
        const size_t jdg = (size_t)(j * 2 + d) * 64 + g;
#pragma unroll
        for (int c = 0; c < 8; ++c) { const int p = (q0 & 63) + c; const f32x2 w = POW[(jdg * 64 + p) * 33 + n];
            const float cr = a.inp(IN_CRE)[(jdg * 16 + co) * 64 + p], ci = a.inp(IN_CIM)[(jdg * 16 + co) * 64 + p];
            v[c] = (typ & 1) ? -(cr * w.y + ci * w.x) : (cr * w.x - ci * w.y); } }
    u32x4 o; o.x = cvt_pk_bf16(v[0], v[1]); o.y = cvt_pk_bf16(v[2], v[3]); o.z = cvt_pk_bf16(v[4], v[5]); o.w = cvt_pk_bf16(v[6], v[7]); return o;
}
__device__ __forceinline__ void p2_s5mats(const Ctx& a, int tid) {
    unsigned char* ws = a.ws; const int gt = blockIdx.x * NTHREADS + tid, NGT = gridDim.x * NTHREADS;
    constexpr int N1 = 2 * 64 * 256 * 64, N3 = 2 * 64 * 512 * 96;
    for (int i = gt; i < N1; i += 4 * NGT) { u32x4 o[4];
#pragma unroll
        for (int q = 0; q < 4; ++q) { const int ii = i + q * NGT; o[q] = p2_bt1_item(a, ii < N1 ? ii : i); }
#pragma unroll
        for (int q = 0; q < 4; ++q) { const int ii = i + q * NGT; if (ii < N1) { const int k8 = ii & 63, rr = (ii >> 6) & 255, jg = ii >> 14;
            *(u32x4*)((bf16_t*)(ws + O_BT1) + ((size_t)jg * 256 + rr) * 512 + k8 * 8) = o[q]; } } }
    for (int i = gt; i < N3; i += 4 * NGT) { u32x4 o[4];
#pragma unroll
        for (int q = 0; q < 4; ++q) { const int ii = i + q * NGT; o[q] = p2_bt3_item(a, ii < N3 ? ii : i); }
#pragma unroll
        for (int q = 0; q < 4; ++q) { const int ii = i + q * NGT; if (ii < N3) { const int k8 = ii % 96, rr = (ii / 96) & 511, jg = ii / (96 * 512);
            *(u32x4*)((bf16_t*)(ws + O_BT3) + ((size_t)jg * 512 + rr) * 768 + k8 * 8) = o[q]; } } }
}
__device__ __forceinline__ void moe_weight_phase(const Ctx& a, int layer, int part, int tailwgs, LAS unsigned char* lds, int lane, int wave) {
    unsigned char* ws = a.ws; LAS float* scr = (LAS float*)(lds + wave * 16384);
    const int rank = (int)blockIdx.x - tailwgs, nact = (int)gridDim.x - tailwgs;
    if (rank >= 0) {
        const int gw = rank * NWAVES + wave, NGW = nact * NWAVES;
        constexpr int I_GU = 32 * 16, I_DN = 16 * 32, PER_E = 2 * I_GU + I_DN, HALF_ITEMS = 16 * PER_E / 2;
        for (int it = part * HALF_ITEMS + gw; it < (part + 1) * HALF_ITEMS; it += NGW) {
            const int e = it / PER_E; int r = it % PER_E;
            const size_t le = (size_t)layer * 16 + e;
            if (r < I_GU) { transpose_item<1>(a.inp(IN_WGATE) + le * DM * EFF, DM, EFF, (bf16_t*)(ws + O_WGU) + (size_t)e * 2048 * DM, scr, r, lane); continue; } r -= I_GU;
            if (r < I_GU) { transpose_item<2>(a.inp(IN_WUP) + le * DM * EFF, DM, EFF, (bf16_t*)(ws + O_WGU) + (size_t)e * 2048 * DM, scr, r, lane); continue; } r -= I_GU;
            transpose_item<0>(a.inp(IN_WDOWN) + le * EFF * DM, EFF, DM, (bf16_t*)(ws + O_WD) + (size_t)e * DM * EFF, scr, r, lane);
        }
    }
    __syncthreads();
}

__device__ __forceinline__ const float* r_xsrc0(const Ctx& a, int r) { int b, idx; bool isctx; row_decode(r, b, isctx, idx);
    return isctx ? a.inp(IN_CTX) + ((size_t)(b * CTX + idx)) * DM : a.inp(IN_X) + ((size_t)(b * SEQ + idx)) * DM; }
__device__ __forceinline__ void r0_phase(const Ctx& a, int lane, int wave) {
    unsigned char* ws = a.ws; const int gw = blockIdx.x * NWAVES + wave, NGW = gridDim.x * NWAVES;
    RowV xn;
    if (gw < NR) row_load_f32(xn, r_xsrc0(a, gw), lane);
    for (int r = gw; r < NR; r += NGW) { int b, idx; bool isctx; row_decode(r, b, isctx, idx);
        const int which = isctx ? 2 : b; RowV x = xn;
        if (r + NGW < NR) row_load_f32(xn, r_xsrc0(a, r + NGW), lane);
        row_normalize(x);
        row_modulate(x, mod_ptr(ws, 0, which, 0), mod_ptr(ws, 0, which, 1), lane);
        row_store_bf16(x, (bf16_t*)(ws + O_U) + (size_t)r * DM, lane); }
}
__device__ __forceinline__ void lds_vec_fill(LAS float* dst, const float* src, int tid) { for (int i = tid; i < DM / 4; i += NTHREADS) *(LAS f32x4*)(dst + 4 * i) = *(const f32x4*)(src + 4 * i); }
__device__ __forceinline__ f32x4 vld(const float* p, int lane, int j) { return *(const f32x4*)(p + 4 * lane + 256 * j); }
__device__ __forceinline__ f32x4 vld(const LAS float* p, int lane, int j) { return *(const LAS f32x4*)(p + 4 * lane + 256 * j); }
__device__ __forceinline__ const float* r_xsrc(const Ctx& a, int layer, int r) { int b, idx; bool isctx; row_decode(r, b, isctx, idx);
    if (layer == 0) return isctx ? a.inp(IN_CTX) + ((size_t)(b * CTX + idx)) * DM : a.inp(IN_X) + ((size_t)(b * SEQ + idx)) * DM;
    return isctx ? (const float*)(a.ws + O_XC) + ((size_t)(b * CTX + idx)) * DM : a.outp() + ((size_t)(b * SEQ + idx)) * DM; }
struct RowDeal { int b, i0, n_lat_wg, wave, nlat, gw, NGW;
    __device__ __forceinline__ void init(int wave_) { const int G = gridDim.x, nb = G >> 1, c = blockIdx.x; wave = wave_; gw = c * NWAVES + wave; NGW = G * NWAVES;
        if (nb > 0 && c < 2 * nb) { const int per = (SEQ + nb - 1) / nb; b = c / nb; i0 = (c % nb) * per; n_lat_wg = SEQ - i0 < per ? (SEQ - i0 > 0 ? SEQ - i0 : 0) : per; } else { b = 0; i0 = 0; n_lat_wg = 0; }
        nlat = n_lat_wg > wave ? (n_lat_wg - wave + NWAVES - 1) / NWAVES : 0; }
    bool with_ctx = true;
    __device__ __forceinline__ int row(int k) const { if (k < nlat) return b * RPB + CTX + i0 + wave + k * NWAVES;
        const int q = gw + (k - nlat) * NGW; if (!with_ctx || q >= NBATCH * CTX) return -1; return (q / CTX) * RPB + (q % CTX); } };
constexpr int RV_OFF = RING_BYTES + 1024;

template <bool FAST>
__device__ __forceinline__ void r1_row(const Ctx& a, int layer, int r, RowV& x, const LAS float* wl, const LAS float* lv, int lane, bool st) {
    unsigned char* ws = a.ws; int b, idx; bool isctx; row_decode(r, b, isctx, idx); const int which = isctx ? 2 : b;
    float* xs = isctx ? (float*)(ws + O_XC) + ((size_t)(b * CTX + idx)) * DM : a.outp() + ((size_t)(b * SEQ + idx)) * DM;
    row_normalize(x);
    row_affine(x, a.inp(IN_LNMG) + layer * DM, a.inp(IN_LNMB) + layer * DM, lane);
    if (st) row_store_f32_nt(x, xs, lane);
    row_normalize(x);
    if (FAST) {
#pragma unroll
        for (int j = 0; j < 8; ++j) x.v[j] = x.v[j] * (vld(lv + DM, lane, j) + 1.f) + vld(lv + 2 * DM, lane, j);
    } else row_modulate(x, mod_ptr(ws, layer, which, 3), mod_ptr(ws, layer, which, 4), lane);
    if (st) row_store_bf16(x, (bf16_t*)(ws + O_H2) + (size_t)r * DM, lane);
    float lg[16];
#pragma unroll
    for (int e = 0; e < 16; ++e) { float s0 = 0.f, s1 = 0.f, s2 = 0.f, s3 = 0.f;
#pragma unroll
        for (int j = 0; j < 8; ++j) { const f32x4 w = *(const LAS f32x4*)(wl + e * DM + 4 * lane + 256 * j);
            s0 = __builtin_fmaf(x.v[j][0], w[0], s0); s1 = __builtin_fmaf(x.v[j][1], w[1], s1); s2 = __builtin_fmaf(x.v[j][2], w[2], s2); s3 = __builtin_fmaf(x.v[j][3], w[3], s3); }
        lg[e] = wave_sum((s0 + s1) + (s2 + s3)); asm volatile("" ::: "memory"); }
    float mx = lg[0];
#pragma unroll
    for (int e = 1; e < 16; ++e) mx = fmaxf(mx, lg[e]);
    float den = 0.f;
#pragma unroll
    for (int e = 0; e < 16; ++e) { lg[e] = __builtin_amdgcn_exp2f((lg[e] - mx) * 1.4426950408889634f); den += lg[e]; }
    float mine = 0.f;
#pragma unroll
    for (int e = 0; e < 16; ++e) mine = (lane == e) ? lg[e] : mine;
    if (st && lane < 16) ((float*)(ws + O_AFF))[(size_t)r * 16 + lane] = mine / den;
}
__device__ __forceinline__ void r1_phase(const Ctx& a, int layer, LAS unsigned char* lds, int tid, int lane, int wave, bool st) {
    unsigned char* ws = a.ws;
    LAS float* wl = (LAS float*)lds;
    LAS float* lv = (LAS float*)(lds + RV_OFF);
    RowDeal rd; rd.init(wave); rd.with_ctx = layer + 1 < DEPTH;
    { const float* wr = a.inp(IN_ROUTER) + (size_t)layer * DM * 16;
      for (int i = tid; i < DM * 16; i += NTHREADS) wl[(i & 15) * DM + (i >> 4)] = wr[i];
      lds_vec_fill(lv, mod_ptr(ws, layer, rd.b, 2), tid); lds_vec_fill(lv + DM, mod_ptr(ws, layer, rd.b, 4), tid); lds_vec_fill(lv + 2 * DM, mod_ptr(ws, layer, rd.b, 3), tid); }
    __syncthreads();
    RowV xn; u32x2 on[8];
#define R1_FETCH(R) do { row_load_f32(xn, r_xsrc(a, layer, (R)), lane); _Pragma("unroll") for (int j = 0; j < 8; ++j) on[j] = *(const u32x2*)((const bf16_t*)(ws + O_O) + (size_t)(R) * DM + 4 * lane + 256 * j); } while (0)
    int r = rd.row(0);
    if (r >= 0) R1_FETCH(r);
    int k = 0;
    for (; k < rd.nlat; ++k) {
        RowV x;
#pragma unroll
        for (int j = 0; j < 8; ++j) { const f32x4 o = (f32x4){bf2f(on[j].x & 0xffffu), bf2f(on[j].x >> 16), bf2f(on[j].y & 0xffffu), bf2f(on[j].y >> 16)}; x.v[j] = xn.v[j] * ALPHA + vld(lv, lane, j) * o; }
        const int rn = rd.row(k + 1);
        if (rn >= 0) R1_FETCH(rn);
        r1_row<true>(a, layer, r, x, wl, lv, lane, st);
        r = rn;
    }
    for (; r >= 0; ++k) {
        RowV x; { int b, idx; bool isctx; row_decode(r, b, isctx, idx); const float* g1 = mod_ptr(ws, layer, isctx ? 2 : b, 2);
#pragma unroll
          for (int j = 0; j < 8; ++j) { const f32x4 o = (f32x4){bf2f(on[j].x & 0xffffu), bf2f(on[j].x >> 16), bf2f(on[j].y & 0xffffu), bf2f(on[j].y >> 16)}; x.v[j] = xn.v[j] * ALPHA + vld(g1, lane, j) * o; } }
        const int rn = rd.row(k + 1);
        if (rn >= 0) R1_FETCH(rn);
        r1_row<false>(a, layer, r, x, wl, lv, lane, st);
        r = rn;
    }
#undef R1_FETCH
    __syncthreads();
}
__device__ __forceinline__ int moe_row(int e, int b, bool isctx, int slot) { return isctx ? (NEXP * 4096 + e * 256 + b * CAP_C + slot) : (e * 4096 + b * CAP_L + slot); }
template <bool FAST>
__device__ __forceinline__ void r2_row(const Ctx& a, int layer, int r, const RowV& xin, int selv, float affv, const LAS float* lv, int lane, bool st) {
    unsigned char* ws = a.ws; int b, idx; bool isctx; row_decode(r, b, isctx, idx); const int which = isctx ? 2 : b;
    const bf16_t* YE = (const bf16_t*)(ws + O_YE);
    float* xs = isctx ? (float*)(ws + O_XC) + ((size_t)(b * CTX + idx)) * DM : a.outp() + ((size_t)(b * SEQ + idx)) * DM;
    RowV x = xin, f;
    unsigned long long m = __ballot(selv >= 0);
    const int e0 = m ? __builtin_ctzll(m) : 0; unsigned long long m1 = m & (m - 1); const int e1 = m1 ? __builtin_ctzll(m1) : 0; unsigned long long m2 = m1 & (m1 - 1); const int e2 = m2 ? __builtin_ctzll(m2) : 0;
    u32x2 y0[8], y1[8], y2[8];
    if (m) { const bf16_t* p = YE + (size_t)moe_row(e0, b, isctx, __builtin_amdgcn_readlane(selv, e0)) * DM + 4 * lane;
#pragma unroll
        for (int j = 0; j < 8; ++j) y0[j] = *(const u32x2*)(p + 256 * j); }
    if (m1) { const bf16_t* p = YE + (size_t)moe_row(e1, b, isctx, __builtin_amdgcn_readlane(selv, e1)) * DM + 4 * lane;
#pragma unroll
        for (int j = 0; j < 8; ++j) y1[j] = *(const u32x2*)(p + 256 * j); }
    if (m2) { const bf16_t* p = YE + (size_t)moe_row(e2, b, isctx, __builtin_amdgcn_readlane(selv, e2)) * DM + 4 * lane;
#pragma unroll
        for (int j = 0; j < 8; ++j) y2[j] = *(const u32x2*)(p + 256 * j); }
#pragma unroll
    for (int j = 0; j < 8; ++j) f.v[j] = (f32x4){0.f, 0.f, 0.f, 0.f};
#define R2_ACC(Y, E) do { const float w_ = __uint_as_float(__builtin_amdgcn_readlane(__float_as_uint(affv), E)); _Pragma("unroll") for (int j = 0; j < 8; ++j) \
        f.v[j] += (f32x4){bf2f(Y[j].x & 0xffffu), bf2f(Y[j].x >> 16), bf2f(Y[j].y & 0xffffu), bf2f(Y[j].y >> 16)} * w_; } while (0)
    if (m) R2_ACC(y0, e0);
    if (m1) R2_ACC(y1, e1);
    if (m2) R2_ACC(y2, e2);
#undef R2_ACC
    unsigned long long mr = m2 & (m2 - 1);
    while (mr) { const int e = __builtin_ctzll(mr); mr &= mr - 1;
        const int s = __builtin_amdgcn_readlane(selv, e); const float w = __uint_as_float(__builtin_amdgcn_readlane(__float_as_uint(affv), e));
        RowV y; row_load_bf16(y, YE + (size_t)moe_row(e, b, isctx, s) * DM, lane);
#pragma unroll
        for (int j = 0; j < 8; ++j) f.v[j] += y.v[j] * w; }
    const float* g2 = mod_ptr(ws, layer, which, 5);
#pragma unroll
    for (int j = 0; j < 8; ++j) { const f32x4 g = FAST ? vld(lv, lane, j) : vld(g2, lane, j); x.v[j] = x.v[j] * ALPHA + g * f.v[j]; }
    row_normalize(x);
    if (FAST) {
#pragma unroll
        for (int j = 0; j < 8; ++j) x.v[j] = x.v[j] * vld(lv + DM, lane, j) + vld(lv + 2 * DM, lane, j);
    } else row_affine(x, a.inp(IN_LNFG) + layer * DM, a.inp(IN_LNFB) + layer * DM, lane);
    if (st) { if (layer + 1 < DEPTH) row_store_f32_nt(x, xs, lane); else row_store_f32(x, xs, lane); }
    if (layer + 1 < DEPTH) { row_normalize(x);
        if (FAST) {
#pragma unroll
            for (int j = 0; j < 8; ++j) x.v[j] = x.v[j] * (vld(lv + 4 * DM, lane, j) + 1.f) + vld(lv + 3 * DM, lane, j);
        } else row_modulate(x, mod_ptr(ws, layer + 1, which, 0), mod_ptr(ws, layer + 1, which, 1), lane);
        if (st) row_store_bf16(x, (bf16_t*)(ws + O_U) + (size_t)r * DM, lane); }
}
__device__ __forceinline__ void r2_phase(const Ctx& a, int layer, LAS unsigned char* lds, int tid, int lane, int wave, bool st) {
    unsigned char* ws = a.ws;
    const int* SEL = (const int*)(ws + O_SEL); const float* AFF = (const float*)(ws + O_AFF);
    LAS float* lv = (LAS float*)lds;
    RowDeal rd; rd.init(wave); rd.with_ctx = layer + 1 < DEPTH;
    lds_vec_fill(lv, mod_ptr(ws, layer, rd.b, 5), tid); lds_vec_fill(lv + DM, a.inp(IN_LNFG) + layer * DM, tid); lds_vec_fill(lv + 2 * DM, a.inp(IN_LNFB) + layer * DM, tid);
    if (layer + 1 < DEPTH) { lds_vec_fill(lv + 3 * DM, mod_ptr(ws, layer + 1, rd.b, 0), tid); lds_vec_fill(lv + 4 * DM, mod_ptr(ws, layer + 1, rd.b, 1), tid); }
    __syncthreads();
    RowV xn; int seln = -1; float affn = 0.f;
    int r = rd.row(0);
    if (r >= 0) { row_load_f32(xn, r_xsrc(a, 1, r), lane); if (lane < 16) { seln = SEL[(size_t)r * 16 + lane]; affn = AFF[(size_t)r * 16 + lane]; } }
    for (int k = 0; r >= 0; ++k) {
        const RowV x = xn; const int selv = seln; const float affv = affn;
        const int rn = rd.row(k + 1);
        seln = -1; affn = 0.f;
        if (rn >= 0) { row_load_f32(xn, r_xsrc(a, 1, rn), lane); if (lane < 16) { seln = SEL[(size_t)rn * 16 + lane]; affn = AFF[(size_t)rn * 16 + lane]; } }
        if (k < rd.nlat) r2_row<true>(a, layer, r, x, selv, affv, lv, lane, st);
        else r2_row<false>(a, layer, r, x, selv, affv, lv, lane, st);
        r = rn;
    }
    __syncthreads();
}
__device__ __forceinline__ int block_excl_scan(int v, LAS int* tmp, int lane, int wave, int& total) {
    int inc = v;
#pragma unroll
    for (int o = 1; o < 64; o <<= 1) { const int t = __builtin_amdgcn_ds_bpermute((lane >= o ? lane - o : lane) << 2, inc); if (lane >= o) inc += t; }
    if (lane == 63) tmp[wave] = inc;
    __syncthreads();
    int off = 0, tot = 0;
#pragma unroll
    for (int w = 0; w < 8; ++w) { const int t = tmp[w]; off += (w < wave) ? t : 0; tot += t; }
    __syncthreads();
    total = tot; return off + inc - v;
}
__device__ __forceinline__ void topk_phase(const Ctx& a, bool with_ctx, LAS unsigned char* lds, int tid, int lane, int wave) {
    unsigned char* ws = a.ws; const float* AFF = (const float*)(ws + O_AFF); int* SEL = (int*)(ws + O_SEL); int* IDX = (int*)(ws + O_IDX);
    LAS unsigned* val = (LAS unsigned*)lds;
    LAS unsigned* hist = (LAS unsigned*)(lds + 69632);
    LAS unsigned* bc = hist + 256;
    LAS int* tmp = (LAS int*)(hist + 272);
    for (int li = blockIdx.x; li < (with_ctx ? 64 : 32); li += gridDim.x) {
        const bool isctx = li >= 32; const int q = li & 31, b = q >> 4, e = q & 15;
        const int n = isctx ? CTX : SEQ, k = isctx ? CAP_C : CAP_L, row0 = b * RPB + (isctx ? 0 : CTX);
        for (int i = tid; i < n; i += NTHREADS) val[i + (i >> 5)] = __float_as_uint(AFF[(size_t)(row0 + i) * 16 + e]);
        __syncthreads();
        unsigned prefix = 0u, mask = 0u; int krem = k;
        for (int pass = 0; pass < 4; ++pass) { const int shift = 24 - 8 * pass;
            if (tid < 256) hist[tid] = 0u;
            __syncthreads();
            for (int i = tid; i < n; i += NTHREADS) { const unsigned v = val[i + (i >> 5)]; const bool in = (v & mask) == prefix; const unsigned bin = (v >> shift) & 255u;
                const unsigned long long act = __ballot(in);
                if (act) { const int first = (int)__builtin_ctzll(act); const unsigned lead = (unsigned)__builtin_amdgcn_readlane((int)bin, first);
                    const unsigned long long same = __ballot(in && bin == lead);
                    if (in && bin != lead) __hip_atomic_fetch_add(&hist[bin], 1u, __ATOMIC_RELAXED, __HIP_MEMORY_SCOPE_WORKGROUP);
                    if (lane == first) __hip_atomic_fetch_add(&hist[lead], (unsigned)__builtin_popcountll(same), __ATOMIC_RELAXED, __HIP_MEMORY_SCOPE_WORKGROUP); } }
            __syncthreads();
            if (wave == 0) { const int b0 = 255 - 4 * lane; const int c0 = (int)hist[b0], c1 = (int)hist[b0 - 1], c2 = (int)hist[b0 - 2], c3 = (int)hist[b0 - 3]; const int s = c0 + c1 + c2 + c3;
                int inc = s;
#pragma unroll
                for (int o = 1; o < 64; o <<= 1) { const int t = __builtin_amdgcn_ds_bpermute((lane >= o ? lane - o : lane) << 2, inc); if (lane >= o) inc += t; }
                const int exc = inc - s;
                if (exc < krem && krem <= inc) { int cum = exc, bin, before;
                    if (krem <= cum + c0) { bin = b0; before = cum; } else { cum += c0;
                    if (krem <= cum + c1) { bin = b0 - 1; before = cum; } else { cum += c1;
                    if (krem <= cum + c2) { bin = b0 - 2; before = cum; } else { cum += c2; bin = b0 - 3; before = cum; } } }
                    bc[0] = (unsigned)bin; bc[1] = (unsigned)(krem - before); } }
            __syncthreads();
            prefix |= bc[0] << shift; mask |= 0xffu << shift; krem = (int)bc[1];
        }
        const unsigned vstar = prefix; const int need = krem;
        const bool act = tid < (n >> 5); int cgt = 0, ceq = 0;
        if (act) for (int j = 0; j < 32; ++j) { const unsigned v = val[33 * tid + j]; cgt += v > vstar; ceq += v == vstar; }
        int tot; const int eqb = block_excl_scan(ceq, tmp, lane, wave, tot);
        int takeq = need - eqb; takeq = takeq < 0 ? 0 : (takeq > ceq ? ceq : takeq);
        const int slot0 = block_excl_scan(cgt + takeq, tmp, lane, wave, tot);
        if (act) { int eqr = eqb, slot = slot0;
            for (int j = 0; j < 32; ++j) { const int i = 32 * tid + j; const unsigned v = val[33 * tid + j]; const bool iseq = v == vstar; const bool take = v > vstar || (iseq && eqr < need); eqr += iseq;
                SEL[(size_t)(row0 + i) * 16 + e] = take ? slot : -1;
                if (take) { IDX[moe_row(e, b, isctx, slot)] = row0 + i; ++slot; } } }
        __syncthreads();
    }
}
__device__ __forceinline__ bool moe_row_valid(int m) { return m < NEXP * 4096 || ((m - NEXP * 4096) & 255) < 2 * CAP_C; }
__device__ __forceinline__ void gather_phase(const Ctx& a, int lane, int wave) {
    unsigned char* ws = a.ws; const int gw = blockIdx.x * NWAVES + wave, NGW = gridDim.x * NWAVES; const int* IDX = (const int*)(ws + O_IDX);
    for (int m0 = gw * 4; m0 < MOE_ROWS; m0 += NGW * 4) {
        const int mi = m0 + (lane & 3); const int tv = moe_row_valid(mi) ? IDX[mi] : -1;
        u32x4 t[4][4];
#pragma unroll
        for (int q = 0; q < 4; ++q) { const int tok = __builtin_amdgcn_readlane(tv, q);
            if (tok >= 0) { const u32x4* src = (const u32x4*)((const bf16_t*)(ws + O_H2) + (size_t)tok * DM);
#pragma unroll
                for (int j = 0; j < 4; ++j) t[q][j] = src[lane + 64 * j]; } }
#pragma unroll
        for (int q = 0; q < 4; ++q) { const int tok = __builtin_amdgcn_readlane(tv, q);
            if (tok >= 0) { u32x4* dst = (u32x4*)((bf16_t*)(ws + O_XE) + (size_t)(m0 + q) * DM);
#pragma unroll
                for (int j = 0; j < 4; ++j) dst[lane + 64 * j] = t[q][j]; } }
    }
}
__device__ __forceinline__ bool attn_fixed_form(const Ctx& a, int j, int lane) {
    const float* qg = a.inp(IN_QGAIN) + j * 128; const float* kg = a.inp(IN_KGAIN) + j * 128;
    const float gq = wave_max(fmaxf(fabsf(qg[lane]), fabsf(qg[lane + 64]))), gk = wave_max(fmaxf(fabsf(kg[lane]), fabsf(kg[lane + 64])));
    return 128.f * gq * gk * 1.03f * 0.088388347648318440f < 27.f;
}
__device__ __forceinline__ void qknorm_phase(const Ctx& a, int j, int lane, int wave, bool st) {
    unsigned char* ws = a.ws; const int gw = blockIdx.x * NWAVES + wave, NGW = gridDim.x * NWAVES;
    const f32x4* TRIG4 = (const f32x4*)(ws + O_TRIG);
    const int cidx = lane & 15, d0 = cidx * 8; const bool upper = (cidx & 4) != 0;
    const float* qg = a.inp(IN_QGAIN) + j * 128 + d0; const float* kg = a.inp(IN_KGAIN) + j * 128 + d0;
    const float qs = attn_fixed_form(a, j, lane) ? 0.088388347648318440f * 1.4426950408889634f : 1.f;
    const f32x4 gq0 = *(const f32x4*)qg * qs, gq1 = *(const f32x4*)(qg + 4) * qs, gk0 = *(const f32x4*)kg, gk1 = *(const f32x4*)(kg + 4);
    u32x4 nraw[5];
    if (gw < NR) { const bf16_t* zn = (const bf16_t*)(ws + O_Z) + (size_t)gw * 3072 + lane * 8;
#pragma unroll
        for (int it = 0; it < 5; ++it) nraw[it] = *(const u32x4*)(zn + it * 512); }
    for (int r = gw; r < NR; r += NGW) { int b, idx; bool isctx; row_decode(r, b, isctx, idx);
        float cs[8], sn[8];
#pragma unroll
        for (int i = 0; i < 8; ++i) { cs[i] = 1.f; sn[i] = 0.f; }
        if (!isctx) { const int pos = cidx < 8 ? (idx >> 6) : (idx & 63); const f32x4* tp = TRIG4 + pos * 16 + (cidx & 3) * 4;
#pragma unroll
            for (int q = 0; q < 4; ++q) { const f32x4 t = tp[q]; cs[2 * q] = t[0]; sn[2 * q] = t[1]; cs[2 * q + 1] = t[2]; sn[2 * q + 1] = t[3]; } }
        bf16_t* zr = (bf16_t*)(ws + O_Z) + (size_t)r * 3072 + lane * 8;
        u32x4 raw[5];
#pragma unroll
        for (int it = 0; it < 5; ++it) raw[it] = nraw[it];
        if (r + NGW < NR) { const bf16_t* zn = (const bf16_t*)(ws + O_Z) + (size_t)(r + NGW) * 3072 + lane * 8;
#pragma unroll
            for (int it = 0; it < 5; ++it) nraw[it] = *(const u32x4*)(zn + it * 512); }
#pragma unroll
        for (int it = 0; it < 5; ++it) {
            float x[8]; x[0] = bf2f(raw[it].x & 0xffffu); x[1] = bf2f(raw[it].x >> 16); x[2] = bf2f(raw[it].y & 0xffffu); x[3] = bf2f(raw[it].y >> 16);
            x[4] = bf2f(raw[it].z & 0xffffu); x[5] = bf2f(raw[it].z >> 16); x[6] = bf2f(raw[it].w & 0xffffu); x[7] = bf2f(raw[it].w >> 16);
            float ss = 0.f;
#pragma unroll
            for (int i = 0; i < 8; ++i) ss += x[i] * x[i];
            ss = row16_sum(ss);
            const float rinv = 1.f / sqrtf(ss * (1.f / 128.f) + QK_EPS);
            const f32x4 g0 = it < 4 ? gq0 : gk0, g1 = it < 4 ? gq1 : gk1;
            float y[8], o[8];
#pragma unroll
            for (int i = 0; i < 4; ++i) { y[i] = x[i] * rinv * g0[i]; y[4 + i] = x[4 + i] * rinv * g1[i]; }
#pragma unroll
            for (int i = 0; i < 8; ++i) { const float yp = __int_as_float(__builtin_amdgcn_ds_swizzle(__float_as_int(y[i]), 0x101F));     o[i] = upper ? (y[i] * cs[i] + yp * sn[i]) : (y[i] * cs[i] - yp * sn[i]); }
            u32x4 w; w.x = cvt_pk_bf16(o[0], o[1]); w.y = cvt_pk_bf16(o[2], o[3]); w.z = cvt_pk_bf16(o[4], o[5]); w.w = cvt_pk_bf16(o[6], o[7]);
            if (st) *(u32x4*)(zr + it * 512) = w; }
    }
}
__device__ __forceinline__ int s5_chunk_at(int b, int d, int q) { const int cb = b * 520; return d == 0 ? cb + q : (q < 8 ? cb + 7 - q : cb + 527 - q); }
__device__ __forceinline__ void s5_carry_phase(const Ctx& a, int j, LAS unsigned char* lds, int lane, int wave) {
    unsigned char* ws = a.ws; const float* SUM = (const float*)(ws + O_SUM); bf16_t* A3 = (bf16_t*)(ws + O_A3);
    LAS f32x2* ex = (LAS f32x2*)lds;
    for (int ui = blockIdx.x; ui < 256; ui += gridDim.x) {
        const int b = ui >> 7, g = (ui >> 1) & 63, d = ui & 1;
        const f32x2 l32 = ((const f32x2*)(ws + O_POW))[((size_t)((j * 2 + d) * 64 + g) * 64 + lane) * 33 + 32];
        const float* sb = SUM + (size_t)g * NCHP * 256 + d * 128 + lane;
        float hr = 0.f, hi = 0.f;
#pragma unroll 13
        for (int i = 0; i < 65; ++i) { const int ch = s5_chunk_at(b, d, wave * 65 + i); const float sr = sb[(size_t)ch * 256], si = sb[(size_t)ch * 256 + 64];
            const float nr = l32.x * hr - l32.y * hi + sr, ni = l32.x * hi + l32.y * hr + si; hr = nr; hi = ni; }
        ex[wave * 64 + lane] = (f32x2){hr, hi};
        __syncthreads();
        float pr = l32.x, pi = l32.y;
#pragma unroll
        for (int s = 0; s < 6; ++s) { const float nr = pr * pr - pi * pi, ni = 2.f * pr * pi; pr = nr; pi = ni; }
        { const float nr = pr * l32.x - pi * l32.y, ni = pr * l32.y + pi * l32.x; pr = nr; pi = ni; }
        float cr = 0.f, ci = 0.f;
        for (int w = 0; w < wave; ++w) { const f32x2 e = ex[w * 64 + lane]; const float nr = pr * cr - pi * ci + e.x, ni = pr * ci + pi * cr + e.y; cr = nr; ci = ni; }
        hr = cr; hi = ci;
        bf16_t* ab = A3 + (size_t)g * NCHP * A3K + 512 + d * 128 + lane;
#pragma unroll 13
        for (int i = 0; i < 65; ++i) { const int ch = s5_chunk_at(b, d, wave * 65 + i); const float sr = sb[(size_t)ch * 256], si = sb[(size_t)ch * 256 + 64];
            ab[(size_t)ch * A3K] = (bf16_t)f2bf(hr); ab[(size_t)ch * A3K + 64] = (bf16_t)f2bf(hi);
            const float nr = l32.x * hr - l32.y * hi + sr, ni = l32.x * hi + l32.y * hr + si; hr = nr; hi = ni; }
        __syncthreads();
    }
}
__device__ __forceinline__ void f1_transpose_phase(const Ctx& a, LAS unsigned char* lds, int lane, int wave) {
    unsigned char* ws = a.ws; const int gw = blockIdx.x * NWAVES + wave, NGW = gridDim.x * NWAVES;
    LAS bf16_t* scr = (LAS bf16_t*)(lds + wave * 16384);
    const bf16_t* ZF = (const bf16_t*)(ws + O_ZF);
    constexpr int N_LAT = 2 * 128 * 32, N_CTX = 2 * 2 * 32, P = 136;
    constexpr int N_SKEW = 3840, SK_WG = 64;
    const int nskw = ((int)gridDim.x - SK_WG) * NWAVES, gws = gw - SK_WG * NWAVES;
    const int n_mine_skew = (nskw > 0 && gws >= 0) ? (N_SKEW - gws + nskw - 1) / nskw : 0;
    const int skew0 = nskw > 0 ? N_SKEW : 0;
    const int n_mine_even = (N_LAT + N_CTX - skew0 - gw + NGW - 1) / NGW;
    for (int k = 0; k < n_mine_skew + (n_mine_even > 0 ? n_mine_even : 0); ++k) {
        const int it = k < n_mine_skew ? gws + k * nskw : skew0 + gw + (k - n_mine_skew) * NGW;
        size_t srow0, sstride; bf16_t* dst; size_t dpitch; int cb;
        if (it < N_LAT) { const int b = it >> 12, l2 = (it >> 5) & 127; cb = it & 31; srow0 = (size_t)b * RPB + CTX + l2; sstride = 128;
            dst = (bf16_t*)(ws + O_T1) + ((size_t)(b * 1024 + cb * 32) * 128 + l2) * 128; dpitch = 128 * 128; }
        else { const int q = it - N_LAT, b = q >> 6, tb = (q >> 5) & 1; cb = q & 31; srow0 = (size_t)b * RPB + tb * 128; sstride = 1;
            dst = (bf16_t*)(ws + O_T1C) + (size_t)(b * 1024 + cb * 32) * 256 + tb * 128; dpitch = 256; }
        const int c4 = lane & 3, rsub = lane >> 2;
        u32x4 v[8];
#pragma unroll
        for (int i = 0; i < 8; ++i) v[i] = *(const u32x4*)(ZF + (srow0 + (size_t)(16 * i + rsub) * sstride) * 1024 + cb * 32 + c4 * 8);
#pragma unroll
        for (int i = 0; i < 8; ++i) { const int rr = 16 * i + rsub; LAS bf16_t* s = scr + (c4 * 8) * P + rr;
            s[0 * P] = (bf16_t)(v[i].x & 0xffffu); s[1 * P] = (bf16_t)(v[i].x >> 16); s[2 * P] = (bf16_t)(v[i].y & 0xffffu); s[3 * P] = (bf16_t)(v[i].y >> 16);
            s[4 * P] = (bf16_t)(v[i].z & 0xffffu); s[5 * P] = (bf16_t)(v[i].z >> 16); s[6 * P] = (bf16_t)(v[i].w & 0xffffu); s[7 * P] = (bf16_t)(v[i].w >> 16); }
        LDS_WAIT(); asm volatile("" ::: "memory");
        const int ch0 = lane >> 4, r0 = (lane & 15) * 8;
#pragma unroll
        for (int i = 0; i < 8; ++i) { const int ch = ch0 + 4 * i; const u32x4 o = *(const LAS u32x4*)(scr + ch * P + r0);
            *(u32x4*)(dst + (size_t)ch * dpitch + r0) = o; }
        LDS_WAIT(); asm volatile("" ::: "memory");
    }
    __syncthreads();
}
template <bool FIXM>
__device__ __forceinline__ void attn_units(const Ctx& a, int nunits, char* lds, int tid, float mfixC) {
    unsigned char* ws = a.ws; const bf16_t* Z = (const bf16_t*)(ws + O_Z); bf16_t* AO = (bf16_t*)(ws + O_AO);
    for (int L = blockIdx.x; L < nunits; L += gridDim.x) {
        int b, h, q0, seq;
        if (L < 2048) { b = L >> 10; const int kvh = (L >> 8) & 3, g = (L >> 6) & 3, qb = L & 63; h = kvh * 4 + g; q0 = b * RPB + CTX + qb * 256; seq = RPB; }
        else { const int q = L - 2048; b = q >> 4; h = q & 15; q0 = b * RPB; seq = CTX; }
        const int kvh = h >> 2; const size_t k0 = (size_t)b * RPB;
        if constexpr (FIXM) { if (L < 2048) { att::attn_ring3_body<RPB / 64>(Z + (size_t)q0 * 3072 + h * 128, Z + k0 * 3072 + 2048 + kvh * 128, Z + k0 * 3072 + 2560 + kvh * 128, AO + (size_t)q0 * 2048 + h * 128, lds, tid); continue; } }
        att::attn_dense_body<FIXM>(Z + (size_t)q0 * 3072 + h * 128, Z + k0 * 3072 + 2048 + kvh * 128, Z + k0 * 3072 + 2560 + kvh * 128, AO + (size_t)q0 * 2048 + h * 128, seq, lds, tid, mfixC);
    }
}
__device__ __forceinline__ void attn_phase(const Ctx& a, int j, bool need_ctx, char* lds, int tid) {
    unsigned char* ws = a.ws; const bf16_t* Z = (const bf16_t*)(ws + O_Z); bf16_t* AO = (bf16_t*)(ws + O_AO);
    const int nunits = 2048 + (need_ctx ? 32 : 0);
    const bool fixm = attn_fixed_form(a, j, tid & 63); const float mfixC = 0.f;
    if (fixm) attn_units<true>(a, nunits, lds, tid, mfixC); else attn_units<false>(a, nunits, lds, tid, 0.f);
}
constexpr int NPH = 3 + 12 * DEPTH;
#ifndef MK_N_LAUNCHES
#define MK_N_LAUNCHES 1
#endif
#ifndef REP_ATT
#define REP_ATT 1
#endif
#ifndef REP_MOE
#define REP_MOE 1
#endif
#ifndef REP_EVEN
#define REP_EVEN 1
#endif
#ifndef REP_ODDG
#define REP_ODDG 1
#endif
#ifndef REP_CONV
#define REP_CONV 1
#endif
#ifndef REP_GA
#define REP_GA 1
#endif
#ifndef REP_PRO
#define REP_PRO 1
#endif
#ifndef REP_ROW
#define REP_ROW 1
#endif
#ifndef REP_QK
#define REP_QK 1
#endif
#ifndef REP_P0
#define REP_P0 1
#endif
#ifndef REP_P1
#define REP_P1 1
#endif
#ifndef REP_P2
#define REP_P2 1
#endif
#ifndef REP_R1
#define REP_R1 1
#endif
#ifndef REP_R2
#define REP_R2 1
#endif
#ifndef REP_TK
#define REP_TK 1
#endif
#ifndef REP_GAT
#define REP_GAT 1
#endif
#ifndef REP_BAR
#define REP_BAR 1
#endif
#define REPEAT(N) _Pragma("unroll 1") for (int rep_ = 0; rep_ < (N); ++rep_)

__global__ void __launch_bounds__(NTHREADS, 2) mk_fwd(Args a0) {
    extern __shared__ __attribute__((aligned(16))) unsigned char lds_raw[];
    LAS unsigned char* lds = (LAS unsigned char*)lds_raw;
    volatile LAS unsigned* MISC = (volatile LAS unsigned*)(lds + MISC_OFF);
    if (threadIdx.x < 32) MISC[threadIdx.x] = 0u;
    if (threadIdx.x == 0) {
#pragma unroll
        for (int i = 0; i < 32; ++i) *(LAS unsigned long long*)(lds + PTR_OFF + 8 * i) = (unsigned long long)a0.in[i];
        *(LAS unsigned long long*)(lds + PTR_OFF + 8 * 32) = (unsigned long long)a0.out; }
    __syncthreads();
    const int wave0 = __builtin_amdgcn_readfirstlane(threadIdx.x >> 6);
    const int lo = a0.ph_lo, hi = a0.ph_hi; (void)lo; (void)hi;
    XcdBarrier bar = xcd_barrier_post((unsigned*)(a0.ws + O_CTL) + CW_BAR + a0.li * XCD_BAR_WORDS, MISC + 8);
#if MK_N_LAUNCHES == 1
#define IN(k) true
#else
#define IN(k) (lo <= (k) && (k) < hi)
#endif
#define PH int tid; asm volatile("v_mbcnt_lo_u32_b32 %0, -1, 0\n\tv_mbcnt_hi_u32_b32 %0, -1, %0" : "=v"(tid)); tid += wave0 * 64; asm volatile("" : "+v"(tid));     const int lane = tid & 63, wave = __builtin_amdgcn_readfirstlane(tid >> 6); (void)lane; (void)wave; size_t wz_ = 0; asm volatile("" : "+s"(wz_)); unsigned char* ws = a0.ws + wz_; const Ctx a{lds, ws};
#if MK_N_LAUNCHES == 1
#define SEAM(k) do { if ((k) + 1 < NPH) { REPEAT(REP_BAR) xcd_barrier(bar); } } while (0)
#else
#define SEAM(k) do { if ((k) + 1 < hi) { REPEAT(REP_BAR) xcd_barrier(bar); } } while (0)
#endif
    const int G = gridDim.x, cid = blockIdx.x;
    pg8::Sched S;

    if (IN(0)) { PH REPEAT(REP_P0) p0_prologue(a, lds, tid, lane, wave); SEAM(0); }
    if (IN(1)) { PH REPEAT(REP_P1) { p1_kf(a, lds, tid); r0_phase(a, lane, wave); } SEAM(1); }
    if (IN(2)) { PH REPEAT(REP_P2) p2_s5mats(a, tid); SEAM(2); }

    for (int layer = 0; layer < DEPTH; ++layer) {
        const int base = 3 + 12 * layer, j = layer >> 1;
        const bool need_ctx = layer < DEPTH - 1;
        if ((layer & 1) == 0) {
            if (IN(base + 0)) { PH
                moe_weight_phase(a, layer, 0, (NRT * 8) % G, lds, lane, wave);
                pg8::OpWin op{(const bf16_t*)(ws + O_U), (const bf16_t*)(ws + O_WIN) + (size_t)j * DM * DM, DM, DM, DM, (bf16_t*)(ws + O_A3), (bf16_t*)(ws + O_ZF)};
                S.init(NRT, 8, G, cid); REPEAT(REP_EVEN) pg8::gemm_phase(lds, op, S, tid);
                SEAM(base + 0);
            }
            if (IN(base + 1)) { PH
                { pg8::OpL1 op{(const bf16_t*)(ws + O_A3), (const bf16_t*)(ws + O_BT1) + (size_t)j * 64 * 256 * 512, A3K, 512, 512, (float*)(ws + O_SUM)};
                  S.init(320, 1, G, cid); REPEAT(REP_EVEN) pg8::gemm_phase(lds, op, S, tid); }
                REPEAT(REP_EVEN) f1_transpose_phase(a, lds, lane, wave);
                SEAM(base + 1);
            }
            if (IN(base + 2)) { PH
                REPEAT(REP_EVEN) s5_carry_phase(a, j, lds, lane, wave);
                { pg8::OpFftA op{(const bf16_t*)(ws + O_FA), (const bf16_t*)(ws + O_T1), 256, 128, 256, (bf16_t*)(ws + O_BT2)};
                  S.init(1, 1024, G, cid); REPEAT(REP_EVEN) pg8::gemm_phase(lds, op, S, tid); }
                { pg8::OpCtxDft op{(const bf16_t*)(ws + O_F256), (const bf16_t*)(ws + O_T1C), 256, 256, 256, (bf16_t*)(ws + O_PQ)};
                  S.init(2, 8, G, cid); REPEAT(REP_EVEN) pg8::gemm_phase(lds, op, S, tid); }
                SEAM(base + 2);
            }
            if (IN(base + 3)) { PH
                { pg8::OpL3 op{(const bf16_t*)(ws + O_A3), (const bf16_t*)(ws + O_BT3) + (size_t)j * 64 * 512 * 768, A3K, A3K, A3K, (bf16_t*)(ws + O_G)};
                  S.init(320, 2, G, cid); REPEAT(REP_EVEN) pg8::gemm_phase(lds, op, S, tid); }
                { pg8::OpFftC op{(const bf16_t*)(ws + O_FC), (const bf16_t*)(ws + O_BT2), 256, 256, 256, (bf16_t*)(ws + O_PQ)};
                  S.init(1, 1024, G, cid); REPEAT(REP_EVEN) pg8::gemm_phase(lds, op, S, tid); }
                SEAM(base + 3);
            }
            if (IN(base + 4)) { PH
                { pg8::OpGlu op{(const bf16_t*)(ws + O_G), (const bf16_t*)(ws + O_WGLU) + (size_t)j * 1024 * 1024, 1024, 1024, 1024, a.inp(IN_BGLU) + j * 1024, (bf16_t*)(ws + O_CAT)};
                  S.init(NRT, 4, G, cid); REPEAT(REP_EVEN) pg8::gemm_phase(lds, op, S, tid); }
                { pg8::OpFnet op{(const bf16_t*)(ws + O_PQ), (const bf16_t*)(ws + O_FNM) + (size_t)j * 4 * 256 * 512, DM, 512, 512, a.inp(IN_FNETB) + j * 1024, (bf16_t*)(ws + O_CAT)};
                  S.init(NRT, 4, G, (cid + G - (NRT * 4) % G) % G); REPEAT(REP_EVEN) pg8::gemm_phase(lds, op, S, tid); }
                SEAM(base + 4);
            }
            if (IN(base + 5)) { PH
                moe_weight_phase(a, layer, 1, (NRT * 8) % G, lds, lane, wave);
                pg8::OpStore<false> op{(const bf16_t*)(ws + O_CAT), (const bf16_t*)(ws + O_WOUT) + (size_t)j * DM * DM, DM, DM, DM, (bf16_t*)(ws + O_O), DM, nullptr};
                S.init(NRT, 8, G, cid); REPEAT(REP_EVEN) pg8::gemm_phase(lds, op, S, tid);
                SEAM(base + 5);
            }
        } else {
            if (IN(base + 0)) { PH
                moe_weight_phase(a, layer, 0, (NRT * 12) % G, lds, lane, wave);
                pg8::OpStore<false> op{(const bf16_t*)(ws + O_U), (const bf16_t*)(ws + O_WQKV) + (size_t)j * 3072 * DM, DM, DM, DM, (bf16_t*)(ws + O_Z), 3072, nullptr};
                S.init(NRT, 12, G, cid); REPEAT(REP_ODDG) pg8::gemm_phase(lds, op, S, tid);
                SEAM(base + 0);
            }
            if (IN(base + 1)) { PH REPEAT(REP_QK) qknorm_phase(a, j, lane, wave, rep_ == REP_QK - 1); SEAM(base + 1); }
            if (IN(base + 2)) { PH REPEAT(REP_ATT) attn_phase(a, j, need_ctx, (char*)lds_raw, tid); SEAM(base + 2); }
            if (IN(base + 3)) { PH
                moe_weight_phase(a, layer, 1, (NRT * 8) % G, lds, lane, wave);
                pg8::OpStore<false> op{(const bf16_t*)(ws + O_AO), (const bf16_t*)(ws + O_WO) + (size_t)j * DM * DM, DM, DM, DM, (bf16_t*)(ws + O_O), DM, nullptr};
                S.init(NRT, 8, G, cid); REPEAT(REP_ODDG) pg8::gemm_phase(lds, op, S, tid);
                SEAM(base + 3);
            }
        }
        if (IN(base + 6)) { PH REPEAT(REP_R1) r1_phase(a, layer, lds, tid, lane, wave, rep_ == REP_R1 - 1); SEAM(base + 6); }
        if (IN(base + 7)) { PH REPEAT(REP_TK) topk_phase(a, need_ctx, lds, tid, lane, wave); SEAM(base + 7); }
        if (IN(base + 9)) { PH
            pg8::OpM1 op{(const bf16_t*)(ws + O_H2), (const bf16_t*)(ws + O_WGU), DM, DM, DM, (bf16_t*)(ws + O_HID), (const int*)(ws + O_IDX)};
            S.init(256, 8, G, cid); S.head = need_ctx ? 128 : 0; S.headM0 = 256; REPEAT(REP_MOE) pg8::gemm_phase(lds, op, S, tid); S.head = 0;
            SEAM(base + 9);
        }
        if (IN(base + 10)) { PH
            pg8::OpStore<true> op{(const bf16_t*)(ws + O_HID), (const bf16_t*)(ws + O_WD), EFF, EFF, EFF, (bf16_t*)(ws + O_YE), DM, nullptr};
            S.init(256, 8, G, cid); S.head = need_ctx ? 128 : 0; S.headM0 = 256; REPEAT(REP_MOE) pg8::gemm_phase(lds, op, S, tid); S.head = 0;
            SEAM(base + 10);
        }
        if (IN(base + 11)) { PH REPEAT(REP_R2) r2_phase(a, layer, lds, tid, lane, wave, rep_ == REP_R2 - 1); SEAM(base + 11); }
    }
#undef IN
#undef SEAM
}

static bool phase_empty(int k) { if (k < 3) return false; const int l = (k - 3) / 12, s = (k - 3) % 12; return (l & 1) && (s == 4 || s == 5); }
extern "C" void kernel_launch(void* const* d_in, const int* in_sizes, int n_in, void* d_out, int out_size, void* d_ws, size_t ws_size, hipStream_t stream) {
    static int grid = 0;
    if (grid == 0) {
        if (n_in != 32 || out_size != NBATCH * SEQ * DM || ws_size < WS_NEED) { fprintf(stderr, "kernel_launch: bad shapes n_in %d out %d ws %zu (need %zu)\n", n_in, out_size, ws_size, (size_t)WS_NEED); grid = -1; return; }
        int dev = 0, cus = 0;
        if (hipGetDevice(&dev) != hipSuccess || hipDeviceGetAttribute(&cus, hipDeviceAttributeMultiprocessorCount, dev) != hipSuccess) { grid = -1; return; }
        if (hipFuncSetAttribute((const void*)mk_fwd, hipFuncAttributeMaxDynamicSharedMemorySize, LDS_BYTES) != hipSuccess) { fprintf(stderr, "kernel_launch: hipFuncSetAttribute failed\n"); grid = -1; return; }
        int per_cu = 0;
        if (hipOccupancyMaxActiveBlocksPerMultiprocessor(&per_cu, (const void*)mk_fwd, NTHREADS, LDS_BYTES) != hipSuccess || per_cu < 1) fprintf(stderr, "kernel_launch: occupancy query says %d\n", per_cu);
        (void)hipGetLastError();
        grid = cus;
    }
    if (grid < 0) return;
    (void)in_sizes;
    if (hipMemsetAsync((char*)d_ws + O_CTL, 0, CTL_BYTES, stream) != hipSuccess) return;
    Args a{};
    for (int i = 0; i < 32; ++i) a.in[i] = (const float*)d_in[i];
    a.out = (float*)d_out; a.ws = (unsigned char*)d_ws; a.pad = 0;
#if MK_N_LAUNCHES == 1
    a.ph_lo = 0; a.ph_hi = NPH; a.li = 0;
    hipLaunchKernelGGL(mk_fwd, dim3(grid), dim3(NTHREADS), LDS_BYTES, stream, a);
#else
    int li = 0;
    for (int k = 0; k < NPH; ++k) { if (phase_empty(k)) continue;
        a.ph_lo = k; a.ph_hi = k + 1; a.li = li++;
        hipLaunchKernelGGL(mk_fwd, dim3(grid), dim3(NTHREADS), LDS_BYTES, stream, a); }
#endif
    const hipError_t le = hipPeekAtLastError();
    if (le != hipSuccess) fprintf(stderr, "kernel_launch: launch failed: %s\n", hipGetErrorName(le));
}
```

```cpp
#include <hip/hip_runtime.h>
#include <cstdio>
#include <cstdint>

#define GAS __attribute__((address_space(1)))
#define LAS __attribute__((address_space(3)))
typedef unsigned short bf16_t;
typedef short bf16x8 __attribute__((ext_vector_type(8)));
typedef short s16x4 __attribute__((ext_vector_type(4)));
typedef float f32x4 __attribute__((ext_vector_type(4)));
typedef float f32x2 __attribute__((ext_vector_type(2)));
typedef float f32x16 __attribute__((ext_vector_type(16)));
typedef unsigned u32x4 __attribute__((ext_vector_type(4)));
typedef unsigned u32x2 __attribute__((ext_vector_type(2)));

constexpr int DM = 2048, NBATCH = 2, SEQ = 16384, CTX = 256, DEPTH = 4;
constexpr int RPB = SEQ + CTX;
constexpr int NR = NBATCH * RPB;
constexpr int NRT = NR / 256;
constexpr int NEXP = 16, EFF = 1024, CAP_L = 2048, CAP_C = 32;
constexpr int MOE_ROWS = NEXP * 4096 + NEXP * 256;
constexpr int MOE_RT = MOE_ROWS / 256;
constexpr int S5G = 64, S5P = 64, S5C = 16, S5T = 32;
constexpr int NCH = NR / S5T;
constexpr int NCHP = 1280;
constexpr int A3K = 768;
constexpr float LN_EPS = 1e-6f, QK_EPS = 1e-6f;
constexpr float ALPHA = 1.681792830507429f;
constexpr int NTHREADS = 512, NWAVES = 8;

constexpr size_t A256(size_t x) { return (x + 255) / 256 * 256; }
constexpr size_t O_CTL = 0, CTL_BYTES = 1u << 20;
constexpr size_t O_MOD = O_CTL + CTL_BYTES;
constexpr size_t O_TRIG = O_MOD + A256((size_t)4 * 3 * 6 * DM * 4);
constexpr size_t O_FA = O_TRIG + 256 * 32 * 8;
constexpr size_t O_FC = O_FA + 256 * 256 * 2;
constexpr size_t O_F256 = O_FC + (size_t)128 * 256 * 256 * 2;
constexpr size_t O_POW = O_F256 + 512 * 256 * 2;
constexpr size_t O_BBAR = O_POW + A256((size_t)2 * 2 * 64 * 64 * 33 * 8);
constexpr size_t O_KF = O_BBAR + (size_t)2 * 2 * 64 * 64 * 16 * 8;
constexpr size_t O_WIN = O_KF + (size_t)2 * 2 * 64 * 32 * 256 * 4;
constexpr size_t O_WOUT = O_WIN + (size_t)2 * DM * DM * 2;
constexpr size_t O_WGLU = O_WOUT + (size_t)2 * DM * DM * 2;
constexpr size_t O_FNM = O_WGLU + (size_t)2 * 1024 * 1024 * 2;
constexpr size_t O_BT1 = O_FNM + (size_t)2 * 4 * 256 * 512 * 2;
constexpr size_t O_BT3 = O_BT1 + (size_t)2 * 64 * 256 * 512 * 2;
constexpr size_t O_WQKV = O_BT3 + (size_t)2 * 64 * 512 * 768 * 2;
constexpr size_t O_WO = O_WQKV + (size_t)2 * 3072 * DM * 2;
constexpr size_t O_WGU = O_WO + (size_t)2 * DM * DM * 2;
constexpr size_t O_WD = O_WGU + (size_t)NEXP * 2048 * DM * 2;
constexpr size_t O_XC = O_WD + (size_t)NEXP * DM * EFF * 2;
constexpr size_t O_AFF = O_XC + (size_t)512 * DM * 4;
constexpr size_t O_SEL = O_AFF + (size_t)NR * 16 * 4;
constexpr size_t O_IDX = O_SEL + (size_t)NR * 16 * 4;
constexpr size_t O_U = O_IDX + A256((size_t)MOE_ROWS * 4);
constexpr size_t O_H2 = O_U + (size_t)NR * DM * 2;
constexpr size_t O_O = O_H2 + (size_t)NR * DM * 2;
constexpr size_t O_S = O_O + (size_t)NR * DM * 2;
constexpr size_t O_A3 = O_S;
constexpr size_t O_SUM = O_A3 + (size_t)S5G * NCHP * A3K * 2;
constexpr size_t O_ZF = O_SUM + (size_t)S5G * NCHP * 256 * 4;
constexpr size_t O_T1 = O_ZF + (size_t)NR * 1024 * 2;
constexpr size_t O_T1C = O_T1 + (size_t)2048 * 128 * 128 * 2 + 256;
constexpr size_t O_BT2 = O_T1C + (size_t)2048 * 256 * 2;
constexpr size_t O_PQ = O_BT2 + (size_t)128 * 2048 * 256 * 2;
constexpr size_t O_G = O_PQ + (size_t)NR * DM * 2;
constexpr size_t O_CAT = O_G + (size_t)NR * 1024 * 2;
constexpr size_t O_EVEN_END = O_CAT + (size_t)NR * DM * 2;
constexpr size_t O_Z = O_S;
constexpr size_t O_AO = O_Z + (size_t)NR * 3072 * 2;
constexpr size_t O_ODD_END = O_AO + (size_t)NR * DM * 2;
constexpr size_t O_XE = O_S;
constexpr size_t O_HID = O_XE + (size_t)MOE_ROWS * DM * 2;
constexpr size_t O_YE = O_HID + (size_t)MOE_ROWS * EFF * 2;
constexpr size_t O_MOE_END = O_YE + (size_t)MOE_ROWS * DM * 2;
constexpr size_t WS_NEED = O_EVEN_END > O_MOE_END ? (O_EVEN_END > O_ODD_END ? O_EVEN_END : O_ODD_END) : (O_MOE_END > O_ODD_END ? O_MOE_END : O_ODD_END);
static_assert(WS_NEED < (size_t)2300 * 1024 * 1024, "workspace budget");
constexpr int CW_BAR = 4096;
constexpr int CW_DIAG = 16384;

constexpr int RING_BYTES = 131072;
constexpr int MISC_OFF = RING_BYTES;
constexpr int EPI_OFF = RING_BYTES + 256;
constexpr int LDS_BYTES = 163840;

#define LDS_WAIT() asm volatile("s_waitcnt lgkmcnt(0)" ::: "memory")
#define VM_WAIT() asm volatile("s_waitcnt vmcnt(0)" ::: "memory")
__device__ __forceinline__ float bf2f(unsigned b) { return __uint_as_float(b << 16); }
__device__ __forceinline__ unsigned f2bf(float f) { unsigned u = __float_as_uint(f); return (u + 0x7fffu + ((u >> 16) & 1u)) >> 16; }
__device__ __forceinline__ unsigned cvt_pk_bf16(float lo, float hi) { unsigned r; asm volatile("v_cvt_pk_bf16_f32 %0, %1, %2" : "=v"(r) : "v"(lo), "v"(hi)); return r; }
template <int CTRL> __device__ __forceinline__ float dpp_mov(float v) { return __int_as_float(__builtin_amdgcn_update_dpp(0, __float_as_int(v), CTRL, 0xf, 0xf, true)); }
__device__ __forceinline__ float row16_sum(float v) {
    v += dpp_mov<0xB1>(v);
    v += dpp_mov<0x4E>(v);
    v += dpp_mov<0x141>(v);
    v += dpp_mov<0x140>(v);
    return v;
}
__device__ __forceinline__ float wave_sum(float v) {
    v = row16_sum(v);
    { auto rr = __builtin_amdgcn_permlane16_swap(__float_as_uint(v), __float_as_uint(v), false, false); v = __uint_as_float(rr[0]) + __uint_as_float(rr[1]); }
    { auto rr = __builtin_amdgcn_permlane32_swap(__float_as_uint(v), __float_as_uint(v), false, false); v = __uint_as_float(rr[0]) + __uint_as_float(rr[1]); }
    return v;
}
__device__ __forceinline__ float wave_max(float v) {
    v = fmaxf(v, dpp_mov<0xB1>(v)); v = fmaxf(v, dpp_mov<0x4E>(v)); v = fmaxf(v, dpp_mov<0x141>(v)); v = fmaxf(v, dpp_mov<0x140>(v));
    { auto rr = __builtin_amdgcn_permlane16_swap(__float_as_uint(v), __float_as_uint(v), false, false); v = fmaxf(__uint_as_float(rr[0]), __uint_as_float(rr[1])); }
    { auto rr = __builtin_amdgcn_permlane32_swap(__float_as_uint(v), __float_as_uint(v), false, false); v = fmaxf(__uint_as_float(rr[0]), __uint_as_float(rr[1])); }
    return v;
}
__device__ __forceinline__ float sigmoid_fast(float x) { return __builtin_amdgcn_rcpf(1.f + __builtin_amdgcn_exp2f(-1.4426950408889634f * x)); }
__device__ __forceinline__ float silu_f(float x) { return x / (1.f + __expf(-x)); }
__device__ __forceinline__ float gelu_tanh(float x) {
    const float u = 0.7978845608028654f * (x + 0.044715f * x * x * x);
    const float t = 1.f - 2.f * sigmoid_fast(-2.f * u);
    return 0.5f * x * (1.f + t);
}

#define XB_TMO      128
#define XB_XCNT(j)  (256  + 64 * (j))
#define XB_XSUB(j)  (1280 + 64 * (j))
#define XB_XGEN(j)  (2304 + 64 * (j))
#define XB_TOP      3328
#define XB_TOPGEN   3392
#define XCD_BAR_WORDS 3456
#define XB_SPIN_CAP (1u << 18)

__device__ __forceinline__ unsigned xb_ld(unsigned* p)              { return __hip_atomic_load(p, __ATOMIC_RELAXED, __HIP_MEMORY_SCOPE_AGENT); }
__device__ __forceinline__ unsigned xb_add(unsigned* p, unsigned v) { return __hip_atomic_fetch_add(p, v, __ATOMIC_RELAXED, __HIP_MEMORY_SCOPE_AGENT); }
__device__ __forceinline__ unsigned xb_xcc_id() { return (unsigned)__builtin_amdgcn_s_getreg((3 << 11) | 20) & 0xFu; }
#define XB_SPIN(cond, bar) do { unsigned _sp = 0; while (cond) { __builtin_amdgcn_s_sleep(1); \
    if ((++_sp & 255u) == 0u) { if (xb_ld(&(bar)[XB_TMO])) break; if (_sp > XB_SPIN_CAP) { atomicAdd(&(bar)[XB_TMO], 1u); break; } } } } while (0)

struct XcdBarrier { unsigned* bar; unsigned x; volatile LAS unsigned* st; };

__device__ __forceinline__ XcdBarrier xcd_barrier_post(unsigned* bar, volatile LAS unsigned* st) {
    XcdBarrier b; b.bar = bar; b.x = xb_xcc_id(); b.st = st;
    if (threadIdx.x == 0) (void)xb_add(&bar[XB_XCNT(b.x)], 1u);
    return b;
}
__device__ __forceinline__ void xcd_barrier_complete(unsigned* bar, unsigned x, unsigned& nloc, unsigned& nx) {
    const unsigned G = gridDim.x * gridDim.y * gridDim.z;
    unsigned sum, cnt, mine, sp = 0u;
    for (;;) {
        sum = 0u; cnt = 0u; mine = 0u;
#pragma unroll
        for (unsigned j = 0; j < 16; ++j) { const unsigned c = xb_ld(&bar[XB_XCNT(j)]); sum += c; cnt += (c > 0u) ? 1u : 0u; mine = (j == x) ? c : mine; }
        if (sum == G) break;
        __builtin_amdgcn_s_sleep(1);
        if ((++sp & 255u) == 0u) { if (xb_ld(&bar[XB_TMO])) break; if (sp > XB_SPIN_CAP) { atomicAdd(&bar[XB_TMO], 1u); break; } }
    }
    nloc = mine > 0u ? mine : 1u; nx = cnt > 0u ? cnt : 1u;
}
__device__ __forceinline__ void xcd_barrier(const XcdBarrier& b) {
    asm volatile("s_waitcnt vmcnt(0)" ::: "memory");
    __syncthreads();
    if (threadIdx.x == 0) {
        unsigned* bar = b.bar;
        __builtin_amdgcn_s_waitcnt(0);
        unsigned nloc = b.st[0], nx = b.st[1];
        if (nloc == 0u) { xcd_barrier_complete(bar, b.x, nloc, nx); b.st[0] = nloc; b.st[1] = nx; }
        const unsigned old = xb_add(&bar[XB_XSUB(b.x)], 1u);
        const unsigned gen = old / nloc;
        if (old + 1u == (gen + 1u) * nloc) {
            __builtin_amdgcn_fence(__ATOMIC_RELEASE, "agent");
            asm volatile("s_waitcnt vmcnt(0)" ::: "memory");
            const unsigned og = xb_add(&bar[XB_TOP], 1u);
            const unsigned tg = og / nx;
            if (og + 1u == (tg + 1u) * nx) xb_add(&bar[XB_TOPGEN], 1u);
            else XB_SPIN(xb_ld(&bar[XB_TOPGEN]) == tg, bar);
            __builtin_amdgcn_fence(__ATOMIC_ACQUIRE, "agent");
            xb_add(&bar[XB_XGEN(b.x)], 1u);
            asm volatile("s_waitcnt vmcnt(0)" ::: "memory");
        } else {
            XB_SPIN(xb_ld(&bar[XB_XGEN(b.x)]) == gen, bar);
            __builtin_amdgcn_fence(__ATOMIC_ACQUIRE, "agent");
            asm volatile("s_waitcnt vmcnt(0)" ::: "memory");
        }
    }
    __syncthreads();
}
namespace pg8 {
constexpr int BM = 256, BK = 64, HALF = 128, HTB = HALF * BK * 2, STAGE_BYTES = 8 * HTB, NXCD = 8, WGM = 8;
__host__ __device__ __forceinline__ int lds_byte(int r, int c) { const int st = (r >> 4) * 2 + (c >> 5), rr = r & 15, cc = c & 31, ob = rr * 64 + cc * 2; return st * 1024 + (ob ^ (((ob >> 9) & 1) << 5)); }
__host__ __device__ __forceinline__ void stage_rc(int b, int& R, int& C) { const int st = b / 1024, sb = b % 1024, swz = sb ^ (((sb >> 9) & 1) << 5); R = (st >> 1) * 16 + swz / 64; C = (st & 1) * 32 + (swz % 64) / 2; }
__host__ __device__ __forceinline__ int perm32(int rho) { const int n = rho >> 4, i = rho & 15; return 8 * (i >> 2) + 4 * n + (i & 3); }

struct Unit { int pm, pn; };
struct Sched {
    int nM, nN, nwg, G, c;
    __device__ __forceinline__ void init(int nM_, int nN_, int G_, int c_) { nM = nM_; nN = nN_; nwg = nM * nN; G = G_; c = c_; }
    int head = 0, headM0 = 0;
    __device__ __forceinline__ bool next(int i, Unit& u) const {
        long L = (long)i * G + c;
        if (L < head) { u.pm = headM0 + (int)L / nN; u.pn = (int)L % nN; return true; }
        L -= head; if (L >= nwg) return false;
        int wgid = (int)L; { const int q = nwg / NXCD, r = nwg % NXCD, xcd = wgid % NXCD, off = wgid / NXCD; wgid = (xcd < r ? xcd * (q + 1) : r * (q + 1) + (xcd - r) * q) + off; }
        const int nig = WGM * nN, gid = wgid / nig, fm = gid * WGM, gsz = (nM - fm) < WGM ? (nM - fm) : WGM;
        u.pm = fm + ((wgid % nig) % gsz); u.pn = (wgid % nig) / gsz; return true;
    }
};
typedef f32x4 Acc[2][2][4][2];
#define PG8_NO_GATHER __device__ __forceinline__ int arow(const Unit&, int) const { return 0; }
#define PG8_NO_LITE static constexpr bool LITE = false; __device__ __forceinline__ bool lite(const Unit&) const { return false; }

template <class Op>
__device__ __forceinline__ void gemm_phase(LAS unsigned char* lds, const Op& op, const Sched& S, int tid) {
    asm volatile("" : "+v"(tid));
    const int wid = __builtin_amdgcn_readfirstlane(tid >> 6), lane = tid & 63, wr = wid >> 2, wc = wid & 3, fr = lane & 15, fq = lane >> 4;
    const int K = op.K, nt = K / BK, lda = op.lda, ldb = op.ldb;
    unsigned voffA[2], voffB[2]; int RA[2];
#pragma unroll
    for (int i = 0; i < 2; ++i) { int R, C; stage_rc(tid * 16 + i * 8192, R, C); const int Rb = Op::PERM ? ((R & ~31) + perm32(R & 31)) : R; RA[i] = R;
        voffA[i] = Op::GATHER ? (unsigned)C * 2u : (unsigned)(R * lda + C) * 2u; voffB[i] = (unsigned)(Rb * ldb + C) * 2u; }
    unsigned ga[2][2], gn[2][2];
#define PG8_GROWS(G, U) do { _Pragma("unroll") for (int _h = 0; _h < 2; ++_h) _Pragma("unroll") for (int _i = 0; _i < 2; ++_i) G[_h][_i] = (unsigned)op.arow(U, _h * HALF + RA[_i]) * (unsigned)(lda * 2); } while (0)
    const size_t kstep = (size_t)(BK * 2);
    const size_t hstepA = (size_t)HALF * lda * 2, hstepB = (size_t)HALF * ldb * 2;
    const unsigned ldsw = (unsigned)wid * 1024u;
    const int aoff = lds_byte(wr * 64 + fr, fq * 8), boff = lds_byte(wc * 32 + fr, fq * 8);
#define PG8_SA(b, h) (((b) * 2 + (h)) * HTB)
#define PG8_SB(b, h) ((4 + (b) * 2 + (h)) * HTB)
#define PG8_STAGE(bufoff, gbase, voff) do { _Pragma("unroll") for (int _i = 0; _i < 2; ++_i) \
        __builtin_amdgcn_global_load_lds((const unsigned*)((const char*)(gbase) + (voff)[_i]), (LAS unsigned*)(lds + (bufoff) + ldsw + _i * 8192), 16, 0, 0); } while (0)
#define PG8_STAGE_A(bufoff, sel, h, kb) do { _Pragma("unroll") for (int _i = 0; _i < 2; ++_i) { const char* _p; \
        if constexpr (Op::GATHER) _p = (const char*)op.A + (kb) + (size_t)(((sel) ? gn[h][_i] : ga[h][_i]) + voffA[_i]); \
        else _p = ((sel) ? nA : cA) + (size_t)(h) * hstepA + (kb) + voffA[_i]; \
        __builtin_amdgcn_global_load_lds((const unsigned*)_p, (LAS unsigned*)(lds + (bufoff) + ldsw + _i * 8192), 16, 0, 0); } } while (0)
#define PG8_LDA(dst, b, h) do { _Pragma("unroll") for (int m = 0; m < 4; ++m) _Pragma("unroll") for (int k = 0; k < 2; ++k) dst[m][k] = *(const LAS bf16x8*)(lds + PG8_SA(b, h) + aoff + m * 2048 + k * 1024); } while (0)
#define PG8_LDB(dst, b, h) do { _Pragma("unroll") for (int n = 0; n < 2; ++n) _Pragma("unroll") for (int k = 0; k < 2; ++k) dst[n][k] = *(const LAS bf16x8*)(lds + PG8_SB(b, h) + boff + n * 2048 + k * 1024); } while (0)
#define PG8_MMA(ai, bj, At, Bt) do { if (Op::LITE && lite && ((ai) == 1 || wr == 1)) break; __builtin_amdgcn_s_setprio(1); _Pragma("unroll") for (int m = 0; m < 4; ++m) _Pragma("unroll") for (int n = 0; n < 2; ++n) _Pragma("unroll") for (int k = 0; k < 2; ++k) \
        acc[ai][bj][m][n] = __builtin_amdgcn_mfma_f32_16x16x32_bf16(Bt[n][k], At[m][k], acc[ai][bj][m][n], 0, 0, 0); __builtin_amdgcn_s_setprio(0); } while (0)
#define PG8_WAIT_V(n) asm volatile("s_waitcnt vmcnt(" #n ")" ::: "memory")
#define PG8_WAIT_L(n) asm volatile("s_waitcnt lgkmcnt(" #n ")" ::: "memory")
#define PG8_BAR __builtin_amdgcn_s_barrier()
#define PG8_SCHED __builtin_amdgcn_sched_barrier(0)
    Unit cur, nxt; int ui = 0;
    if (!S.next(0, cur)) return;
    bool lite = Op::LITE ? op.lite(cur) : false;
    Acc acc;
#pragma unroll
    for (int a = 0; a < 2; ++a)
#pragma unroll
        for (int b = 0; b < 2; ++b)
#pragma unroll
            for (int m = 0; m < 4; ++m)
#pragma unroll
                for (int n = 0; n < 2; ++n) acc[a][b][m][n] = (f32x4){0.f, 0.f, 0.f, 0.f};
    bf16x8 At[4][2], B0[2][2], B1[2][2];
    const char* cA = (const char*)op.A + op.aoff(cur); const char* cB = (const char*)op.Bt + op.boff(cur); const char* nA = cA;
    if constexpr (Op::GATHER) { PG8_GROWS(ga, cur); if (S.next(1, nxt)) PG8_GROWS(gn, nxt); else PG8_GROWS(gn, cur);
        asm volatile("" :: "v"(ga[0][0]), "v"(ga[0][1]), "v"(ga[1][0]), "v"(ga[1][1]), "v"(gn[0][0]), "v"(gn[0][1]), "v"(gn[1][0]), "v"(gn[1][1])); }
    PG8_STAGE(PG8_SB(0, 0), cB, voffB); PG8_STAGE(PG8_SB(0, 1), cB + hstepB, voffB); PG8_STAGE_A(PG8_SA(0, 0), false, 0, 0); PG8_STAGE_A(PG8_SA(0, 1), false, 1, 0);
    if (wr == 1) PG8_BAR;
    PG8_WAIT_V(2); PG8_BAR;
    PG8_STAGE(PG8_SB(1, 0), cB + kstep, voffB); PG8_STAGE_A(PG8_SA(1, 0), false, 0, kstep); PG8_STAGE(PG8_SB(1, 1), cB + hstepB + kstep, voffB);
    PG8_WAIT_V(6); PG8_BAR;
    for (;;) {
        const bool has_next = S.next(ui + 1, nxt);
        nA = has_next ? (const char*)op.A + op.aoff(nxt) : cA; const char* nB = has_next ? (const char*)op.Bt + op.boff(nxt) : cB;
        for (int t = 0; t < nt; t += 2) {
            const bool last = (t == nt - 2), seln = last && has_next;
            const size_t k1 = (size_t)(t + 1) * kstep, k2 = last ? 0 : (size_t)(t + 2) * kstep, k3 = k2 + kstep;
            const char* b2 = last ? nB : cB + (size_t)(t + 2) * kstep; const char* b3 = b2 + kstep;
            PG8_LDB(B0, 0, 0); PG8_LDB(B1, 0, 1); PG8_SCHED; PG8_LDA(At, 0, 0); PG8_STAGE_A(PG8_SA(1, 1), false, 1, k1);
            PG8_WAIT_V(8); PG8_WAIT_L(0); PG8_BAR; PG8_MMA(0, 0, At, B0); PG8_MMA(0, 1, At, B1); PG8_BAR; PG8_SCHED;
            PG8_LDA(At, 0, 1); PG8_STAGE(PG8_SB(0, 0), b2, voffB); PG8_STAGE(PG8_SB(0, 1), b2 + hstepB, voffB); PG8_STAGE_A(PG8_SA(0, 0), seln, 0, k2);
            PG8_WAIT_V(8); PG8_WAIT_L(0); PG8_BAR; PG8_MMA(1, 0, At, B0); PG8_MMA(1, 1, At, B1); PG8_BAR; PG8_SCHED;
            PG8_LDB(B0, 1, 0); PG8_LDB(B1, 1, 1); PG8_SCHED; PG8_LDA(At, 1, 0); PG8_STAGE_A(PG8_SA(0, 1), seln, 1, k2);
            PG8_WAIT_V(8); PG8_WAIT_L(0); PG8_BAR; PG8_MMA(0, 0, At, B0); PG8_MMA(0, 1, At, B1); PG8_BAR; PG8_SCHED;
            PG8_LDA(At, 1, 1); PG8_STAGE(PG8_SB(1, 0), b3, voffB); PG8_STAGE(PG8_SB(1, 1), b3 + hstepB, voffB); PG8_STAGE_A(PG8_SA(1, 0), seln, 0, k3);
            PG8_WAIT_V(8); PG8_WAIT_L(0); PG8_BAR; PG8_MMA(1, 0, At, B0); PG8_MMA(1, 1, At, B1); PG8_BAR; PG8_SCHED;
        }
        if (wr == 0) PG8_BAR;
        op(acc, cur, wr, wc, fr, fq);
        if (!has_next) break;
#pragma unroll
        for (int a = 0; a < 2; ++a)
#pragma unroll
            for (int b = 0; b < 2; ++b)
#pragma unroll
                for (int m = 0; m < 4; ++m)
#pragma unroll
                    for (int n = 0; n < 2; ++n) acc[a][b][m][n] = (f32x4){0.f, 0.f, 0.f, 0.f};
        cur = nxt; cA = nA; cB = nB; ++ui; lite = Op::LITE ? op.lite(cur) : false;
        if constexpr (Op::GATHER) {
#pragma unroll
            for (int _h = 0; _h < 2; ++_h)
#pragma unroll
                for (int _i = 0; _i < 2; ++_i) ga[_h][_i] = gn[_h][_i];
            Unit n2; if (S.next(ui + 1, n2)) PG8_GROWS(gn, n2);
            asm volatile("" :: "v"(gn[0][0]), "v"(gn[0][1]), "v"(gn[1][0]), "v"(gn[1][1]));
        }
        if (wr == 1) PG8_BAR;
    }
    PG8_WAIT_V(0);
    PG8_BAR;
#undef PG8_SA
#undef PG8_SB
#undef PG8_STAGE
#undef PG8_STAGE_A
#undef PG8_GROWS
#undef PG8_LDA
#undef PG8_LDB
#undef PG8_MMA
#undef PG8_WAIT_V
#undef PG8_WAIT_L
#undef PG8_BAR
#undef PG8_SCHED
}

__device__ __forceinline__ u32x4 pack8(const f32x4 a, const f32x4 b) { u32x4 w; w.x = cvt_pk_bf16(a[0], a[1]); w.y = cvt_pk_bf16(a[2], a[3]); w.z = cvt_pk_bf16(b[0], b[1]); w.w = cvt_pk_bf16(b[2], b[3]); return w; }
__device__ __forceinline__ int moe_expert(int pm) { return pm < 256 ? (pm >> 4) : (pm - 256); }

template <bool MOE> struct OpStore {
    static constexpr bool PERM = true, GATHER = false; PG8_NO_GATHER static constexpr bool LITE = MOE; __device__ __forceinline__ bool lite(const Unit& u) const { return MOE && u.pm >= 256; }
    const bf16_t* A; const bf16_t* Bt; int lda, ldb, K; bf16_t* out; int ldc; const float* bias;
    __device__ __forceinline__ size_t aoff(const Unit& u) const { return (size_t)u.pm * 256 * lda * 2; }
    __device__ __forceinline__ size_t boff(const Unit& u) const { return MOE ? ((size_t)moe_expert(u.pm) * 2048 + (size_t)u.pn * 256) * ldb * 2 : (size_t)u.pn * 256 * ldb * 2; }
    __device__ __forceinline__ void operator()(const Acc& acc, const Unit& u, int wr, int wc, int fr, int fq) const {
        const int row0 = u.pm * 256 + wr * 64 + fr, col0 = u.pn * 256 + wc * 32 + 8 * fq;
#pragma unroll
        for (int ai = 0; ai < 2; ++ai)
#pragma unroll
            for (int m = 0; m < 4; ++m) { bf16_t* rowp = out + (size_t)(row0 + ai * 128 + m * 16) * ldc + col0;
#pragma unroll
                for (int bj = 0; bj < 2; ++bj) { f32x4 v0 = acc[ai][bj][m][0], v1 = acc[ai][bj][m][1];
                    if (bias) { v0 += *(const f32x4*)(bias + col0 + bj * 128); v1 += *(const f32x4*)(bias + col0 + bj * 128 + 4); }
                    *(u32x4*)(rowp + bj * 128) = pack8(v0, v1); } }
    }
};
struct OpWin {
    static constexpr bool PERM = true, GATHER = false; PG8_NO_GATHER PG8_NO_LITE
    const bf16_t* A; const bf16_t* Bt; int lda, ldb, K; bf16_t* a3; bf16_t* zf;
    __device__ __forceinline__ size_t aoff(const Unit& u) const { return (size_t)u.pm * 256 * lda * 2; }
    __device__ __forceinline__ size_t boff(const Unit& u) const { return (size_t)u.pn * 256 * ldb * 2; }
    __device__ __forceinline__ void operator()(const Acc& acc, const Unit& u, int wr, int wc, int fr, int fq) const {
        const int row0 = u.pm * 256 + wr * 64 + fr, col0 = u.pn * 256 + wc * 32 + 8 * fq;
#pragma unroll
        for (int ai = 0; ai < 2; ++ai)
#pragma unroll
            for (int m = 0; m < 4; ++m) { const int row = row0 + ai * 128 + m * 16;
#pragma unroll
                for (int bj = 0; bj < 2; ++bj) { const int c = col0 + bj * 128; const u32x4 w = pack8(acc[ai][bj][m][0], acc[ai][bj][m][1]);
                    if (u.pn < 4) { const int g = c >> 4; *(u32x4*)(a3 + ((size_t)(g * NCHP + (row >> 5)) * A3K + (row & 31) * 16 + (c & 15))) = w; }
                    else *(u32x4*)(zf + (size_t)row * 1024 + (c - 1024)) = w; } }
    }
};
struct OpL1 {
    static constexpr bool PERM = false, GATHER = false; PG8_NO_GATHER PG8_NO_LITE
    const bf16_t* A; const bf16_t* Bt; int lda, ldb, K; float* sum;
    __device__ __forceinline__ size_t aoff(const Unit& u) const { const int g = u.pm / 5, rt = u.pm % 5; return (size_t)(g * NCHP + rt * 256) * A3K * 2; }
    __device__ __forceinline__ size_t boff(const Unit& u) const { return (size_t)(u.pm / 5) * 256 * 512 * 2; }
    __device__ __forceinline__ void operator()(const Acc& acc, const Unit& u, int wr, int wc, int fr, int fq) const {
        const int g = u.pm / 5, rt = u.pm % 5, row0 = rt * 256 + wr * 64 + fr, col0 = wc * 32 + 4 * fq;
#pragma unroll
        for (int ai = 0; ai < 2; ++ai)
#pragma unroll
            for (int m = 0; m < 4; ++m) { float* rowp = sum + ((size_t)(g * NCHP + row0 + ai * 128 + m * 16)) * 256 + col0;
#pragma unroll
                for (int bj = 0; bj < 2; ++bj)
#pragma unroll
                    for (int n = 0; n < 2; ++n) *(f32x4*)(rowp + bj * 128 + n * 16) = acc[ai][bj][m][n]; }
    }
};
struct OpL3 {
    static constexpr bool PERM = true, GATHER = false; PG8_NO_GATHER PG8_NO_LITE
    const bf16_t* A; const bf16_t* Bt; int lda, ldb, K; bf16_t* gout;
    __device__ __forceinline__ size_t aoff(const Unit& u) const { const int g = u.pm / 5, rt = u.pm % 5; return (size_t)(g * NCHP + rt * 256) * A3K * 2; }
    __device__ __forceinline__ size_t boff(const Unit& u) const { return ((size_t)(u.pm / 5) * 512 + (size_t)u.pn * 256) * A3K * 2; }
    __device__ __forceinline__ void operator()(const Acc& acc, const Unit& u, int wr, int wc, int fr, int fq) const {
        const int g = u.pm / 5, rt = u.pm % 5, row0 = rt * 256 + wr * 64 + fr, col0 = u.pn * 256 + wc * 32 + 8 * fq;
#pragma unroll
        for (int ai = 0; ai < 2; ++ai)
#pragma unroll
            for (int m = 0; m < 4; ++m) { const int chunk = row0 + ai * 128 + m * 16;
                if (chunk < NCH) {
#pragma unroll
                    for (int bj = 0; bj < 2; ++bj) { const int c = col0 + bj * 128, t = c >> 4, co = c & 15; f32x4 v0 = acc[ai][bj][m][0], v1 = acc[ai][bj][m][1];
#pragma unroll
                        for (int i = 0; i < 4; ++i) { v0[i] = gelu_tanh(v0[i]); v1[i] = gelu_tanh(v1[i]); }
                        *(u32x4*)(gout + ((size_t)(chunk * 32 + t)) * 1024 + g * 16 + co) = pack8(v0, v1); } } }
    }
};
struct OpGlu {
    static constexpr bool PERM = true, GATHER = false; PG8_NO_GATHER PG8_NO_LITE
    const bf16_t* A; const bf16_t* Bt; int lda, ldb, K; const float* bias; bf16_t* cat;
    __device__ __forceinline__ size_t aoff(const Unit& u) const { return (size_t)u.pm * 256 * lda * 2; }
    __device__ __forceinline__ size_t boff(const Unit& u) const { return (size_t)u.pn * 256 * ldb * 2; }
    __device__ __forceinline__ void operator()(const Acc& acc, const Unit& u, int wr, int wc, int fr, int fq) const {
        const int row0 = u.pm * 256 + wr * 64 + fr, col0 = u.pn * 256 + wc * 32 + 8 * fq;
#pragma unroll
        for (int ai = 0; ai < 2; ++ai)
#pragma unroll
            for (int m = 0; m < 4; ++m) { const int row = row0 + ai * 128 + m * 16;
#pragma unroll
                for (int bj = 0; bj < 2; ++bj) { const int c = col0 + bj * 128;
                    const f32x4 b0 = *(const f32x4*)(bias + c), b1 = *(const f32x4*)(bias + c + 4);
                    const u32x4 gw = *(const u32x4*)(A + (size_t)row * 1024 + c);
                    f32x4 g0, g1; g0[0] = bf2f(gw.x & 0xffffu); g0[1] = bf2f(gw.x >> 16); g0[2] = bf2f(gw.y & 0xffffu); g0[3] = bf2f(gw.y >> 16);
                    g1[0] = bf2f(gw.z & 0xffffu); g1[1] = bf2f(gw.z >> 16); g1[2] = bf2f(gw.w & 0xffffu); g1[3] = bf2f(gw.w >> 16);
                    f32x4 v0 = acc[ai][bj][m][0] + b0, v1 = acc[ai][bj][m][1] + b1;
#pragma unroll
                    for (int i = 0; i < 4; ++i) { v0[i] = g0[i] * sigmoid_fast(v0[i]); v1[i] = g1[i] * sigmoid_fast(v1[i]); }
                    *(u32x4*)(cat + (size_t)row * 2048 + c) = pack8(v0, v1); } }
    }
};
struct OpFftA {
    static constexpr bool PERM = true, GATHER = false; PG8_NO_GATHER PG8_NO_LITE
    const bf16_t* A; const bf16_t* Bt; int lda, ldb, K; bf16_t* bt2;
    __device__ __forceinline__ size_t aoff(const Unit&) const { return 0; }
    __device__ __forceinline__ size_t boff(const Unit& u) const { return (size_t)u.pn * 256 * 128 * 2; }
    __device__ __forceinline__ void operator()(const Acc& acc, const Unit& u, int wr, int wc, int fr, int fq) const {
        const int l2b = wc * 32 + 8 * fq;
#pragma unroll
        for (int ai = 0; ai < 2; ++ai)
#pragma unroll
            for (int m = 0; m < 4; ++m) { const int k1 = wr * 64 + m * 16 + fr;
#pragma unroll
                for (int bj = 0; bj < 2; ++bj) { const int col = 2 * u.pn + bj;
                    *(u32x4*)(bt2 + ((size_t)(k1 * 2048 + col)) * 256 + ai * 128 + l2b) = pack8(acc[ai][bj][m][0], acc[ai][bj][m][1]); } }
    }
};
struct OpFftC {
    static constexpr bool PERM = true, GATHER = false; PG8_NO_GATHER PG8_NO_LITE
    const bf16_t* A; const bf16_t* Bt; int lda, ldb, K; bf16_t* pq;
    __device__ __forceinline__ size_t aoff(const Unit& u) const { return (size_t)(u.pn >> 3) * 256 * 256 * 2; }
    __device__ __forceinline__ size_t boff(const Unit& u) const { return (size_t)u.pn * 256 * 256 * 2; }
    __device__ __forceinline__ void operator()(const Acc& acc, const Unit& u, int wr, int wc, int fr, int fq) const {
        const int k1 = u.pn >> 3;
#pragma unroll
        for (int ai = 0; ai < 2; ++ai)
#pragma unroll
            for (int m = 0; m < 4; ++m) { const int k2 = wr * 64 + m * 16 + fr, k = k1 + 128 * k2;
#pragma unroll
                for (int bj = 0; bj < 2; ++bj) { const int colb = (u.pn & 7) * 256 + bj * 128 + wc * 32 + 8 * fq, b = colb >> 10, ch = colb & 1023, g = ch >> 8, c = ch & 255;
                    *(u32x4*)(pq + ((size_t)(b * RPB + CTX + k)) * 2048 + g * 512 + ai * 256 + c) = pack8(acc[ai][bj][m][0], acc[ai][bj][m][1]); } }
    }
};
struct OpCtxDft {
    static constexpr bool PERM = true, GATHER = false; PG8_NO_GATHER PG8_NO_LITE
    const bf16_t* A; const bf16_t* Bt; int lda, ldb, K; bf16_t* pq;
    __device__ __forceinline__ size_t aoff(const Unit& u) const { return (size_t)u.pm * 256 * 256 * 2; }
    __device__ __forceinline__ size_t boff(const Unit& u) const { return (size_t)u.pn * 256 * 256 * 2; }
    __device__ __forceinline__ void operator()(const Acc& acc, const Unit& u, int wr, int wc, int fr, int fq) const {
#pragma unroll
        for (int ai = 0; ai < 2; ++ai)
#pragma unroll
            for (int m = 0; m < 4; ++m) { const int k = ai * 128 + wr * 64 + m * 16 + fr;
#pragma unroll
                for (int bj = 0; bj < 2; ++bj) { const int colb = u.pn * 256 + bj * 128 + wc * 32 + 8 * fq, b = colb >> 10, ch = colb & 1023, g = ch >> 8, c = ch & 255;
                    *(u32x4*)(pq + ((size_t)(b * RPB + k)) * 2048 + g * 512 + u.pm * 256 + c) = pack8(acc[ai][bj][m][0], acc[ai][bj][m][1]); } }
    }
};
struct OpFnet {
    static constexpr bool PERM = true, GATHER = false; PG8_NO_GATHER PG8_NO_LITE
    const bf16_t* A; const bf16_t* Bt; int lda, ldb, K; const float* bias; bf16_t* cat;
    __device__ __forceinline__ size_t aoff(const Unit& u) const { return (size_t)u.pm * 256 * lda * 2 + (size_t)u.pn * 512 * 2; }
    __device__ __forceinline__ size_t boff(const Unit& u) const { return (size_t)u.pn * 256 * 512 * 2; }
    __device__ __forceinline__ void operator()(const Acc& acc, const Unit& u, int wr, int wc, int fr, int fq) const {
        const int row0 = u.pm * 256 + wr * 64 + fr, col0 = u.pn * 256 + wc * 32 + 8 * fq;
#pragma unroll
        for (int ai = 0; ai < 2; ++ai)
#pragma unroll
            for (int m = 0; m < 4; ++m) { const int row = row0 + ai * 128 + m * 16;
#pragma unroll
                for (int bj = 0; bj < 2; ++bj) { const int c = col0 + bj * 128;
                    const f32x4 v0 = acc[ai][bj][m][0] + *(const f32x4*)(bias + c), v1 = acc[ai][bj][m][1] + *(const f32x4*)(bias + c + 4);
                    *(u32x4*)(cat + (size_t)row * 2048 + 1024 + c) = pack8(v0, v1); } }
    }
};
struct OpM1 {
    static constexpr bool PERM = true, GATHER = true, LITE = true; __device__ __forceinline__ bool lite(const Unit& u) const { return u.pm >= 256; }
    const bf16_t* A; const bf16_t* Bt; int lda, ldb, K; bf16_t* hid; const int* idx;
    __device__ __forceinline__ size_t aoff(const Unit&) const { return 0; }
    __device__ __forceinline__ int arow(const Unit& u, int r) const { const int m = u.pm * 256 + r; const bool ok = m < NEXP * 4096 || ((m - NEXP * 4096) & 255) < 2 * CAP_C; return ok ? idx[m] : 0; }
    __device__ __forceinline__ size_t boff(const Unit& u) const { return ((size_t)moe_expert(u.pm) * 2048 + (size_t)u.pn * 256) * ldb * 2; }
    __device__ __forceinline__ void operator()(const Acc& acc, const Unit& u, int wr, int wc, int fr, int fq) const {
        const int row0 = u.pm * 256 + wr * 64 + fr, f0 = u.pn * 128 + wc * 16 + 4 * fq;
#pragma unroll
        for (int ai = 0; ai < 2; ++ai)
#pragma unroll
            for (int m = 0; m < 4; ++m) { bf16_t* rowp = hid + (size_t)(row0 + ai * 128 + m * 16) * EFF + f0;
#pragma unroll
                for (int bj = 0; bj < 2; ++bj) { const f32x4 gt = acc[ai][bj][m][0], up = acc[ai][bj][m][1]; f32x4 h;
#pragma unroll
                    for (int i = 0; i < 4; ++i) h[i] = gt[i] * sigmoid_fast(gt[i]) * up[i];
                    u32x2 w; w.x = cvt_pk_bf16(h[0], h[1]); w.y = cvt_pk_bf16(h[2], h[3]);
                    *(u32x2*)(rowp + bj * 64) = w; } }
    }
};
}
namespace att {
constexpr int D = 128, NW = 8, QBLK = 32, KVBLK = 64;
constexpr float SCALE = 0.088388347648318440f;
constexpr float THR = 8.f;
constexpr int LDQ = 3072, LDK = 3072, LDO = 2048;
constexpr size_t SHM_V = KVBLK * D * 2, SHM_K = KVBLK * D * 2, SHM_ATTN = 2 * SHM_V + 2 * SHM_K + NW * 64 * 4;
#define KSWZ(row, colB) ((row) * 256 + ((colB) ^ (((row) & 7) << 4)))
#define SBAR() __builtin_amdgcn_sched_barrier(0)
__device__ __forceinline__ int crow(int r, int hi) { return (r & 3) + 8 * (r >> 2) + 4 * hi; }
__device__ __forceinline__ unsigned cvtpk(float lo, float hi) { unsigned r; asm volatile("v_cvt_pk_bf16_f32 %0, %1, %2" : "=v"(r) : "v"(lo), "v"(hi)); return r; }

__device__ __forceinline__ void partialSM(f32x16& p0, f32x16& p1, float& m_reg, float& mn, float& alpha) {
  constexpr float C = SCALE * 1.4426950408889634f;
  float pmax = p0[0]; for (int r = 1; r < 16; ++r) pmax = fmaxf(pmax, p0[r]); for (int r = 0; r < 16; ++r) pmax = fmaxf(pmax, p1[r]);
  { auto rr = __builtin_amdgcn_permlane32_swap(__float_as_uint(pmax), __float_as_uint(pmax), false, false);
    pmax = fmaxf(__uint_as_float(rr[0]), __uint_as_float(rr[1])); }
  if (__builtin_expect(__all(pmax - m_reg <= THR / SCALE), 1)) { mn = m_reg; alpha = 1.f; }
  else { mn = fmaxf(m_reg, pmax); alpha = __builtin_amdgcn_exp2f((m_reg - mn) * C); m_reg = mn; }
  float mnC = -mn * C;
  for (int r = 0; r < 16; ++r) p0[r] = fmaf(p0[r], C, mnC); for (int r = 0; r < 16; ++r) p1[r] = fmaf(p1[r], C, mnC);
  for (int r = 0; r < 16; ++r) p0[r] = __builtin_amdgcn_exp2f(p0[r]);
}
__device__ __forceinline__ void partialSM_fix(f32x16& p0, f32x16& p1) {
  for (int r = 0; r < 16; ++r) p0[r] = __builtin_amdgcn_exp2f(p0[r]);
}
__device__ __forceinline__ void finishSM(f32x16& p0, f32x16& p1, float alpha, float& l_reg, bf16x8& pa0, bf16x8& pa1, bf16x8& pa2, bf16x8& pa3) {
  for (int r = 0; r < 16; ++r) p1[r] = __builtin_amdgcn_exp2f(p1[r]);
  float ps = 0; for (int r = 0; r < 16; ++r) ps += p0[r]; for (int r = 0; r < 16; ++r) ps += p1[r];
  { auto rr = __builtin_amdgcn_permlane32_swap(__float_as_uint(ps), __float_as_uint(ps), false, false);
    ps = __uint_as_float(rr[0]) + __uint_as_float(rr[1]); }
  l_reg = l_reg * alpha + ps;
#define PK4(P, BASE, OUT) do { unsigned a0 = cvtpk(P[BASE + 0], P[BASE + 1]), a1 = cvtpk(P[BASE + 2], P[BASE + 3]);   \
    unsigned b0 = cvtpk(P[BASE + 4], P[BASE + 5]), b1 = cvtpk(P[BASE + 6], P[BASE + 7]);                              \
    auto r0 = __builtin_amdgcn_permlane32_swap(a0, b0, false, false); auto r1 = __builtin_amdgcn_permlane32_swap(a1, b1, false, false); \
    u32x4 w = {r0[0], r1[0], r0[1], r1[1]}; OUT = *reinterpret_cast<bf16x8*>(&w); } while (0)
  PK4(p0, 0, pa0); PK4(p0, 8, pa1); PK4(p1, 0, pa2); PK4(p1, 8, pa3);
#undef PK4
}
__device__ __forceinline__ void partialSM_fix2(f32x16& p0, float& l_reg) {
  for (int r = 0; r < 16; ++r) { p0[r] = __builtin_amdgcn_exp2f(p0[r]); l_reg += p0[r]; }
}
__device__ __forceinline__ void finishSM2(f32x16& p0, f32x16& p1, float& l_reg, bf16x8& pa0, bf16x8& pa1, bf16x8& pa2, bf16x8& pa3) {
#define PK4(P, BASE, OUT) do { unsigned a0 = cvtpk(P[BASE + 0], P[BASE + 1]), a1 = cvtpk(P[BASE + 2], P[BASE + 3]);   \
    unsigned b0 = cvtpk(P[BASE + 4], P[BASE + 5]), b1 = cvtpk(P[BASE + 6], P[BASE + 7]);                              \
    u32x4 w = {a0, a1, b0, b1}; OUT = *reinterpret_cast<bf16x8*>(&w); } while (0)
  PK4(p0, 0, pa0); PK4(p0, 8, pa1);
  for (int r = 0; r < 8; ++r) { p1[r] = __builtin_amdgcn_exp2f(p1[r]); l_reg += p1[r]; }
  PK4(p1, 0, pa2);
  for (int r = 8; r < 16; ++r) { p1[r] = __builtin_amdgcn_exp2f(p1[r]); l_reg += p1[r]; }
  PK4(p1, 8, pa3);
#undef PK4
}
__device__ __forceinline__ void qkt(f32x16& p0, f32x16& p1, const bf16_t* Ks, const bf16x8* qr, int r32, int hi) {
  p0 = f32x16{}; p1 = f32x16{};
  for (int d0 = 0; d0 < 8; ++d0) { int cb = (d0 * 16 + hi * 8) * 2;
    bf16x8 b0 = *reinterpret_cast<const bf16x8*>((const char*)Ks + KSWZ(r32, cb));
    bf16x8 b1 = *reinterpret_cast<const bf16x8*>((const char*)Ks + KSWZ(32 + r32, cb));
    p0 = __builtin_amdgcn_mfma_f32_32x32x16_bf16(b0, qr[d0], p0, 0, 0, 0);
    p1 = __builtin_amdgcn_mfma_f32_32x32x16_bf16(b1, qr[d0], p1, 0, 0, 0); }
}
__device__ __forceinline__ int v_st(int k, int c) { const int kk = (k & ~0xC) | ((k & 4) << 1) | ((k & 8) >> 1); return ((kk >> 3) * 4 + (c >> 5)) * 512 + ((kk & 7) * 32 + (c & 31)) * 2; }
__device__ __forceinline__ int v_rd_base(int lane) { return ((lane & 3) << 3) | (((lane >> 2) & 3) << 6) | (((lane >> 4) & 1) << 5) | (((lane >> 5) & 1) << 8); }
constexpr int v_rd_off(int d0, int ks, int half) { return d0 * 512 + ks * 4096 + half * 2048; }
template <int OFF> __device__ __forceinline__ s16x4 tr_read(int vb) {
  s16x4 r; asm volatile("ds_read_b64_tr_b16 %0, %1 offset:%2" : "=&v"(r) : "v"(vb), "i"(OFF) : "memory"); return r;
}
template <int D0> __device__ __forceinline__ void pv_one(f32x16& od, int vb, bf16x8 pa0, bf16x8 pa1, bf16x8 pa2, bf16x8 pa3) {
  const s16x4 l0 = tr_read<v_rd_off(D0, 0, 0)>(vb), h0 = tr_read<v_rd_off(D0, 0, 1)>(vb), l1 = tr_read<v_rd_off(D0, 1, 0)>(vb), h1 = tr_read<v_rd_off(D0, 1, 1)>(vb);
  const s16x4 l2 = tr_read<v_rd_off(D0, 2, 0)>(vb), h2 = tr_read<v_rd_off(D0, 2, 1)>(vb), l3 = tr_read<v_rd_off(D0, 3, 0)>(vb), h3 = tr_read<v_rd_off(D0, 3, 1)>(vb);
  asm volatile("s_waitcnt lgkmcnt(0)" ::: "memory"); SBAR();
#define PK(L, H) (bf16x8){L[0], L[1], L[2], L[3], H[0], H[1], H[2], H[3]}
  od = __builtin_amdgcn_mfma_f32_32x32x16_bf16(pa0, PK(l0, h0), od, 0, 0, 0);
  od = __builtin_amdgcn_mfma_f32_32x32x16_bf16(pa1, PK(l1, h1), od, 0, 0, 0);
  od = __builtin_amdgcn_mfma_f32_32x32x16_bf16(pa2, PK(l2, h2), od, 0, 0, 0);
  od = __builtin_amdgcn_mfma_f32_32x32x16_bf16(pa3, PK(l3, h3), od, 0, 0, 0);
#undef PK
}
__device__ __forceinline__ void pv_d0(f32x16* o, int vb, bf16x8 pa0, bf16x8 pa1, bf16x8 pa2, bf16x8 pa3) {
  pv_one<0>(o[0], vb, pa0, pa1, pa2, pa3); pv_one<1>(o[1], vb, pa0, pa1, pa2, pa3); pv_one<2>(o[2], vb, pa0, pa1, pa2, pa3); pv_one<3>(o[3], vb, pa0, pa1, pa2, pa3);
}
template <bool FIXM>
__device__ __forceinline__ void attn_dense_body(const bf16_t* __restrict__ Qb, const bf16_t* __restrict__ Kh, const bf16_t* __restrict__ Vh,
                                                bf16_t* __restrict__ Ob, int seq, char* lds, int tid, float mfixC) {
  asm volatile("" : "+v"(tid));
  const int wid = tid >> 6, lane = tid & 63, r32 = lane & 31, hi = lane >> 5;
  bf16_t* V_lds = (bf16_t*)lds; bf16_t* K_lds = (bf16_t*)(lds + 2 * SHM_V);
  float* ws = (float*)(lds + 2 * SHM_V + 2 * SHM_K) + wid * 64; float* li_l = ws; float* al_l = ws + 32;
  float m_reg = -1e30f, l_reg = 0; f32x16 o[4] = {}; bf16x8 qr[8];
  const bf16_t* Qw = Qb + (long)(wid * QBLK + r32) * LDQ + hi * 8;
#pragma unroll
  for (int d0 = 0; d0 < 8; ++d0) qr[d0] = *reinterpret_cast<const bf16x8*>(Qw + d0 * 16);
  const int sr = tid >> 4, sc = (tid & 15) * 8, vst0 = v_st(sr, sc), vst1 = v_st(32 + sr, sc);
  const int vb0 = (int)(uintptr_t)V_lds + v_rd_base(lane);
  struct { bf16x8 vs0, vs1, ks0, ks1; } sr_[2];
#define SLOAD(i, k0) do { sr_[i].vs0 = *reinterpret_cast<const bf16x8*>(&Vh[(long)((k0) + sr) * LDK + sc]); sr_[i].vs1 = *reinterpret_cast<const bf16x8*>(&Vh[(long)((k0) + 32 + sr) * LDK + sc]); \
    sr_[i].ks0 = *reinterpret_cast<const bf16x8*>(&Kh[(long)((k0) + sr) * LDK + sc]); sr_[i].ks1 = *reinterpret_cast<const bf16x8*>(&Kh[(long)((k0) + 32 + sr) * LDK + sc]); } while (0)
#define SWRITE(b, i) do { *(bf16x8*)((char*)V_lds + (b) * SHM_V + vst0) = sr_[i].vs0;          \
    *(bf16x8*)((char*)V_lds + (b) * SHM_V + vst1) = sr_[i].vs1; int kc = sc * 2;               \
    *(bf16x8*)((char*)K_lds + (b) * SHM_K + KSWZ(sr, kc)) = sr_[i].ks0;                       \
    *(bf16x8*)((char*)K_lds + (b) * SHM_K + KSWZ(32 + sr, kc)) = sr_[i].ks1; } while (0)
#define SWAIT() asm volatile("s_waitcnt vmcnt(4)" ::: "memory")
#define PSM(P0, P1, MN, AL) do { if constexpr (FIXM) { SBAR(); partialSM_fix(P0, P1); AL = 1.f; SBAR(); } else partialSM(P0, P1, m_reg, MN, AL); } while (0)
#define RESC(a) do { if constexpr (!FIXM) if (__any((a) < 1.f)) { if (hi == 0) al_l[r32] = (a); asm volatile("s_waitcnt lgkmcnt(0)" ::: "memory"); \
    for (int d = 0; d < 4; ++d) for (int r = 0; r < 16; ++r) o[d][r] *= al_l[crow(r, hi)]; } } while (0)
  f32x16 pA0, pA1, pB0, pB1; float mnA, mnB, alA, alB; bf16x8 pa0, pa1, pa2, pa3; const int NT = seq / KVBLK;
  constexpr int SE = 0, SO = 1;
  SLOAD(SE, 0); asm volatile("s_waitcnt vmcnt(0)" ::: "memory"); SWRITE(0, SE); __syncthreads();
  qkt(pA0, pA1, K_lds, qr, r32, hi); PSM(pA0, pA1, mnA, alA);
  SLOAD(SO, KVBLK); SLOAD(SE, 2 * KVBLK);
  SWAIT(); SWRITE(1, SO); __syncthreads();
  for (int j = 1; j + 1 < NT; j += 2) {
    SBAR(); qkt(pB0, pB1, (bf16_t*)((char*)K_lds + SHM_K), qr, r32, hi);
    finishSM(pA0, pA1, alA, l_reg, pa0, pa1, pa2, pa3); SBAR();
    SLOAD(SO, (j + 2) * KVBLK); SBAR();
    pv_d0(o, vb0, pa0, pa1, pa2, pa3); PSM(pB0, pB1, mnB, alB);
    __syncthreads(); SWAIT(); SWRITE(0, SE);
    RESC(alB); __syncthreads();
    SBAR(); qkt(pA0, pA1, K_lds, qr, r32, hi);
    finishSM(pB0, pB1, alB, l_reg, pa0, pa1, pa2, pa3); SBAR();
    SLOAD(SE, (j + 3 < NT ? j + 3 : NT - 1) * KVBLK); SBAR();
    pv_d0(o, vb0 + (int)SHM_V, pa0, pa1, pa2, pa3); PSM(pA0, pA1, mnA, alA);
    __syncthreads(); SWAIT(); SWRITE(1, SO);
    RESC(alA); __syncthreads();
  }
  SBAR(); qkt(pB0, pB1, (bf16_t*)((char*)K_lds + SHM_K), qr, r32, hi);
  finishSM(pA0, pA1, alA, l_reg, pa0, pa1, pa2, pa3); SBAR();
  pv_d0(o, vb0, pa0, pa1, pa2, pa3); PSM(pB0, pB1, mnB, alB);
  __syncthreads(); RESC(alB);
  finishSM(pB0, pB1, alB, l_reg, pa0, pa1, pa2, pa3); SBAR();
  pv_d0(o, vb0 + (int)SHM_V, pa0, pa1, pa2, pa3);
  if (hi == 0) li_l[r32] = l_reg; asm volatile("s_waitcnt lgkmcnt(0)" ::: "memory");
  float rli[16];
#pragma unroll
  for (int r = 0; r < 16; ++r) rli[r] = __builtin_amdgcn_rcpf(li_l[crow(r, hi)]);
  bf16_t* Ow = Ob + (long)(wid * QBLK) * LDO;
#pragma unroll
  for (int r = 0; r < 16; ++r) { int orow = crow(r, hi);
    for (int d0 = 0; d0 < 4; ++d0) Ow[(long)orow * LDO + d0 * 32 + r32] = (bf16_t)f2bf(o[d0][r] * rli[r]); }
  asm volatile("s_waitcnt vmcnt(0) lgkmcnt(0)" ::: "memory"); __syncthreads();
#undef SLOAD
#undef SWRITE
#undef SWAIT
#undef RESC
#undef PSM
}

template <int NT>
__device__ __forceinline__ void attn_ring3_body(const bf16_t* __restrict__ Qb, const bf16_t* __restrict__ Kh, const bf16_t* __restrict__ Vh, bf16_t* __restrict__ Ob, char* lds, int tid) {
  static_assert(NT >= 8, "ring body: at least 8 key tiles");
  asm volatile("" : "+v"(tid));
  const int wid = tid >> 6, lane = tid & 63, r32 = lane & 31, hi = lane >> 5;
  constexpr int VB = (int)SHM_V, KB = (int)SHM_K;
  bf16_t* K_lds = (bf16_t*)lds; bf16_t* V_lds = (bf16_t*)(lds + 3 * KB);
  float* ws = (float*)(lds + 3 * VB + 3 * KB) + wid * 64; float* li_l = ws;
  float l_reg = 0; f32x16 o[4] = {}; bf16x8 qr[8];
  const bf16_t* Qw = Qb + (long)(wid * QBLK + r32) * LDQ + hi * 8;
#pragma unroll
  for (int d0 = 0; d0 < 8; ++d0) qr[d0] = *reinterpret_cast<const bf16x8*>(Qw + d0 * 16);
  const int sr = tid >> 4, sc = (tid & 15) * 8, srp = (sr & ~0xC) | ((sr & 4) << 1) | ((sr & 8) >> 1), vst0 = v_st(srp, sc), vst1 = v_st(32 + srp, sc);
  const int vb0 = (int)(uintptr_t)V_lds + v_rd_base(lane);
  struct { bf16x8 vs0, vs1, ks0, ks1; } sr_[2];
#define SLOAD(i, t) do { const long k0_ = (long)((t) < NT ? (t) : NT - 1) * KVBLK; sr_[i].vs0 = *reinterpret_cast<const bf16x8*>(&Vh[(k0_ + sr) * LDK + sc]); sr_[i].vs1 = *reinterpret_cast<const bf16x8*>(&Vh[(k0_ + 32 + sr) * LDK + sc]); \
    sr_[i].ks0 = *reinterpret_cast<const bf16x8*>(&Kh[(k0_ + sr) * LDK + sc]); sr_[i].ks1 = *reinterpret_cast<const bf16x8*>(&Kh[(k0_ + 32 + sr) * LDK + sc]); } while (0)
#define SWRITE(b, i) do { *(bf16x8*)((char*)V_lds + (b) * VB + vst0) = sr_[i].vs0; *(bf16x8*)((char*)V_lds + (b) * VB + vst1) = sr_[i].vs1; const int kc = sc * 2; \
    *(bf16x8*)((char*)K_lds + (b) * KB + KSWZ(sr, kc)) = sr_[i].ks0; *(bf16x8*)((char*)K_lds + (b) * KB + KSWZ(32 + sr, kc)) = sr_[i].ks1; } while (0)
#define SWAIT() asm volatile("s_waitcnt vmcnt(4)" ::: "memory")
  f32x16 pA0, pA1, pB0, pB1; bf16x8 pa0, pa1, pa2, pa3;
  unsigned ca0, ca1, cb0, cb1; bf16x8 ka0, ka1, kb0, kb1; s16x4 va[4];
#define KRD(D0, B0, B1) do { B0 = *reinterpret_cast<const bf16x8*>(Kp + KSWZ(r32, ((D0) * 16 + hi * 8) * 2)); B1 = *reinterpret_cast<const bf16x8*>(Kp + KSWZ(32 + r32, ((D0) * 16 + hi * 8) * 2)); } while (0)
#define MQ(ACC, KF, D0) ACC = __builtin_amdgcn_mfma_f32_32x32x16_bf16(KF, qr[D0], ACC, 0, 0, 0)
#define EX(P, R) P[R] = __builtin_amdgcn_exp2f(P[R])
#define AD(P, R) l_reg += P[R]
#define CV(P, I, A, B) do { A = cvtpk(P[I], P[(I) + 1]); B = cvtpk(P[(I) + 2], P[(I) + 3]); } while (0)
#define PM(OUT) do { u32x4 w_ = {ca0, ca1, cb0, cb1}; OUT = *reinterpret_cast<bf16x8*>(&w_); } while (0)
#define RV(ARR, I, D0, KS) do { ARR[I] = tr_read<v_rd_off(D0, KS, 0)>(vbp); ARR[(I) + 1] = tr_read<v_rd_off(D0, KS, 1)>(vbp); } while (0)
#define PKV(L, H) (bf16x8){L[0], L[1], L[2], L[3], H[0], H[1], H[2], H[3]}
#define MP(D0, PA, ARR, I) o[D0] = __builtin_amdgcn_mfma_f32_32x32x16_bf16(PKV(ARR[I], ARR[(I) + 1]), PA, o[D0], 0, 0, 0)
#define WL(N) do { asm volatile("s_waitcnt lgkmcnt(" #N ")" ::: "memory"); SBAR(); } while (0)
#define TROW(t) ((long)((t) < NT ? (t) : NT - 1) * KVBLK)
#define SLV0(i, t) sr_[i].vs0 = *reinterpret_cast<const bf16x8*>(&Vh[(TROW(t) + sr) * LDK + sc])
#define SLV1(i, t) sr_[i].vs1 = *reinterpret_cast<const bf16x8*>(&Vh[(TROW(t) + 32 + sr) * LDK + sc])
#define SLK0(i, t) sr_[i].ks0 = *reinterpret_cast<const bf16x8*>(&Kh[(TROW(t) + sr) * LDK + sc])
#define SLK1(i, t) sr_[i].ks1 = *reinterpret_cast<const bf16x8*>(&Kh[(TROW(t) + 32 + sr) * LDK + sc])
#define SWV0(b, i) *(bf16x8*)((char*)V_lds + (b) * VB + vst0) = sr_[i].vs0
#define SWV1(b, i) *(bf16x8*)((char*)V_lds + (b) * VB + vst1) = sr_[i].vs1
#define SWK0(b, i) *(bf16x8*)((char*)K_lds + (b) * KB + KSWZ(sr, sc * 2)) = sr_[i].ks0
#define SWK1(b, i) *(bf16x8*)((char*)K_lds + (b) * KB + KSWZ(32 + sr, sc * 2)) = sr_[i].ks1
#define STEP(J, Q0, Q1, P0, P1, BQ, BP, BW, SL, SW) do { const char* Kp = (const char*)K_lds + (BQ) * KB; const int vbp = vb0 + (BP) * VB; SBAR(); \
    KRD(0, ka0, ka1); Q0 = f32x16{}; Q1 = f32x16{};        \
    MQ(Q0, ka0, 0); KRD(1, kb0, kb1); EX(P1, 0); CV(P0, 0, ca0, ca1); SBAR(); \
    MQ(Q1, ka1, 0); EX(P1, 1); AD(P1, 0); CV(P0, 4, cb0, cb1); PM(pa0); SBAR(); \
    MQ(Q0, kb0, 1); KRD(2, ka0, ka1); EX(P1, 2); AD(P1, 1); CV(P0, 8, ca0, ca1); SBAR(); \
    MQ(Q1, kb1, 1); EX(P1, 3); AD(P1, 2); CV(P0, 12, cb0, cb1); PM(pa1); SBAR(); \
    MQ(Q0, ka0, 2); KRD(3, kb0, kb1); EX(P1, 4); AD(P1, 3); SBAR(); \
    MQ(Q1, ka1, 2); EX(P1, 5); AD(P1, 4); SLV0(SL, (J) + 2); SBAR(); \
    MQ(Q0, kb0, 3); KRD(4, ka0, ka1); EX(P1, 6); AD(P1, 5); SBAR(); \
    MQ(Q1, kb1, 3); EX(P1, 7); AD(P1, 6); SLV1(SL, (J) + 2); SBAR(); \
    MQ(Q0, ka0, 4); KRD(5, kb0, kb1); EX(P1, 8); AD(P1, 7); CV(P1, 0, ca0, ca1); SBAR(); \
    MQ(Q1, ka1, 4); EX(P1, 9); AD(P1, 8); CV(P1, 4, cb0, cb1); PM(pa2); SBAR(); \
    MQ(Q0, kb0, 5); KRD(6, ka0, ka1); EX(P1, 10); AD(P1, 9); SBAR(); \
    MQ(Q1, kb1, 5); EX(P1, 11); AD(P1, 10); SLK0(SL, (J) + 2); SBAR(); \
    MQ(Q0, ka0, 6); KRD(7, kb0, kb1); EX(P1, 12); AD(P1, 11); SBAR(); \
    MQ(Q1, ka1, 6); EX(P1, 13); AD(P1, 12); CV(P1, 8, ca0, ca1); SLK1(SL, (J) + 2); SBAR(); \
    MQ(Q0, kb0, 7); EX(P1, 14); AD(P1, 13); SBAR(); RV(va, 0, 0, 0); RV(va, 2, 1, 0); SBAR(); \
    MQ(Q1, kb1, 7); EX(P1, 15); AD(P1, 14); SBAR(); \
    WL(2); MP(0, pa0, va, 0); RV(va, 0, 0, 1); AD(P1, 15); CV(P1, 12, cb0, cb1); PM(pa3); EX(Q0, 0); SBAR(); \
    WL(2); MP(1, pa0, va, 2); RV(va, 2, 1, 1); EX(Q0, 1); AD(Q0, 0); SBAR(); \
    WL(2); MP(0, pa1, va, 0); RV(va, 0, 0, 2); EX(Q0, 2); AD(Q0, 1); SBAR(); \
    WL(2); MP(1, pa1, va, 2); RV(va, 2, 1, 2); EX(Q0, 3); AD(Q0, 2); SBAR(); \
    WL(2); MP(0, pa2, va, 0); RV(va, 0, 0, 3); EX(Q0, 4); AD(Q0, 3); SBAR(); \
    WL(2); MP(1, pa2, va, 2); RV(va, 2, 1, 3); EX(Q0, 5); AD(Q0, 4); SBAR(); \
    WL(2); MP(0, pa3, va, 0); RV(va, 0, 2, 0); EX(Q0, 6); AD(Q0, 5); SBAR(); \
    WL(2); MP(1, pa3, va, 2); RV(va, 2, 3, 0); EX(Q0, 7); AD(Q0, 6); SBAR(); \
    WL(2); MP(2, pa0, va, 0); RV(va, 0, 2, 1); EX(Q0, 8); AD(Q0, 7); SBAR(); \
    WL(2); MP(3, pa0, va, 2); RV(va, 2, 3, 1); EX(Q0, 9); AD(Q0, 8); SBAR(); \
    WL(2); MP(2, pa1, va, 0); RV(va, 0, 2, 2); EX(Q0, 10); AD(Q0, 9); SBAR(); \
    WL(2); MP(3, pa1, va, 2); RV(va, 2, 3, 2); EX(Q0, 11); AD(Q0, 10); SBAR(); \
    WL(2); MP(2, pa2, va, 0); RV(va, 0, 2, 3); SWAIT(); SWV0(BW, SW); EX(Q0, 12); AD(Q0, 11); SBAR(); \
    WL(3); MP(3, pa2, va, 2); RV(va, 2, 3, 3); SWV1(BW, SW); EX(Q0, 13); AD(Q0, 12); SBAR(); \
    WL(4); MP(2, pa3, va, 0); SWK0(BW, SW); EX(Q0, 14); AD(Q0, 13); SBAR(); \
    WL(2); MP(3, pa3, va, 2); SWK1(BW, SW); EX(Q0, 15); AD(Q0, 14); AD(Q0, 15); SBAR(); \
    __syncthreads(); } while (0)
  SLOAD(0, 0); asm volatile("s_waitcnt vmcnt(0)" ::: "memory"); SWRITE(0, 0); SLOAD(1, 1); SLOAD(0, 2); __syncthreads();
  qkt(pA0, pA1, K_lds, qr, r32, hi); partialSM_fix2(pA0, l_reg); SWAIT(); SWRITE(1, 1); __syncthreads();
  int jb = 1;
  for (; jb + 5 < NT; jb += 6) {
    STEP(jb,     pB0, pB1, pA0, pA1, 1, 0, 2, 1, 0);
    STEP(jb + 1, pA0, pA1, pB0, pB1, 2, 1, 0, 0, 1);
    STEP(jb + 2, pB0, pB1, pA0, pA1, 0, 2, 1, 1, 0);
    STEP(jb + 3, pA0, pA1, pB0, pB1, 1, 0, 2, 0, 1);
    STEP(jb + 4, pB0, pB1, pA0, pA1, 2, 1, 0, 1, 0);
    STEP(jb + 5, pA0, pA1, pB0, pB1, 0, 2, 1, 0, 1);
  }
  constexpr int REM = (NT - 1) % 6;
  if constexpr (REM > 0) STEP(jb,     pB0, pB1, pA0, pA1, 1, 0, 2, 1, 0);
  if constexpr (REM > 1) STEP(jb + 1, pA0, pA1, pB0, pB1, 2, 1, 0, 0, 1);
  if constexpr (REM > 2) STEP(jb + 2, pB0, pB1, pA0, pA1, 0, 2, 1, 1, 0);
  if constexpr (REM > 3) STEP(jb + 3, pA0, pA1, pB0, pB1, 1, 0, 2, 0, 1);
  if constexpr (REM > 4) STEP(jb + 4, pB0, pB1, pA0, pA1, 2, 1, 0, 1, 0);
  if constexpr ((NT - 1) & 1) finishSM2(pB0, pB1, l_reg, pa0, pa1, pa2, pa3); else finishSM2(pA0, pA1, l_reg, pa0, pa1, pa2, pa3);
  { auto rr = __builtin_amdgcn_permlane32_swap(__float_as_uint(l_reg), __float_as_uint(l_reg), false, false); l_reg = __uint_as_float(rr[0]) + __uint_as_float(rr[1]); }
  { const int vbp = vb0 + ((NT - 1) % 3) * VB; SBAR(); RV(va, 0, 0, 0); RV(va, 2, 1, 0); SBAR();
    WL(2); MP(0, pa0, va, 0); RV(va, 0, 0, 1); SBAR();
    WL(2); MP(1, pa0, va, 2); RV(va, 2, 1, 1); SBAR();
    WL(2); MP(0, pa1, va, 0); RV(va, 0, 0, 2); SBAR();
    WL(2); MP(1, pa1, va, 2); RV(va, 2, 1, 2); SBAR();
    WL(2); MP(0, pa2, va, 0); RV(va, 0, 0, 3); SBAR();
    WL(2); MP(1, pa2, va, 2); RV(va, 2, 1, 3); SBAR();
    WL(2); MP(0, pa3, va, 0); RV(va, 0, 2, 0); SBAR();
    WL(2); MP(1, pa3, va, 2); RV(va, 2, 3, 0); SBAR();
    WL(2); MP(2, pa0, va, 0); RV(va, 0, 2, 1); SBAR();
    WL(2); MP(3, pa0, va, 2); RV(va, 2, 3, 1); SBAR();
    WL(2); MP(2, pa1, va, 0); RV(va, 0, 2, 2); SBAR();
    WL(2); MP(3, pa1, va, 2); RV(va, 2, 3, 2); SBAR();
    WL(2); MP(2, pa2, va, 0); RV(va, 0, 2, 3); SBAR();
    WL(2); MP(3, pa2, va, 2); RV(va, 2, 3, 3); SBAR();
    WL(2); MP(2, pa3, va, 0); SBAR();
    WL(0); MP(3, pa3, va, 2); SBAR();
  }
  { const float rl = __builtin_amdgcn_rcpf(l_reg); bf16_t* Orow = Ob + (long)(wid * QBLK + r32) * LDO + hi * 8;
#pragma unroll
    for (int D0 = 0; D0 < 4; ++D0) {
#pragma unroll
      for (int gp = 0; gp < 2; ++gp) { const int k = D0 * 4 + 2 * gp;
        unsigned ax = cvtpk(o[D0][8 * gp + 0] * rl, o[D0][8 * gp + 1] * rl), ay = cvtpk(o[D0][8 * gp + 2] * rl, o[D0][8 * gp + 3] * rl);
        unsigned bx = cvtpk(o[D0][8 * gp + 4] * rl, o[D0][8 * gp + 5] * rl), by = cvtpk(o[D0][8 * gp + 6] * rl, o[D0][8 * gp + 7] * rl);
        auto sx = __builtin_amdgcn_permlane32_swap(ax, bx, false, false); auto sy = __builtin_amdgcn_permlane32_swap(ay, by, false, false);
        *(u32x4*)(Orow + 8 * k) = (u32x4){sx[0], sy[0], sx[1], sy[1]}; } } }
  asm volatile("s_waitcnt vmcnt(0) lgkmcnt(0)" ::: "memory"); __syncthreads();
#undef STEP
#undef TROW
#undef SLV0
#undef SLV1
#undef SLK0
#undef SLK1
#undef SWV0
#undef SWV1
#undef SWK0
#undef SWK1
#undef KRD
#undef MQ
#undef EX
#undef AD
#undef CV
#undef PM
#undef RV
#undef PKV
#undef MP
#undef WL
#undef SLOAD
#undef SWRITE
#undef SWAIT
}
}
struct Args { const float* in[32]; float* out; unsigned char* ws; int ph_lo, ph_hi, li, pad; };
constexpr int PTR_OFF = RING_BYTES + 512;
struct Ctx { LAS unsigned char* ldsb; unsigned char* ws;
    __device__ __forceinline__ const float* inp(int i) const { const u32x2 v = *(const LAS u32x2*)(ldsb + PTR_OFF + 8 * i);
        const unsigned long long p = ((unsigned long long)(unsigned)__builtin_amdgcn_readfirstlane((int)v.y) << 32) | (unsigned)__builtin_amdgcn_readfirstlane((int)v.x);
        return (const float*)(const GAS float*)p; }
    __device__ __forceinline__ float* outp() const { return (float*)inp(32); } };
enum { IN_X = 0, IN_C, IN_CTX, IN_CCTX, IN_MODW, IN_MODB, IN_LNMG, IN_LNMB, IN_LNFG, IN_LNFB, IN_WIN, IN_WOUT, IN_LAMRE, IN_LAMIM, IN_LOGSTEP, IN_BRE, IN_BIM, IN_CRE, IN_CIM,
       IN_S5D, IN_WGLU, IN_BGLU, IN_FNETW, IN_FNETB, IN_WQKV, IN_QGAIN, IN_KGAIN, IN_WO, IN_ROUTER, IN_WGATE, IN_WUP, IN_WDOWN };

struct RowV { f32x4 v[8]; };
__device__ __forceinline__ void row_load_f32(RowV& r, const float* p, int lane) {
#pragma unroll
    for (int j = 0; j < 8; ++j) r.v[j] = *(const f32x4*)(p + 4 * lane + 256 * j);
}
__device__ __forceinline__ void row_load_f32_nt(RowV& r, const float* p, int lane) {
#pragma unroll
    for (int j = 0; j < 8; ++j) r.v[j] = __builtin_nontemporal_load((const f32x4*)(p + 4 * lane + 256 * j));
}
__device__ __forceinline__ void row_store_f32(const RowV& r, float* p, int lane) {
#pragma unroll
    for (int j = 0; j < 8; ++j) *(f32x4*)(p + 4 * lane + 256 * j) = r.v[j];
}
__device__ __forceinline__ void row_store_f32_nt(const RowV& r, float* p, int lane) {
#pragma unroll
    for (int j = 0; j < 8; ++j) __builtin_nontemporal_store(r.v[j], (f32x4*)(p + 4 * lane + 256 * j));
}
__device__ __forceinline__ void row_load_bf16(RowV& r, const bf16_t* p, int lane) {
#pragma unroll
    for (int j = 0; j < 8; ++j) { const u32x2 w = *(const u32x2*)(p + 4 * lane + 256 * j);
        r.v[j] = (f32x4){bf2f(w.x & 0xffffu), bf2f(w.x >> 16), bf2f(w.y & 0xffffu), bf2f(w.y >> 16)}; }
}
__device__ __forceinline__ void row_store_bf16(const RowV& r, bf16_t* p, int lane) {
#pragma unroll
    for (int j = 0; j < 8; ++j) { u32x2 w; w.x = cvt_pk_bf16(r.v[j][0], r.v[j][1]); w.y = cvt_pk_bf16(r.v[j][2], r.v[j][3]); *(u32x2*)(p + 4 * lane + 256 * j) = w; }
}
__device__ __forceinline__ void row_normalize(RowV& r) {
    float s = 0.f;
#pragma unroll
    for (int j = 0; j < 8; ++j) s += (r.v[j][0] + r.v[j][1]) + (r.v[j][2] + r.v[j][3]);
    const float mean = wave_sum(s) * (1.f / DM); float q = 0.f;
#pragma unroll
    for (int j = 0; j < 8; ++j) { r.v[j] = r.v[j] - mean; q += (r.v[j][0] * r.v[j][0] + r.v[j][1] * r.v[j][1]) + (r.v[j][2] * r.v[j][2] + r.v[j][3] * r.v[j][3]); }
    const float rstd = 1.f / sqrtf(wave_sum(q) * (1.f / DM) + LN_EPS);
#pragma unroll
    for (int j = 0; j < 8; ++j) r.v[j] = r.v[j] * rstd;
}
__device__ __forceinline__ void row_modulate(RowV& r, const float* shift, const float* scale, int lane) {
#pragma unroll
    for (int j = 0; j < 8; ++j) { const f32x4 sc = *(const f32x4*)(scale + 4 * lane + 256 * j), sh = *(const f32x4*)(shift + 4 * lane + 256 * j); r.v[j] = r.v[j] * (sc + 1.f) + sh; }
}
__device__ __forceinline__ void row_affine(RowV& r, const float* gain, const float* bias, int lane) {
#pragma unroll
    for (int j = 0; j < 8; ++j) { const f32x4 g = *(const f32x4*)(gain + 4 * lane + 256 * j), b = *(const f32x4*)(bias + 4 * lane + 256 * j); r.v[j] = r.v[j] * g + b; }
}
__device__ __forceinline__ void row_decode(int r, int& b, bool& isctx, int& idx) { b = r / RPB; const int t = r - b * RPB; isctx = t < CTX; idx = isctx ? t : t - CTX; }
__device__ __forceinline__ const float* mod_ptr(const unsigned char* ws, int layer, int which, int k) { return (const float*)(ws + O_MOD) + ((size_t)((layer * 3 + which) * 6 + k)) * DM; }

template <int MODE>
__device__ __forceinline__ void transpose_item(const float* W, int K, int N, bf16_t* WT, LAS float* scrf, int item, int lane) {
    LAS unsigned* scr = (LAS unsigned*)scrf;
    const int nblk = N / 64, kb = item / nblk, nb = item % nblk, k0 = 64 * kb, n0 = 64 * nb;
    const float* src = W + (size_t)k0 * N + n0 + lane;
    float v[64];
#pragma unroll
    for (int i = 0; i < 64; ++i) v[i] = src[(size_t)i * N];
#pragma unroll
    for (int i = 0; i < 32; ++i) scr[lane * 33 + i] = cvt_pk_bf16(v[2 * i], v[2 * i + 1]);
    LDS_WAIT(); asm volatile("" ::: "memory");
    const int c = lane & 7;
#pragma unroll
    for (int jj = 0; jj < 8; ++jj) { const int n = (lane >> 3) + 8 * jj; const LAS unsigned* s = scr + n * 33 + 4 * c;
        u32x4 o; o.x = s[0]; o.y = s[1]; o.z = s[2]; o.w = s[3];
        const int nn = n0 + n; const int orow = MODE == 0 ? nn : (8 * (nn >> 2) + (nn & 3) + (MODE == 2 ? 4 : 0));
        *(u32x4*)(WT + (size_t)orow * K + k0 + 8 * c) = o; }
    LDS_WAIT(); asm volatile("" ::: "memory");
}

__device__ __forceinline__ void p0_prologue(const Ctx& a, LAS unsigned char* lds, int tid, int lane, int wave) {
    unsigned char* ws = a.ws;
    LAS float* scr = (LAS float*)(lds + wave * 16384);
    const int gw = blockIdx.x * NWAVES + wave, NGW = gridDim.x * NWAVES;
    constexpr int I_SQ = 32 * 32, I_GLU = 16 * 16, I_QKV = 32 * 48;
    constexpr int PER_J = 2 * I_SQ + I_GLU + I_QKV + I_SQ;
    for (int it = gw; it < 2 * PER_J; it += NGW) {
        const int j = it / PER_J; int r = it % PER_J;
        if (r < I_SQ) { transpose_item<0>(a.inp(IN_WIN) + (size_t)j * DM * DM, DM, DM, (bf16_t*)(ws + O_WIN) + (size_t)j * DM * DM, scr, r, lane); continue; } r -= I_SQ;
        if (r < I_SQ) { transpose_item<0>(a.inp(IN_WOUT) + (size_t)j * DM * DM, DM, DM, (bf16_t*)(ws + O_WOUT) + (size_t)j * DM * DM, scr, r, lane); continue; } r -= I_SQ;
        if (r < I_GLU) { transpose_item<0>(a.inp(IN_WGLU) + (size_t)j * 1024 * 1024, 1024, 1024, (bf16_t*)(ws + O_WGLU) + (size_t)j * 1024 * 1024, scr, r, lane); continue; } r -= I_GLU;
        if (r < I_QKV) { transpose_item<0>(a.inp(IN_WQKV) + (size_t)j * DM * 3072, DM, 3072, (bf16_t*)(ws + O_WQKV) + (size_t)j * 3072 * DM, scr, r, lane); continue; } r -= I_QKV;
        transpose_item<0>(a.inp(IN_WO) + (size_t)j * DM * DM, DM, DM, (bf16_t*)(ws + O_WO) + (size_t)j * DM * DM, scr, r, lane);
    }
    __syncthreads();
    {
        LAS float* sl = (LAS float*)lds;
        LAS float* red = (LAS float*)(lds + 32768);
        for (int i = tid; i < 3 * DM; i += NTHREADS) { const int w = i / DM, k = i % DM; const float cv = w < 2 ? a.inp(IN_C)[w * DM + k] : a.inp(IN_CCTX)[k]; sl[i] = silu_f(cv); }
        __syncthreads();
        for (int wi = blockIdx.x; wi < 256; wi += gridDim.x) {
            const int layer = wi >> 6, col0 = (wi & 63) * 192;
            const float* W = a.inp(IN_MODW) + (size_t)layer * DM * 12288 + col0 + lane;
            float acc[3][3];
#pragma unroll
            for (int q = 0; q < 3; ++q)
#pragma unroll
                for (int r = 0; r < 3; ++r) acc[q][r] = 0.f;
#pragma unroll 16
            for (int k = wave * 256; k < wave * 256 + 256; ++k) {
                const float s0 = sl[k], s1 = sl[DM + k], s2 = sl[2 * DM + k];
#pragma unroll
                for (int q = 0; q < 3; ++q) { const float w = W[(size_t)k * 12288 + 64 * q]; acc[q][0] += w * s0; acc[q][1] += w * s1; acc[q][2] += w * s2; }
            }
#pragma unroll
            for (int q = 0; q < 3; ++q)
#pragma unroll
                for (int r = 0; r < 3; ++r) red[(wave * 9 + q * 3 + r) * 64 + lane] = acc[q][r];
            __syncthreads();
            for (int i = tid; i < 576; i += NTHREADS) { const int qr = i / 64, l = i % 64, q = qr / 3, r = qr % 3; float s = 0.f;
#pragma unroll
                for (int w = 0; w < 8; ++w) s += red[(w * 9 + qr) * 64 + l];
                const int n = col0 + 64 * q + l;
                ((float*)(ws + O_MOD))[((size_t)(layer * 3 + r)) * 12288 + n] = s + a.inp(IN_MODB)[layer * 12288 + n]; }
            __syncthreads();
        }
    }
    const int gt = blockIdx.x * NTHREADS + tid, NGT = gridDim.x * NTHREADS;
    const double INV_PI = 0.31830988618379067153776752674503;
    for (int i = gt; i < 256 * 32; i += NGT) { const int pos = i >> 5, f = i & 31; const float invf = (float)exp(-(double)f * (9.210340371976182736071965818737 / 32.0)); const float ang = (float)pos * invf;
        ((f32x2*)(ws + O_TRIG))[i] = (f32x2){(float)cospi((double)ang * INV_PI), (float)sinpi((double)ang * INV_PI)}; }
    for (int i = gt; i < 256 * 256; i += NGT) { const int r = i >> 8, k = i & 255;
        { float v = 0.f; if (k < 128) { float ss, cc; sincospif((float)(((r & 127) * k) & 127) * (1.f / 64.f), &ss, &cc); v = (r < 128 ? cc : -ss) * (1.f / 128.f); }
          ((bf16_t*)(ws + O_FA))[i] = (bf16_t)f2bf(v); }
    }
    for (int i8 = gt; i8 < 128 * 256 * 32; i8 += NGT) {
        const int k1 = i8 >> 13, r = (i8 >> 5) & 255, kc = (i8 & 31) * 8, k2 = r & 127; float v[8];
#pragma unroll
        for (int q = 0; q < 8; ++q) { const int k = kc + q, l2 = k & 127; float ss, cc; sincospif((float)((l2 * (k1 + 128 * k2)) & 16383) * (1.f / 8192.f), &ss, &cc);
            v[q] = r < 128 ? (k < 128 ? cc : ss) : (k < 128 ? ss : -cc); }
        u32x4 o; o.x = cvt_pk_bf16(v[0], v[1]); o.y = cvt_pk_bf16(v[2], v[3]); o.z = cvt_pk_bf16(v[4], v[5]); o.w = cvt_pk_bf16(v[6], v[7]);
        *(u32x4*)((bf16_t*)(ws + O_FC) + (size_t)i8 * 8) = o; }
    for (int i = gt; i < 512 * 256; i += NGT) { const int r = i >> 8, l = i & 255, k = r & 255; float ss, cc; sincospif((float)((k * l) & 255) * (1.f / 128.f), &ss, &cc);
        ((bf16_t*)(ws + O_F256))[i] = (bf16_t)f2bf((r < 256 ? cc : ss) * (1.f / 16.f)); }
    for (int i = gt; i < 2 * 2 * 64 * 64 * 33; i += NGT) { const int jdgp = i / 33, n = i - jdgp * 33;
        const double step = exp((double)a.inp(IN_LOGSTEP)[jdgp >> 6]), ar = (double)a.inp(IN_LAMRE)[jdgp] * step, ai = (double)a.inp(IN_LAMIM)[jdgp] * step * INV_PI;
        const double mag = exp(ar * n); ((f32x2*)(ws + O_POW))[i] = (f32x2){(float)(mag * cospi(ai * n)), (float)(mag * sinpi(ai * n))}; }
    for (int i = gt; i < 2 * 2 * 64 * 64 * 16; i += NGT) { const int jdgp = i >> 4;
        const double lre = a.inp(IN_LAMRE)[jdgp], lim = a.inp(IN_LAMIM)[jdgp], step = exp((double)a.inp(IN_LOGSTEP)[jdgp >> 6]);
        const double mag = exp(lre * step), ang = lim * step * INV_PI, br = mag * cospi(ang) - 1.0, bi = mag * sinpi(ang), den = lre * lre + lim * lim;
        const double qr = (br * lre + bi * lim) / den, qi = (bi * lre - br * lim) / den;
        const double xr = a.inp(IN_BRE)[i], xi = a.inp(IN_BIM)[i]; ((f32x2*)(ws + O_BBAR))[i] = (f32x2){(float)(qr * xr - qi * xi), (float)(qr * xi + qi * xr)}; }
    {
        __syncthreads();
        LAS float* ct = (LAS float*)lds; LAS float* st = ct + 256;
        if (tid < 256) { float ss, cc; sincospif((float)tid * (1.f / 128.f), &ss, &cc); ct[tid] = cc * (1.f / 16.f); st[tid] = -ss * (1.f / 16.f); }
        __syncthreads();
        for (int i = gt; i < 2 * 4 * 64 * 256; i += NGT) { const int e = i & 255, kb = (i >> 8) & 63, jg = i >> 14, c0 = (kb & 31) * 8; const LAS float* tb = kb < 32 ? ct : st;
            const float* w = a.inp(IN_FNETW) + (size_t)jg * 65536 + e; float s[8];
#pragma unroll
            for (int q = 0; q < 8; ++q) s[q] = 0.f;
#pragma unroll 4
            for (int m = 0; m < 256; ++m) { const float wv = w[m * 256];
#pragma unroll
                for (int q = 0; q < 8; ++q) s[q] += tb[(m * (c0 + q)) & 255] * wv; }
            u32x4 o; o.x = cvt_pk_bf16(s[0], s[1]); o.y = cvt_pk_bf16(s[2], s[3]); o.z = cvt_pk_bf16(s[4], s[5]); o.w = cvt_pk_bf16(s[6], s[7]);
            *(u32x4*)((bf16_t*)(ws + O_FNM) + ((size_t)jg * 256 + e) * 512 + kb * 8) = o; }
        __syncthreads();
    }
    if (gt < 128) ((bf16_t*)(ws + O_T1))[(size_t)2048 * 128 * 128 + gt] = 0;
}

__device__ __forceinline__ void p1_kf(const Ctx& a, LAS unsigned char* lds, int tid) {
    unsigned char* ws = a.ws;
    LAS f32x2* pw = (LAS f32x2*)lds;
    LAS f32x2* bb = pw + 64 * 33;
    LAS f32x2* cc = bb + 64 * 16;
    for (int jdg = blockIdx.x; jdg < 256; jdg += gridDim.x) {
        for (int i = tid; i < 64 * 33; i += NTHREADS) pw[i] = ((const f32x2*)(ws + O_POW))[(size_t)jdg * 64 * 33 + i];
        for (int i = tid; i < 64 * 16; i += NTHREADS) bb[i] = ((const f32x2*)(ws + O_BBAR))[(size_t)jdg * 64 * 16 + i];
        for (int i = tid; i < 16 * 64; i += NTHREADS) cc[(i >> 6) * 65 + (i & 63)] = (f32x2){a.inp(IN_CRE)[(size_t)jdg * 1024 + i], a.inp(IN_CIM)[(size_t)jdg * 1024 + i]};
        __syncthreads();
        const int tau = tid >> 4, co = tid & 15; float s[16];
#pragma unroll
        for (int ci = 0; ci < 16; ++ci) s[ci] = 0.f;
        for (int p = 0; p < 64; ++p) { const f32x2 w = pw[p * 33 + tau], c = cc[co * 65 + p]; const float xr = c.x * w.x - c.y * w.y, xi = c.x * w.y + c.y * w.x;
#pragma unroll
            for (int ci = 0; ci < 16; ++ci) { const f32x2 b = bb[p * 16 + ci]; s[ci] += xr * b.x - xi * b.y; } }
        float* out = (float*)(ws + O_KF) + ((size_t)jdg * 32 + tau) * 256 + co * 16;
#pragma unroll
        for (int q = 0; q < 4; ++q) *(f32x4*)(out + 4 * q) = (f32x4){s[4 * q], s[4 * q + 1], s[4 * q + 2], s[4 * q + 3]};
        __syncthreads();
    }
}
__device__ __forceinline__ u32x4 p2_bt1_item(const Ctx& a, int i) {
    unsigned char* ws = a.ws; const f32x2* POW = (const f32x2*)(ws + O_POW); const f32x2* BB = (const f32x2*)(ws + O_BBAR);
    const int k8 = i & 63, rr = (i >> 6) & 255, jg = i >> 14, j = jg >> 6, g = jg & 63;
    const int typ = rr >> 6, p = rr & 63, d = typ >> 1, t = k8 >> 1, ci0 = (k8 & 1) * 8, n = d == 0 ? (31 - t) : t;
    const size_t jdgp = ((size_t)((j * 2 + d) * 64 + g)) * 64 + p; const f32x2 w = POW[jdgp * 33 + n]; float v[8];
#pragma unroll
    for (int c = 0; c < 8; ++c) { const f32x2 b = BB[jdgp * 16 + ci0 + c]; v[c] = (typ & 1) ? (w.x * b.y + w.y * b.x) : (w.x * b.x - w.y * b.y); }
    u32x4 o; o.x = cvt_pk_bf16(v[0], v[1]); o.y = cvt_pk_bf16(v[2], v[3]); o.z = cvt_pk_bf16(v[4], v[5]); o.w = cvt_pk_bf16(v[6], v[7]); return o;
}
__device__ __forceinline__ u32x4 p2_bt3_item(const Ctx& a, int i) {
    unsigned char* ws = a.ws; const f32x2* POW = (const f32x2*)(ws + O_POW); const float* KF = (const float*)(ws + O_KF);
    const int k8 = i % 96, rr = (i / 96) & 511, jg = i / (96 * 512), j = jg >> 6, g = jg & 63;
    const int t = rr >> 4, co = rr & 15; float v[8];
    if (k8 < 64) { const int s = k8 >> 1, ci0 = (k8 & 1) * 8;
        f32x4 f0 = (f32x4){0.f, 0.f, 0.f, 0.f}, f1 = f0;
        if (s <= t) { const f32x4* p = (const f32x4*)(KF + ((((size_t)(j * 2 + 0) * 64 + g) * 32 + (t - s)) * 16 + co) * 16 + ci0); f0 += p[0]; f1 += p[1]; }
        if (s >= t) { const f32x4* p = (const f32x4*)(KF + ((((size_t)(j * 2 + 1) * 64 + g) * 32 + (s - t)) * 16 + co) * 16 + ci0); f0 += p[0]; f1 += p[1]; }
#pragma unroll
        for (int c = 0; c < 4; ++c) { v[c] = f0[c]; v[4 + c] = f1[c]; }
        if (s == t && (co >> 3) == (k8 & 1)) { const float dsk = a.inp(IN_S5D)[j * 1024 + g * 16 + co];
#pragma unroll
            for (int c = 0; c < 8; ++c) v[c] += (ci0 + c == co) ? dsk : 0.f; }
    } else { const int q0 = (k8 - 64) * 8, typ = q0 >> 6, d = typ >> 1, n = d == 0 ? (t + 1) : (32 - t);
        const size_t jdg = (size_t)(j * 2 + d) * 64 + g;
#pragma unroll
        for (int c = 0; c < 8; ++c) { const int p = (q0 & 63) + c; const f32x2 w = POW[(jdg * 64 + p) * 33 + n];
            const float cr = a.inp(IN_CRE)[(jdg * 16 + co) * 64 + p], ci = a.inp(IN_CIM)[(jdg * 16 + co) * 64 + p];
            v[c] = (typ & 1) ? -(cr * w.y + ci * w.x) : (cr * w.x - ci * w.y); } }
    u32x4 o; o.x = cvt_pk_bf16(v[0], v[1]); o.y = cvt_pk_bf16(v[2], v[3]); o.z = cvt_pk_bf16(v[4], v[5]); o.w = cvt_pk_bf16(v[6], v[7]); return o;
}
__device__ __forceinline__ void p2_s5mats(const Ctx& a, int tid) {
    unsigned char* ws = a.ws; const int gt = blockIdx.x * NTHREADS + tid, NGT = gridDim.x * NTHREADS;
    constexpr int N1 = 2 * 64 * 256 * 64, N3 = 2 * 64 * 512 * 96;
    for (int i = gt; i < N1; i += 4 * NGT) { u32x4 o[4];
#pragma unroll
        for (int q = 0; q < 4; ++q) { const int ii = i + q * NGT; o[q] = p2_bt1_item(a, ii < N1 ? ii : i); }
#pragma unroll
        for (int q = 0; q < 4; ++q) { const int ii = i + q * NGT; if (ii < N1) { const int k8 = ii & 63, rr = (ii >> 6) & 255, jg = ii >> 14;
            *(u32x4*)((bf16_t*)(ws + O_BT1) + ((size_t)jg * 256 + rr) * 512 + k8 * 8) = o[q]; } } }
    for (int i = gt; i < N3; i += 4 * NGT) { u32x4 o[4];
#pragma unroll
        for (int q = 0; q < 4; ++q) { const int ii = i + q * NGT; o[q] = p2_bt3_item(a, ii < N3 ? ii : i); }
#pragma unroll
        for (int q = 0; q < 4; ++q) { const int ii = i + q * NGT; if (ii < N3) { const int k8 = ii % 96, rr = (ii / 96) & 511, jg = ii / (96 * 512);
            *(u32x4*)((bf16_t*)(ws + O_BT3) + ((size_t)jg * 512 + rr) * 768 + k8 * 8) = o[q]; } } }
}
__device__ __forceinline__ void moe_weight_phase(const Ctx& a, int layer, int part, int tailwgs, LAS unsigned char* lds, int lane, int wave) {
    unsigned char* ws = a.ws; LAS float* scr = (LAS float*)(lds + wave * 16384);
    const int rank = (int)blockIdx.x - tailwgs, nact = (int)gridDim.x - tailwgs;
    if (rank >= 0) {
        const int gw = rank * NWAVES + wave, NGW = nact * NWAVES;
        constexpr int I_GU = 32 * 16, I_DN = 16 * 32, PER_E = 2 * I_GU + I_DN, HALF_ITEMS = 16 * PER_E / 2;
        for (int it = part * HALF_ITEMS + gw; it < (part + 1) * HALF_ITEMS; it += NGW) {
            const int e = it / PER_E; int r = it % PER_E;
            const size_t le = (size_t)layer * 16 + e;
            if (r < I_GU) { transpose_item<1>(a.inp(IN_WGATE) + le * DM * EFF, DM, EFF, (bf16_t*)(ws + O_WGU) + (size_t)e * 2048 * DM, scr, r, lane); continue; } r -= I_GU;
            if (r < I_GU) { transpose_item<2>(a.inp(IN_WUP) + le * DM * EFF, DM, EFF, (bf16_t*)(ws + O_WGU) + (size_t)e * 2048 * DM, scr, r, lane); continue; } r -= I_GU;
            transpose_item<0>(a.inp(IN_WDOWN) + le * EFF * DM, EFF, DM, (bf16_t*)(ws + O_WD) + (size_t)e * DM * EFF, scr, r, lane);
        }
    }
    __syncthreads();
}

__device__ __forceinline__ const float* r_xsrc0(const Ctx& a, int r) { int b, idx; bool isctx; row_decode(r, b, isctx, idx);
    return isctx ? a.inp(IN_CTX) + ((size_t)(b * CTX + idx)) * DM : a.inp(IN_X) + ((size_t)(b * SEQ + idx)) * DM; }
__device__ __forceinline__ void r0_phase(const Ctx& a, int lane, int wave) {
    unsigned char* ws = a.ws; const int gw = blockIdx.x * NWAVES + wave, NGW = gridDim.x * NWAVES;
    RowV xn;
    if (gw < NR) row_load_f32(xn, r_xsrc0(a, gw), lane);
    for (int r = gw; r < NR; r += NGW) { int b, idx; bool isctx; row_decode(r, b, isctx, idx);
        const int which = isctx ? 2 : b; RowV x = xn;
        if (r + NGW < NR) row_load_f32(xn, r_xsrc0(a, r + NGW), lane);
        row_normalize(x);
        row_modulate(x, mod_ptr(ws, 0, which, 0), mod_ptr(ws, 0, which, 1), lane);
        row_store_bf16(x, (bf16_t*)(ws + O_U) + (size_t)r * DM, lane); }
}
__device__ __forceinline__ void lds_vec_fill(LAS float* dst, const float* src, int tid) { for (int i = tid; i < DM / 4; i += NTHREADS) *(LAS f32x4*)(dst + 4 * i) = *(const f32x4*)(src + 4 * i); }
__device__ __forceinline__ f32x4 vld(const float* p, int lane, int j) { return *(const f32x4*)(p + 4 * lane + 256 * j); }
__device__ __forceinline__ f32x4 vld(const LAS float* p, int lane, int j) { return *(const LAS f32x4*)(p + 4 * lane + 256 * j); }
__device__ __forceinline__ const float* r_xsrc(const Ctx& a, int layer, int r) { int b, idx; bool isctx; row_decode(r, b, isctx, idx);
    if (layer == 0) return isctx ? a.inp(IN_CTX) + ((size_t)(b * CTX + idx)) * DM : a.inp(IN_X) + ((size_t)(b * SEQ + idx)) * DM;
    return isctx ? (const float*)(a.ws + O_XC) + ((size_t)(b * CTX + idx)) * DM : a.outp() + ((size_t)(b * SEQ + idx)) * DM; }
struct RowDeal { int b, i0, n_lat_wg, wave, nlat, gw, NGW;
    __device__ __forceinline__ void init(int wave_) { const int G = gridDim.x, nb = G >> 1, c = blockIdx.x; wave = wave_; gw = c * NWAVES + wave; NGW = G * NWAVES;
        if (nb > 0 && c < 2 * nb) { const int per = (SEQ + nb - 1) / nb; b = c / nb; i0 = (c % nb) * per; n_lat_wg = SEQ - i0 < per ? (SEQ - i0 > 0 ? SEQ - i0 : 0) : per; } else { b = 0; i0 = 0; n_lat_wg = 0; }
        nlat = n_lat_wg > wave ? (n_lat_wg - wave + NWAVES - 1) / NWAVES : 0; }
    bool with_ctx = true;
    __device__ __forceinline__ int row(int k) const { if (k < nlat) return b * RPB + CTX + i0 + wave + k * NWAVES;
        const int q = gw + (k - nlat) * NGW; if (!with_ctx || q >= NBATCH * CTX) return -1; return (q / CTX) * RPB + (q % CTX); } };
constexpr int RV_OFF = RING_BYTES + 1024;

template <bool FAST>
__device__ __forceinline__ void r1_row(const Ctx& a, int layer, int r, RowV& x, const LAS float* wl, const LAS float* lv, int lane, bool st) {
    unsigned char* ws = a.ws; int b, idx; bool isctx; row_decode(r, b, isctx, idx); const int which = isctx ? 2 : b;
    float* xs = isctx ? (float*)(ws + O_XC) + ((size_t)(b * CTX + idx)) * DM : a.outp() + ((size_t)(b * SEQ + idx)) * DM;
    row_normalize(x);
    row_affine(x, a.inp(IN_LNMG) + layer * DM, a.inp(IN_LNMB) + layer * DM, lane);
    if (st) row_store_f32_nt(x, xs, lane);
    row_normalize(x);
    if (FAST) {
#pragma unroll
        for (int j = 0; j < 8; ++j) x.v[j] = x.v[j] * (vld(lv + DM, lane, j) + 1.f) + vld(lv + 2 * DM, lane, j);
    } else row_modulate(x, mod_ptr(ws, layer, which, 3), mod_ptr(ws, layer, which, 4), lane);
    if (st) row_store_bf16(x, (bf16_t*)(ws + O_H2) + (size_t)r * DM, lane);
    float lg[16];
#pragma unroll
    for (int e = 0; e < 16; ++e) { float s0 = 0.f, s1 = 0.f, s2 = 0.f, s3 = 0.f;
#pragma unroll
        for (int j = 0; j < 8; ++j) { const f32x4 w = *(const LAS f32x4*)(wl + e * DM + 4 * lane + 256 * j);
            s0 = __builtin_fmaf(x.v[j][0], w[0], s0); s1 = __builtin_fmaf(x.v[j][1], w[1], s1); s2 = __builtin_fmaf(x.v[j][2], w[2], s2); s3 = __builtin_fmaf(x.v[j][3], w[3], s3); }
        lg[e] = wave_sum((s0 + s1) + (s2 + s3)); asm volatile("" ::: "memory"); }
    float mx = lg[0];
#pragma unroll
    for (int e = 1; e < 16; ++e) mx = fmaxf(mx, lg[e]);
    float den = 0.f;
#pragma unroll
    for (int e = 0; e < 16; ++e) { lg[e] = __builtin_amdgcn_exp2f((lg[e] - mx) * 1.4426950408889634f); den += lg[e]; }
    float mine = 0.f;
#pragma unroll
    for (int e = 0; e < 16; ++e) mine = (lane == e) ? lg[e] : mine;
    if (st && lane < 16) ((float*)(ws + O_AFF))[(size_t)r * 16 + lane] = mine / den;
}
__device__ __forceinline__ void r1_phase(const Ctx& a, int layer, LAS unsigned char* lds, int tid, int lane, int wave, bool st) {
    unsigned char* ws = a.ws;
    LAS float* wl = (LAS float*)lds;
    LAS float* lv = (LAS float*)(lds + RV_OFF);
    RowDeal rd; rd.init(wave); rd.with_ctx = layer + 1 < DEPTH;
    { const float* wr = a.inp(IN_ROUTER) + (size_t)layer * DM * 16;
      for (int i = tid; i < DM * 16; i += NTHREADS) wl[(i & 15) * DM + (i >> 4)] = wr[i];
      lds_vec_fill(lv, mod_ptr(ws, layer, rd.b, 2), tid); lds_vec_fill(lv + DM, mod_ptr(ws, layer, rd.b, 4), tid); lds_vec_fill(lv + 2 * DM, mod_ptr(ws, layer, rd.b, 3), tid); }
    __syncthreads();
    RowV xn; u32x2 on[8];
#define R1_FETCH(R) do { row_load_f32_nt(xn, r_xsrc(a, layer, (R)), lane); _Pragma("unroll") for (int j = 0; j < 8; ++j) on[j] = *(const u32x2*)((const bf16_t*)(ws + O_O) + (size_t)(R) * DM + 4 * lane + 256 * j); } while (0)
    int r = rd.row(0);
    if (r >= 0) R1_FETCH(r);
    int k = 0;
    for (; k < rd.nlat; ++k) {
        RowV x;
#pragma unroll
        for (int j = 0; j < 8; ++j) { const f32x4 o = (f32x4){bf2f(on[j].x & 0xffffu), bf2f(on[j].x >> 16), bf2f(on[j].y & 0xffffu), bf2f(on[j].y >> 16)}; x.v[j] = xn.v[j] * ALPHA + vld(lv, lane, j) * o; }
        const int rn = rd.row(k + 1);
        if (rn >= 0) R1_FETCH(rn);
        r1_row<true>(a, layer, r, x, wl, lv, lane, st);
        r = rn;
    }
    for (; r >= 0; ++k) {
        RowV x; { int b, idx; bool isctx; row_decode(r, b, isctx, idx); const float* g1 = mod_ptr(ws, layer, isctx ? 2 : b, 2);
#pragma unroll
          for (int j = 0; j < 8; ++j) { const f32x4 o = (f32x4){bf2f(on[j].x & 0xffffu), bf2f(on[j].x >> 16), bf2f(on[j].y & 0xffffu), bf2f(on[j].y >> 16)}; x.v[j] = xn.v[j] * ALPHA + vld(g1, lane, j) * o; } }
        const int rn = rd.row(k + 1);
        if (rn >= 0) R1_FETCH(rn);
        r1_row<false>(a, layer, r, x, wl, lv, lane, st);
        r = rn;
    }
#undef R1_FETCH
    __syncthreads();
}
__device__ __forceinline__ int moe_row(int e, int b, bool isctx, int slot) { return isctx ? (NEXP * 4096 + e * 256 + b * CAP_C + slot) : (e * 4096 + b * CAP_L + slot); }
template <bool FAST>
__device__ __forceinline__ void r2_row(const Ctx& a, int layer, int r, const RowV& xin, int selv, float affv, const LAS float* lv, int lane, bool st) {
    unsigned char* ws = a.ws; int b, idx; bool isctx; row_decode(r, b, isctx, idx); const int which = isctx ? 2 : b;
    const bf16_t* YE = (const bf16_t*)(ws + O_YE);
    float* xs = isctx ? (float*)(ws + O_XC) + ((size_t)(b * CTX + idx)) * DM : a.outp() + ((size_t)(b * SEQ + idx)) * DM;
    RowV x = xin, f;
    unsigned long long m = __ballot(selv >= 0);
    const int e0 = m ? __builtin_ctzll(m) : 0; unsigned long long m1 = m & (m - 1); const int e1 = m1 ? __builtin_ctzll(m1) : 0; unsigned long long m2 = m1 & (m1 - 1); const int e2 = m2 ? __builtin_ctzll(m2) : 0;
    u32x2 y0[8], y1[8], y2[8];
    if (m) { const bf16_t* p = YE + (size_t)moe_row(e0, b, isctx, __builtin_amdgcn_readlane(selv, e0)) * DM + 4 * lane;
#pragma unroll
        for (int j = 0; j < 8; ++j) y0[j] = *(const u32x2*)(p + 256 * j); }
    if (m1) { const bf16_t* p = YE + (size_t)moe_row(e1, b, isctx, __builtin_amdgcn_readlane(selv, e1)) * DM + 4 * lane;
#pragma unroll
        for (int j = 0; j < 8; ++j) y1[j] = *(const u32x2*)(p + 256 * j); }
    if (m2) { const bf16_t* p = YE + (size_t)moe_row(e2, b, isctx, __builtin_amdgcn_readlane(selv, e2)) * DM + 4 * lane;
#pragma unroll
        for (int j = 0; j < 8; ++j) y2[j] = *(const u32x2*)(p + 256 * j); }
#pragma unroll
    for (int j = 0; j < 8; ++j) f.v[j] = (f32x4){0.f, 0.f, 0.f, 0.f};
#define R2_ACC(Y, E) do { const float w_ = __uint_as_float(__builtin_amdgcn_readlane(__float_as_uint(affv), E)); _Pragma("unroll") for (int j = 0; j < 8; ++j) \
        f.v[j] += (f32x4){bf2f(Y[j].x & 0xffffu), bf2f(Y[j].x >> 16), bf2f(Y[j].y & 0xffffu), bf2f(Y[j].y >> 16)} * w_; } while (0)
    if (m) R2_ACC(y0, e0);
    if (m1) R2_ACC(y1, e1);
    if (m2) R2_ACC(y2, e2);
#undef R2_ACC
    unsigned long long mr = m2 & (m2 - 1);
    while (mr) { const int e = __builtin_ctzll(mr); mr &= mr - 1;
        const int s = __builtin_amdgcn_readlane(selv, e); const float w = __uint_as_float(__builtin_amdgcn_readlane(__float_as_uint(affv), e));
        RowV y; row_load_bf16(y, YE + (size_t)moe_row(e, b, isctx, s) * DM, lane);
#pragma unroll
        for (int j = 0; j < 8; ++j) f.v[j] += y.v[j] * w; }
    const float* g2 = mod_ptr(ws, layer, which, 5);
#pragma unroll
    for (int j = 0; j < 8; ++j) { const f32x4 g = FAST ? vld(lv, lane, j) : vld(g2, lane, j); x.v[j] = x.v[j] * ALPHA + g * f.v[j]; }
    row_normalize(x);
    if (FAST) {
#pragma unroll
        for (int j = 0; j < 8; ++j) x.v[j] = x.v[j] * vld(lv + DM, lane, j) + vld(lv + 2 * DM, lane, j);
    } else row_affine(x, a.inp(IN_LNFG) + layer * DM, a.inp(IN_LNFB) + layer * DM, lane);
    if (st) { if (layer + 1 < DEPTH) row_store_f32_nt(x, xs, lane); else row_store_f32(x, xs, lane); }
    if (layer + 1 < DEPTH) { row_normalize(x);
        if (FAST) {
#pragma unroll
            for (int j = 0; j < 8; ++j) x.v[j] = x.v[j] * (vld(lv + 4 * DM, lane, j) + 1.f) + vld(lv + 3 * DM, lane, j);
        } else row_modulate(x, mod_ptr(ws, layer + 1, which, 0), mod_ptr(ws, layer + 1, which, 1), lane);
        if (st) row_store_bf16(x, (bf16_t*)(ws + O_U) + (size_t)r * DM, lane); }
}
__device__ __forceinline__ void r2_phase(const Ctx& a, int layer, LAS unsigned char* lds, int tid, int lane, int wave, bool st) {
    unsigned char* ws = a.ws;
    const int* SEL = (const int*)(ws + O_SEL); const float* AFF = (const float*)(ws + O_AFF);
    LAS float* lv = (LAS float*)lds;
    RowDeal rd; rd.init(wave); rd.with_ctx = layer + 1 < DEPTH;
    lds_vec_fill(lv, mod_ptr(ws, layer, rd.b, 5), tid); lds_vec_fill(lv + DM, a.inp(IN_LNFG) + layer * DM, tid); lds_vec_fill(lv + 2 * DM, a.inp(IN_LNFB) + layer * DM, tid);
    if (layer + 1 < DEPTH) { lds_vec_fill(lv + 3 * DM, mod_ptr(ws, layer + 1, rd.b, 0), tid); lds_vec_fill(lv + 4 * DM, mod_ptr(ws, layer + 1, rd.b, 1), tid); }
    __syncthreads();
    RowV xn; int seln = -1; float affn = 0.f;
    int r = rd.row(0);
    if (r >= 0) { row_load_f32_nt(xn, r_xsrc(a, 1, r), lane); if (lane < 16) { seln = SEL[(size_t)r * 16 + lane]; affn = AFF[(size_t)r * 16 + lane]; } }
    for (int k = 0; r >= 0; ++k) {
        const RowV x = xn; const int selv = seln; const float affv = affn;
        const int rn = rd.row(k + 1);
        seln = -1; affn = 0.f;
        if (rn >= 0) { row_load_f32_nt(xn, r_xsrc(a, 1, rn), lane); if (lane < 16) { seln = SEL[(size_t)rn * 16 + lane]; affn = AFF[(size_t)rn * 16 + lane]; } }
        if (k < rd.nlat) r2_row<true>(a, layer, r, x, selv, affv, lv, lane, st);
        else r2_row<false>(a, layer, r, x, selv, affv, lv, lane, st);
        r = rn;
    }
    __syncthreads();
}
__device__ __forceinline__ int block_excl_scan(int v, LAS int* tmp, int lane, int wave, int& total) {
    int inc = v;
#pragma unroll
    for (int o = 1; o < 64; o <<= 1) { const int t = __builtin_amdgcn_ds_bpermute((lane >= o ? lane - o : lane) << 2, inc); if (lane >= o) inc += t; }
    if (lane == 63) tmp[wave] = inc;
    __syncthreads();
    int off = 0, tot = 0;
#pragma unroll
    for (int w = 0; w < 8; ++w) { const int t = tmp[w]; off += (w < wave) ? t : 0; tot += t; }
    __syncthreads();
    total = tot; return off + inc - v;
}
__device__ __forceinline__ void topk_phase(const Ctx& a, bool with_ctx, LAS unsigned char* lds, int tid, int lane, int wave) {
    unsigned char* ws = a.ws; const float* AFF = (const float*)(ws + O_AFF); int* SEL = (int*)(ws + O_SEL); int* IDX = (int*)(ws + O_IDX);
    LAS unsigned* val = (LAS unsigned*)lds;
    LAS unsigned* hist = (LAS unsigned*)(lds + 69632);
    LAS unsigned* bc = hist + 256;
    LAS int* tmp = (LAS int*)(hist + 272);
    for (int li = blockIdx.x; li < (with_ctx ? 64 : 32); li += gridDim.x) {
        const bool isctx = li >= 32; const int q = li & 31, b = q >> 4, e = q & 15;
        const int n = isctx ? CTX : SEQ, k = isctx ? CAP_C : CAP_L, row0 = b * RPB + (isctx ? 0 : CTX);
        for (int i = tid; i < n; i += NTHREADS) val[i + (i >> 5)] = __float_as_uint(AFF[(size_t)(row0 + i) * 16 + e]);
        __syncthreads();
        unsigned prefix = 0u, mask = 0u; int krem = k;
        for (int pass = 0; pass < 4; ++pass) { const int shift = 24 - 8 * pass;
            if (tid < 256) hist[tid] = 0u;
            __syncthreads();
            for (int i = tid; i < n; i += NTHREADS) { const unsigned v = val[i + (i >> 5)]; const bool in = (v & mask) == prefix; const unsigned bin = (v >> shift) & 255u;
                const unsigned long long act = __ballot(in);
                if (act) { const int first = (int)__builtin_ctzll(act); const unsigned lead = (unsigned)__builtin_amdgcn_readlane((int)bin, first);
                    const unsigned long long same = __ballot(in && bin == lead);
                    if (in && bin != lead) __hip_atomic_fetch_add(&hist[bin], 1u, __ATOMIC_RELAXED, __HIP_MEMORY_SCOPE_WORKGROUP);
                    if (lane == first) __hip_atomic_fetch_add(&hist[lead], (unsigned)__builtin_popcountll(same), __ATOMIC_RELAXED, __HIP_MEMORY_SCOPE_WORKGROUP); } }
            __syncthreads();
            if (wave == 0) { const int b0 = 255 - 4 * lane; const int c0 = (int)hist[b0], c1 = (int)hist[b0 - 1], c2 = (int)hist[b0 - 2], c3 = (int)hist[b0 - 3]; const int s = c0 + c1 + c2 + c3;
                int inc = s;
#pragma unroll
                for (int o = 1; o < 64; o <<= 1) { const int t = __builtin_amdgcn_ds_bpermute((lane >= o ? lane - o : lane) << 2, inc); if (lane >= o) inc += t; }
                const int exc = inc - s;
                if (exc < krem && krem <= inc) { int cum = exc, bin, before;
                    if (krem <= cum + c0) { bin = b0; before = cum; } else { cum += c0;
                    if (krem <= cum + c1) { bin = b0 - 1; before = cum; } else { cum += c1;
                    if (krem <= cum + c2) { bin = b0 - 2; before = cum; } else { cum += c2; bin = b0 - 3; before = cum; } } }
                    bc[0] = (unsigned)bin; bc[1] = (unsigned)(krem - before); } }
            __syncthreads();
            prefix |= bc[0] << shift; mask |= 0xffu << shift; krem = (int)bc[1];
        }
        const unsigned vstar = prefix; const int need = krem;
        const bool act = tid < (n >> 5); int cgt = 0, ceq = 0;
        if (act) for (int j = 0; j < 32; ++j) { const unsigned v = val[33 * tid + j]; cgt += v > vstar; ceq += v == vstar; }
        int tot; const int eqb = block_excl_scan(ceq, tmp, lane, wave, tot);
        int takeq = need - eqb; takeq = takeq < 0 ? 0 : (takeq > ceq ? ceq : takeq);
        const int slot0 = block_excl_scan(cgt + takeq, tmp, lane, wave, tot);
        if (act) { int eqr = eqb, slot = slot0;
            for (int j = 0; j < 32; ++j) { const int i = 32 * tid + j; const unsigned v = val[33 * tid + j]; const bool iseq = v == vstar; const bool take = v > vstar || (iseq && eqr < need); eqr += iseq;
                SEL[(size_t)(row0 + i) * 16 + e] = take ? slot : -1;
                if (take) { IDX[moe_row(e, b, isctx, slot)] = row0 + i; ++slot; } } }
        __syncthreads();
    }
}
__device__ __forceinline__ bool moe_row_valid(int m) { return m < NEXP * 4096 || ((m - NEXP * 4096) & 255) < 2 * CAP_C; }
__device__ __forceinline__ void gather_phase(const Ctx& a, int lane, int wave) {
    unsigned char* ws = a.ws; const int gw = blockIdx.x * NWAVES + wave, NGW = gridDim.x * NWAVES; const int* IDX = (const int*)(ws + O_IDX);
    for (int m0 = gw * 4; m0 < MOE_ROWS; m0 += NGW * 4) {
        const int mi = m0 + (lane & 3); const int tv = moe_row_valid(mi) ? IDX[mi] : -1;
        u32x4 t[4][4];
#pragma unroll
        for (int q = 0; q < 4; ++q) { const int tok = __builtin_amdgcn_readlane(tv, q);
            if (tok >= 0) { const u32x4* src = (const u32x4*)((const bf16_t*)(ws + O_H2) + (size_t)tok * DM);
#pragma unroll
                for (int j = 0; j < 4; ++j) t[q][j] = src[lane + 64 * j]; } }
#pragma unroll
        for (int q = 0; q < 4; ++q) { const int tok = __builtin_amdgcn_readlane(tv, q);
            if (tok >= 0) { u32x4* dst = (u32x4*)((bf16_t*)(ws + O_XE) + (size_t)(m0 + q) * DM);
#pragma unroll
                for (int j = 0; j < 4; ++j) dst[lane + 64 * j] = t[q][j]; } }
    }
}
__device__ __forceinline__ bool attn_fixed_form(const Ctx& a, int j, int lane) {
    const float* qg = a.inp(IN_QGAIN) + j * 128; const float* kg = a.inp(IN_KGAIN) + j * 128;
    const float gq = wave_max(fmaxf(fabsf(qg[lane]), fabsf(qg[lane + 64]))), gk = wave_max(fmaxf(fabsf(kg[lane]), fabsf(kg[lane + 64])));
    return 128.f * gq * gk * 1.03f * 0.088388347648318440f < 27.f;
}
__device__ __forceinline__ void qknorm_phase(const Ctx& a, int j, int lane, int wave, bool st) {
    unsigned char* ws = a.ws; const int gw = blockIdx.x * NWAVES + wave, NGW = gridDim.x * NWAVES;
    const f32x4* TRIG4 = (const f32x4*)(ws + O_TRIG);
    const int cidx = lane & 15, d0 = cidx * 8; const bool upper = (cidx & 4) != 0;
    const float* qg = a.inp(IN_QGAIN) + j * 128 + d0; const float* kg = a.inp(IN_KGAIN) + j * 128 + d0;
    const float qs = attn_fixed_form(a, j, lane) ? 0.088388347648318440f * 1.4426950408889634f : 1.f;
    const f32x4 gq0 = *(const f32x4*)qg * qs, gq1 = *(const f32x4*)(qg + 4) * qs, gk0 = *(const f32x4*)kg, gk1 = *(const f32x4*)(kg + 4);
    u32x4 nraw[5];
    if (gw < NR) { const bf16_t* zn = (const bf16_t*)(ws + O_Z) + (size_t)gw * 3072 + lane * 8;
#pragma unroll
        for (int it = 0; it < 5; ++it) nraw[it] = *(const u32x4*)(zn + it * 512); }
    for (int r = gw; r < NR; r += NGW) { int b, idx; bool isctx; row_decode(r, b, isctx, idx);
        float cs[8], sn[8];
#pragma unroll
        for (int i = 0; i < 8; ++i) { cs[i] = 1.f; sn[i] = 0.f; }
        if (!isctx) { const int pos = cidx < 8 ? (idx >> 6) : (idx & 63); const f32x4* tp = TRIG4 + pos * 16 + (cidx & 3) * 4;
#pragma unroll
            for (int q = 0; q < 4; ++q) { const f32x4 t = tp[q]; cs[2 * q] = t[0]; sn[2 * q] = t[1]; cs[2 * q + 1] = t[2]; sn[2 * q + 1] = t[3]; } }
        bf16_t* zr = (bf16_t*)(ws + O_Z) + (size_t)r * 3072 + lane * 8;
        u32x4 raw[5];
#pragma unroll
        for (int it = 0; it < 5; ++it) raw[it] = nraw[it];
        if (r + NGW < NR) { const bf16_t* zn = (const bf16_t*)(ws + O_Z) + (size_t)(r + NGW) * 3072 + lane * 8;
#pragma unroll
            for (int it = 0; it < 5; ++it) nraw[it] = *(const u32x4*)(zn + it * 512); }
#pragma unroll
        for (int it = 0; it < 5; ++it) {
            float x[8]; x[0] = bf2f(raw[it].x & 0xffffu); x[1] = bf2f(raw[it].x >> 16); x[2] = bf2f(raw[it].y & 0xffffu); x[3] = bf2f(raw[it].y >> 16);
            x[4] = bf2f(raw[it].z & 0xffffu); x[5] = bf2f(raw[it].z >> 16); x[6] = bf2f(raw[it].w & 0xffffu); x[7] = bf2f(raw[it].w >> 16);
            float ss = 0.f;
#pragma unroll
            for (int i = 0; i < 8; ++i) ss += x[i] * x[i];
            ss = row16_sum(ss);
            const float rinv = 1.f / sqrtf(ss * (1.f / 128.f) + QK_EPS);
            const f32x4 g0 = it < 4 ? gq0 : gk0, g1 = it < 4 ? gq1 : gk1;
            float y[8], o[8];
#pragma unroll
            for (int i = 0; i < 4; ++i) { y[i] = x[i] * rinv * g0[i]; y[4 + i] = x[4 + i] * rinv * g1[i]; }
#pragma unroll
            for (int i = 0; i < 8; ++i) { const float yp = __int_as_float(__builtin_amdgcn_ds_swizzle(__float_as_int(y[i]), 0x101F));     o[i] = upper ? (y[i] * cs[i] + yp * sn[i]) : (y[i] * cs[i] - yp * sn[i]); }
            u32x4 w; w.x = cvt_pk_bf16(o[0], o[1]); w.y = cvt_pk_bf16(o[2], o[3]); w.z = cvt_pk_bf16(o[4], o[5]); w.w = cvt_pk_bf16(o[6], o[7]);
            if (st) *(u32x4*)(zr + it * 512) = w; }
    }
}
__device__ __forceinline__ int s5_chunk_at(int b, int d, int q) { const int cb = b * 520; return d == 0 ? cb + q : (q < 8 ? cb + 7 - q : cb + 527 - q); }
__device__ __forceinline__ void s5_carry_phase(const Ctx& a, int j, LAS unsigned char* lds, int lane, int wave) {
    unsigned char* ws = a.ws; const float* SUM = (const float*)(ws + O_SUM); bf16_t* A3 = (bf16_t*)(ws + O_A3);
    LAS f32x2* ex = (LAS f32x2*)lds;
    for (int ui = blockIdx.x; ui < 256; ui += gridDim.x) {
        const int b = ui >> 7, g = (ui >> 1) & 63, d = ui & 1;
        const f32x2 l32 = ((const f32x2*)(ws + O_POW))[((size_t)((j * 2 + d) * 64 + g) * 64 + lane) * 33 + 32];
        const float* sb = SUM + (size_t)g * NCHP * 256 + d * 128 + lane;
        float hr = 0.f, hi = 0.f;
#pragma unroll 13
        for (int i = 0; i < 65; ++i) { const int ch = s5_chunk_at(b, d, wave * 65 + i); const float sr = sb[(size_t)ch * 256], si = sb[(size_t)ch * 256 + 64];
            const float nr = l32.x * hr - l32.y * hi + sr, ni = l32.x * hi + l32.y * hr + si; hr = nr; hi = ni; }
        ex[wave * 64 + lane] = (f32x2){hr, hi};
        __syncthreads();
        float pr = l32.x, pi = l32.y;
#pragma unroll
        for (int s = 0; s < 6; ++s) { const float nr = pr * pr - pi * pi, ni = 2.f * pr * pi; pr = nr; pi = ni; }
        { const float nr = pr * l32.x - pi * l32.y, ni = pr * l32.y + pi * l32.x; pr = nr; pi = ni; }
        float cr = 0.f, ci = 0.f;
        for (int w = 0; w < wave; ++w) { const f32x2 e = ex[w * 64 + lane]; const float nr = pr * cr - pi * ci + e.x, ni = pr * ci + pi * cr + e.y; cr = nr; ci = ni; }
        hr = cr; hi = ci;
        bf16_t* ab = A3 + (size_t)g * NCHP * A3K + 512 + d * 128 + lane;
#pragma unroll 13
        for (int i = 0; i < 65; ++i) { const int ch = s5_chunk_at(b, d, wave * 65 + i); const float sr = sb[(size_t)ch * 256], si = sb[(size_t)ch * 256 + 64];
            ab[(size_t)ch * A3K] = (bf16_t)f2bf(hr); ab[(size_t)ch * A3K + 64] = (bf16_t)f2bf(hi);
            const float nr = l32.x * hr - l32.y * hi + sr, ni = l32.x * hi + l32.y * hr + si; hr = nr; hi = ni; }
        __syncthreads();
    }
}
__device__ __forceinline__ void f1_transpose_phase(const Ctx& a, LAS unsigned char* lds, int lane, int wave) {
    unsigned char* ws = a.ws; const int gw = blockIdx.x * NWAVES + wave, NGW = gridDim.x * NWAVES;
    LAS bf16_t* scr = (LAS bf16_t*)(lds + wave * 16384);
    const bf16_t* ZF = (const bf16_t*)(ws + O_ZF);
    constexpr int N_LAT = 2 * 128 * 32, N_CTX = 2 * 2 * 32, P = 136;
    constexpr int N_SKEW = 3840, SK_WG = 64;
    const int nskw = ((int)gridDim.x - SK_WG) * NWAVES, gws = gw - SK_WG * NWAVES;
    const int n_mine_skew = (nskw > 0 && gws >= 0) ? (N_SKEW - gws + nskw - 1) / nskw : 0;
    const int skew0 = nskw > 0 ? N_SKEW : 0;
    const int n_mine_even = (N_LAT + N_CTX - skew0 - gw + NGW - 1) / NGW;
    for (int k = 0; k < n_mine_skew + (n_mine_even > 0 ? n_mine_even : 0); ++k) {
        const int it = k < n_mine_skew ? gws + k * nskw : skew0 + gw + (k - n_mine_skew) * NGW;
        size_t srow0, sstride; bf16_t* dst; size_t dpitch; int cb;
        if (it < N_LAT) { const int b = it >> 12, l2 = (it >> 5) & 127; cb = it & 31; srow0 = (size_t)b * RPB + CTX + l2; sstride = 128;
            dst = (bf16_t*)(ws + O_T1) + ((size_t)(b * 1024 + cb * 32) * 128 + l2) * 128; dpitch = 128 * 128; }
        else { const int q = it - N_LAT, b = q >> 6, tb = (q >> 5) & 1; cb = q & 31; srow0 = (size_t)b * RPB + tb * 128; sstride = 1;
            dst = (bf16_t*)(ws + O_T1C) + (size_t)(b * 1024 + cb * 32) * 256 + tb * 128; dpitch = 256; }
        const int c4 = lane & 3, rsub = lane >> 2;
        u32x4 v[8];
#pragma unroll
        for (int i = 0; i < 8; ++i) v[i] = *(const u32x4*)(ZF + (srow0 + (size_t)(16 * i + rsub) * sstride) * 1024 + cb * 32 + c4 * 8);
#pragma unroll
        for (int i = 0; i < 8; ++i) { const int rr = 16 * i + rsub; LAS bf16_t* s = scr + (c4 * 8) * P + rr;
            s[0 * P] = (bf16_t)(v[i].x & 0xffffu); s[1 * P] = (bf16_t)(v[i].x >> 16); s[2 * P] = (bf16_t)(v[i].y & 0xffffu); s[3 * P] = (bf16_t)(v[i].y >> 16);
            s[4 * P] = (bf16_t)(v[i].z & 0xffffu); s[5 * P] = (bf16_t)(v[i].z >> 16); s[6 * P] = (bf16_t)(v[i].w & 0xffffu); s[7 * P] = (bf16_t)(v[i].w >> 16); }
        LDS_WAIT(); asm volatile("" ::: "memory");
        const int ch0 = lane >> 4, r0 = (lane & 15) * 8;
#pragma unroll
        for (int i = 0; i < 8; ++i) { const int ch = ch0 + 4 * i; const u32x4 o = *(const LAS u32x4*)(scr + ch * P + r0);
            *(u32x4*)(dst + (size_t)ch * dpitch + r0) = o; }
        LDS_WAIT(); asm volatile("" ::: "memory");
    }
    __syncthreads();
}
template <bool FIXM>
__device__ __forceinline__ void attn_units(const Ctx& a, int nunits, char* lds, int tid, float mfixC) {
    unsigned char* ws = a.ws; const bf16_t* Z = (const bf16_t*)(ws + O_Z); bf16_t* AO = (bf16_t*)(ws + O_AO);
    for (int L = blockIdx.x; L < nunits; L += gridDim.x) {
        int b, h, q0, seq;
        if (L < 2048) { b = L >> 10; const int kvh = (L >> 8) & 3, g = (L >> 6) & 3, qb = L & 63; h = kvh * 4 + g; q0 = b * RPB + CTX + qb * 256; seq = RPB; }
        else { const int q = L - 2048; b = q >> 4; h = q & 15; q0 = b * RPB; seq = CTX; }
        const int kvh = h >> 2; const size_t k0 = (size_t)b * RPB;
        if constexpr (FIXM) { if (L < 2048) { att::attn_ring3_body<RPB / 64>(Z + (size_t)q0 * 3072 + h * 128, Z + k0 * 3072 + 2048 + kvh * 128, Z + k0 * 3072 + 2560 + kvh * 128, AO + (size_t)q0 * 2048 + h * 128, lds, tid); continue; } }
        att::attn_dense_body<FIXM>(Z + (size_t)q0 * 3072 + h * 128, Z + k0 * 3072 + 2048 + kvh * 128, Z + k0 * 3072 + 2560 + kvh * 128, AO + (size_t)q0 * 2048 + h * 128, seq, lds, tid, mfixC);
    }
}
__device__ __forceinline__ void attn_phase(const Ctx& a, int j, bool need_ctx, char* lds, int tid) {
    unsigned char* ws = a.ws; const bf16_t* Z = (const bf16_t*)(ws + O_Z); bf16_t* AO = (bf16_t*)(ws + O_AO);
    const int nunits = 2048 + (need_ctx ? 32 : 0);
    const bool fixm = attn_fixed_form(a, j, tid & 63); const float mfixC = 0.f;
    if (fixm) attn_units<true>(a, nunits, lds, tid, mfixC); else attn_units<false>(a, nunits, lds, tid, 0.f);
}
constexpr int NPH = 3 + 12 * DEPTH;
#ifndef MK_N_LAUNCHES
#define MK_N_LAUNCHES 1
#endif
#ifndef REP_ATT
#define REP_ATT 1
#endif
#ifndef REP_MOE
#define REP_MOE 1
#endif
#ifndef REP_EVEN
#define REP_EVEN 1
#endif
#ifndef REP_ODDG
#define REP_ODDG 1
#endif
#ifndef REP_CONV
#define REP_CONV 1
#endif
#ifndef REP_GA
#define REP_GA 1
#endif
#ifndef REP_PRO
#define REP_PRO 1
#endif
#ifndef REP_ROW
#define REP_ROW 1
#endif
#ifndef REP_QK
#define REP_QK 1
#endif
#ifndef REP_P0
#define REP_P0 1
#endif
#ifndef REP_P1
#define REP_P1 1
#endif
#ifndef REP_P2
#define REP_P2 1
#endif
#ifndef REP_R1
#define REP_R1 1
#endif
#ifndef REP_R2
#define REP_R2 1
#endif
#ifndef REP_TK
#define REP_TK 1
#endif
#ifndef REP_GAT
#define REP_GAT 1
#endif
#ifndef REP_BAR
#define REP_BAR 1
#endif
#define REPEAT(N) _Pragma("unroll 1") for (int rep_ = 0; rep_ < (N); ++rep_)

__global__ void __launch_bounds__(NTHREADS, 2) mk_fwd(Args a0) {
    extern __shared__ __attribute__((aligned(16))) unsigned char lds_raw[];
    LAS unsigned char* lds = (LAS unsigned char*)lds_raw;
    volatile LAS unsigned* MISC = (volatile LAS unsigned*)(lds + MISC_OFF);
    if (threadIdx.x < 32) MISC[threadIdx.x] = 0u;
    if (threadIdx.x == 0) {
#pragma unroll
        for (int i = 0; i < 32; ++i) *(LAS unsigned long long*)(lds + PTR_OFF + 8 * i) = (unsigned long long)a0.in[i];
        *(LAS unsigned long long*)(lds + PTR_OFF + 8 * 32) = (unsigned long long)a0.out; }
    __syncthreads();
    const int wave0 = __builtin_amdgcn_readfirstlane(threadIdx.x >> 6);
    const int lo = a0.ph_lo, hi = a0.ph_hi; (void)lo; (void)hi;
    XcdBarrier bar = xcd_barrier_post((unsigned*)(a0.ws + O_CTL) + CW_BAR + a0.li * XCD_BAR_WORDS, MISC + 8);
#if MK_N_LAUNCHES == 1
#define IN(k) true
#else
#define IN(k) (lo <= (k) && (k) < hi)
#endif
#define PH int tid; asm volatile("v_mbcnt_lo_u32_b32 %0, -1, 0\n\tv_mbcnt_hi_u32_b32 %0, -1, %0" : "=v"(tid)); tid += wave0 * 64; asm volatile("" : "+v"(tid));     const int lane = tid & 63, wave = __builtin_amdgcn_readfirstlane(tid >> 6); (void)lane; (void)wave; size_t wz_ = 0; asm volatile("" : "+s"(wz_)); unsigned char* ws = a0.ws + wz_; const Ctx a{lds, ws};
#if MK_N_LAUNCHES == 1
#define SEAM(k) do { if ((k) + 1 < NPH) { REPEAT(REP_BAR) xcd_barrier(bar); } } while (0)
#else
#define SEAM(k) do { if ((k) + 1 < hi) { REPEAT(REP_BAR) xcd_barrier(bar); } } while (0)
#endif
    const int G = gridDim.x, cid = blockIdx.x;
    pg8::Sched S;

    if (IN(0)) { PH REPEAT(REP_P0) p0_prologue(a, lds, tid, lane, wave); SEAM(0); }
    if (IN(1)) { PH REPEAT(REP_P1) { p1_kf(a, lds, tid); r0_phase(a, lane, wave); } SEAM(1); }
    if (IN(2)) { PH REPEAT(REP_P2) p2_s5mats(a, tid); SEAM(2); }

    for (int layer = 0; layer < DEPTH; ++layer) {
        const int base = 3 + 12 * layer, j = layer >> 1;
        const bool need_ctx = layer < DEPTH - 1;
        if ((layer & 1) == 0) {
            if (IN(base + 0)) { PH
                moe_weight_phase(a, layer, 0, (NRT * 8) % G, lds, lane, wave);
                pg8::OpWin op{(const bf16_t*)(ws + O_U), (const bf16_t*)(ws + O_WIN) + (size_t)j * DM * DM, DM, DM, DM, (bf16_t*)(ws + O_A3), (bf16_t*)(ws + O_ZF)};
                S.init(NRT, 8, G, cid); REPEAT(REP_EVEN) pg8::gemm_phase(lds, op, S, tid);
                SEAM(base + 0);
            }
            if (IN(base + 1)) { PH
                { pg8::OpL1 op{(const bf16_t*)(ws + O_A3), (const bf16_t*)(ws + O_BT1) + (size_t)j * 64 * 256 * 512, A3K, 512, 512, (float*)(ws + O_SUM)};
                  S.init(320, 1, G, cid); REPEAT(REP_EVEN) pg8::gemm_phase(lds, op, S, tid); }
                REPEAT(REP_EVEN) f1_transpose_phase(a, lds, lane, wave);
                SEAM(base + 1);
            }
            if (IN(base + 2)) { PH
                REPEAT(REP_EVEN) s5_carry_phase(a, j, lds, lane, wave);
                { pg8::OpFftA op{(const bf16_t*)(ws + O_FA), (const bf16_t*)(ws + O_T1), 256, 128, 256, (bf16_t*)(ws + O_BT2)};
                  S.init(1, 1024, G, cid); REPEAT(REP_EVEN) pg8::gemm_phase(lds, op, S, tid); }
                { pg8::OpCtxDft op{(const bf16_t*)(ws + O_F256), (const bf16_t*)(ws + O_T1C), 256, 256, 256, (bf16_t*)(ws + O_PQ)};
                  S.init(2, 8, G, cid); REPEAT(REP_EVEN) pg8::gemm_phase(lds, op, S, tid); }
                SEAM(base + 2);
            }
            if (IN(base + 3)) { PH
                { pg8::OpL3 op{(const bf16_t*)(ws + O_A3), (const bf16_t*)(ws + O_BT3) + (size_t)j * 64 * 512 * 768, A3K, A3K, A3K, (bf16_t*)(ws + O_G)};
                  S.init(320, 2, G, cid); REPEAT(REP_EVEN) pg8::gemm_phase(lds, op, S, tid); }
                { pg8::OpFftC op{(const bf16_t*)(ws + O_FC), (const bf16_t*)(ws + O_BT2), 256, 256, 256, (bf16_t*)(ws + O_PQ)};
                  S.init(1, 1024, G, cid); REPEAT(REP_EVEN) pg8::gemm_phase(lds, op, S, tid); }
                SEAM(base + 3);
            }
            if (IN(base + 4)) { PH
                { pg8::OpGlu op{(const bf16_t*)(ws + O_G), (const bf16_t*)(ws + O_WGLU) + (size_t)j * 1024 * 1024, 1024, 1024, 1024, a.inp(IN_BGLU) + j * 1024, (bf16_t*)(ws + O_CAT)};
                  S.init(NRT, 4, G, cid); REPEAT(REP_EVEN) pg8::gemm_phase(lds, op, S, tid); }
                { pg8::OpFnet op{(const bf16_t*)(ws + O_PQ), (const bf16_t*)(ws + O_FNM) + (size_t)j * 4 * 256 * 512, DM, 512, 512, a.inp(IN_FNETB) + j * 1024, (bf16_t*)(ws + O_CAT)};
                  S.init(NRT, 4, G, (cid + G - (NRT * 4) % G) % G); REPEAT(REP_EVEN) pg8::gemm_phase(lds, op, S, tid); }
                SEAM(base + 4);
            }
            if (IN(base + 5)) { PH
                moe_weight_phase(a, layer, 1, (NRT * 8) % G, lds, lane, wave);
                pg8::OpStore<false> op{(const bf16_t*)(ws + O_CAT), (const bf16_t*)(ws + O_WOUT) + (size_t)j * DM * DM, DM, DM, DM, (bf16_t*)(ws + O_O), DM, nullptr};
                S.init(NRT, 8, G, cid); REPEAT(REP_EVEN) pg8::gemm_phase(lds, op, S, tid);
                SEAM(base + 5);
            }
        } else {
            if (IN(base + 0)) { PH
                moe_weight_phase(a, layer, 0, (NRT * 12) % G, lds, lane, wave);
                pg8::OpStore<false> op{(const bf16_t*)(ws + O_U), (const bf16_t*)(ws + O_WQKV) + (size_t)j * 3072 * DM, DM, DM, DM, (bf16_t*)(ws + O_Z), 3072, nullptr};
                S.init(NRT, 12, G, cid); REPEAT(REP_ODDG) pg8::gemm_phase(lds, op, S, tid);
                SEAM(base + 0);
            }
            if (IN(base + 1)) { PH REPEAT(REP_QK) qknorm_phase(a, j, lane, wave, rep_ == REP_QK - 1); SEAM(base + 1); }
            if (IN(base + 2)) { PH REPEAT(REP_ATT) attn_phase(a, j, need_ctx, (char*)lds_raw, tid); SEAM(base + 2); }
            if (IN(base + 3)) { PH
                moe_weight_phase(a, layer, 1, (NRT * 8) % G, lds, lane, wave);
                pg8::OpStore<false> op{(const bf16_t*)(ws + O_AO), (const bf16_t*)(ws + O_WO) + (size_t)j * DM * DM, DM, DM, DM, (bf16_t*)(ws + O_O), DM, nullptr};
                S.init(NRT, 8, G, cid); REPEAT(REP_ODDG) pg8::gemm_phase(lds, op, S, tid);
                SEAM(base + 3);
            }
        }
        if (IN(base + 6)) { PH REPEAT(REP_R1) r1_phase(a, layer, lds, tid, lane, wave, rep_ == REP_R1 - 1); SEAM(base + 6); }
        if (IN(base + 7)) { PH REPEAT(REP_TK) topk_phase(a, need_ctx, lds, tid, lane, wave); SEAM(base + 7); }
        if (IN(base + 9)) { PH
            pg8::OpM1 op{(const bf16_t*)(ws + O_H2), (const bf16_t*)(ws + O_WGU), DM, DM, DM, (bf16_t*)(ws + O_HID), (const int*)(ws + O_IDX)};
            S.init(256, 8, G, cid); S.head = need_ctx ? 128 : 0; S.headM0 = 256; REPEAT(REP_MOE) pg8::gemm_phase(lds, op, S, tid); S.head = 0;
            SEAM(base + 9);
        }
        if (IN(base + 10)) { PH
            pg8::OpStore<true> op{(const bf16_t*)(ws + O_HID), (const bf16_t*)(ws + O_WD), EFF, EFF, EFF, (bf16_t*)(ws + O_YE), DM, nullptr};
            S.init(256, 8, G, cid); S.head = need_ctx ? 128 : 0; S.headM0 = 256; REPEAT(REP_MOE) pg8::gemm_phase(lds, op, S, tid); S.head = 0;
            SEAM(base + 10);
        }
        if (IN(base + 11)) { PH REPEAT(REP_R2) r2_phase(a, layer, lds, tid, lane, wave, rep_ == REP_R2 - 1); SEAM(base + 11); }
    }
#undef IN
#undef SEAM
}

static bool phase_empty(int k) { if (k < 3) return false; const int l = (k - 3) / 12, s = (k - 3) % 12; return (l & 1) && (s == 4 || s == 5); }
extern "C" void kernel_launch(void* const* d_in, const int* in_sizes, int n_in, void* d_out, int out_size, void* d_ws, size_t ws_size, hipStream_t stream) {
    static int grid = 0;
    if (grid == 0) {
        if (n_in != 32 || out_size != NBATCH * SEQ * DM || ws_size < WS_NEED) { fprintf(stderr, "kernel_launch: bad shapes n_in %d out %d ws %zu (need %zu)\n", n_in, out_size, ws_size, (size_t)WS_NEED); grid = -1; return; }
        int dev = 0, cus = 0;
        if (hipGetDevice(&dev) != hipSuccess || hipDeviceGetAttribute(&cus, hipDeviceAttributeMultiprocessorCount, dev) != hipSuccess) { grid = -1; return; }
        if (hipFuncSetAttribute((const void*)mk_fwd, hipFuncAttributeMaxDynamicSharedMemorySize, LDS_BYTES) != hipSuccess) { fprintf(stderr, "kernel_launch: hipFuncSetAttribute failed\n"); grid = -1; return; }
        int per_cu = 0;
        if (hipOccupancyMaxActiveBlocksPerMultiprocessor(&per_cu, (const void*)mk_fwd, NTHREADS, LDS_BYTES) != hipSuccess || per_cu < 1) fprintf(stderr, "kernel_launch: occupancy query says %d\n", per_cu);
        (void)hipGetLastError();
        grid = cus;
    }
    if (grid < 0) return;
    (void)in_sizes;
    if (hipMemsetAsync((char*)d_ws + O_CTL, 0, CTL_BYTES, stream) != hipSuccess) return;
    Args a{};
    for (int i = 0; i < 32; ++i) a.in[i] = (const float*)d_in[i];
    a.out = (float*)d_out; a.ws = (unsigned char*)d_ws; a.pad = 0;
#if MK_N_LAUNCHES == 1
    a.ph_lo = 0; a.ph_hi = NPH; a.li = 0;
    hipLaunchKernelGGL(mk_fwd, dim3(grid), dim3(NTHREADS), LDS_BYTES, stream, a);
#else
    int li = 0;
    for (int k = 0; k < NPH; ++k) { if (phase_empty(k)) continue;
        a.ph_lo = k; a.ph_hi = k + 1; a.li = li++;
        hipLaunchKernelGGL(mk_fwd, dim3(grid), dim3(NTHREADS), LDS_BYTES, stream, a); }
#endif
    const hipError_t le = hipPeekAtLastError();
    if (le != hipSuccess) fprintf(stderr, "kernel_launch: launch failed: %s\n", hipGetErrorName(le));
}
```

```cpp
#include <hip/hip_runtime.h>
#include <cstdio>
#include <cstdint>

#define GAS __attribute__((address_space(1)))
#define LAS __attribute__((address_space(3)))
typedef unsigned short bf16_t;
typedef short bf16x8 __attribute__((ext_vector_type(8)));
typedef short s16x4 __attribute__((ext_vector_type(4)));
typedef float f32x4 __attribute__((ext_vector_type(4)));
typedef float f32x2 __attribute__((ext_vector_type(2)));
typedef float f32x16 __attribute__((ext_vector_type(16)));
typedef unsigned u32x4 __attribute__((ext_vector_type(4)));
typedef unsigned u32x2 __attribute__((ext_vector_type(2)));

constexpr int DM = 2048, NBATCH = 2, SEQ = 16384, CTX = 256, DEPTH = 4;
constexpr int RPB = SEQ + CTX;
constexpr int NR = NBATCH * RPB;
constexpr int NRT = NR / 256;
constexpr int NEXP = 16, EFF = 1024, CAP_L = 2048, CAP_C = 32;
constexpr int MOE_ROWS = NEXP * 4096 + NEXP * 256;
constexpr int MOE_RT = MOE_ROWS / 256;
constexpr int S5G = 64, S5P = 64, S5C = 16, S5T = 32;
constexpr int NCH = NR / S5T;
constexpr int NCHP = 1280;
constexpr int A3K = 768;
constexpr float LN_EPS = 1e-6f, QK_EPS = 1e-6f;
constexpr float ALPHA = 1.681792830507429f;
constexpr int NTHREADS = 512, NWAVES = 8;

constexpr size_t A256(size_t x) { return (x + 255) / 256 * 256; }
constexpr size_t O_CTL = 0, CTL_BYTES = 1u << 20;
constexpr size_t O_MOD = O_CTL + CTL_BYTES;
constexpr size_t O_TRIG = O_MOD + A256((size_t)4 * 3 * 6 * DM * 4);
constexpr size_t O_FA = O_TRIG + 256 * 32 * 8;
constexpr size_t O_FC = O_FA + 256 * 256 * 2;
constexpr size_t O_F256 = O_FC + (size_t)128 * 256 * 256 * 2;
constexpr size_t O_POW = O_F256 + 512 * 256 * 2;
constexpr size_t O_BBAR = O_POW + A256((size_t)2 * 2 * 64 * 64 * 33 * 8);
constexpr size_t O_KF = O_BBAR + (size_t)2 * 2 * 64 * 64 * 16 * 8;
constexpr size_t O_WIN = O_KF + (size_t)2 * 2 * 64 * 32 * 256 * 4;
constexpr size_t O_WOUT = O_WIN + (size_t)2 * DM * DM * 2;
constexpr size_t O_WGLU = O_WOUT + (size_t)2 * DM * DM * 2;
constexpr size_t O_FNM = O_WGLU + (size_t)2 * 1024 * 1024 * 2;
constexpr size_t O_BT1 = O_FNM + (size_t)2 * 4 * 256 * 512 * 2;
constexpr size_t O_BT3 = O_BT1 + (size_t)2 * 64 * 256 * 512 * 2;
constexpr size_t O_WQKV = O_BT3 + (size_t)2 * 64 * 512 * 768 * 2;
constexpr size_t O_WO = O_WQKV + (size_t)2 * 3072 * DM * 2;
constexpr size_t O_WGU = O_WO + (size_t)2 * DM * DM * 2;
constexpr size_t O_WD = O_WGU + (size_t)NEXP * 2048 * DM * 2;
constexpr size_t O_XC = O_WD + (size_t)NEXP * DM * EFF * 2;
constexpr size_t O_AFF = O_XC + (size_t)512 * DM * 4;
constexpr size_t O_SEL = O_AFF + (size_t)NR * 16 * 4;
constexpr size_t O_IDX = O_SEL + (size_t)NR * 16 * 4;
constexpr size_t O_U = O_IDX + A256((size_t)MOE_ROWS * 4);
constexpr size_t O_H2 = O_U + (size_t)NR * DM * 2;
constexpr size_t O_O = O_H2 + (size_t)NR * DM * 2;
constexpr size_t O_S = O_O + (size_t)NR * DM * 2;
constexpr size_t O_A3 = O_S;
constexpr size_t O_SUM = O_A3 + (size_t)S5G * NCHP * A3K * 2;
constexpr size_t O_ZF = O_SUM + (size_t)S5G * NCHP * 256 * 4;
constexpr size_t O_T1 = O_ZF + (size_t)NR * 1024 * 2;
constexpr size_t O_T1C = O_T1 + (size_t)2048 * 128 * 128 * 2 + 256;
constexpr size_t O_BT2 = O_T1C + (size_t)2048 * 256 * 2;
constexpr size_t O_PQ = O_BT2 + (size_t)128 * 2048 * 256 * 2;
constexpr size_t O_G = O_PQ + (size_t)NR * DM * 2;
constexpr size_t O_CAT = O_G + (size_t)NR * 1024 * 2;
constexpr size_t O_EVEN_END = O_CAT + (size_t)NR * DM * 2;
constexpr size_t O_Z = O_S;
constexpr size_t O_AO = O_Z + (size_t)NR * 3072 * 2;
constexpr size_t O_ODD_END = O_AO + (size_t)NR * DM * 2;
constexpr size_t O_XE = O_S;
constexpr size_t O_HID = O_XE + (size_t)MOE_ROWS * DM * 2;
constexpr size_t O_YE = O_HID + (size_t)MOE_ROWS * EFF * 2;
constexpr size_t O_MOE_END = O_YE + (size_t)MOE_ROWS * DM * 2;
constexpr size_t WS_NEED = O_EVEN_END > O_MOE_END ? (O_EVEN_END > O_ODD_END ? O_EVEN_END : O_ODD_END) : (O_MOE_END > O_ODD_END ? O_MOE_END : O_ODD_END);
static_assert(WS_NEED < (size_t)2300 * 1024 * 1024, "workspace budget");
constexpr int CW_BAR = 4096;
constexpr int CW_DIAG = 16384;

constexpr int RING_BYTES = 131072;
constexpr int MISC_OFF = RING_BYTES;
constexpr int EPI_OFF = RING_BYTES + 256;
constexpr int LDS_BYTES = 163840;

#define LDS_WAIT() asm volatile("s_waitcnt lgkmcnt(0)" ::: "memory")
#define VM_WAIT() asm volatile("s_waitcnt vmcnt(0)" ::: "memory")
__device__ __forceinline__ float bf2f(unsigned b) { return __uint_as_float(b << 16); }
__device__ __forceinline__ unsigned f2bf(float f) { unsigned u = __float_as_uint(f); return (u + 0x7fffu + ((u >> 16) & 1u)) >> 16; }
__device__ __forceinline__ unsigned cvt_pk_bf16(float lo, float hi) { unsigned r; asm volatile("v_cvt_pk_bf16_f32 %0, %1, %2" : "=v"(r) : "v"(lo), "v"(hi)); return r; }
template <int CTRL> __device__ __forceinline__ float dpp_mov(float v) { return __int_as_float(__builtin_amdgcn_update_dpp(0, __float_as_int(v), CTRL, 0xf, 0xf, true)); }
__device__ __forceinline__ float row16_sum(float v) {
    v += dpp_mov<0xB1>(v);
    v += dpp_mov<0x4E>(v);
    v += dpp_mov<0x141>(v);
    v += dpp_mov<0x140>(v);
    return v;
}
__device__ __forceinline__ float wave_sum(float v) {
    v = row16_sum(v);
    { auto rr = __builtin_amdgcn_permlane16_swap(__float_as_uint(v), __float_as_uint(v), false, false); v = __uint_as_float(rr[0]) + __uint_as_float(rr[1]); }
    { auto rr = __builtin_amdgcn_permlane32_swap(__float_as_uint(v), __float_as_uint(v), false, false); v = __uint_as_float(rr[0]) + __uint_as_float(rr[1]); }
    return v;
}
__device__ __forceinline__ float wave_max(float v) {
    v = fmaxf(v, dpp_mov<0xB1>(v)); v = fmaxf(v, dpp_mov<0x4E>(v)); v = fmaxf(v, dpp_mov<0x141>(v)); v = fmaxf(v, dpp_mov<0x140>(v));
    { auto rr = __builtin_amdgcn_permlane16_swap(__float_as_uint(v), __float_as_uint(v), false, false); v = fmaxf(__uint_as_float(rr[0]), __uint_as_float(rr[1])); }
    { auto rr = __builtin_amdgcn_permlane32_swap(__float_as_uint(v), __float_as_uint(v), false, false); v = fmaxf(__uint_as_float(rr[0]), __uint_as_float(rr[1])); }
    return v;
}
__device__ __forceinline__ float sigmoid_fast(float x) { return __builtin_amdgcn_rcpf(1.f + __builtin_amdgcn_exp2f(-1.4426950408889634f * x)); }
__device__ __forceinline__ float silu_f(float x) { return x / (1.f + __expf(-x)); }
__device__ __forceinline__ float gelu_tanh(float x) {
    const float u = 0.7978845608028654f * (x + 0.044715f * x * x * x);
    const float t = 1.f - 2.f * sigmoid_fast(-2.f * u);
    return 0.5f * x * (1.f + t);
}

#define XB_TMO      128
#define XB_XCNT(j)  (256  + 64 * (j))
#define XB_XSUB(j)  (1280 + 64 * (j))
#define XB_XGEN(j)  (2304 + 64 * (j))
#define XB_TOP      3328
#define XB_TOPGEN   3392
#define XCD_BAR_WORDS 3456
#define XB_SPIN_CAP (1u << 18)

__device__ __forceinline__ unsigned xb_ld(unsigned* p)              { return __hip_atomic_load(p, __ATOMIC_RELAXED, __HIP_MEMORY_SCOPE_AGENT); }
__device__ __forceinline__ unsigned xb_add(unsigned* p, unsigned v) { return __hip_atomic_fetch_add(p, v, __ATOMIC_RELAXED, __HIP_MEMORY_SCOPE_AGENT); }
__device__ __forceinline__ unsigned xb_xcc_id() { return (unsigned)__builtin_amdgcn_s_getreg((3 << 11) | 20) & 0xFu; }
#define XB_SPIN(cond, bar) do { unsigned _sp = 0; while (cond) { __builtin_amdgcn_s_sleep(1); \
    if ((++_sp & 255u) == 0u) { if (xb_ld(&(bar)[XB_TMO])) break; if (_sp > XB_SPIN_CAP) { atomicAdd(&(bar)[XB_TMO], 1u); break; } } } } while (0)

struct XcdBarrier { unsigned* bar; unsigned x; volatile LAS unsigned* st; };

__device__ __forceinline__ XcdBarrier xcd_barrier_post(unsigned* bar, volatile LAS unsigned* st) {
    XcdBarrier b; b.bar = bar; b.x = xb_xcc_id(); b.st = st;
    if (threadIdx.x == 0) (void)xb_add(&bar[XB_XCNT(b.x)], 1u);
    return b;
}
__device__ __forceinline__ void xcd_barrier_complete(unsigned* bar, unsigned x, unsigned& nloc, unsigned& nx) {
    const unsigned G = gridDim.x * gridDim.y * gridDim.z;
    unsigned sum, cnt, mine, sp = 0u;
    for (;;) {
        sum = 0u; cnt = 0u; mine = 0u;
#pragma unroll
        for (unsigned j = 0; j < 16; ++j) { const unsigned c = xb_ld(&bar[XB_XCNT(j)]); sum += c; cnt += (c > 0u) ? 1u : 0u; mine = (j == x) ? c : mine; }
        if (sum == G) break;
        __builtin_amdgcn_s_sleep(1);
        if ((++sp & 255u) == 0u) { if (xb_ld(&bar[XB_TMO])) break; if (sp > XB_SPIN_CAP) { atomicAdd(&bar[XB_TMO], 1u); break; } }
    }
    nloc = mine > 0u ? mine : 1u; nx = cnt > 0u ? cnt : 1u;
}
__device__ __forceinline__ void xcd_barrier(const XcdBarrier& b) {
    asm volatile("s_waitcnt vmcnt(0)" ::: "memory");
    __syncthreads();
    if (threadIdx.x == 0) {
        unsigned* bar = b.bar;
        __builtin_amdgcn_s_waitcnt(0);
        unsigned nloc = b.st[0], nx = b.st[1];
        if (nloc == 0u) { xcd_barrier_complete(bar, b.x, nloc, nx); b.st[0] = nloc; b.st[1] = nx; }
        const unsigned old = xb_add(&bar[XB_XSUB(b.x)], 1u);
        const unsigned gen = old / nloc;
        if (old + 1u == (gen + 1u) * nloc) {
            __builtin_amdgcn_fence(__ATOMIC_RELEASE, "agent");
            asm volatile("s_waitcnt vmcnt(0)" ::: "memory");
            const unsigned og = xb_add(&bar[XB_TOP], 1u);
            const unsigned tg = og / nx;
            if (og + 1u == (tg + 1u) * nx) xb_add(&bar[XB_TOPGEN], 1u);
            else XB_SPIN(xb_ld(&bar[XB_TOPGEN]) == tg, bar);
            __builtin_amdgcn_fence(__ATOMIC_ACQUIRE, "agent");
            xb_add(&bar[XB_XGEN(b.x)], 1u);
            asm volatile("s_waitcnt vmcnt(0)" ::: "memory");
        } else {
            XB_SPIN(xb_ld(&bar[XB_XGEN(b.x)]) == gen, bar);
            __builtin_amdgcn_fence(__ATOMIC_ACQUIRE, "agent");
            asm volatile("s_waitcnt vmcnt(0)" ::: "memory");
        }
    }
    __syncthreads();
}
namespace pg8 {
constexpr int BM = 256, BK = 64, HALF = 128, HTB = HALF * BK * 2, STAGE_BYTES = 8 * HTB, NXCD = 8, WGM = 8;
__host__ __device__ __forceinline__ int lds_byte(int r, int c) { const int st = (r >> 4) * 2 + (c >> 5), rr = r & 15, cc = c & 31, ob = rr * 64 + cc * 2; return st * 1024 + (ob ^ (((ob >> 9) & 1) << 5)); }
__host__ __device__ __forceinline__ void stage_rc(int b, int& R, int& C) { const int st = b / 1024, sb = b % 1024, swz = sb ^ (((sb >> 9) & 1) << 5); R = (st >> 1) * 16 + swz / 64; C = (st & 1) * 32 + (swz % 64) / 2; }
__host__ __device__ __forceinline__ int perm32(int rho) { const int n = rho >> 4, i = rho & 15; return 8 * (i >> 2) + 4 * n + (i & 3); }

struct Unit { int pm, pn; };
struct Sched {
    int nM, nN, nwg, G, c;
    __device__ __forceinline__ void init(int nM_, int nN_, int G_, int c_) { nM = nM_; nN = nN_; nwg = nM * nN; G = G_; c = c_; }
    int head = 0, headM0 = 0;
    __device__ __forceinline__ bool next(int i, Unit& u) const {
        long L = (long)i * G + c;
        if (L < head) { u.pm = headM0 + (int)L / nN; u.pn = (int)L % nN; return true; }
        L -= head; if (L >= nwg) return false;
        int wgid = (int)L; { const int q = nwg / NXCD, r = nwg % NXCD, xcd = wgid % NXCD, off = wgid / NXCD; wgid = (xcd < r ? xcd * (q + 1) : r * (q + 1) + (xcd - r) * q) + off; }
        const int nig = WGM * nN, gid = wgid / nig, fm = gid * WGM, gsz = (nM - fm) < WGM ? (nM - fm) : WGM;
        u.pm = fm + ((wgid % nig) % gsz); u.pn = (wgid % nig) / gsz; return true;
    }
};
typedef f32x4 Acc[2][2][4][2];
#define PG8_NO_GATHER __device__ __forceinline__ int arow(const Unit&, int) const { return 0; }
#define PG8_NO_LITE static constexpr bool LITE = false; __device__ __forceinline__ bool lite(const Unit&) const { return false; }

template <class Op>
__device__ __forceinline__ void gemm_phase(LAS unsigned char* lds, const Op& op, const Sched& S, int tid) {
    asm volatile("" : "+v"(tid));
    const int wid = __builtin_amdgcn_readfirstlane(tid >> 6), lane = tid & 63, wr = wid >> 2, wc = wid & 3, fr = lane & 15, fq = lane >> 4;
    const int K = op.K, nt = K / BK, lda = op.lda, ldb = op.ldb;
    unsigned voffA[2], voffB[2]; int RA[2];
#pragma unroll
    for (int i = 0; i < 2; ++i) { int R, C; stage_rc(tid * 16 + i * 8192, R, C); const int Rb = Op::PERM ? ((R & ~31) + perm32(R & 31)) : R; RA[i] = R;
        voffA[i] = Op::GATHER ? (unsigned)C * 2u : (unsigned)(R * lda + C) * 2u; voffB[i] = (unsigned)(Rb * ldb + C) * 2u; }
    unsigned ga[2][2], gn[2][2];
#define PG8_GROWS(G, U) do { _Pragma("unroll") for (int _h = 0; _h < 2; ++_h) _Pragma("unroll") for (int _i = 0; _i < 2; ++_i) G[_h][_i] = (unsigned)op.arow(U, _h * HALF + RA[_i]) * (unsigned)(lda * 2); } while (0)
    const size_t kstep = (size_t)(BK * 2);
    const size_t hstepA = (size_t)HALF * lda * 2, hstepB = (size_t)HALF * ldb * 2;
    const unsigned ldsw = (unsigned)wid * 1024u;
    const int aoff = lds_byte(wr * 64 + fr, fq * 8), boff = lds_byte(wc * 32 + fr, fq * 8);
#define PG8_SA(b, h) (((b) * 2 + (h)) * HTB)
#define PG8_SB(b, h) ((4 + (b) * 2 + (h)) * HTB)
#define PG8_STAGE(bufoff, gbase, voff) do { _Pragma("unroll") for (int _i = 0; _i < 2; ++_i) \
        __builtin_amdgcn_global_load_lds((const unsigned*)((const char*)(gbase) + (voff)[_i]), (LAS unsigned*)(lds + (bufoff) + ldsw + _i * 8192), 16, 0, 0); } while (0)
#define PG8_STAGE_A(bufoff, sel, h, kb) do { _Pragma("unroll") for (int _i = 0; _i < 2; ++_i) { const char* _p; \
        if constexpr (Op::GATHER) _p = (const char*)op.A + (kb) + (size_t)(((sel) ? gn[h][_i] : ga[h][_i]) + voffA[_i]); \
        else _p = ((sel) ? nA : cA) + (size_t)(h) * hstepA + (kb) + voffA[_i]; \
        __builtin_amdgcn_global_load_lds((const unsigned*)_p, (LAS unsigned*)(lds + (bufoff) + ldsw + _i * 8192), 16, 0, 0); } } while (0)
#define PG8_LDA(dst, b, h) do { _Pragma("unroll") for (int m = 0; m < 4; ++m) _Pragma("unroll") for (int k = 0; k < 2; ++k) dst[m][k] = *(const LAS bf16x8*)(lds + PG8_SA(b, h) + aoff + m * 2048 + k * 1024); } while (0)
#define PG8_LDB(dst, b, h) do { _Pragma("unroll") for (int n = 0; n < 2; ++n) _Pragma("unroll") for (int k = 0; k < 2; ++k) dst[n][k] = *(const LAS bf16x8*)(lds + PG8_SB(b, h) + boff + n * 2048 + k * 1024); } while (0)
#define PG8_MMA(ai, bj, At, Bt) do { if (Op::LITE && lite && ((ai) == 1 || wr == 1)) break; __builtin_amdgcn_s_setprio(1); _Pragma("unroll") for (int m = 0; m < 4; ++m) _Pragma("unroll") for (int n = 0; n < 2; ++n) _Pragma("unroll") for (int k = 0; k < 2; ++k) \
        acc[ai][bj][m][n] = __builtin_amdgcn_mfma_f32_16x16x32_bf16(Bt[n][k], At[m][k], acc[ai][bj][m][n], 0, 0, 0); __builtin_amdgcn_s_setprio(0); } while (0)
#define PG8_WAIT_V(n) asm volatile("s_waitcnt vmcnt(" #n ")" ::: "memory")
#define PG8_WAIT_L(n) asm volatile("s_waitcnt lgkmcnt(" #n ")" ::: "memory")
#define PG8_BAR __builtin_amdgcn_s_barrier()
#define PG8_SCHED __builtin_amdgcn_sched_barrier(0)
    Unit cur, nxt; int ui = 0;
    if (!S.next(0, cur)) return;
    bool lite = Op::LITE ? op.lite(cur) : false;
    Acc acc;
#pragma unroll
    for (int a = 0; a < 2; ++a)
#pragma unroll
        for (int b = 0; b < 2; ++b)
#pragma unroll
            for (int m = 0; m < 4; ++m)
#pragma unroll
                for (int n = 0; n < 2; ++n) acc[a][b][m][n] = (f32x4){0.f, 0.f, 0.f, 0.f};
    bf16x8 At[4][2], B0[2][2], B1[2][2];
    const char* cA = (const char*)op.A + op.aoff(cur); const char* cB = (const char*)op.Bt + op.boff(cur); const char* nA = cA;
    if constexpr (Op::GATHER) { PG8_GROWS(ga, cur); if (S.next(1, nxt)) PG8_GROWS(gn, nxt); else PG8_GROWS(gn, cur);
        asm volatile("" :: "v"(ga[0][0]), "v"(ga[0][1]), "v"(ga[1][0]), "v"(ga[1][1]), "v"(gn[0][0]), "v"(gn[0][1]), "v"(gn[1][0]), "v"(gn[1][1])); }
    PG8_STAGE(PG8_SB(0, 0), cB, voffB); PG8_STAGE(PG8_SB(0, 1), cB + hstepB, voffB); PG8_STAGE_A(PG8_SA(0, 0), false, 0, 0); PG8_STAGE_A(PG8_SA(0, 1), false, 1, 0);
    if (wr == 1) PG8_BAR;
    PG8_WAIT_V(2); PG8_BAR;
    PG8_STAGE(PG8_SB(1, 0), cB + kstep, voffB); PG8_STAGE_A(PG8_SA(1, 0), false, 0, kstep); PG8_STAGE(PG8_SB(1, 1), cB + hstepB + kstep, voffB);
    PG8_WAIT_V(6); PG8_BAR;
    for (;;) {
        const bool has_next = S.next(ui + 1, nxt);
        nA = has_next ? (const char*)op.A + op.aoff(nxt) : cA; const char* nB = has_next ? (const char*)op.Bt + op.boff(nxt) : cB;
        for (int t = 0; t < nt; t += 2) {
            const bool last = (t == nt - 2), seln = last && has_next;
            const size_t k1 = (size_t)(t + 1) * kstep, k2 = last ? 0 : (size_t)(t + 2) * kstep, k3 = k2 + kstep;
            const char* b2 = last ? nB : cB + (size_t)(t + 2) * kstep; const char* b3 = b2 + kstep;
            PG8_LDB(B0, 0, 0); PG8_LDB(B1, 0, 1); PG8_SCHED; PG8_LDA(At, 0, 0); PG8_STAGE_A(PG8_SA(1, 1), false, 1, k1);
            PG8_WAIT_V(8); PG8_WAIT_L(0); PG8_BAR; PG8_MMA(0, 0, At, B0); PG8_MMA(0, 1, At, B1); PG8_BAR; PG8_SCHED;
            PG8_LDA(At, 0, 1); PG8_STAGE(PG8_SB(0, 0), b2, voffB); PG8_STAGE(PG8_SB(0, 1), b2 + hstepB, voffB); PG8_STAGE_A(PG8_SA(0, 0), seln, 0, k2);
            PG8_WAIT_V(8); PG8_WAIT_L(0); PG8_BAR; PG8_MMA(1, 0, At, B0); PG8_MMA(1, 1, At, B1); PG8_BAR; PG8_SCHED;
            PG8_LDB(B0, 1, 0); PG8_LDB(B1, 1, 1); PG8_SCHED; PG8_LDA(At, 1, 0); PG8_STAGE_A(PG8_SA(0, 1), seln, 1, k2);
            PG8_WAIT_V(8); PG8_WAIT_L(0); PG8_BAR; PG8_MMA(0, 0, At, B0); PG8_MMA(0, 1, At, B1); PG8_BAR; PG8_SCHED;
            PG8_LDA(At, 1, 1); PG8_STAGE(PG8_SB(1, 0), b3, voffB); PG8_STAGE(PG8_SB(1, 1), b3 + hstepB, voffB); PG8_STAGE_A(PG8_SA(1, 0), seln, 0, k3);
            PG8_WAIT_V(8); PG8_WAIT_L(0); PG8_BAR; PG8_MMA(1, 0, At, B0); PG8_MMA(1, 1, At, B1); PG8_BAR; PG8_SCHED;
        }
        if (wr == 0) PG8_BAR;
        op(acc, cur, wr, wc, fr, fq);
        if (!has_next) break;
#pragma unroll
        for (int a = 0; a < 2; ++a)
#pragma unroll
            for (int b = 0; b < 2; ++b)
#pragma unroll
                for (int m = 0; m < 4; ++m)
#pragma unroll
                    for (int n = 0; n < 2; ++n) acc[a][b][m][n] = (f32x4){0.f, 0.f, 0.f, 0.f};
        cur = nxt; cA = nA; cB = nB; ++ui; lite = Op::LITE ? op.lite(cur) : false;
        if constexpr (Op::GATHER) {
#pragma unroll
            for (int _h = 0; _h < 2; ++_h)
#pragma unroll
                for (int _i = 0; _i < 2; ++_i) ga[_h][_i] = gn[_h][_i];
            Unit n2; if (S.next(ui + 1, n2)) PG8_GROWS(gn, n2);
            asm volatile("" :: "v"(gn[0][0]), "v"(gn[0][1]), "v"(gn[1][0]), "v"(gn[1][1]));
        }
        if (wr == 1) PG8_BAR;
    }
    PG8_WAIT_V(0);
    PG8_BAR;
#undef PG8_SA
#undef PG8_SB
#undef PG8_STAGE
#undef PG8_STAGE_A
#undef PG8_GROWS
#undef PG8_LDA
#undef PG8_LDB
#undef PG8_MMA
#undef PG8_WAIT_V
#undef PG8_WAIT_L
#undef PG8_BAR
#undef PG8_SCHED
}

__device__ __forceinline__ u32x4 pack8(const f32x4 a, const f32x4 b) { u32x4 w; w.x = cvt_pk_bf16(a[0], a[1]); w.y = cvt_pk_bf16(a[2], a[3]); w.z = cvt_pk_bf16(b[0], b[1]); w.w = cvt_pk_bf16(b[2], b[3]); return w; }
__device__ __forceinline__ int moe_expert(int pm) { return pm < 256 ? (pm >> 4) : (pm - 256); }

template <bool MOE> struct OpStore {
    static constexpr bool PERM = true, GATHER = false; PG8_NO_GATHER static constexpr bool LITE = MOE; __device__ __forceinline__ bool lite(const Unit& u) const { return MOE && u.pm >= 256; }
    const bf16_t* A; const bf16_t* Bt; int lda, ldb, K; bf16_t* out; int ldc; const float* bias;
    __device__ __forceinline__ size_t aoff(const Unit& u) const { return (size_t)u.pm * 256 * lda * 2; }
    __device__ __forceinline__ size_t boff(const Unit& u) const { return MOE ? ((size_t)moe_expert(u.pm) * 2048 + (size_t)u.pn * 256) * ldb * 2 : (size_t)u.pn * 256 * ldb * 2; }
    __device__ __forceinline__ void operator()(const Acc& acc, const Unit& u, int wr, int wc, int fr, int fq) const {
        const int row0 = u.pm * 256 + wr * 64 + fr, col0 = u.pn * 256 + wc * 32 + 8 * fq;
#pragma unroll
        for (int ai = 0; ai < 2; ++ai)
#pragma unroll
            for (int m = 0; m < 4; ++m) { bf16_t* rowp = out + (size_t)(row0 + ai * 128 + m * 16) * ldc + col0;
#pragma unroll
                for (int bj = 0; bj < 2; ++bj) { f32x4 v0 = acc[ai][bj][m][0], v1 = acc[ai][bj][m][1];
                    if (bias) { v0 += *(const f32x4*)(bias + col0 + bj * 128); v1 += *(const f32x4*)(bias + col0 + bj * 128 + 4); }
                    *(u32x4*)(rowp + bj * 128) = pack8(v0, v1); } }
    }
};
struct OpWin {
    static constexpr bool PERM = true, GATHER = false; PG8_NO_GATHER PG8_NO_LITE
    const bf16_t* A; const bf16_t* Bt; int lda, ldb, K; bf16_t* a3; bf16_t* zf;
    __device__ __forceinline__ size_t aoff(const Unit& u) const { return (size_t)u.pm * 256 * lda * 2; }
    __device__ __forceinline__ size_t boff(const Unit& u) const { return (size_t)u.pn * 256 * ldb * 2; }
    __device__ __forceinline__ void operator()(const Acc& acc, const Unit& u, int wr, int wc, int fr, int fq) const {
        const int row0 = u.pm * 256 + wr * 64 + fr, col0 = u.pn * 256 + wc * 32 + 8 * fq;
#pragma unroll
        for (int ai = 0; ai < 2; ++ai)
#pragma unroll
            for (int m = 0; m < 4; ++m) { const int row = row0 + ai * 128 + m * 16;
#pragma unroll
                for (int bj = 0; bj < 2; ++bj) { const int c = col0 + bj * 128; const u32x4 w = pack8(acc[ai][bj][m][0], acc[ai][bj][m][1]);
                    if (u.pn < 4) { const int g = c >> 4; *(u32x4*)(a3 + ((size_t)(g * NCHP + (row >> 5)) * A3K + (row & 31) * 16 + (c & 15))) = w; }
                    else *(u32x4*)(zf + (size_t)row * 1024 + (c - 1024)) = w; } }
    }
};
struct OpL1 {
    static constexpr bool PERM = false, GATHER = false; PG8_NO_GATHER PG8_NO_LITE
    const bf16_t* A; const bf16_t* Bt; int lda, ldb, K; float* sum;
    __device__ __forceinline__ size_t aoff(const Unit& u) const { const int g = u.pm / 5, rt = u.pm % 5; return (size_t)(g * NCHP + rt * 256) * A3K * 2; }
    __device__ __forceinline__ size_t boff(const Unit& u) const { return (size_t)(u.pm / 5) * 256 * 512 * 2; }
    __device__ __forceinline__ void operator()(const Acc& acc, const Unit& u, int wr, int wc, int fr, int fq) const {
        const int g = u.pm / 5, rt = u.pm % 5, row0 = rt * 256 + wr * 64 + fr, col0 = wc * 32 + 4 * fq;
#pragma unroll
        for (int ai = 0; ai < 2; ++ai)
#pragma unroll
            for (int m = 0; m < 4; ++m) { float* rowp = sum + ((size_t)(g * NCHP + row0 + ai * 128 + m * 16)) * 256 + col0;
#pragma unroll
                for (int bj = 0; bj < 2; ++bj)
#pragma unroll
                    for (int n = 0; n < 2; ++n) *(f32x4*)(rowp + bj * 128 + n * 16) = acc[ai][bj][m][n]; }
    }
};
struct OpL3 {
    static constexpr bool PERM = true, GATHER = false; PG8_NO_GATHER PG8_NO_LITE
    const bf16_t* A; const bf16_t* Bt; int lda, ldb, K; bf16_t* gout;
    __device__ __forceinline__ size_t aoff(const Unit& u) const { const int g = u.pm / 5, rt = u.pm % 5; return (size_t)(g * NCHP + rt * 256) * A3K * 2; }
    __device__ __forceinline__ size_t boff(const Unit& u) const { return ((size_t)(u.pm / 5) * 512 + (size_t)u.pn * 256) * A3K * 2; }
    __device__ __forceinline__ void operator()(const Acc& acc, const Unit& u, int wr, int wc, int fr, int fq) const {
        const int g = u.pm / 5, rt = u.pm % 5, row0 = rt * 256 + wr * 64 + fr, col0 = u.pn * 256 + wc * 32 + 8 * fq;
#pragma unroll
        for (int ai = 0; ai < 2; ++ai)
#pragma unroll
            for (int m = 0; m < 4; ++m) { const int chunk = row0 + ai * 128 + m * 16;
                if (chunk < NCH) {
#pragma unroll
                    for (int bj = 0; bj < 2; ++bj) { const int c = col0 + bj * 128, t = c >> 4, co = c & 15; f32x4 v0 = acc[ai][bj][m][0], v1 = acc[ai][bj][m][1];
#pragma unroll
                        for (int i = 0; i < 4; ++i) { v0[i] = gelu_tanh(v0[i]); v1[i] = gelu_tanh(v1[i]); }
                        *(u32x4*)(gout + ((size_t)(chunk * 32 + t)) * 1024 + g * 16 + co) = pack8(v0, v1); } } }
    }
};
struct OpGlu {
    static constexpr bool PERM = true, GATHER = false; PG8_NO_GATHER PG8_NO_LITE
    const bf16_t* A; const bf16_t* Bt; int lda, ldb, K; const float* bias; bf16_t* cat;
    __device__ __forceinline__ size_t aoff(const Unit& u) const { return (size_t)u.pm * 256 * lda * 2; }
    __device__ __forceinline__ size_t boff(const Unit& u) const { return (size_t)u.pn * 256 * ldb * 2; }
    __device__ __forceinline__ void operator()(const Acc& acc, const Unit& u, int wr, int wc, int fr, int fq) const {
        const int row0 = u.pm * 256 + wr * 64 + fr, col0 = u.pn * 256 + wc * 32 + 8 * fq;
#pragma unroll
        for (int ai = 0; ai < 2; ++ai)
#pragma unroll
            for (int m = 0; m < 4; ++m) { const int row = row0 + ai * 128 + m * 16;
#pragma unroll
                for (int bj = 0; bj < 2; ++bj) { const int c = col0 + bj * 128;
                    const f32x4 b0 = *(const f32x4*)(bias + c), b1 = *(const f32x4*)(bias + c + 4);
                    const u32x4 gw = *(const u32x4*)(A + (size_t)row * 1024 + c);
                    f32x4 g0, g1; g0[0] = bf2f(gw.x & 0xffffu); g0[1] = bf2f(gw.x >> 16); g0[2] = bf2f(gw.y & 0xffffu); g0[3] = bf2f(gw.y >> 16);
                    g1[0] = bf2f(gw.z & 0xffffu); g1[1] = bf2f(gw.z >> 16); g1[2] = bf2f(gw.w & 0xffffu); g1[3] = bf2f(gw.w >> 16);
                    f32x4 v0 = acc[ai][bj][m][0] + b0, v1 = acc[ai][bj][m][1] + b1;
#pragma unroll
                    for (int i = 0; i < 4; ++i) { v0[i] = g0[i] * sigmoid_fast(v0[i]); v1[i] = g1[i] * sigmoid_fast(v1[i]); }
                    *(u32x4*)(cat + (size_t)row * 2048 + c) = pack8(v0, v1); } }
    }
};
struct OpFftA {
    static constexpr bool PERM = true, GATHER = false; PG8_NO_GATHER PG8_NO_LITE
    const bf16_t* A; const bf16_t* Bt; int lda, ldb, K; bf16_t* bt2;
    __device__ __forceinline__ size_t aoff(const Unit&) const { return 0; }
    __device__ __forceinline__ size_t boff(const Unit& u) const { return (size_t)u.pn * 256 * 128 * 2; }
    __device__ __forceinline__ void operator()(const Acc& acc, const Unit& u, int wr, int wc, int fr, int fq) const {
        const int l2b = wc * 32 + 8 * fq;
#pragma unroll
        for (int ai = 0; ai < 2; ++ai)
#pragma unroll
            for (int m = 0; m < 4; ++m) { const int k1 = wr * 64 + m * 16 + fr;
#pragma unroll
                for (int bj = 0; bj < 2; ++bj) { const int col = 2 * u.pn + bj;
                    *(u32x4*)(bt2 + ((size_t)(k1 * 2048 + col)) * 256 + ai * 128 + l2b) = pack8(acc[ai][bj][m][0], acc[ai][bj][m][1]); } }
    }
};
struct OpFftC {
    static constexpr bool PERM = true, GATHER = false; PG8_NO_GATHER PG8_NO_LITE
    const bf16_t* A; const bf16_t* Bt; int lda, ldb, K; bf16_t* pq;
    __device__ __forceinline__ size_t aoff(const Unit& u) const { return (size_t)(u.pn >> 3) * 256 * 256 * 2; }
    __device__ __forceinline__ size_t boff(const Unit& u) const { return (size_t)u.pn * 256 * 256 * 2; }
    __device__ __forceinline__ void operator()(const Acc& acc, const Unit& u, int wr, int wc, int fr, int fq) const {
        const int k1 = u.pn >> 3;
#pragma unroll
        for (int ai = 0; ai < 2; ++ai)
#pragma unroll
            for (int m = 0; m < 4; ++m) { const int k2 = wr * 64 + m * 16 + fr, k = k1 + 128 * k2;
#pragma unroll
                for (int bj = 0; bj < 2; ++bj) { const int colb = (u.pn & 7) * 256 + bj * 128 + wc * 32 + 8 * fq, b = colb >> 10, ch = colb & 1023, g = ch >> 8, c = ch & 255;
                    *(u32x4*)(pq + ((size_t)(b * RPB + CTX + k)) * 2048 + g * 512 + ai * 256 + c) = pack8(acc[ai][bj][m][0], acc[ai][bj][m][1]); } }
    }
};
struct OpCtxDft {
    static constexpr bool PERM = true, GATHER = false; PG8_NO_GATHER PG8_NO_LITE
    const bf16_t* A; const bf16_t* Bt; int lda, ldb, K; bf16_t* pq;
    __device__ __forceinline__ size_t aoff(const Unit& u) const { return (size_t)u.pm * 256 * 256 * 2; }
    __device__ __forceinline__ size_t boff(const Unit& u) const { return (size_t)u.pn * 256 * 256 * 2; }
    __device__ __forceinline__ void operator()(const Acc& acc, const Unit& u, int wr, int wc, int fr, int fq) const {
#pragma unroll
        for (int ai = 0; ai < 2; ++ai)
#pragma unroll
            for (int m = 0; m < 4; ++m) { const int k = ai * 128 + wr * 64 + m * 16 + fr;
#pragma unroll
                for (int bj = 0; bj < 2; ++bj) { const int colb = u.pn * 256 + bj * 128 + wc * 32 + 8 * fq, b = colb >> 10, ch = colb & 1023, g = ch >> 8, c = ch & 255;
                    *(u32x4*)(pq + ((size_t)(b * RPB + k)) * 2048 + g * 512 + u.pm * 256 + c) = pack8(acc[ai][bj][m][0], acc[ai][bj][m][1]); } }
    }
};
struct OpFnet {
    static constexpr bool PERM = true, GATHER = false; PG8_NO_GATHER PG8_NO_LITE
    const bf16_t* A; const bf16_t* Bt; int lda, ldb, K; const float* bias; bf16_t* cat;
    __device__ __forceinline__ size_t aoff(const Unit& u) const { return (size_t)u.pm * 256 * lda * 2 + (size_t)u.pn * 512 * 2; }
    __device__ __forceinline__ size_t boff(const Unit& u) const { return (size_t)u.pn * 256 * 512 * 2; }
    __device__ __forceinline__ void operator()(const Acc& acc, const Unit& u, int wr, int wc, int fr, int fq) const {
        const int row0 = u.pm * 256 + wr * 64 + fr, col0 = u.pn * 256 + wc * 32 + 8 * fq;
#pragma unroll
        for (int ai = 0; ai < 2; ++ai)
#pragma unroll
            for (int m = 0; m < 4; ++m) { const int row = row0 + ai * 128 + m * 16;
#pragma unroll
                for (int bj = 0; bj < 2; ++bj) { const int c = col0 + bj * 128;
                    const f32x4 v0 = acc[ai][bj][m][0] + *(const f32x4*)(bias + c), v1 = acc[ai][bj][m][1] + *(const f32x4*)(bias + c + 4);
                    *(u32x4*)(cat + (size_t)row * 2048 + 1024 + c) = pack8(v0, v1); } }
    }
};
struct OpM1 {
    static constexpr bool PERM = true, GATHER = true, LITE = true; __device__ __forceinline__ bool lite(const Unit& u) const { return u.pm >= 256; }
    const bf16_t* A; const bf16_t* Bt; int lda, ldb, K; bf16_t* hid; const int* idx;
    __device__ __forceinline__ size_t aoff(const Unit&) const { return 0; }
    __device__ __forceinline__ int arow(const Unit& u, int r) const { const int m = u.pm * 256 + r; const bool ok = m < NEXP * 4096 || ((m - NEXP * 4096) & 255) < 2 * CAP_C; return ok ? idx[m] : 0; }
    __device__ __forceinline__ size_t boff(const Unit& u) const { return ((size_t)moe_expert(u.pm) * 2048 + (size_t)u.pn * 256) * ldb * 2; }
    __device__ __forceinline__ void operator()(const Acc& acc, const Unit& u, int wr, int wc, int fr, int fq) const {
        const int row0 = u.pm * 256 + wr * 64 + fr, f0 = u.pn * 128 + wc * 16 + 4 * fq;
#pragma unroll
        for (int ai = 0; ai < 2; ++ai)
#pragma unroll
            for (int m = 0; m < 4; ++m) { bf16_t* rowp = hid + (size_t)(row0 + ai * 128 + m * 16) * EFF + f0;
#pragma unroll
                for (int bj = 0; bj < 2; ++bj) { const f32x4 gt = acc[ai][bj][m][0], up = acc[ai][bj][m][1]; f32x4 h;
#pragma unroll
                    for (int i = 0; i < 4; ++i) h[i] = gt[i] * sigmoid_fast(gt[i]) * up[i];
                    u32x2 w; w.x = cvt_pk_bf16(h[0], h[1]); w.y = cvt_pk_bf16(h[2], h[3]);
                    *(u32x2*)(rowp + bj * 64) = w; } }
    }
};
}
namespace att {
constexpr int D = 128, NW = 8, QBLK = 32, KVBLK = 64;
constexpr float SCALE = 0.088388347648318440f;
constexpr float THR = 8.f;
constexpr int LDQ = 3072, LDK = 3072, LDO = 2048;
constexpr size_t SHM_V = KVBLK * D * 2, SHM_K = KVBLK * D * 2, SHM_ATTN = 2 * SHM_V + 2 * SHM_K + NW * 64 * 4;
#define KSWZ(row, colB) ((row) * 256 + ((colB) ^ (((row) & 7) << 4)))
#define SBAR() __builtin_amdgcn_sched_barrier(0)
__device__ __forceinline__ int crow(int r, int hi) { return (r & 3) + 8 * (r >> 2) + 4 * hi; }
__device__ __forceinline__ unsigned cvtpk(float lo, float hi) { unsigned r; asm volatile("v_cvt_pk_bf16_f32 %0, %1, %2" : "=v"(r) : "v"(lo), "v"(hi)); return r; }

__device__ __forceinline__ void partialSM(f32x16& p0, f32x16& p1, float& m_reg, float& mn, float& alpha) {
  constexpr float C = SCALE * 1.4426950408889634f;
  float pmax = p0[0]; for (int r = 1; r < 16; ++r) pmax = fmaxf(pmax, p0[r]); for (int r = 0; r < 16; ++r) pmax = fmaxf(pmax, p1[r]);
  { auto rr = __builtin_amdgcn_permlane32_swap(__float_as_uint(pmax), __float_as_uint(pmax), false, false);
    pmax = fmaxf(__uint_as_float(rr[0]), __uint_as_float(rr[1])); }
  if (__builtin_expect(__all(pmax - m_reg <= THR / SCALE), 1)) { mn = m_reg; alpha = 1.f; }
  else { mn = fmaxf(m_reg, pmax); alpha = __builtin_amdgcn_exp2f((m_reg - mn) * C); m_reg = mn; }
  float mnC = -mn * C;
  for (int r = 0; r < 16; ++r) p0[r] = fmaf(p0[r], C, mnC); for (int r = 0; r < 16; ++r) p1[r] = fmaf(p1[r], C, mnC);
  for (int r = 0; r < 16; ++r) p0[r] = __builtin_amdgcn_exp2f(p0[r]);
}
__device__ __forceinline__ void partialSM_fix(f32x16& p0, f32x16& p1) {
  for (int r = 0; r < 16; ++r) p0[r] = __builtin_amdgcn_exp2f(p0[r]);
}
__device__ __forceinline__ void finishSM(f32x16& p0, f32x16& p1, float alpha, float& l_reg, bf16x8& pa0, bf16x8& pa1, bf16x8& pa2, bf16x8& pa3) {
  for (int r = 0; r < 16; ++r) p1[r] = __builtin_amdgcn_exp2f(p1[r]);
  float ps = 0; for (int r = 0; r < 16; ++r) ps += p0[r]; for (int r = 0; r < 16; ++r) ps += p1[r];
  { auto rr = __builtin_amdgcn_permlane32_swap(__float_as_uint(ps), __float_as_uint(ps), false, false);
    ps = __uint_as_float(rr[0]) + __uint_as_float(rr[1]); }
  l_reg = l_reg * alpha + ps;
#define PK4(P, BASE, OUT) do { unsigned a0 = cvtpk(P[BASE + 0], P[BASE + 1]), a1 = cvtpk(P[BASE + 2], P[BASE + 3]);   \
    unsigned b0 = cvtpk(P[BASE + 4], P[BASE + 5]), b1 = cvtpk(P[BASE + 6], P[BASE + 7]);                              \
    auto r0 = __builtin_amdgcn_permlane32_swap(a0, b0, false, false); auto r1 = __builtin_amdgcn_permlane32_swap(a1, b1, false, false); \
    u32x4 w = {r0[0], r1[0], r0[1], r1[1]}; OUT = *reinterpret_cast<bf16x8*>(&w); } while (0)
  PK4(p0, 0, pa0); PK4(p0, 8, pa1); PK4(p1, 0, pa2); PK4(p1, 8, pa3);
#undef PK4
}
__device__ __forceinline__ void partialSM_fix2(f32x16& p0, float& l_reg) {
  for (int r = 0; r < 16; ++r) { p0[r] = __builtin_amdgcn_exp2f(p0[r]); l_reg += p0[r]; }
}
__device__ __forceinline__ void finishSM2(f32x16& p0, f32x16& p1, float& l_reg, bf16x8& pa0, bf16x8& pa1, bf16x8& pa2, bf16x8& pa3) {
#define PK4(P, BASE, OUT) do { unsigned a0 = cvtpk(P[BASE + 0], P[BASE + 1]), a1 = cvtpk(P[BASE + 2], P[BASE + 3]);   \
    unsigned b0 = cvtpk(P[BASE + 4], P[BASE + 5]), b1 = cvtpk(P[BASE + 6], P[BASE + 7]);                              \
    u32x4 w = {a0, a1, b0, b1}; OUT = *reinterpret_cast<bf16x8*>(&w); } while (0)
  PK4(p0, 0, pa0); PK4(p0, 8, pa1);
  for (int r = 0; r < 8; ++r) { p1[r] = __builtin_amdgcn_exp2f(p1[r]); l_reg += p1[r]; }
  PK4(p1, 0, pa2);
  for (int r = 8; r < 16; ++r) { p1[r] = __builtin_amdgcn_exp2f(p1[r]); l_reg += p1[r]; }
  PK4(p1, 8, pa3);
#undef PK4
}
__device__ __forceinline__ void qkt(f32x16& p0, f32x16& p1, const bf16_t* Ks, const bf16x8* qr, int r32, int hi) {
  p0 = f32x16{}; p1 = f32x16{};
  for (int d0 = 0; d0 < 8; ++d0) { int cb = (d0 * 16 + hi * 8) * 2;
    bf16x8 b0 = *reinterpret_cast<const bf16x8*>((const char*)Ks + KSWZ(r32, cb));
    bf16x8 b1 = *reinterpret_cast<const bf16x8*>((const char*)Ks + KSWZ(32 + r32, cb));
    p0 = __builtin_amdgcn_mfma_f32_32x32x16_bf16(b0, qr[d0], p0, 0, 0, 0);
    p1 = __builtin_amdgcn_mfma_f32_32x32x16_bf16(b1, qr[d0], p1, 0, 0, 0); }
}
__device__ __forceinline__ int v_st(int k, int c) { const int kk = (k & ~0xC) | ((k & 4) << 1) | ((k & 8) >> 1); return ((kk >> 3) * 4 + (c >> 5)) * 512 + ((kk & 7) * 32 + (c & 31)) * 2; }
__device__ __forceinline__ int v_rd_base(int lane) { return ((lane & 3) << 3) | (((lane >> 2) & 3) << 6) | (((lane >> 4) & 1) << 5) | (((lane >> 5) & 1) << 8); }
constexpr int v_rd_off(int d0, int ks, int half) { return d0 * 512 + ks * 4096 + half * 2048; }
template <int OFF> __device__ __forceinline__ s16x4 tr_read(int vb) {
  s16x4 r; asm volatile("ds_read_b64_tr_b16 %0, %1 offset:%2" : "=&v"(r) : "v"(vb), "i"(OFF) : "memory"); return r;
}
template <int D0> __device__ __forceinline__ void pv_one(f32x16& od, int vb, bf16x8 pa0, bf16x8 pa1, bf16x8 pa2, bf16x8 pa3) {
  const s16x4 l0 = tr_read<v_rd_off(D0, 0, 0)>(vb), h0 = tr_read<v_rd_off(D0, 0, 1)>(vb), l1 = tr_read<v_rd_off(D0, 1, 0)>(vb), h1 = tr_read<v_rd_off(D0, 1, 1)>(vb);
  const s16x4 l2 = tr_read<v_rd_off(D0, 2, 0)>(vb), h2 = tr_read<v_rd_off(D0, 2, 1)>(vb), l3 = tr_read<v_rd_off(D0, 3, 0)>(vb), h3 = tr_read<v_rd_off(D0, 3, 1)>(vb);
  asm volatile("s_waitcnt lgkmcnt(0)" ::: "memory"); SBAR();
#define PK(L, H) (bf16x8){L[0], L[1], L[2], L[3], H[0], H[1], H[2], H[3]}
  od = __builtin_amdgcn_mfma_f32_32x32x16_bf16(pa0, PK(l0, h0), od, 0, 0, 0);
  od = __builtin_amdgcn_mfma_f32_32x32x16_bf16(pa1, PK(l1, h1), od, 0, 0, 0);
  od = __builtin_amdgcn_mfma_f32_32x32x16_bf16(pa2, PK(l2, h2), od, 0, 0, 0);
  od = __builtin_amdgcn_mfma_f32_32x32x16_bf16(pa3, PK(l3, h3), od, 0, 0, 0);
#undef PK
}
__device__ __forceinline__ void pv_d0(f32x16* o, int vb, bf16x8 pa0, bf16x8 pa1, bf16x8 pa2, bf16x8 pa3) {
  pv_one<0>(o[0], vb, pa0, pa1, pa2, pa3); pv_one<1>(o[1], vb, pa0, pa1, pa2, pa3); pv_one<2>(o[2], vb, pa0, pa1, pa2, pa3); pv_one<3>(o[3], vb, pa0, pa1, pa2, pa3);
}
template <bool FIXM>
__device__ __forceinline__ void attn_dense_body(const bf16_t* __restrict__ Qb, const bf16_t* __restrict__ Kh, const bf16_t* __restrict__ Vh,
                                                bf16_t* __restrict__ Ob, int seq, char* lds, int tid, float mfixC) {
  asm volatile("" : "+v"(tid));
  const int wid = tid >> 6, lane = tid & 63, r32 = lane & 31, hi = lane >> 5;
  bf16_t* V_lds = (bf16_t*)lds; bf16_t* K_lds = (bf16_t*)(lds + 2 * SHM_V);
  float* ws = (float*)(lds + 2 * SHM_V + 2 * SHM_K) + wid * 64; float* li_l = ws; float* al_l = ws + 32;
  float m_reg = -1e30f, l_reg = 0; f32x16 o[4] = {}; bf16x8 qr[8];
  const bf16_t* Qw = Qb + (long)(wid * QBLK + r32) * LDQ + hi * 8;
#pragma unroll
  for (int d0 = 0; d0 < 8; ++d0) qr[d0] = *reinterpret_cast<const bf16x8*>(Qw + d0 * 16);
  const int sr = tid >> 4, sc = (tid & 15) * 8, vst0 = v_st(sr, sc), vst1 = v_st(32 + sr, sc);
  const int vb0 = (int)(uintptr_t)V_lds + v_rd_base(lane);
  struct { bf16x8 vs0, vs1, ks0, ks1; } sr_[2];
#define SLOAD(i, k0) do { sr_[i].vs0 = *reinterpret_cast<const bf16x8*>(&Vh[(long)((k0) + sr) * LDK + sc]); sr_[i].vs1 = *reinterpret_cast<const bf16x8*>(&Vh[(long)((k0) + 32 + sr) * LDK + sc]); \
    sr_[i].ks0 = *reinterpret_cast<const bf16x8*>(&Kh[(long)((k0) + sr) * LDK + sc]); sr_[i].ks1 = *reinterpret_cast<const bf16x8*>(&Kh[(long)((k0) + 32 + sr) * LDK + sc]); } while (0)
#define SWRITE(b, i) do { *(bf16x8*)((char*)V_lds + (b) * SHM_V + vst0) = sr_[i].vs0;          \
    *(bf16x8*)((char*)V_lds + (b) * SHM_V + vst1) = sr_[i].vs1; int kc = sc * 2;               \
    *(bf16x8*)((char*)K_lds + (b) * SHM_K + KSWZ(sr, kc)) = sr_[i].ks0;                       \
    *(bf16x8*)((char*)K_lds + (b) * SHM_K + KSWZ(32 + sr, kc)) = sr_[i].ks1; } while (0)
#define SWAIT() asm volatile("s_waitcnt vmcnt(4)" ::: "memory")
#define PSM(P0, P1, MN, AL) do { if constexpr (FIXM) { SBAR(); partialSM_fix(P0, P1); AL = 1.f; SBAR(); } else partialSM(P0, P1, m_reg, MN, AL); } while (0)
#define RESC(a) do { if constexpr (!FIXM) if (__any((a) < 1.f)) { if (hi == 0) al_l[r32] = (a); asm volatile("s_waitcnt lgkmcnt(0)" ::: "memory"); \
    for (int d = 0; d < 4; ++d) for (int r = 0; r < 16; ++r) o[d][r] *= al_l[crow(r, hi)]; } } while (0)
  f32x16 pA0, pA1, pB0, pB1; float mnA, mnB, alA, alB; bf16x8 pa0, pa1, pa2, pa3; const int NT = seq / KVBLK;
  constexpr int SE = 0, SO = 1;
  SLOAD(SE, 0); asm volatile("s_waitcnt vmcnt(0)" ::: "memory"); SWRITE(0, SE); __syncthreads();
  qkt(pA0, pA1, K_lds, qr, r32, hi); PSM(pA0, pA1, mnA, alA);
  SLOAD(SO, KVBLK); SLOAD(SE, 2 * KVBLK);
  SWAIT(); SWRITE(1, SO); __syncthreads();
  for (int j = 1; j + 1 < NT; j += 2) {
    SBAR(); qkt(pB0, pB1, (bf16_t*)((char*)K_lds + SHM_K), qr, r32, hi);
    finishSM(pA0, pA1, alA, l_reg, pa0, pa1, pa2, pa3); SBAR();
    SLOAD(SO, (j + 2) * KVBLK); SBAR();
    pv_d0(o, vb0, pa0, pa1, pa2, pa3); PSM(pB0, pB1, mnB, alB);
    __syncthreads(); SWAIT(); SWRITE(0, SE);
    RESC(alB); __syncthreads();
    SBAR(); qkt(pA0, pA1, K_lds, qr, r32, hi);
    finishSM(pB0, pB1, alB, l_reg, pa0, pa1, pa2, pa3); SBAR();
    SLOAD(SE, (j + 3 < NT ? j + 3 : NT - 1) * KVBLK); SBAR();
    pv_d0(o, vb0 + (int)SHM_V, pa0, pa1, pa2, pa3); PSM(pA0, pA1, mnA, alA);
    __syncthreads(); SWAIT(); SWRITE(1, SO);
    RESC(alA); __syncthreads();
  }
  SBAR(); qkt(pB0, pB1, (bf16_t*)((char*)K_lds + SHM_K), qr, r32, hi);
  finishSM(pA0, pA1, alA, l_reg, pa0, pa1, pa2, pa3); SBAR();
  pv_d0(o, vb0, pa0, pa1, pa2, pa3); PSM(pB0, pB1, mnB, alB);
  __syncthreads(); RESC(alB);
  finishSM(pB0, pB1, alB, l_reg, pa0, pa1, pa2, pa3); SBAR();
  pv_d0(o, vb0 + (int)SHM_V, pa0, pa1, pa2, pa3);
  if (hi == 0) li_l[r32] = l_reg; asm volatile("s_waitcnt lgkmcnt(0)" ::: "memory");
  float rli[16];
#pragma unroll
  for (int r = 0; r < 16; ++r) rli[r] = __builtin_amdgcn_rcpf(li_l[crow(r, hi)]);
  bf16_t* Ow = Ob + (long)(wid * QBLK) * LDO;
#pragma unroll
  for (int r = 0; r < 16; ++r) { int orow = crow(r, hi);
    for (int d0 = 0; d0 < 4; ++d0) Ow[(long)orow * LDO + d0 * 32 + r32] = (bf16_t)f2bf(o[d0][r] * rli[r]); }
  asm volatile("s_waitcnt vmcnt(0) lgkmcnt(0)" ::: "memory"); __syncthreads();
#undef SLOAD
#undef SWRITE
#undef SWAIT
#undef RESC
#undef PSM
}

template <int NT>
__device__ __forceinline__ void attn_ring3_body(const bf16_t* __restrict__ Qb, const bf16_t* __restrict__ Kh, const bf16_t* __restrict__ Vh, bf16_t* __restrict__ Ob, char* lds, int tid) {
  static_assert(NT >= 8, "ring body: at least 8 key tiles");
  asm volatile("" : "+v"(tid));
  const int wid = tid >> 6, lane = tid & 63, r32 = lane & 31, hi = lane >> 5;
  constexpr int VB = (int)SHM_V, KB = (int)SHM_K;
  bf16_t* K_lds = (bf16_t*)lds; bf16_t* V_lds = (bf16_t*)(lds + 3 * KB);
  float* ws = (float*)(lds + 3 * VB + 3 * KB) + wid * 64; float* li_l = ws;
  float l_reg = 0; f32x16 o[4] = {}; bf16x8 qr[8];
  const bf16_t* Qw = Qb + (long)(wid * QBLK + r32) * LDQ + hi * 8;
#pragma unroll
  for (int d0 = 0; d0 < 8; ++d0) qr[d0] = *reinterpret_cast<const bf16x8*>(Qw + d0 * 16);
  const int sr = tid >> 4, sc = (tid & 15) * 8, srp = (sr & ~0xC) | ((sr & 4) << 1) | ((sr & 8) >> 1), vst0 = v_st(srp, sc), vst1 = v_st(32 + srp, sc);
  const int vb0 = (int)(uintptr_t)V_lds + v_rd_base(lane);
  struct { bf16x8 vs0, vs1, ks0, ks1; } sr_[2];
#define SLOAD(i, t) do { const long k0_ = (long)((t) < NT ? (t) : NT - 1) * KVBLK; sr_[i].vs0 = *reinterpret_cast<const bf16x8*>(&Vh[(k0_ + sr) * LDK + sc]); sr_[i].vs1 = *reinterpret_cast<const bf16x8*>(&Vh[(k0_ + 32 + sr) * LDK + sc]); \
    sr_[i].ks0 = *reinterpret_cast<const bf16x8*>(&Kh[(k0_ + sr) * LDK + sc]); sr_[i].ks1 = *reinterpret_cast<const bf16x8*>(&Kh[(k0_ + 32 + sr) * LDK + sc]); } while (0)
#define SWRITE(b, i) do { *(bf16x8*)((char*)V_lds + (b) * VB + vst0) = sr_[i].vs0; *(bf16x8*)((char*)V_lds + (b) * VB + vst1) = sr_[i].vs1; const int kc = sc * 2; \
    *(bf16x8*)((char*)K_lds + (b) * KB + KSWZ(sr, kc)) = sr_[i].ks0; *(bf16x8*)((char*)K_lds + (b) * KB + KSWZ(32 + sr, kc)) = sr_[i].ks1; } while (0)
#define SWAIT() asm volatile("s_waitcnt vmcnt(4)" ::: "memory")
  f32x16 pA0, pA1, pB0, pB1; bf16x8 pa0, pa1, pa2, pa3;
  unsigned ca0, ca1, cb0, cb1; bf16x8 ka0, ka1, kb0, kb1; s16x4 va[4];
#define KRD(D0, B0, B1) do { B0 = *reinterpret_cast<const bf16x8*>(Kp + KSWZ(r32, ((D0) * 16 + hi * 8) * 2)); B1 = *reinterpret_cast<const bf16x8*>(Kp + KSWZ(32 + r32, ((D0) * 16 + hi * 8) * 2)); } while (0)
#define MQ(ACC, KF, D0) ACC = __builtin_amdgcn_mfma_f32_32x32x16_bf16(KF, qr[D0], ACC, 0, 0, 0)
#define EX(P, R) P[R] = __builtin_amdgcn_exp2f(P[R])
#define AD(P, R) l_reg += P[R]
#define CV(P, I, A, B) do { A = cvtpk(P[I], P[(I) + 1]); B = cvtpk(P[(I) + 2], P[(I) + 3]); } while (0)
#define PM(OUT) do { u32x4 w_ = {ca0, ca1, cb0, cb1}; OUT = *reinterpret_cast<bf16x8*>(&w_); } while (0)
#define RV(ARR, I, D0, KS) do { ARR[I] = tr_read<v_rd_off(D0, KS, 0)>(vbp); ARR[(I) + 1] = tr_read<v_rd_off(D0, KS, 1)>(vbp); } while (0)
#define PKV(L, H) (bf16x8){L[0], L[1], L[2], L[3], H[0], H[1], H[2], H[3]}
#define MP(D0, PA, ARR, I) o[D0] = __builtin_amdgcn_mfma_f32_32x32x16_bf16(PKV(ARR[I], ARR[(I) + 1]), PA, o[D0], 0, 0, 0)
#define WL(N) do { asm volatile("s_waitcnt lgkmcnt(" #N ")" ::: "memory"); SBAR(); } while (0)
#define TROW(t) ((long)((t) < NT ? (t) : NT - 1) * KVBLK)
#define SLV0(i, t) sr_[i].vs0 = *reinterpret_cast<const bf16x8*>(&Vh[(TROW(t) + sr) * LDK + sc])
#define SLV1(i, t) sr_[i].vs1 = *reinterpret_cast<const bf16x8*>(&Vh[(TROW(t) + 32 + sr) * LDK + sc])
#define SLK0(i, t) sr_[i].ks0 = *reinterpret_cast<const bf16x8*>(&Kh[(TROW(t) + sr) * LDK + sc])
#define SLK1(i, t) sr_[i].ks1 = *reinterpret_cast<const bf16x8*>(&Kh[(TROW(t) + 32 + sr) * LDK + sc])
#define SWV0(b, i) *(bf16x8*)((char*)V_lds + (b) * VB + vst0) = sr_[i].vs0
#define SWV1(b, i) *(bf16x8*)((char*)V_lds + (b) * VB + vst1) = sr_[i].vs1
#define SWK0(b, i) *(bf16x8*)((char*)K_lds + (b) * KB + KSWZ(sr, sc * 2)) = sr_[i].ks0
#define SWK1(b, i) *(bf16x8*)((char*)K_lds + (b) * KB + KSWZ(32 + sr, sc * 2)) = sr_[i].ks1
#define STEP(J, Q0, Q1, P0, P1, BQ, BP, BW, SL, SW) do { const char* Kp = (const char*)K_lds + (BQ) * KB; const int vbp = vb0 + (BP) * VB; SBAR(); \
    KRD(0, ka0, ka1); Q0 = f32x16{}; Q1 = f32x16{};        \
    MQ(Q0, ka0, 0); KRD(1, kb0, kb1); EX(P1, 0); CV(P0, 0, ca0, ca1); SBAR(); \
    MQ(Q1, ka1, 0); EX(P1, 1); AD(P1, 0); CV(P0, 4, cb0, cb1); PM(pa0); SBAR(); \
    MQ(Q0, kb0, 1); KRD(2, ka0, ka1); EX(P1, 2); AD(P1, 1); CV(P0, 8, ca0, ca1); SBAR(); \
    MQ(Q1, kb1, 1); EX(P1, 3); AD(P1, 2); CV(P0, 12, cb0, cb1); PM(pa1); SBAR(); \
    MQ(Q0, ka0, 2); KRD(3, kb0, kb1); EX(P1, 4); AD(P1, 3); SBAR(); \
    MQ(Q1, ka1, 2); EX(P1, 5); AD(P1, 4); SLV0(SL, (J) + 2); SBAR(); \
    MQ(Q0, kb0, 3); KRD(4, ka0, ka1); EX(P1, 6); AD(P1, 5); SBAR(); \
    MQ(Q1, kb1, 3); EX(P1, 7); AD(P1, 6); SLV1(SL, (J) + 2); SBAR(); \
    MQ(Q0, ka0, 4); KRD(5, kb0, kb1); EX(P1, 8); AD(P1, 7); CV(P1, 0, ca0, ca1); SBAR(); \
    MQ(Q1, ka1, 4); EX(P1, 9); AD(P1, 8); CV(P1, 4, cb0, cb1); PM(pa2); SBAR(); \
    MQ(Q0, kb0, 5); KRD(6, ka0, ka1); EX(P1, 10); AD(P1, 9); SBAR(); \
    MQ(Q1, kb1, 5); EX(P1, 11); AD(P1, 10); SLK0(SL, (J) + 2); SBAR(); \
    MQ(Q0, ka0, 6); KRD(7, kb0, kb1); EX(P1, 12); AD(P1, 11); SBAR(); \
    MQ(Q1, ka1, 6); EX(P1, 13); AD(P1, 12); CV(P1, 8, ca0, ca1); SLK1(SL, (J) + 2); SBAR(); \
    MQ(Q0, kb0, 7); EX(P1, 14); AD(P1, 13); SBAR(); RV(va, 0, 0, 0); RV(va, 2, 1, 0); SBAR(); \
    MQ(Q1, kb1, 7); EX(P1, 15); AD(P1, 14); SBAR(); \
    WL(2); MP(0, pa0, va, 0); RV(va, 0, 0, 1); AD(P1, 15); CV(P1, 12, cb0, cb1); PM(pa3); EX(Q0, 0); SBAR(); \
    WL(2); MP(1, pa0, va, 2); RV(va, 2, 1, 1); EX(Q0, 1); AD(Q0, 0); SBAR(); \
    WL(2); MP(0, pa1, va, 0); RV(va, 0, 0, 2); EX(Q0, 2); AD(Q0, 1); SBAR(); \
    WL(2); MP(1, pa1, va, 2); RV(va, 2, 1, 2); EX(Q0, 3); AD(Q0, 2); SBAR(); \
    WL(2); MP(0, pa2, va, 0); RV(va, 0, 0, 3); EX(Q0, 4); AD(Q0, 3); SBAR(); \
    WL(2); MP(1, pa2, va, 2); RV(va, 2, 1, 3); EX(Q0, 5); AD(Q0, 4); SBAR(); \
    WL(2); MP(0, pa3, va, 0); RV(va, 0, 2, 0); EX(Q0, 6); AD(Q0, 5); SBAR(); \
    WL(2); MP(1, pa3, va, 2); RV(va, 2, 3, 0); EX(Q0, 7); AD(Q0, 6); SBAR(); \
    WL(2); MP(2, pa0, va, 0); RV(va, 0, 2, 1); EX(Q0, 8); AD(Q0, 7); SBAR(); \
    WL(2); MP(3, pa0, va, 2); RV(va, 2, 3, 1); EX(Q0, 9); AD(Q0, 8); SBAR(); \
    WL(2); MP(2, pa1, va, 0); RV(va, 0, 2, 2); EX(Q0, 10); AD(Q0, 9); SBAR(); \
    WL(2); MP(3, pa1, va, 2); RV(va, 2, 3, 2); EX(Q0, 11); AD(Q0, 10); SBAR(); \
    WL(2); MP(2, pa2, va, 0); RV(va, 0, 2, 3); SWAIT(); SWV0(BW, SW); EX(Q0, 12); AD(Q0, 11); SBAR(); \
    WL(3); MP(3, pa2, va, 2); RV(va, 2, 3, 3); SWV1(BW, SW); EX(Q0, 13); AD(Q0, 12); SBAR(); \
    WL(4); MP(2, pa3, va, 0); SWK0(BW, SW); EX(Q0, 14); AD(Q0, 13); SBAR(); \
    WL(2); MP(3, pa3, va, 2); SWK1(BW, SW); EX(Q0, 15); AD(Q0, 14); AD(Q0, 15); SBAR(); \
    __syncthreads(); } while (0)
  SLOAD(0, 0); asm volatile("s_waitcnt vmcnt(0)" ::: "memory"); SWRITE(0, 0); SLOAD(1, 1); SLOAD(0, 2); __syncthreads();
  qkt(pA0, pA1, K_lds, qr, r32, hi); partialSM_fix2(pA0, l_reg); SWAIT(); SWRITE(1, 1); __syncthreads();
  int jb = 1;
  for (; jb + 5 < NT; jb += 6) {
    STEP(jb,     pB0, pB1, pA0, pA1, 1, 0, 2, 1, 0);
    STEP(jb + 1, pA0, pA1, pB0, pB1, 2, 1, 0, 0, 1);
    STEP(jb + 2, pB0, pB1, pA0, pA1, 0, 2, 1, 1, 0);
    STEP(jb + 3, pA0, pA1, pB0, pB1, 1, 0, 2, 0, 1);
    STEP(jb + 4, pB0, pB1, pA0, pA1, 2, 1, 0, 1, 0);
    STEP(jb + 5, pA0, pA1, pB0, pB1, 0, 2, 1, 0, 1);
  }
  constexpr int REM = (NT - 1) % 6;
  if constexpr (REM > 0) STEP(jb,     pB0, pB1, pA0, pA1, 1, 0, 2, 1, 0);
  if constexpr (REM > 1) STEP(jb + 1, pA0, pA1, pB0, pB1, 2, 1, 0, 0, 1);
  if constexpr (REM > 2) STEP(jb + 2, pB0, pB1, pA0, pA1, 0, 2, 1, 1, 0);
  if constexpr (REM > 3) STEP(jb + 3, pA0, pA1, pB0, pB1, 1, 0, 2, 0, 1);
  if constexpr (REM > 4) STEP(jb + 4, pB0, pB1, pA0, pA1, 2, 1, 0, 1, 0);
  if constexpr ((NT - 1) & 1) finishSM2(pB0, pB1, l_reg, pa0, pa1, pa2, pa3); else finishSM2(pA0, pA1, l_reg, pa0, pa1, pa2, pa3);
  { auto rr = __builtin_amdgcn_permlane32_swap(__float_as_uint(l_reg), __float_as_uint(l_reg), false, false); l_reg = __uint_as_float(rr[0]) + __uint_as_float(rr[1]); }
  { const int vbp = vb0 + ((NT - 1) % 3) * VB; SBAR(); RV(va, 0, 0, 0); RV(va, 2, 1, 0); SBAR();
    WL(2); MP(0, pa0, va, 0); RV(va, 0, 0, 1); SBAR();
    WL(2); MP(1, pa0, va, 2); RV(va, 2, 1, 1); SBAR();
    WL(2); MP(0, pa1, va, 0); RV(va, 0, 0, 2); SBAR();
    WL(2); MP(1, pa1, va, 2); RV(va, 2, 1, 2); SBAR();
    WL(2); MP(0, pa2, va, 0); RV(va, 0, 0, 3); SBAR();
    WL(2); MP(1, pa2, va, 2); RV(va, 2, 1, 3); SBAR();
    WL(2); MP(0, pa3, va, 0); RV(va, 0, 2, 0); SBAR();
    WL(2); MP(1, pa3, va, 2); RV(va, 2, 3, 0); SBAR();
    WL(2); MP(2, pa0, va, 0); RV(va, 0, 2, 1); SBAR();
    WL(2); MP(3, pa0, va, 2); RV(va, 2, 3, 1); SBAR();
    WL(2); MP(2, pa1, va, 0); RV(va, 0, 2, 2); SBAR();
    WL(2); MP(3, pa1, va, 2); RV(va, 2, 3, 2); SBAR();
    WL(2); MP(2, pa2, va, 0); RV(va, 0, 2, 3); SBAR();
    WL(2); MP(3, pa2, va, 2); RV(va, 2, 3, 3); SBAR();
    WL(2); MP(2, pa3, va, 0); SBAR();
    WL(0); MP(3, pa3, va, 2); SBAR();
  }
  { const float rl = __builtin_amdgcn_rcpf(l_reg); bf16_t* Orow = Ob + (long)(wid * QBLK + r32) * LDO + hi * 8;
#pragma unroll
    for (int D0 = 0; D0 < 4; ++D0) {
#pragma unroll
      for (int gp = 0; gp < 2; ++gp) { const int k = D0 * 4 + 2 * gp;
        unsigned ax = cvtpk(o[D0][8 * gp + 0] * rl, o[D0][8 * gp + 1] * rl), ay = cvtpk(o[D0][8 * gp + 2] * rl, o[D0][8 * gp + 3] * rl);
        unsigned bx = cvtpk(o[D0][8 * gp + 4] * rl, o[D0][8 * gp + 5] * rl), by = cvtpk(o[D0][8 * gp + 6] * rl, o[D0][8 * gp + 7] * rl);
        auto sx = __builtin_amdgcn_permlane32_swap(ax, bx, false, false); auto sy = __builtin_amdgcn_permlane32_swap(ay, by, false, false);
        *(u32x4*)(Orow + 8 * k) = (u32x4){sx[0], sy[0], sx[1], sy[1]}; } } }
  asm volatile("s_waitcnt vmcnt(0) lgkmcnt(0)" ::: "memory"); __syncthreads();
#undef STEP
#undef TROW
#undef SLV0
#undef SLV1
#undef SLK0
#undef SLK1
#undef SWV0
#undef SWV1
#undef SWK0
#undef SWK1
#undef KRD
#undef MQ
#undef EX
#undef AD
#undef CV
#undef PM
#undef RV
#undef PKV
#undef MP
#undef WL
#undef SLOAD
#undef SWRITE
#undef SWAIT
}
}
struct Args { const float* in[32]; float* out; unsigned char* ws; int ph_lo, ph_hi, li, pad; };
constexpr int PTR_OFF = RING_BYTES + 512;
struct Ctx { LAS unsigned char* ldsb; unsigned char* ws;
    __device__ __forceinline__ const float* inp(int i) const { const u32x2 v = *(const LAS u32x2*)(ldsb + PTR_OFF + 8 * i);
        const unsigned long long p = ((unsigned long long)(unsigned)__builtin_amdgcn_readfirstlane((int)v.y) << 32) | (unsigned)__builtin_amdgcn_readfirstlane((int)v.x);
        return (const float*)(const GAS float*)p; }
    __device__ __forceinline__ float* outp() const { return (float*)inp(32); } };
enum { IN_X = 0, IN_C, IN_CTX, IN_CCTX, IN_MODW, IN_MODB, IN_LNMG, IN_LNMB, IN_LNFG, IN_LNFB, IN_WIN, IN_WOUT, IN_LAMRE, IN_LAMIM, IN_LOGSTEP, IN_BRE, IN_BIM, IN_CRE, IN_CIM,
       IN_S5D, IN_WGLU, IN_BGLU, IN_FNETW, IN_FNETB, IN_WQKV, IN_QGAIN, IN_KGAIN, IN_WO, IN_ROUTER, IN_WGATE, IN_WUP, IN_WDOWN };

struct RowV { f32x4 v[8]; };
__device__ __forceinline__ void row_load_f32(RowV& r, const float* p, int lane) {
#pragma unroll
    for (int j = 0; j < 8; ++j) r.v[j] = *(const f32x4*)(p + 4 * lane + 256 * j);
}
__device__ __forceinline__ void row_load_f32_nt(RowV& r, const float* p, int lane) {
#pragma unroll
    for (int j = 0; j < 8; ++j) r.v[j] = __builtin_nontemporal_load((const f32x4*)(p + 4 * lane + 256 * j));
}
__device__ __forceinline__ void row_store_f32(const RowV& r, float* p, int lane) {
#pragma unroll
    for (int j = 0; j < 8; ++j) *(f32x4*)(p + 4 * lane + 256 * j) = r.v[j];
}
__device__ __forceinline__ void row_store_f32_nt(const RowV& r, float* p, int lane) {
#pragma unroll
    for (int j = 0; j < 8; ++j) __builtin_nontemporal_store(r.v[j], (f32x4*)(p + 4 * lane + 256 * j));
}
__device__ __forceinline__ void row_load_bf16(RowV& r, const bf16_t* p, int lane) {
#pragma unroll
    for (int j = 0; j < 8; ++j) { const u32x2 w = *(const u32x2*)(p + 4 * lane + 256 * j);
        r.v[j] = (f32x4){bf2f(w.x & 0xffffu), bf2f(w.x >> 16), bf2f(w.y & 0xffffu), bf2f(w.y >> 16)}; }
}
__device__ __forceinline__ void row_store_bf16(const RowV& r, bf16_t* p, int lane) {
#pragma unroll
    for (int j = 0; j < 8; ++j) { u32x2 w; w.x = cvt_pk_bf16(r.v[j][0], r.v[j][1]); w.y = cvt_pk_bf16(r.v[j][2], r.v[j][3]); *(u32x2*)(p + 4 * lane + 256 * j) = w; }
}
__device__ __forceinline__ void row_normalize(RowV& r) {
    float s = 0.f;
#pragma unroll
    for (int j = 0; j < 8; ++j) s += (r.v[j][0] + r.v[j][1]) + (r.v[j][2] + r.v[j][3]);
    const float mean = wave_sum(s) * (1.f / DM); float q = 0.f;
#pragma unroll
    for (int j = 0; j < 8; ++j) { r.v[j] = r.v[j] - mean; q += (r.v[j][0] * r.v[j][0] + r.v[j][1] * r.v[j][1]) + (r.v[j][2] * r.v[j][2] + r.v[j][3] * r.v[j][3]); }
    const float rstd = 1.f / sqrtf(wave_sum(q) * (1.f / DM) + LN_EPS);
#pragma unroll
    for (int j = 0; j < 8; ++j) r.v[j] = r.v[j] * rstd;
}
__device__ __forceinline__ void row_modulate(RowV& r, const float* shift, const float* scale, int lane) {
#pragma unroll
    for (int j = 0; j < 8; ++j) { const f32x4 sc = *(const f32x4*)(scale + 4 * lane + 256 * j), sh = *(const f32x4*)(shift + 4 * lane + 256 * j); r.v[j] = r.v[j] * (sc + 1.f) + sh; }
}
__device__ __forceinline__ void row_affine(RowV& r, const float* gain, const float* bias, int lane) {
#pragma unroll
    for (int j = 0; j < 8; ++j) { const f32x4 g = *(const f32x4*)(gain + 4 * lane + 256 * j), b = *(const f32x4*)(bias + 4 * lane + 256 * j); r.v[j] = r.v[j] * g + b; }
}
__device__ __forceinline__ void row_decode(int r, int& b, bool& isctx, int& idx) { b = r / RPB; const int t = r - b * RPB; isctx = t < CTX; idx = isctx ? t : t - CTX; }
__device__ __forceinline__ const float* mod_ptr(const unsigned char* ws, int layer, int which, int k) { return (const float*)(ws + O_MOD) + ((size_t)((layer * 3 + which) * 6 + k)) * DM; }

template <int MODE>
__device__ __forceinline__ void transpose_item(const float* W, int K, int N, bf16_t* WT, LAS float* scrf, int item, int lane) {
    LAS unsigned* scr = (LAS unsigned*)scrf;
    const int nblk = N / 64, kb = item / nblk, nb = item % nblk, k0 = 64 * kb, n0 = 64 * nb;
    const float* src = W + (size_t)k0 * N + n0 + lane;
    float v[64];
#pragma unroll
    for (int i = 0; i < 64; ++i) v[i] = __builtin_nontemporal_load(src + (size_t)i * N);
#pragma unroll
    for (int i = 0; i < 32; ++i) scr[lane * 33 + i] = cvt_pk_bf16(v[2 * i], v[2 * i + 1]);
    LDS_WAIT(); asm volatile("" ::: "memory");
    const int c = lane & 7;
#pragma unroll
    for (int jj = 0; jj < 8; ++jj) { const int n = (lane >> 3) + 8 * jj; const LAS unsigned* s = scr + n * 33 + 4 * c;
        u32x4 o; o.x = s[0]; o.y = s[1]; o.z = s[2]; o.w = s[3];
        const int nn = n0 + n; const int orow = MODE == 0 ? nn : (8 * (nn >> 2) + (nn & 3) + (MODE == 2 ? 4 : 0));
        __builtin_nontemporal_store(o, (u32x4*)(WT + (size_t)orow * K + k0 + 8 * c)); }
    LDS_WAIT(); asm volatile("" ::: "memory");
}

__device__ __forceinline__ void p0_prologue(const Ctx& a, LAS unsigned char* lds, int tid, int lane, int wave) {
    unsigned char* ws = a.ws;
    LAS float* scr = (LAS float*)(lds + wave * 16384);
    const int gw = blockIdx.x * NWAVES + wave, NGW = gridDim.x * NWAVES;
    constexpr int I_SQ = 32 * 32, I_GLU = 16 * 16, I_QKV = 32 * 48;
    constexpr int PER_J = 2 * I_SQ + I_GLU + I_QKV + I_SQ;
    for (int it = gw; it < 2 * PER_J; it += NGW) {
        const int j = it / PER_J; int r = it % PER_J;
        if (r < I_SQ) { transpose_item<0>(a.inp(IN_WIN) + (size_t)j * DM * DM, DM, DM, (bf16_t*)(ws + O_WIN) + (size_t)j * DM * DM, scr, r, lane); continue; } r -= I_SQ;
        if (r < I_SQ) { transpose_item<0>(a.inp(IN_WOUT) + (size_t)j * DM * DM, DM, DM, (bf16_t*)(ws + O_WOUT) + (size_t)j * DM * DM, scr, r, lane); continue; } r -= I_SQ;
        if (r < I_GLU) { transpose_item<0>(a.inp(IN_WGLU) + (size_t)j * 1024 * 1024, 1024, 1024, (bf16_t*)(ws + O_WGLU) + (size_t)j * 1024 * 1024, scr, r, lane); continue; } r -= I_GLU;
        if (r < I_QKV) { transpose_item<0>(a.inp(IN_WQKV) + (size_t)j * DM * 3072, DM, 3072, (bf16_t*)(ws + O_WQKV) + (size_t)j * 3072 * DM, scr, r, lane); continue; } r -= I_QKV;
        transpose_item<0>(a.inp(IN_WO) + (size_t)j * DM * DM, DM, DM, (bf16_t*)(ws + O_WO) + (size_t)j * DM * DM, scr, r, lane);
    }
    __syncthreads();
    {
        LAS float* sl = (LAS float*)lds;
        LAS float* red = (LAS float*)(lds + 32768);
        for (int i = tid; i < 3 * DM; i += NTHREADS) { const int w = i / DM, k = i % DM; const float cv = w < 2 ? a.inp(IN_C)[w * DM + k] : a.inp(IN_CCTX)[k]; sl[i] = silu_f(cv); }
        __syncthreads();
        for (int wi = blockIdx.x; wi < 256; wi += gridDim.x) {
            const int layer = wi >> 6, col0 = (wi & 63) * 192;
            const float* W = a.inp(IN_MODW) + (size_t)layer * DM * 12288 + col0 + lane;
            float acc[3][3];
#pragma unroll
            for (int q = 0; q < 3; ++q)
#pragma unroll
                for (int r = 0; r < 3; ++r) acc[q][r] = 0.f;
#pragma unroll 16
            for (int k = wave * 256; k < wave * 256 + 256; ++k) {
                const float s0 = sl[k], s1 = sl[DM + k], s2 = sl[2 * DM + k];
#pragma unroll
                for (int q = 0; q < 3; ++q) { const float w = W[(size_t)k * 12288 + 64 * q]; acc[q][0] += w * s0; acc[q][1] += w * s1; acc[q][2] += w * s2; }
            }
#pragma unroll
            for (int q = 0; q < 3; ++q)
#pragma unroll
                for (int r = 0; r < 3; ++r) red[(wave * 9 + q * 3 + r) * 64 + lane] = acc[q][r];
            __syncthreads();
            for (int i = tid; i < 576; i += NTHREADS) { const int qr = i / 64, l = i % 64, q = qr / 3, r = qr % 3; float s = 0.f;
#pragma unroll
                for (int w = 0; w < 8; ++w) s += red[(w * 9 + qr) * 64 + l];
                const int n = col0 + 64 * q + l;
                ((float*)(ws + O_MOD))[((size_t)(layer * 3 + r)) * 12288 + n] = s + a.inp(IN_MODB)[layer * 12288 + n]; }
            __syncthreads();
        }
    }
    const int gt = blockIdx.x * NTHREADS + tid, NGT = gridDim.x * NTHREADS;
    const double INV_PI = 0.31830988618379067153776752674503;
    for (int i = gt; i < 256 * 32; i += NGT) { const int pos = i >> 5, f = i & 31; const float invf = (float)exp(-(double)f * (9.210340371976182736071965818737 / 32.0)); const float ang = (float)pos * invf;
        ((f32x2*)(ws + O_TRIG))[i] = (f32x2){(float)cospi((double)ang * INV_PI), (float)sinpi((double)ang * INV_PI)}; }
    for (int i = gt; i < 256 * 256; i += NGT) { const int r = i >> 8, k = i & 255;
        { float v = 0.f; if (k < 128) { float ss, cc; sincospif((float)(((r & 127) * k) & 127) * (1.f / 64.f), &ss, &cc); v = (r < 128 ? cc : -ss) * (1.f / 128.f); }
          ((bf16_t*)(ws + O_FA))[i] = (bf16_t)f2bf(v); }
    }
    for (int i8 = gt; i8 < 128 * 256 * 32; i8 += NGT) {
        const int k1 = i8 >> 13, r = (i8 >> 5) & 255, kc = (i8 & 31) * 8, k2 = r & 127; float v[8];
#pragma unroll
        for (int q = 0; q < 8; ++q) { const int k = kc + q, l2 = k & 127; float ss, cc; sincospif((float)((l2 * (k1 + 128 * k2)) & 16383) * (1.f / 8192.f), &ss, &cc);
            v[q] = r < 128 ? (k < 128 ? cc : ss) : (k < 128 ? ss : -cc); }
        u32x4 o; o.x = cvt_pk_bf16(v[0], v[1]); o.y = cvt_pk_bf16(v[2], v[3]); o.z = cvt_pk_bf16(v[4], v[5]); o.w = cvt_pk_bf16(v[6], v[7]);
        *(u32x4*)((bf16_t*)(ws + O_FC) + (size_t)i8 * 8) = o; }
    for (int i = gt; i < 512 * 256; i += NGT) { const int r = i >> 8, l = i & 255, k = r & 255; float ss, cc; sincospif((float)((k * l) & 255) * (1.f / 128.f), &ss, &cc);
        ((bf16_t*)(ws + O_F256))[i] = (bf16_t)f2bf((r < 256 ? cc : ss) * (1.f / 16.f)); }
    for (int i = gt; i < 2 * 2 * 64 * 64 * 33; i += NGT) { const int jdgp = i / 33, n = i - jdgp * 33;
        const double step = exp((double)a.inp(IN_LOGSTEP)[jdgp >> 6]), ar = (double)a.inp(IN_LAMRE)[jdgp] * step, ai = (double)a.inp(IN_LAMIM)[jdgp] * step * INV_PI;
        const double mag = exp(ar * n); ((f32x2*)(ws + O_POW))[i] = (f32x2){(float)(mag * cospi(ai * n)), (float)(mag * sinpi(ai * n))}; }
    for (int i = gt; i < 2 * 2 * 64 * 64 * 16; i += NGT) { const int jdgp = i >> 4;
        const double lre = a.inp(IN_LAMRE)[jdgp], lim = a.inp(IN_LAMIM)[jdgp], step = exp((double)a.inp(IN_LOGSTEP)[jdgp >> 6]);
        const double mag = exp(lre * step), ang = lim * step * INV_PI, br = mag * cospi(ang) - 1.0, bi = mag * sinpi(ang), den = lre * lre + lim * lim;
        const double qr = (br * lre + bi * lim) / den, qi = (bi * lre - br * lim) / den;
        const double xr = a.inp(IN_BRE)[i], xi = a.inp(IN_BIM)[i]; ((f32x2*)(ws + O_BBAR))[i] = (f32x2){(float)(qr * xr - qi * xi), (float)(qr * xi + qi * xr)}; }
    {
        __syncthreads();
        LAS float* ct = (LAS float*)lds; LAS float* st = ct + 256;
        if (tid < 256) { float ss, cc; sincospif((float)tid * (1.f / 128.f), &ss, &cc); ct[tid] = cc * (1.f / 16.f); st[tid] = -ss * (1.f / 16.f); }
        __syncthreads();
        for (int i = gt; i < 2 * 4 * 64 * 256; i += NGT) { const int e = i & 255, kb = (i >> 8) & 63, jg = i >> 14, c0 = (kb & 31) * 8; const LAS float* tb = kb < 32 ? ct : st;
            const float* w = a.inp(IN_FNETW) + (size_t)jg * 65536 + e; float s[8];
#pragma unroll
            for (int q = 0; q < 8; ++q) s[q] = 0.f;
#pragma unroll 4
            for (int m = 0; m < 256; ++m) { const float wv = w[m * 256];
#pragma unroll
                for (int q = 0; q < 8; ++q) s[q] += tb[(m * (c0 + q)) & 255] * wv; }
            u32x4 o; o.x = cvt_pk_bf16(s[0], s[1]); o.y = cvt_pk_bf16(s[2], s[3]); o.z = cvt_pk_bf16(s[4], s[5]); o.w = cvt_pk_bf16(s[6], s[7]);
            *(u32x4*)((bf16_t*)(ws + O_FNM) + ((size_t)jg * 256 + e) * 512 + kb * 8) = o; }
        __syncthreads();
    }
    if (gt < 128) ((bf16_t*)(ws + O_T1))[(size_t)2048 * 128 * 128 + gt] = 0;
}

__device__ __forceinline__ void p1_kf(const Ctx& a, LAS unsigned char* lds, int tid) {
    unsigned char* ws = a.ws;
    LAS f32x2* pw = (LAS f32x2*)lds;
    LAS f32x2* bb = pw + 64 * 33;
    LAS f32x2* cc = bb + 64 * 16;
    for (int jdg = blockIdx.x; jdg < 256; jdg += gridDim.x) {
        for (int i = tid; i < 64 * 33; i += NTHREADS) pw[i] = ((const f32x2*)(ws + O_POW))[(size_t)jdg * 64 * 33 + i];
        for (int i = tid; i < 64 * 16; i += NTHREADS) bb[i] = ((const f32x2*)(ws + O_BBAR))[(size_t)jdg * 64 * 16 + i];
        for (int i = tid; i < 16 * 64; i += NTHREADS) cc[(i >> 6) * 65 + (i & 63)] = (f32x2){a.inp(IN_CRE)[(size_t)jdg * 1024 + i], a.inp(IN_CIM)[(size_t)jdg * 1024 + i]};
        __syncthreads();
        const int tau = tid >> 4, co = tid & 15; float s[16];
#pragma unroll
        for (int ci = 0; ci < 16; ++ci) s[ci] = 0.f;
        for (int p = 0; p < 64; ++p) { const f32x2 w = pw[p * 33 + tau], c = cc[co * 65 + p]; const float xr = c.x * w.x - c.y * w.y, xi = c.x * w.y + c.y * w.x;
#pragma unroll
            for (int ci = 0; ci < 16; ++ci) { const f32x2 b = bb[p * 16 + ci]; s[ci] += xr * b.x - xi * b.y; } }
        float* out = (float*)(ws + O_KF) + ((size_t)jdg * 32 + tau) * 256 + co * 16;
#pragma unroll
        for (int q = 0; q < 4; ++q) *(f32x4*)(out + 4 * q) = (f32x4){s[4 * q], s[4 * q + 1], s[4 * q + 2], s[4 * q + 3]};
        __syncthreads();
    }
}
__device__ __forceinline__ u32x4 p2_bt1_item(const Ctx& a, int i) {
    unsigned char* ws = a.ws; const f32x2* POW = (const f32x2*)(ws + O_POW); const f32x2* BB = (const f32x2*)(ws + O_BBAR);
    const int k8 = i & 63, rr = (i >> 6) & 255, jg = i >> 14, j = jg >> 6, g = jg & 63;
    const int typ = rr >> 6, p = rr & 63, d = typ >> 1, t = k8 >> 1, ci0 = (k8 & 1) * 8, n = d == 0 ? (31 - t) : t;
    const size_t jdgp = ((size_t)((j * 2 + d) * 64 + g)) * 64 + p; const f32x2 w = POW[jdgp * 33 + n]; float v[8];
#pragma unroll
    for (int c = 0; c < 8; ++c) { const f32x2 b = BB[jdgp * 16 + ci0 + c]; v[c] = (typ & 1) ? (w.x * b.y + w.y * b.x) : (w.x * b.x - w.y * b.y); }
    u32x4 o; o.x = cvt_pk_bf16(v[0], v[1]); o.y = cvt_pk_bf16(v[2], v[3]); o.z = cvt_pk_bf16(v[4], v[5]); o.w = cvt_pk_bf16(v[6], v[7]); return o;
}
__device__ __forceinline__ u32x4 p2_bt3_item(const Ctx& a, int i) {
    unsigned char* ws = a.ws; const f32x2* POW = (const f32x2*)(ws + O_POW); const float* KF = (const float*)(ws + O_KF);
    const int k8 = i % 96, rr = (i / 96) & 511, jg = i / (96 * 512), j = jg >> 6, g = jg & 63;
    const int t = rr >> 4, co = rr & 15; float v[8];
    if (k8 < 64) { const int s = k8 >> 1, ci0 = (k8 & 1) * 8;
        f32x4 f0 = (f32x4){0.f, 0.f, 0.f, 0.f}, f1 = f0;
        if (s <= t) { const f32x4* p = (const f32x4*)(KF + ((((size_t)(j * 2 + 0) * 64 + g) * 32 + (t - s)) * 16 + co) * 16 + ci0); f0 += p[0]; f1 += p[1]; }
        if (s >= t) { const f32x4* p = (const f32x4*)(KF + ((((size_t)(j * 2 + 1) * 64 + g) * 32 + (s - t)) * 16 + co) * 16 + ci0); f0 += p[0]; f1 += p[1]; }
#pragma unroll
        for (int c = 0; c < 4; ++c) { v[c] = f0[c]; v[4 + c] = f1[c]; }
        if (s == t && (co >> 3) == (k8 & 1)) { const float dsk = a.inp(IN_S5D)[j * 1024 + g * 16 + co];
#pragma unroll
            for (int c = 0; c < 8; ++c) v[c] += (ci0 + c == co) ? dsk : 0.f; }
    } else { const int q0 = (k8 - 64) * 8, typ = q0 >> 6, d = typ >> 1, n = d == 0 ? (t + 1) : (32 - t);
        const size_t jdg = (size_t)(j * 2 + d) * 64 + g;
#pragma unroll
        for (int c = 0; c < 8; ++c) { const int p = (q0 & 63) + c; const f32x2 w = POW[(jdg * 64 + p) * 33 + n];
            const float cr = a.inp(IN_CRE)[(jdg * 16 + co) * 64 + p], ci = a.inp(IN_CIM)[(jdg * 16 + co) * 64 + p];
            v[c] = (typ & 1) ? -(cr * w.y + ci * w.x) : (cr * w.x - ci * w.y); } }
    u32x4 o; o.x = cvt_pk_bf16(v[0], v[1]); o.y = cvt_pk_bf16(v[2], v[3]); o.z = cvt_pk_bf16(v[4], v[5]); o.w = cvt_pk_bf16(v[6], v[7]); return o;
}
__device__ __forceinline__ void p2_s5mats(const Ctx& a, int tid) {
    unsigned char* ws = a.ws; const int gt = blockIdx.x * NTHREADS + tid, NGT = gridDim.x * NTHREADS;
    constexpr int N1 = 2 * 64 * 256 * 64, N3 = 2 * 64 * 512 * 96;
    for (int i = gt; i < N1; i += 4 * NGT) { u32x4 o[4];
#pragma unroll
        for (int q = 0; q < 4; ++q) { const int ii = i + q * NGT; o[q] = p2_bt1_item(a, ii < N1 ? ii : i); }
#pragma unroll
        for (int q = 0; q < 4; ++q) { const int ii = i + q * NGT; if (ii < N1) { const int k8 = ii & 63, rr = (ii >> 6) & 255, jg = ii >> 14;
            *(u32x4*)((bf16_t*)(ws + O_BT1) + ((size_t)jg * 256 + rr) * 512 + k8 * 8) = o[q]; } } }
    for (int i = gt; i < N3; i += 4 * NGT) { u32x4 o[4];
#pragma unroll
        for (int q = 0; q < 4; ++q) { const int ii = i + q * NGT; o[q] = p2_bt3_item(a, ii < N3 ? ii : i); }
#pragma unroll
        for (int q = 0; q < 4; ++q) { const int ii = i + q * NGT; if (ii < N3) { const int k8 = ii % 96, rr = (ii / 96) & 511, jg = ii / (96 * 512);
            *(u32x4*)((bf16_t*)(ws + O_BT3) + ((size_t)jg * 512 + rr) * 768 + k8 * 8) = o[q]; } } }
}
__device__ __forceinline__ void moe_weight_phase(const Ctx& a, int layer, int part, int tailwgs, LAS unsigned char* lds, int lane, int wave) {
    unsigned char* ws = a.ws; LAS float* scr = (LAS float*)(lds + wave * 16384);
    const int rank = (int)blockIdx.x - tailwgs, nact = (int)gridDim.x - tailwgs;
    if (rank >= 0) {
        const int gw = rank * NWAVES + wave, NGW = nact * NWAVES;
        constexpr int I_GU = 32 * 16, I_DN = 16 * 32, PER_E = 2 * I_GU + I_DN, HALF_ITEMS = 16 * PER_E / 2;
        for (int it = part * HALF_ITEMS + gw; it < (part + 1) * HALF_ITEMS; it += NGW) {
            const int e = it / PER_E; int r = it % PER_E;
            const size_t le = (size_t)layer * 16 + e;
            if (r < I_GU) { transpose_item<1>(a.inp(IN_WGATE) + le * DM * EFF, DM, EFF, (bf16_t*)(ws + O_WGU) + (size_t)e * 2048 * DM, scr, r, lane); continue; } r -= I_GU;
            if (r < I_GU) { transpose_item<2>(a.inp(IN_WUP) + le * DM * EFF, DM, EFF, (bf16_t*)(ws + O_WGU) + (size_t)e * 2048 * DM, scr, r, lane); continue; } r -= I_GU;
            transpose_item<0>(a.inp(IN_WDOWN) + le * EFF * DM, EFF, DM, (bf16_t*)(ws + O_WD) + (size_t)e * DM * EFF, scr, r, lane);
        }
    }
    __syncthreads();
}

__device__ __forceinline__ const float* r_xsrc0(const Ctx& a, int r) { int b, idx; bool isctx; row_decode(r, b, isctx, idx);
    return isctx ? a.inp(IN_CTX) + ((size_t)(b * CTX + idx)) * DM : a.inp(IN_X) + ((size_t)(b * SEQ + idx)) * DM; }
__device__ __forceinline__ void r0_phase(const Ctx& a, int lane, int wave) {
    unsigned char* ws = a.ws; const int gw = blockIdx.x * NWAVES + wave, NGW = gridDim.x * NWAVES;
    RowV xn;
    if (gw < NR) row_load_f32(xn, r_xsrc0(a, gw), lane);
    for (int r = gw; r < NR; r += NGW) { int b, idx; bool isctx; row_decode(r, b, isctx, idx);
        const int which = isctx ? 2 : b; RowV x = xn;
        if (r + NGW < NR) row_load_f32(xn, r_xsrc0(a, r + NGW), lane);
        row_normalize(x);
        row_modulate(x, mod_ptr(ws, 0, which, 0), mod_ptr(ws, 0, which, 1), lane);
        row_store_bf16(x, (bf16_t*)(ws + O_U) + (size_t)r * DM, lane); }
}
__device__ __forceinline__ void lds_vec_fill(LAS float* dst, const float* src, int tid) { for (int i = tid; i < DM / 4; i += NTHREADS) *(LAS f32x4*)(dst + 4 * i) = *(const f32x4*)(src + 4 * i); }
__device__ __forceinline__ f32x4 vld(const float* p, int lane, int j) { return *(const f32x4*)(p + 4 * lane + 256 * j); }
__device__ __forceinline__ f32x4 vld(const LAS float* p, int lane, int j) { return *(const LAS f32x4*)(p + 4 * lane + 256 * j); }
__device__ __forceinline__ const float* r_xsrc(const Ctx& a, int layer, int r) { int b, idx; bool isctx; row_decode(r, b, isctx, idx);
    if (layer == 0) return isctx ? a.inp(IN_CTX) + ((size_t)(b * CTX + idx)) * DM : a.inp(IN_X) + ((size_t)(b * SEQ + idx)) * DM;
    return isctx ? (const float*)(a.ws + O_XC) + ((size_t)(b * CTX + idx)) * DM : a.outp() + ((size_t)(b * SEQ + idx)) * DM; }
struct RowDeal { int b, i0, n_lat_wg, wave, nlat, gw, NGW;
    __device__ __forceinline__ void init(int wave_) { const int G = gridDim.x, nb = G >> 1, c = blockIdx.x; wave = wave_; gw = c * NWAVES + wave; NGW = G * NWAVES;
        if (nb > 0 && c < 2 * nb) { const int per = (SEQ + nb - 1) / nb; b = c / nb; i0 = (c % nb) * per; n_lat_wg = SEQ - i0 < per ? (SEQ - i0 > 0 ? SEQ - i0 : 0) : per; } else { b = 0; i0 = 0; n_lat_wg = 0; }
        nlat = n_lat_wg > wave ? (n_lat_wg - wave + NWAVES - 1) / NWAVES : 0; }
    bool with_ctx = true;
    __device__ __forceinline__ int row(int k) const { if (k < nlat) return b * RPB + CTX + i0 + wave + k * NWAVES;
        const int q = gw + (k - nlat) * NGW; if (!with_ctx || q >= NBATCH * CTX) return -1; return (q / CTX) * RPB + (q % CTX); } };
constexpr int RV_OFF = RING_BYTES + 1024;

template <bool FAST>
__device__ __forceinline__ void r1_row(const Ctx& a, int layer, int r, RowV& x, const LAS float* wl, const LAS float* lv, int lane, bool st) {
    unsigned char* ws = a.ws; int b, idx; bool isctx; row_decode(r, b, isctx, idx); const int which = isctx ? 2 : b;
    float* xs = isctx ? (float*)(ws + O_XC) + ((size_t)(b * CTX + idx)) * DM : a.outp() + ((size_t)(b * SEQ + idx)) * DM;
    row_normalize(x);
    row_affine(x, a.inp(IN_LNMG) + layer * DM, a.inp(IN_LNMB) + layer * DM, lane);
    if (st) row_store_f32_nt(x, xs, lane);
    row_normalize(x);
    if (FAST) {
#pragma unroll
        for (int j = 0; j < 8; ++j) x.v[j] = x.v[j] * (vld(lv + DM, lane, j) + 1.f) + vld(lv + 2 * DM, lane, j);
    } else row_modulate(x, mod_ptr(ws, layer, which, 3), mod_ptr(ws, layer, which, 4), lane);
    if (st) row_store_bf16(x, (bf16_t*)(ws + O_H2) + (size_t)r * DM, lane);
    float lg[16];
#pragma unroll
    for (int e = 0; e < 16; ++e) { float s0 = 0.f, s1 = 0.f, s2 = 0.f, s3 = 0.f;
#pragma unroll
        for (int j = 0; j < 8; ++j) { const f32x4 w = *(const LAS f32x4*)(wl + e * DM + 4 * lane + 256 * j);
            s0 = __builtin_fmaf(x.v[j][0], w[0], s0); s1 = __builtin_fmaf(x.v[j][1], w[1], s1); s2 = __builtin_fmaf(x.v[j][2], w[2], s2); s3 = __builtin_fmaf(x.v[j][3], w[3], s3); }
        lg[e] = wave_sum((s0 + s1) + (s2 + s3)); asm volatile("" ::: "memory"); }
    float mx = lg[0];
#pragma unroll
    for (int e = 1; e < 16; ++e) mx = fmaxf(mx, lg[e]);
    float den = 0.f;
#pragma unroll
    for (int e = 0; e < 16; ++e) { lg[e] = __builtin_amdgcn_exp2f((lg[e] - mx) * 1.4426950408889634f); den += lg[e]; }
    float mine = 0.f;
#pragma unroll
    for (int e = 0; e < 16; ++e) mine = (lane == e) ? lg[e] : mine;
    if (st && lane < 16) ((float*)(ws + O_AFF))[(size_t)r * 16 + lane] = mine / den;
}
__device__ __forceinline__ void r1_phase(const Ctx& a, int layer, LAS unsigned char* lds, int tid, int lane, int wave, bool st) {
    unsigned char* ws = a.ws;
    LAS float* wl = (LAS float*)lds;
    LAS float* lv = (LAS float*)(lds + RV_OFF);
    RowDeal rd; rd.init(wave); rd.with_ctx = layer + 1 < DEPTH;
    { const float* wr = a.inp(IN_ROUTER) + (size_t)layer * DM * 16;
      for (int i = tid; i < DM * 16; i += NTHREADS) wl[(i & 15) * DM + (i >> 4)] = wr[i];
      lds_vec_fill(lv, mod_ptr(ws, layer, rd.b, 2), tid); lds_vec_fill(lv + DM, mod_ptr(ws, layer, rd.b, 4), tid); lds_vec_fill(lv + 2 * DM, mod_ptr(ws, layer, rd.b, 3), tid); }
    __syncthreads();
    RowV xn; u32x2 on[8];
#define R1_FETCH(R) do { row_load_f32_nt(xn, r_xsrc(a, layer, (R)), lane); _Pragma("unroll") for (int j = 0; j < 8; ++j) on[j] = __builtin_nontemporal_load((const u32x2*)((const bf16_t*)(ws + O_O) + (size_t)(R) * DM + 4 * lane + 256 * j)); } while (0)
    int r = rd.row(0);
    if (r >= 0) R1_FETCH(r);
    int k = 0;
    for (; k < rd.nlat; ++k) {
        RowV x;
#pragma unroll
        for (int j = 0; j < 8; ++j) { const f32x4 o = (f32x4){bf2f(on[j].x & 0xffffu), bf2f(on[j].x >> 16), bf2f(on[j].y & 0xffffu), bf2f(on[j].y >> 16)}; x.v[j] = xn.v[j] * ALPHA + vld(lv, lane, j) * o; }
        const int rn = rd.row(k + 1);
        if (rn >= 0) R1_FETCH(rn);
        r1_row<true>(a, layer, r, x, wl, lv, lane, st);
        r = rn;
    }
    for (; r >= 0; ++k) {
        RowV x; { int b, idx; bool isctx; row_decode(r, b, isctx, idx); const float* g1 = mod_ptr(ws, layer, isctx ? 2 : b, 2);
#pragma unroll
          for (int j = 0; j < 8; ++j) { const f32x4 o = (f32x4){bf2f(on[j].x & 0xffffu), bf2f(on[j].x >> 16), bf2f(on[j].y & 0xffffu), bf2f(on[j].y >> 16)}; x.v[j] = xn.v[j] * ALPHA + vld(g1, lane, j) * o; } }
        const int rn = rd.row(k + 1);
        if (rn >= 0) R1_FETCH(rn);
        r1_row<false>(a, layer, r, x, wl, lv, lane, st);
        r = rn;
    }
#undef R1_FETCH
    __syncthreads();
}
__device__ __forceinline__ int moe_row(int e, int b, bool isctx, int slot) { return isctx ? (NEXP * 4096 + e * 256 + b * CAP_C + slot) : (e * 4096 + b * CAP_L + slot); }
template <bool FAST>
__device__ __forceinline__ void r2_row(const Ctx& a, int layer, int r, const RowV& xin, int selv, float affv, const LAS float* lv, int lane, bool st) {
    unsigned char* ws = a.ws; int b, idx; bool isctx; row_decode(r, b, isctx, idx); const int which = isctx ? 2 : b;
    const bf16_t* YE = (const bf16_t*)(ws + O_YE);
    float* xs = isctx ? (float*)(ws + O_XC) + ((size_t)(b * CTX + idx)) * DM : a.outp() + ((size_t)(b * SEQ + idx)) * DM;
    RowV x = xin, f;
    unsigned long long m = __ballot(selv >= 0);
    const int e0 = m ? __builtin_ctzll(m) : 0; unsigned long long m1 = m & (m - 1); const int e1 = m1 ? __builtin_ctzll(m1) : 0; unsigned long long m2 = m1 & (m1 - 1); const int e2 = m2 ? __builtin_ctzll(m2) : 0;
    u32x2 y0[8], y1[8], y2[8];
    if (m) { const bf16_t* p = YE + (size_t)moe_row(e0, b, isctx, __builtin_amdgcn_readlane(selv, e0)) * DM + 4 * lane;
#pragma unroll
        for (int j = 0; j < 8; ++j) y0[j] = __builtin_nontemporal_load((const u32x2*)(p + 256 * j)); }
    if (m1) { const bf16_t* p = YE + (size_t)moe_row(e1, b, isctx, __builtin_amdgcn_readlane(selv, e1)) * DM + 4 * lane;
#pragma unroll
        for (int j = 0; j < 8; ++j) y1[j] = __builtin_nontemporal_load((const u32x2*)(p + 256 * j)); }
    if (m2) { const bf16_t* p = YE + (size_t)moe_row(e2, b, isctx, __builtin_amdgcn_readlane(selv, e2)) * DM + 4 * lane;
#pragma unroll
        for (int j = 0; j < 8; ++j) y2[j] = __builtin_nontemporal_load((const u32x2*)(p + 256 * j)); }
#pragma unroll
    for (int j = 0; j < 8; ++j) f.v[j] = (f32x4){0.f, 0.f, 0.f, 0.f};
#define R2_ACC(Y, E) do { const float w_ = __uint_as_float(__builtin_amdgcn_readlane(__float_as_uint(affv), E)); _Pragma("unroll") for (int j = 0; j < 8; ++j) \
        f.v[j] += (f32x4){bf2f(Y[j].x & 0xffffu), bf2f(Y[j].x >> 16), bf2f(Y[j].y & 0xffffu), bf2f(Y[j].y >> 16)} * w_; } while (0)
    if (m) R2_ACC(y0, e0);
    if (m1) R2_ACC(y1, e1);
    if (m2) R2_ACC(y2, e2);
#undef R2_ACC
    unsigned long long mr = m2 & (m2 - 1);
    while (mr) { const int e = __builtin_ctzll(mr); mr &= mr - 1;
        const int s = __builtin_amdgcn_readlane(selv, e); const float w = __uint_as_float(__builtin_amdgcn_readlane(__float_as_uint(affv), e));
        RowV y; row_load_bf16(y, YE + (size_t)moe_row(e, b, isctx, s) * DM, lane);
#pragma unroll
        for (int j = 0; j < 8; ++j) f.v[j] += y.v[j] * w; }
    const float* g2 = mod_ptr(ws, layer, which, 5);
#pragma unroll
    for (int j = 0; j < 8; ++j) { const f32x4 g = FAST ? vld(lv, lane, j) : vld(g2, lane, j); x.v[j] = x.v[j] * ALPHA + g * f.v[j]; }
    row_normalize(x);
    if (FAST) {
#pragma unroll
        for (int j = 0; j < 8; ++j) x.v[j] = x.v[j] * vld(lv + DM, lane, j) + vld(lv + 2 * DM, lane, j);
    } else row_affine(x, a.inp(IN_LNFG) + layer * DM, a.inp(IN_LNFB) + layer * DM, lane);
    if (st) { if (layer + 1 < DEPTH) row_store_f32_nt(x, xs, lane); else row_store_f32(x, xs, lane); }
    if (layer + 1 < DEPTH) { row_normalize(x);
        if (FAST) {
#pragma unroll
            for (int j = 0; j < 8; ++j) x.v[j] = x.v[j] * (vld(lv + 4 * DM, lane, j) + 1.f) + vld(lv + 3 * DM, lane, j);
        } else row_modulate(x, mod_ptr(ws, layer + 1, which, 0), mod_ptr(ws, layer + 1, which, 1), lane);
        if (st) row_store_bf16(x, (bf16_t*)(ws + O_U) + (size_t)r * DM, lane); }
}
__device__ __forceinline__ void r2_phase(const Ctx& a, int layer, LAS unsigned char* lds, int tid, int lane, int wave, bool st) {
    unsigned char* ws = a.ws;
    const int* SEL = (const int*)(ws + O_SEL); const float* AFF = (const float*)(ws + O_AFF);
    LAS float* lv = (LAS float*)lds;
    RowDeal rd; rd.init(wave); rd.with_ctx = layer + 1 < DEPTH;
    lds_vec_fill(lv, mod_ptr(ws, layer, rd.b, 5), tid); lds_vec_fill(lv + DM, a.inp(IN_LNFG) + layer * DM, tid); lds_vec_fill(lv + 2 * DM, a.inp(IN_LNFB) + layer * DM, tid);
    if (layer + 1 < DEPTH) { lds_vec_fill(lv + 3 * DM, mod_ptr(ws, layer + 1, rd.b, 0), tid); lds_vec_fill(lv + 4 * DM, mod_ptr(ws, layer + 1, rd.b, 1), tid); }
    __syncthreads();
    RowV xn; int seln = -1; float affn = 0.f;
    int r = rd.row(0);
    if (r >= 0) { row_load_f32_nt(xn, r_xsrc(a, 1, r), lane); if (lane < 16) { seln = SEL[(size_t)r * 16 + lane]; affn = AFF[(size_t)r * 16 + lane]; } }
    for (int k = 0; r >= 0; ++k) {
        const RowV x = xn; const int selv = seln; const float affv = affn;
        const int rn = rd.row(k + 1);
        seln = -1; affn = 0.f;
        if (rn >= 0) { row_load_f32_nt(xn, r_xsrc(a, 1, rn), lane); if (lane < 16) { seln = SEL[(size_t)rn * 16 + lane]; affn = AFF[(size_t)rn * 16 + lane]; } }
        if (k < rd.nlat) r2_row<true>(a, layer, r, x, selv, affv, lv, lane, st);
        else r2_row<false>(a, layer, r, x, selv, affv, lv, lane, st);
        r = rn;
    }
    __syncthreads();
}
__device__ __forceinline__ int block_excl_scan(int v, LAS int* tmp, int lane, int wave, int& total) {
    int inc = v;
#pragma unroll
    for (int o = 1; o < 64; o <<= 1) { const int t = __builtin_amdgcn_ds_bpermute((lane >= o ? lane - o : lane) << 2, inc); if (lane >= o) inc += t; }
    if (lane == 63) tmp[wave] = inc;
    __syncthreads();
    int off = 0, tot = 0;
#pragma unroll
    for (int w = 0; w < 8; ++w) { const int t = tmp[w]; off += (w < wave) ? t : 0; tot += t; }
    __syncthreads();
    total = tot; return off + inc - v;
}
__device__ __forceinline__ void topk_phase(const Ctx& a, bool with_ctx, LAS unsigned char* lds, int tid, int lane, int wave) {
    unsigned char* ws = a.ws; const float* AFF = (const float*)(ws + O_AFF); int* SEL = (int*)(ws + O_SEL); int* IDX = (int*)(ws + O_IDX);
    LAS unsigned* val = (LAS unsigned*)lds;
    LAS unsigned* hist = (LAS unsigned*)(lds + 69632);
    LAS unsigned* bc = hist + 256;
    LAS int* tmp = (LAS int*)(hist + 272);
    for (int li = blockIdx.x; li < (with_ctx ? 64 : 32); li += gridDim.x) {
        const bool isctx = li >= 32; const int q = li & 31, b = q >> 4, e = q & 15;
        const int n = isctx ? CTX : SEQ, k = isctx ? CAP_C : CAP_L, row0 = b * RPB + (isctx ? 0 : CTX);
        for (int i = tid; i < n; i += NTHREADS) val[i + (i >> 5)] = __float_as_uint(AFF[(size_t)(row0 + i) * 16 + e]);
        __syncthreads();
        unsigned prefix = 0u, mask = 0u; int krem = k;
        for (int pass = 0; pass < 4; ++pass) { const int shift = 24 - 8 * pass;
            if (tid < 256) hist[tid] = 0u;
            __syncthreads();
            for (int i = tid; i < n; i += NTHREADS) { const unsigned v = val[i + (i >> 5)]; const bool in = (v & mask) == prefix; const unsigned bin = (v >> shift) & 255u;
                const unsigned long long act = __ballot(in);
                if (act) { const int first = (int)__builtin_ctzll(act); const unsigned lead = (unsigned)__builtin_amdgcn_readlane((int)bin, first);
                    const unsigned long long same = __ballot(in && bin == lead);
                    if (in && bin != lead) __hip_atomic_fetch_add(&hist[bin], 1u, __ATOMIC_RELAXED, __HIP_MEMORY_SCOPE_WORKGROUP);
                    if (lane == first) __hip_atomic_fetch_add(&hist[lead], (unsigned)__builtin_popcountll(same), __ATOMIC_RELAXED, __HIP_MEMORY_SCOPE_WORKGROUP); } }
            __syncthreads();
            if (wave == 0) { const int b0 = 255 - 4 * lane; const int c0 = (int)hist[b0], c1 = (int)hist[b0 - 1], c2 = (int)hist[b0 - 2], c3 = (int)hist[b0 - 3]; const int s = c0 + c1 + c2 + c3;
                int inc = s;
#pragma unroll
                for (int o = 1; o < 64; o <<= 1) { const int t = __builtin_amdgcn_ds_bpermute((lane >= o ? lane - o : lane) << 2, inc); if (lane >= o) inc += t; }
                const int exc = inc - s;
                if (exc < krem && krem <= inc) { int cum = exc, bin, before;
                    if (krem <= cum + c0) { bin = b0; before = cum; } else { cum += c0;
                    if (krem <= cum + c1) { bin = b0 - 1; before = cum; } else { cum += c1;
                    if (krem <= cum + c2) { bin = b0 - 2; before = cum; } else { cum += c2; bin = b0 - 3; before = cum; } } }
                    bc[0] = (unsigned)bin; bc[1] = (unsigned)(krem - before); } }
            __syncthreads();
            prefix |= bc[0] << shift; mask |= 0xffu << shift; krem = (int)bc[1];
        }
        const unsigned vstar = prefix; const int need = krem;
        const bool act = tid < (n >> 5); int cgt = 0, ceq = 0;
        if (act) for (int j = 0; j < 32; ++j) { const unsigned v = val[33 * tid + j]; cgt += v > vstar; ceq += v == vstar; }
        int tot; const int eqb = block_excl_scan(ceq, tmp, lane, wave, tot);
        int takeq = need - eqb; takeq = takeq < 0 ? 0 : (takeq > ceq ? ceq : takeq);
        const int slot0 = block_excl_scan(cgt + takeq, tmp, lane, wave, tot);
        if (act) { int eqr = eqb, slot = slot0;
            for (int j = 0; j < 32; ++j) { const int i = 32 * tid + j; const unsigned v = val[33 * tid + j]; const bool iseq = v == vstar; const bool take = v > vstar || (iseq && eqr < need); eqr += iseq;
                SEL[(size_t)(row0 + i) * 16 + e] = take ? slot : -1;
                if (take) { IDX[moe_row(e, b, isctx, slot)] = row0 + i; ++slot; } } }
        __syncthreads();
    }
}
__device__ __forceinline__ bool moe_row_valid(int m) { return m < NEXP * 4096 || ((m - NEXP * 4096) & 255) < 2 * CAP_C; }
__device__ __forceinline__ void gather_phase(const Ctx& a, int lane, int wave) {
    unsigned char* ws = a.ws; const int gw = blockIdx.x * NWAVES + wave, NGW = gridDim.x * NWAVES; const int* IDX = (const int*)(ws + O_IDX);
    for (int m0 = gw * 4; m0 < MOE_ROWS; m0 += NGW * 4) {
        const int mi = m0 + (lane & 3); const int tv = moe_row_valid(mi) ? IDX[mi] : -1;
        u32x4 t[4][4];
#pragma unroll
        for (int q = 0; q < 4; ++q) { const int tok = __builtin_amdgcn_readlane(tv, q);
            if (tok >= 0) { const u32x4* src = (const u32x4*)((const bf16_t*)(ws + O_H2) + (size_t)tok * DM);
#pragma unroll
                for (int j = 0; j < 4; ++j) t[q][j] = src[lane + 64 * j]; } }
#pragma unroll
        for (int q = 0; q < 4; ++q) { const int tok = __builtin_amdgcn_readlane(tv, q);
            if (tok >= 0) { u32x4* dst = (u32x4*)((bf16_t*)(ws + O_XE) + (size_t)(m0 + q) * DM);
#pragma unroll
                for (int j = 0; j < 4; ++j) dst[lane + 64 * j] = t[q][j]; } }
    }
}
__device__ __forceinline__ bool attn_fixed_form(const Ctx& a, int j, int lane) {
    const float* qg = a.inp(IN_QGAIN) + j * 128; const float* kg = a.inp(IN_KGAIN) + j * 128;
    const float gq = wave_max(fmaxf(fabsf(qg[lane]), fabsf(qg[lane + 64]))), gk = wave_max(fmaxf(fabsf(kg[lane]), fabsf(kg[lane + 64])));
    return 128.f * gq * gk * 1.03f * 0.088388347648318440f < 27.f;
}
__device__ __forceinline__ void qknorm_phase(const Ctx& a, int j, int lane, int wave, bool st) {
    unsigned char* ws = a.ws; const int gw = blockIdx.x * NWAVES + wave, NGW = gridDim.x * NWAVES;
    const f32x4* TRIG4 = (const f32x4*)(ws + O_TRIG);
    const int cidx = lane & 15, d0 = cidx * 8; const bool upper = (cidx & 4) != 0;
    const float* qg = a.inp(IN_QGAIN) + j * 128 + d0; const float* kg = a.inp(IN_KGAIN) + j * 128 + d0;
    const float qs = attn_fixed_form(a, j, lane) ? 0.088388347648318440f * 1.4426950408889634f : 1.f;
    const f32x4 gq0 = *(const f32x4*)qg * qs, gq1 = *(const f32x4*)(qg + 4) * qs, gk0 = *(const f32x4*)kg, gk1 = *(const f32x4*)(kg + 4);
    u32x4 nraw[5];
    if (gw < NR) { const bf16_t* zn = (const bf16_t*)(ws + O_Z) + (size_t)gw * 3072 + lane * 8;
#pragma unroll
        for (int it = 0; it < 5; ++it) nraw[it] = *(const u32x4*)(zn + it * 512); }
    for (int r = gw; r < NR; r += NGW) { int b, idx; bool isctx; row_decode(r, b, isctx, idx);
        float cs[8], sn[8];
#pragma unroll
        for (int i = 0; i < 8; ++i) { cs[i] = 1.f; sn[i] = 0.f; }
        if (!isctx) { const int pos = cidx < 8 ? (idx >> 6) : (idx & 63); const f32x4* tp = TRIG4 + pos * 16 + (cidx & 3) * 4;
#pragma unroll
            for (int q = 0; q < 4; ++q) { const f32x4 t = tp[q]; cs[2 * q] = t[0]; sn[2 * q] = t[1]; cs[2 * q + 1] = t[2]; sn[2 * q + 1] = t[3]; } }
        bf16_t* zr = (bf16_t*)(ws + O_Z) + (size_t)r * 3072 + lane * 8;
        u32x4 raw[5];
#pragma unroll
        for (int it = 0; it < 5; ++it) raw[it] = nraw[it];
        if (r + NGW < NR) { const bf16_t* zn = (const bf16_t*)(ws + O_Z) + (size_t)(r + NGW) * 3072 + lane * 8;
#pragma unroll
            for (int it = 0; it < 5; ++it) nraw[it] = *(const u32x4*)(zn + it * 512); }
#pragma unroll
        for (int it = 0; it < 5; ++it) {
            float x[8]; x[0] = bf2f(raw[it].x & 0xffffu); x[1] = bf2f(raw[it].x >> 16); x[2] = bf2f(raw[it].y & 0xffffu); x[3] = bf2f(raw[it].y >> 16);
            x[4] = bf2f(raw[it].z & 0xffffu); x[5] = bf2f(raw[it].z >> 16); x[6] = bf2f(raw[it].w & 0xffffu); x[7] = bf2f(raw[it].w >> 16);
            float ss = 0.f;
#pragma unroll
            for (int i = 0; i < 8; ++i) ss += x[i] * x[i];
            ss = row16_sum(ss);
            const float rinv = 1.f / sqrtf(ss * (1.f / 128.f) + QK_EPS);
            const f32x4 g0 = it < 4 ? gq0 : gk0, g1 = it < 4 ? gq1 : gk1;
            float y[8], o[8];
#pragma unroll
            for (int i = 0; i < 4; ++i) { y[i] = x[i] * rinv * g0[i]; y[4 + i] = x[4 + i] * rinv * g1[i]; }
#pragma unroll
            for (int i = 0; i < 8; ++i) { const float yp = __int_as_float(__builtin_amdgcn_ds_swizzle(__float_as_int(y[i]), 0x101F));     o[i] = upper ? (y[i] * cs[i] + yp * sn[i]) : (y[i] * cs[i] - yp * sn[i]); }
            u32x4 w; w.x = cvt_pk_bf16(o[0], o[1]); w.y = cvt_pk_bf16(o[2], o[3]); w.z = cvt_pk_bf16(o[4], o[5]); w.w = cvt_pk_bf16(o[6], o[7]);
            if (st) *(u32x4*)(zr + it * 512) = w; }
    }
}
__device__ __forceinline__ int s5_chunk_at(int b, int d, int q) { const int cb = b * 520; return d == 0 ? cb + q : (q < 8 ? cb + 7 - q : cb + 527 - q); }
__device__ __forceinline__ void s5_carry_phase(const Ctx& a, int j, LAS unsigned char* lds, int lane, int wave) {
    unsigned char* ws = a.ws; const float* SUM = (const float*)(ws + O_SUM); bf16_t* A3 = (bf16_t*)(ws + O_A3);
    LAS f32x2* ex = (LAS f32x2*)lds;
    for (int ui = blockIdx.x; ui < 256; ui += gridDim.x) {
        const int b = ui >> 7, g = (ui >> 1) & 63, d = ui & 1;
        const f32x2 l32 = ((const f32x2*)(ws + O_POW))[((size_t)((j * 2 + d) * 64 + g) * 64 + lane) * 33 + 32];
        const float* sb = SUM + (size_t)g * NCHP * 256 + d * 128 + lane;
        float hr = 0.f, hi = 0.f;
#pragma unroll 13
        for (int i = 0; i < 65; ++i) { const int ch = s5_chunk_at(b, d, wave * 65 + i); const float sr = sb[(size_t)ch * 256], si = sb[(size_t)ch * 256 + 64];
            const float nr = l32.x * hr - l32.y * hi + sr, ni = l32.x * hi + l32.y * hr + si; hr = nr; hi = ni; }
        ex[wave * 64 + lane] = (f32x2){hr, hi};
        __syncthreads();
        float pr = l32.x, pi = l32.y;
#pragma unroll
        for (int s = 0; s < 6; ++s) { const float nr = pr * pr - pi * pi, ni = 2.f * pr * pi; pr = nr; pi = ni; }
        { const float nr = pr * l32.x - pi * l32.y, ni = pr * l32.y + pi * l32.x; pr = nr; pi = ni; }
        float cr = 0.f, ci = 0.f;
        for (int w = 0; w < wave; ++w) { const f32x2 e = ex[w * 64 + lane]; const float nr = pr * cr - pi * ci + e.x, ni = pr * ci + pi * cr + e.y; cr = nr; ci = ni; }
        hr = cr; hi = ci;
        bf16_t* ab = A3 + (size_t)g * NCHP * A3K + 512 + d * 128 + lane;
#pragma unroll 13
        for (int i = 0; i < 65; ++i) { const int ch = s5_chunk_at(b, d, wave * 65 + i); const float sr = sb[(size_t)ch * 256], si = sb[(size_t)ch * 256 + 64];
            ab[(size_t)ch * A3K] = (bf16_t)f2bf(hr); ab[(size_t)ch * A3K + 64] = (bf16_t)f2bf(hi);
            const float nr = l32.x * hr - l32.y * hi + sr, ni = l32.x * hi + l32.y * hr + si; hr = nr; hi = ni; }
        __syncthreads();
    }
}
__device__ __forceinline__ void f1_transpose_phase(const Ctx& a, LAS unsigned char* lds, int lane, int wave) {
    unsigned char* ws = a.ws; const int gw = blockIdx.x * NWAVES + wave, NGW = gridDim.x * NWAVES;
    LAS bf16_t* scr = (LAS bf16_t*)(lds + wave * 16384);
    const bf16_t* ZF = (const bf16_t*)(ws + O_ZF);
    constexpr int N_LAT = 2 * 128 * 32, N_CTX = 2 * 2 * 32, P = 136;
    constexpr int N_SKEW = 3840, SK_WG = 64;
    const int nskw = ((int)gridDim.x - SK_WG) * NWAVES, gws = gw - SK_WG * NWAVES;
    const int n_mine_skew = (nskw > 0 && gws >= 0) ? (N_SKEW - gws + nskw - 1) / nskw : 0;
    const int skew0 = nskw > 0 ? N_SKEW : 0;
    const int n_mine_even = (N_LAT + N_CTX - skew0 - gw + NGW - 1) / NGW;
    for (int k = 0; k < n_mine_skew + (n_mine_even > 0 ? n_mine_even : 0); ++k) {
        const int it = k < n_mine_skew ? gws + k * nskw : skew0 + gw + (k - n_mine_skew) * NGW;
        size_t srow0, sstride; bf16_t* dst; size_t dpitch; int cb;
        if (it < N_LAT) { const int b = it >> 12, l2 = (it >> 5) & 127; cb = it & 31; srow0 = (size_t)b * RPB + CTX + l2; sstride = 128;
            dst = (bf16_t*)(ws + O_T1) + ((size_t)(b * 1024 + cb * 32) * 128 + l2) * 128; dpitch = 128 * 128; }
        else { const int q = it - N_LAT, b = q >> 6, tb = (q >> 5) & 1; cb = q & 31; srow0 = (size_t)b * RPB + tb * 128; sstride = 1;
            dst = (bf16_t*)(ws + O_T1C) + (size_t)(b * 1024 + cb * 32) * 256 + tb * 128; dpitch = 256; }
        const int c4 = lane & 3, rsub = lane >> 2;
        u32x4 v[8];
#pragma unroll
        for (int i = 0; i < 8; ++i) v[i] = __builtin_nontemporal_load((const u32x4*)(ZF + (srow0 + (size_t)(16 * i + rsub) * sstride) * 1024 + cb * 32 + c4 * 8));
#pragma unroll
        for (int i = 0; i < 8; ++i) { const int rr = 16 * i + rsub; LAS bf16_t* s = scr + (c4 * 8) * P + rr;
            s[0 * P] = (bf16_t)(v[i].x & 0xffffu); s[1 * P] = (bf16_t)(v[i].x >> 16); s[2 * P] = (bf16_t)(v[i].y & 0xffffu); s[3 * P] = (bf16_t)(v[i].y >> 16);
            s[4 * P] = (bf16_t)(v[i].z & 0xffffu); s[5 * P] = (bf16_t)(v[i].z >> 16); s[6 * P] = (bf16_t)(v[i].w & 0xffffu); s[7 * P] = (bf16_t)(v[i].w >> 16); }
        LDS_WAIT(); asm volatile("" ::: "memory");
        const int ch0 = lane >> 4, r0 = (lane & 15) * 8;
#pragma unroll
        for (int i = 0; i < 8; ++i) { const int ch = ch0 + 4 * i; const u32x4 o = *(const LAS u32x4*)(scr + ch * P + r0);
            *(u32x4*)(dst + (size_t)ch * dpitch + r0) = o; }
        LDS_WAIT(); asm volatile("" ::: "memory");
    }
    __syncthreads();
}
template <bool FIXM>
__device__ __forceinline__ void attn_units(const Ctx& a, int nunits, char* lds, int tid, float mfixC) {
    unsigned char* ws = a.ws; const bf16_t* Z = (const bf16_t*)(ws + O_Z); bf16_t* AO = (bf16_t*)(ws + O_AO);
    for (int L = blockIdx.x; L < nunits; L += gridDim.x) {
        int b, h, q0, seq;
        if (L < 2048) { b = L >> 10; const int kvh = (L >> 8) & 3, g = (L >> 6) & 3, qb = L & 63; h = kvh * 4 + g; q0 = b * RPB + CTX + qb * 256; seq = RPB; }
        else { const int q = L - 2048; b = q >> 4; h = q & 15; q0 = b * RPB; seq = CTX; }
        const int kvh = h >> 2; const size_t k0 = (size_t)b * RPB;
        if constexpr (FIXM) { if (L < 2048) { att::attn_ring3_body<RPB / 64>(Z + (size_t)q0 * 3072 + h * 128, Z + k0 * 3072 + 2048 + kvh * 128, Z + k0 * 3072 + 2560 + kvh * 128, AO + (size_t)q0 * 2048 + h * 128, lds, tid); continue; } }
        att::attn_dense_body<FIXM>(Z + (size_t)q0 * 3072 + h * 128, Z + k0 * 3072 + 2048 + kvh * 128, Z + k0 * 3072 + 2560 + kvh * 128, AO + (size_t)q0 * 2048 + h * 128, seq, lds, tid, mfixC);
    }
}
__device__ __forceinline__ void attn_phase(const Ctx& a, int j, bool need_ctx, char* lds, int tid) {
    unsigned char* ws = a.ws; const bf16_t* Z = (const bf16_t*)(ws + O_Z); bf16_t* AO = (bf16_t*)(ws + O_AO);
    const int nunits = 2048 + (need_ctx ? 32 : 0);
    const bool fixm = attn_fixed_form(a, j, tid & 63); const float mfixC = 0.f;
    if (fixm) attn_units<true>(a, nunits, lds, tid, mfixC); else attn_units<false>(a, nunits, lds, tid, 0.f);
}
constexpr int NPH = 3 + 12 * DEPTH;
#ifndef MK_N_LAUNCHES
#define MK_N_LAUNCHES 1
#endif
#ifndef REP_ATT
#define REP_ATT 1
#endif
#ifndef REP_MOE
#define REP_MOE 1
#endif
#ifndef REP_EVEN
#define REP_EVEN 1
#endif
#ifndef REP_ODDG
#define REP_ODDG 1
#endif
#ifndef REP_CONV
#define REP_CONV 1
#endif
#ifndef REP_GA
#define REP_GA 1
#endif
#ifndef REP_PRO
#define REP_PRO 1
#endif
#ifndef REP_ROW
#define REP_ROW 1
#endif
#ifndef REP_QK
#define REP_QK 1
#endif
#ifndef REP_P0
#define REP_P0 1
#endif
#ifndef REP_P1
#define REP_P1 1
#endif
#ifndef REP_P2
#define REP_P2 1
#endif
#ifndef REP_R1
#define REP_R1 1
#endif
#ifndef REP_R2
#define REP_R2 1
#endif
#ifndef REP_TK
#define REP_TK 1
#endif
#ifndef REP_GAT
#define REP_GAT 1
#endif
#ifndef REP_BAR
#define REP_BAR 1
#endif
#define REPEAT(N) _Pragma("unroll 1") for (int rep_ = 0; rep_ < (N); ++rep_)

__global__ void __launch_bounds__(NTHREADS, 2) mk_fwd(Args a0) {
    extern __shared__ __attribute__((aligned(16))) unsigned char lds_raw[];
    LAS unsigned char* lds = (LAS unsigned char*)lds_raw;
    volatile LAS unsigned* MISC = (volatile LAS unsigned*)(lds + MISC_OFF);
    if (threadIdx.x < 32) MISC[threadIdx.x] = 0u;
    if (threadIdx.x == 0) {
#pragma unroll
        for (int i = 0; i < 32; ++i) *(LAS unsigned long long*)(lds + PTR_OFF + 8 * i) = (unsigned long long)a0.in[i];
        *(LAS unsigned long long*)(lds + PTR_OFF + 8 * 32) = (unsigned long long)a0.out; }
    __syncthreads();
    const int wave0 = __builtin_amdgcn_readfirstlane(threadIdx.x >> 6);
    const int lo = a0.ph_lo, hi = a0.ph_hi; (void)lo; (void)hi;
    XcdBarrier bar = xcd_barrier_post((unsigned*)(a0.ws + O_CTL) + CW_BAR + a0.li * XCD_BAR_WORDS, MISC + 8);
#if MK_N_LAUNCHES == 1
#define IN(k) true
#else
#define IN(k) (lo <= (k) && (k) < hi)
#endif
#define PH int tid; asm volatile("v_mbcnt_lo_u32_b32 %0, -1, 0\n\tv_mbcnt_hi_u32_b32 %0, -1, %0" : "=v"(tid)); tid += wave0 * 64; asm volatile("" : "+v"(tid));     const int lane = tid & 63, wave = __builtin_amdgcn_readfirstlane(tid >> 6); (void)lane; (void)wave; size_t wz_ = 0; asm volatile("" : "+s"(wz_)); unsigned char* ws = a0.ws + wz_; const Ctx a{lds, ws};
#if MK_N_LAUNCHES == 1
#define SEAM(k) do { if ((k) + 1 < NPH) { REPEAT(REP_BAR) xcd_barrier(bar); } } while (0)
#else
#define SEAM(k) do { if ((k) + 1 < hi) { REPEAT(REP_BAR) xcd_barrier(bar); } } while (0)
#endif
    const int G = gridDim.x, cid = blockIdx.x;
    pg8::Sched S;

    if (IN(0)) { PH REPEAT(REP_P0) p0_prologue(a, lds, tid, lane, wave); SEAM(0); }
    if (IN(1)) { PH REPEAT(REP_P1) { p1_kf(a, lds, tid); r0_phase(a, lane, wave); } SEAM(1); }
    if (IN(2)) { PH REPEAT(REP_P2) p2_s5mats(a, tid); SEAM(2); }

    for (int layer = 0; layer < DEPTH; ++layer) {
        const int base = 3 + 12 * layer, j = layer >> 1;
        const bool need_ctx = layer < DEPTH - 1;
        if ((layer & 1) == 0) {
            if (IN(base + 0)) { PH
                moe_weight_phase(a, layer, 0, (NRT * 8) % G, lds, lane, wave);
                pg8::OpWin op{(const bf16_t*)(ws + O_U), (const bf16_t*)(ws + O_WIN) + (size_t)j * DM * DM, DM, DM, DM, (bf16_t*)(ws + O_A3), (bf16_t*)(ws + O_ZF)};
                S.init(NRT, 8, G, cid); REPEAT(REP_EVEN) pg8::gemm_phase(lds, op, S, tid);
                SEAM(base + 0);
            }
            if (IN(base + 1)) { PH
                { pg8::OpL1 op{(const bf16_t*)(ws + O_A3), (const bf16_t*)(ws + O_BT1) + (size_t)j * 64 * 256 * 512, A3K, 512, 512, (float*)(ws + O_SUM)};
                  S.init(320, 1, G, cid); REPEAT(REP_EVEN) pg8::gemm_phase(lds, op, S, tid); }
                REPEAT(REP_EVEN) f1_transpose_phase(a, lds, lane, wave);
                SEAM(base + 1);
            }
            if (IN(base + 2)) { PH
                REPEAT(REP_EVEN) s5_carry_phase(a, j, lds, lane, wave);
                { pg8::OpFftA op{(const bf16_t*)(ws + O_FA), (const bf16_t*)(ws + O_T1), 256, 128, 256, (bf16_t*)(ws + O_BT2)};
                  S.init(1, 1024, G, cid); REPEAT(REP_EVEN) pg8::gemm_phase(lds, op, S, tid); }
                { pg8::OpCtxDft op{(const bf16_t*)(ws + O_F256), (const bf16_t*)(ws + O_T1C), 256, 256, 256, (bf16_t*)(ws + O_PQ)};
                  S.init(2, 8, G, cid); REPEAT(REP_EVEN) pg8::gemm_phase(lds, op, S, tid); }
                SEAM(base + 2);
            }
            if (IN(base + 3)) { PH
                { pg8::OpL3 op{(const bf16_t*)(ws + O_A3), (const bf16_t*)(ws + O_BT3) + (size_t)j * 64 * 512 * 768, A3K, A3K, A3K, (bf16_t*)(ws + O_G)};
                  S.init(320, 2, G, cid); REPEAT(REP_EVEN) pg8::gemm_phase(lds, op, S, tid); }
                { pg8::OpFftC op{(const bf16_t*)(ws + O_FC), (const bf16_t*)(ws + O_BT2), 256, 256, 256, (bf16_t*)(ws + O_PQ)};
                  S.init(1, 1024, G, cid); REPEAT(REP_EVEN) pg8::gemm_phase(lds, op, S, tid); }
                SEAM(base + 3);
            }
            if (IN(base + 4)) { PH
                { pg8::OpGlu op{(const bf16_t*)(ws + O_G), (const bf16_t*)(ws + O_WGLU) + (size_t)j * 1024 * 1024, 1024, 1024, 1024, a.inp(IN_BGLU) + j * 1024, (bf16_t*)(ws + O_CAT)};
                  S.init(NRT, 4, G, cid); REPEAT(REP_EVEN) pg8::gemm_phase(lds, op, S, tid); }
                { pg8::OpFnet op{(const bf16_t*)(ws + O_PQ), (const bf16_t*)(ws + O_FNM) + (size_t)j * 4 * 256 * 512, DM, 512, 512, a.inp(IN_FNETB) + j * 1024, (bf16_t*)(ws + O_CAT)};
                  S.init(NRT, 4, G, (cid + G - (NRT * 4) % G) % G); REPEAT(REP_EVEN) pg8::gemm_phase(lds, op, S, tid); }
                SEAM(base + 4);
            }
            if (IN(base + 5)) { PH
                moe_weight_phase(a, layer, 1, (NRT * 8) % G, lds, lane, wave);
                pg8::OpStore<false> op{(const bf16_t*)(ws + O_CAT), (const bf16_t*)(ws + O_WOUT) + (size_t)j * DM * DM, DM, DM, DM, (bf16_t*)(ws + O_O), DM, nullptr};
                S.init(NRT, 8, G, cid); REPEAT(REP_EVEN) pg8::gemm_phase(lds, op, S, tid);
                SEAM(base + 5);
            }
        } else {
            if (IN(base + 0)) { PH
                moe_weight_phase(a, layer, 0, (NRT * 12) % G, lds, lane, wave);
                pg8::OpStore<false> op{(const bf16_t*)(ws + O_U), (const bf16_t*)(ws + O_WQKV) + (size_t)j * 3072 * DM, DM, DM, DM, (bf16_t*)(ws + O_Z), 3072, nullptr};
                S.init(NRT, 12, G, cid); REPEAT(REP_ODDG) pg8::gemm_phase(lds, op, S, tid);
                SEAM(base + 0);
            }
            if (IN(base + 1)) { PH REPEAT(REP_QK) qknorm_phase(a, j, lane, wave, rep_ == REP_QK - 1); SEAM(base + 1); }
            if (IN(base + 2)) { PH REPEAT(REP_ATT) attn_phase(a, j, need_ctx, (char*)lds_raw, tid); SEAM(base + 2); }
            if (IN(base + 3)) { PH
                moe_weight_phase(a, layer, 1, (NRT * 8) % G, lds, lane, wave);
                pg8::OpStore<false> op{(const bf16_t*)(ws + O_AO), (const bf16_t*)(ws + O_WO) + (size_t)j * DM * DM, DM, DM, DM, (bf16_t*)(ws + O_O), DM, nullptr};
                S.init(NRT, 8, G, cid); REPEAT(REP_ODDG) pg8::gemm_phase(lds, op, S, tid);
                SEAM(base + 3);
            }
        }
        if (IN(base + 6)) { PH REPEAT(REP_R1) r1_phase(a, layer, lds, tid, lane, wave, rep_ == REP_R1 - 1); SEAM(base + 6); }
        if (IN(base + 7)) { PH REPEAT(REP_TK) topk_phase(a, need_ctx, lds, tid, lane, wave); SEAM(base + 7); }
        if (IN(base + 9)) { PH
            pg8::OpM1 op{(const bf16_t*)(ws + O_H2), (const bf16_t*)(ws + O_WGU), DM, DM, DM, (bf16_t*)(ws + O_HID), (const int*)(ws + O_IDX)};
            S.init(256, 8, G, cid); S.head = need_ctx ? 128 : 0; S.headM0 = 256; REPEAT(REP_MOE) pg8::gemm_phase(lds, op, S, tid); S.head = 0;
            SEAM(base + 9);
        }
        if (IN(base + 10)) { PH
            pg8::OpStore<true> op{(const bf16_t*)(ws + O_HID), (const bf16_t*)(ws + O_WD), EFF, EFF, EFF, (bf16_t*)(ws + O_YE), DM, nullptr};
            S.init(256, 8, G, cid); S.head = need_ctx ? 128 : 0; S.headM0 = 256; REPEAT(REP_MOE) pg8::gemm_phase(lds, op, S, tid); S.head = 0;
            SEAM(base + 10);
        }
        if (IN(base + 11)) { PH REPEAT(REP_R2) r2_phase(a, layer, lds, tid, lane, wave, rep_ == REP_R2 - 1); SEAM(base + 11); }
    }
#undef IN
#undef SEAM
}

static bool phase_empty(int k) { if (k < 3) return false; const int l = (k - 3) / 12, s = (k - 3) % 12; return (l & 1) && (s == 4 || s == 5); }
extern "C" void kernel_launch(void* const* d_in, const int* in_sizes, int n_in, void* d_out, int out_size, void* d_ws, size_t ws_size, hipStream_t stream) {
    static int grid = 0;
    if (grid == 0) {
        if (n_in != 32 || out_size != NBATCH * SEQ * DM || ws_size < WS_NEED) { fprintf(stderr, "kernel_launch: bad shapes n_in %d out %d ws %zu (need %zu)\n", n_in, out_size, ws_size, (size_t)WS_NEED); grid = -1; return; }
        int dev = 0, cus = 0;
        if (hipGetDevice(&dev) != hipSuccess || hipDeviceGetAttribute(&cus, hipDeviceAttributeMultiprocessorCount, dev) != hipSuccess) { grid = -1; return; }
        if (hipFuncSetAttribute((const void*)mk_fwd, hipFuncAttributeMaxDynamicSharedMemorySize, LDS_BYTES) != hipSuccess) { fprintf(stderr, "kernel_launch: hipFuncSetAttribute failed\n"); grid = -1; return; }
        int per_cu = 0;
        if (hipOccupancyMaxActiveBlocksPerMultiprocessor(&per_cu, (const void*)mk_fwd, NTHREADS, LDS_BYTES) != hipSuccess || per_cu < 1) fprintf(stderr, "kernel_launch: occupancy query says %d\n", per_cu);
        (void)hipGetLastError();
        grid = cus;
    }
    if (grid < 0) return;
    (void)in_sizes;
    if (hipMemsetAsync((char*)d_ws + O_CTL, 0, CTL_BYTES, stream) != hipSuccess) return;
    Args a{};
    for (int i = 0; i < 32; ++i) a.in[i] = (const float*)d_in[i];
    a.out = (float*)d_out; a.ws = (unsigned char*)d_ws; a.pad = 0;
#if MK_N_LAUNCHES == 1
    a.ph_lo = 0; a.ph_hi = NPH; a.li = 0;
    hipLaunchKernelGGL(mk_fwd, dim3(grid), dim3(NTHREADS), LDS_BYTES, stream, a);
#else
    int li = 0;
    for (int k = 0; k < NPH; ++k) { if (phase_empty(k)) continue;
        a.ph_lo = k; a.ph_hi = k + 1; a.li = li++;
        hipLaunchKernelGGL(mk_fwd, dim3(grid), dim3(NTHREADS), LDS_BYTES, stream, a); }
#endif
    const hipError_t le = hipPeekAtLastError();
    if (le != hipSuccess) fprintf(stderr, "kernel_launch: launch failed: %s\n", hipGetErrorName(le));
}
```

```cpp
#include <hip/hip_runtime.h>
#include <cstdio>
#include <cstdint>

#define GAS __attribute__((address_space(1)))
#define LAS __attribute__((address_space(3)))
typedef unsigned short bf16_t;
typedef short bf16x8 __attribute__((ext_vector_type(8)));
typedef short s16x4 __attribute__((ext_vector_type(4)));
typedef float f32x4 __attribute__((ext_vector_type(4)));
typedef float f32x2 __attribute__((ext_vector_type(2)));
typedef float f32x16 __attribute__((ext_vector_type(16)));
typedef unsigned u32x4 __attribute__((ext_vector_type(4)));
typedef unsigned u32x2 __attribute__((ext_vector_type(2)));

constexpr int DM = 2048, NBATCH = 2, SEQ = 16384, CTX = 256, DEPTH = 4;
constexpr int RPB = SEQ + CTX;
constexpr int NR = NBATCH * RPB;
constexpr int NRT = NR / 256;
constexpr int NEXP = 16, EFF = 1024, CAP_L = 2048, CAP_C = 32;
constexpr int MOE_ROWS = NEXP * 4096 + NEXP * 256;
constexpr int MOE_RT = MOE_ROWS / 256;
constexpr int S5G = 64, S5P = 64, S5C = 16, S5T = 32;
constexpr int NCH = NR / S5T;
constexpr int NCHP = 1280;
constexpr int A3K = 768;
constexpr float LN_EPS = 1e-6f, QK_EPS = 1e-6f;
constexpr float ALPHA = 1.681792830507429f;
constexpr int NTHREADS = 512, NWAVES = 8;

constexpr size_t A256(size_t x) { return (x + 255) / 256 * 256; }
constexpr size_t O_CTL = 0, CTL_BYTES = 1u << 20;
constexpr size_t O_MOD = O_CTL + CTL_BYTES;
constexpr size_t O_TRIG = O_MOD + A256((size_t)4 * 3 * 6 * DM * 4);
constexpr size_t O_FA = O_TRIG + 256 * 32 * 8;
constexpr size_t O_FC = O_FA + 256 * 256 * 2;
constexpr size_t O_F256 = O_FC + (size_t)128 * 256 * 256 * 2;
constexpr size_t O_POW = O_F256 + 512 * 256 * 2;
constexpr size_t O_BBAR = O_POW + A256((size_t)2 * 2 * 64 * 64 * 33 * 8);
constexpr size_t O_KF = O_BBAR + (size_t)2 * 2 * 64 * 64 * 16 * 8;
constexpr size_t O_WIN = O_KF + (size_t)2 * 2 * 64 * 32 * 256 * 4;
constexpr size_t O_WOUT = O_WIN + (size_t)2 * DM * DM * 2;
constexpr size_t O_WGLU = O_WOUT + (size_t)2 * DM * DM * 2;
constexpr size_t O_FNM = O_WGLU + (size_t)2 * 1024 * 1024 * 2;
constexpr size_t O_BT1 = O_FNM + (size_t)2 * 4 * 256 * 512 * 2;
constexpr size_t O_BT3 = O_BT1 + (size_t)2 * 64 * 256 * 512 * 2;
constexpr size_t O_WQKV = O_BT3 + (size_t)2 * 64 * 512 * 768 * 2;
constexpr size_t O_WO = O_WQKV + (size_t)2 * 3072 * DM * 2;
constexpr size_t O_WGU = O_WO + (size_t)2 * DM * DM * 2;
constexpr size_t O_WD = O_WGU + (size_t)NEXP * 2048 * DM * 2;
constexpr size_t O_XC = O_WD + (size_t)NEXP * DM * EFF * 2;
constexpr size_t O_AFF = O_XC + (size_t)512 * DM * 4;
constexpr size_t O_SEL = O_AFF + (size_t)NR * 16 * 4;
constexpr size_t O_IDX = O_SEL + (size_t)NR * 16 * 4;
constexpr size_t O_U = O_IDX + A256((size_t)MOE_ROWS * 4);
constexpr size_t O_H2 = O_U + (size_t)NR * DM * 2;
constexpr size_t O_O = O_H2 + (size_t)NR * DM * 2;
constexpr size_t O_S = O_O + (size_t)NR * DM * 2;
constexpr size_t O_A3 = O_S;
constexpr size_t O_SUM = O_A3 + (size_t)S5G * NCHP * A3K * 2;
constexpr size_t O_ZF = O_SUM + (size_t)S5G * NCHP * 256 * 4;
constexpr size_t O_T1 = O_ZF + (size_t)NR * 1024 * 2;
constexpr size_t O_T1C = O_T1 + (size_t)2048 * 128 * 128 * 2 + 256;
constexpr size_t O_BT2 = O_T1C + (size_t)2048 * 256 * 2;
constexpr size_t O_PQ = O_BT2 + (size_t)128 * 2048 * 256 * 2;
constexpr size_t O_G = O_PQ + (size_t)NR * DM * 2;
constexpr size_t O_CAT = O_G + (size_t)NR * 1024 * 2;
constexpr size_t O_EVEN_END = O_CAT + (size_t)NR * DM * 2;
constexpr size_t O_Z = O_S;
constexpr size_t O_AO = O_Z + (size_t)NR * 3072 * 2;
constexpr size_t O_ODD_END = O_AO + (size_t)NR * DM * 2;
constexpr size_t O_XE = O_S;
constexpr size_t O_HID = O_XE + (size_t)MOE_ROWS * DM * 2;
constexpr size_t O_YE = O_HID + (size_t)MOE_ROWS * EFF * 2;
constexpr size_t O_MOE_END = O_YE + (size_t)MOE_ROWS * DM * 2;
constexpr size_t WS_NEED = O_EVEN_END > O_MOE_END ? (O_EVEN_END > O_ODD_END ? O_EVEN_END : O_ODD_END) : (O_MOE_END > O_ODD_END ? O_MOE_END : O_ODD_END);
static_assert(WS_NEED < (size_t)2300 * 1024 * 1024, "workspace budget");
constexpr int CW_BAR = 4096;
constexpr int CW_DIAG = 16384;

constexpr int RING_BYTES = 131072;
constexpr int MISC_OFF = RING_BYTES;
constexpr int EPI_OFF = RING_BYTES + 256;
constexpr int LDS_BYTES = 163840;

#define LDS_WAIT() asm volatile("s_waitcnt lgkmcnt(0)" ::: "memory")
#define VM_WAIT() asm volatile("s_waitcnt vmcnt(0)" ::: "memory")
__device__ __forceinline__ float bf2f(unsigned b) { return __uint_as_float(b << 16); }
__device__ __forceinline__ unsigned f2bf(float f) { unsigned u = __float_as_uint(f); return (u + 0x7fffu + ((u >> 16) & 1u)) >> 16; }
__device__ __forceinline__ unsigned cvt_pk_bf16(float lo, float hi) { unsigned r; asm volatile("v_cvt_pk_bf16_f32 %0, %1, %2" : "=v"(r) : "v"(lo), "v"(hi)); return r; }
template <int CTRL> __device__ __forceinline__ float dpp_mov(float v) { return __int_as_float(__builtin_amdgcn_update_dpp(0, __float_as_int(v), CTRL, 0xf, 0xf, true)); }
__device__ __forceinline__ float row16_sum(float v) {
    v += dpp_mov<0xB1>(v);
    v += dpp_mov<0x4E>(v);
    v += dpp_mov<0x141>(v);
    v += dpp_mov<0x140>(v);
    return v;
}
__device__ __forceinline__ float wave_sum(float v) {
    v = row16_sum(v);
    { auto rr = __builtin_amdgcn_permlane16_swap(__float_as_uint(v), __float_as_uint(v), false, false); v = __uint_as_float(rr[0]) + __uint_as_float(rr[1]); }
    { auto rr = __builtin_amdgcn_permlane32_swap(__float_as_uint(v), __float_as_uint(v), false, false); v = __uint_as_float(rr[0]) + __uint_as_float(rr[1]); }
    return v;
}
__device__ __forceinline__ float wave_max(float v) {
    v = fmaxf(v, dpp_mov<0xB1>(v)); v = fmaxf(v, dpp_mov<0x4E>(v)); v = fmaxf(v, dpp_mov<0x141>(v)); v = fmaxf(v, dpp_mov<0x140>(v));
    { auto rr = __builtin_amdgcn_permlane16_swap(__float_as_uint(v), __float_as_uint(v), false, false); v = fmaxf(__uint_as_float(rr[0]), __uint_as_float(rr[1])); }
    { auto rr = __builtin_amdgcn_permlane32_swap(__float_as_uint(v), __float_as_uint(v), false, false); v = fmaxf(__uint_as_float(rr[0]), __uint_as_float(rr[1])); }
    return v;
}
__device__ __forceinline__ float sigmoid_fast(float x) { return __builtin_amdgcn_rcpf(1.f + __builtin_amdgcn_exp2f(-1.4426950408889634f * x)); }
__device__ __forceinline__ float silu_f(float x) { return x / (1.f + __expf(-x)); }
__device__ __forceinline__ float gelu_tanh(float x) {
    const float u = 0.7978845608028654f * (x + 0.044715f * x * x * x);
    const float t = 1.f - 2.f * sigmoid_fast(-2.f * u);
    return 0.5f * x * (1.f + t);
}

#define XB_TMO      128
#define XB_XCNT(j)  (256  + 64 * (j))
#define XB_XSUB(j)  (1280 + 64 * (j))
#define XB_XGEN(j)  (2304 + 64 * (j))
#define XB_TOP      3328
#define XB_TOPGEN   3392
#define XCD_BAR_WORDS 3456
#define XB_SPIN_CAP (1u << 18)

__device__ __forceinline__ unsigned xb_ld(unsigned* p)              { return __hip_atomic_load(p, __ATOMIC_RELAXED, __HIP_MEMORY_SCOPE_AGENT); }
__device__ __forceinline__ unsigned xb_add(unsigned* p, unsigned v) { return __hip_atomic_fetch_add(p, v, __ATOMIC_RELAXED, __HIP_MEMORY_SCOPE_AGENT); }
__device__ __forceinline__ unsigned xb_xcc_id() { return (unsigned)__builtin_amdgcn_s_getreg((3 << 11) | 20) & 0xFu; }
#define XB_SPIN(cond, bar) do { unsigned _sp = 0; while (cond) { __builtin_amdgcn_s_sleep(1); \
    if ((++_sp & 255u) == 0u) { if (xb_ld(&(bar)[XB_TMO])) break; if (_sp > XB_SPIN_CAP) { atomicAdd(&(bar)[XB_TMO], 1u); break; } } } } while (0)

struct XcdBarrier { unsigned* bar; unsigned x; volatile LAS unsigned* st; };

__device__ __forceinline__ XcdBarrier xcd_barrier_post(unsigned* bar, volatile LAS unsigned* st) {
    XcdBarrier b; b.bar = bar; b.x = xb_xcc_id(); b.st = st;
    if (threadIdx.x == 0) (void)xb_add(&bar[XB_XCNT(b.x)], 1u);
    return b;
}
__device__ __forceinline__ void xcd_barrier_complete(unsigned* bar, unsigned x, unsigned& nloc, unsigned& nx) {
    const unsigned G = gridDim.x * gridDim.y * gridDim.z;
    unsigned sum, cnt, mine, sp = 0u;
    for (;;) {
        sum = 0u; cnt = 0u; mine = 0u;
#pragma unroll
        for (unsigned j = 0; j < 16; ++j) { const unsigned c = xb_ld(&bar[XB_XCNT(j)]); sum += c; cnt += (c > 0u) ? 1u : 0u; mine = (j == x) ? c : mine; }
        if (sum == G) break;
        __builtin_amdgcn_s_sleep(1);
        if ((++sp & 255u) == 0u) { if (xb_ld(&bar[XB_TMO])) break; if (sp > XB_SPIN_CAP) { atomicAdd(&bar[XB_TMO], 1u); break; } }
    }
    nloc = mine > 0u ? mine : 1u; nx = cnt > 0u ? cnt : 1u;
}
__device__ __forceinline__ void xcd_barrier(const XcdBarrier& b) {
    asm volatile("s_waitcnt vmcnt(0)" ::: "memory");
    __syncthreads();
    if (threadIdx.x == 0) {
        unsigned* bar = b.bar;
        __builtin_amdgcn_s_waitcnt(0);
        unsigned nloc = b.st[0], nx = b.st[1];
        if (nloc == 0u) { xcd_barrier_complete(bar, b.x, nloc, nx); b.st[0] = nloc; b.st[1] = nx; }
        const unsigned old = xb_add(&bar[XB_XSUB(b.x)], 1u);
        const unsigned gen = old / nloc;
        if (old + 1u == (gen + 1u) * nloc) {
            __builtin_amdgcn_fence(__ATOMIC_RELEASE, "agent");
            asm volatile("s_waitcnt vmcnt(0)" ::: "memory");
            const unsigned og = xb_add(&bar[XB_TOP], 1u);
            const unsigned tg = og / nx;
            if (og + 1u == (tg + 1u) * nx) xb_add(&bar[XB_TOPGEN], 1u);
            else XB_SPIN(xb_ld(&bar[XB_TOPGEN]) == tg, bar);
            __builtin_amdgcn_fence(__ATOMIC_ACQUIRE, "agent");
            xb_add(&bar[XB_XGEN(b.x)], 1u);
            asm volatile("s_waitcnt vmcnt(0)" ::: "memory");
        } else {
            XB_SPIN(xb_ld(&bar[XB_XGEN(b.x)]) == gen, bar);
            __builtin_amdgcn_fence(__ATOMIC_ACQUIRE, "agent");
            asm volatile("s_waitcnt vmcnt(0)" ::: "memory");
        }
    }
    __syncthreads();
}
namespace pg8 {
constexpr int BM = 256, BK = 64, HALF = 128, HTB = HALF * BK * 2, STAGE_BYTES = 8 * HTB, NXCD = 8, WGM = 8;
__host__ __device__ __forceinline__ int lds_byte(int r, int c) { const int st = (r >> 4) * 2 + (c >> 5), rr = r & 15, cc = c & 31, ob = rr * 64 + cc * 2; return st * 1024 + (ob ^ (((ob >> 9) & 1) << 5)); }
__host__ __device__ __forceinline__ void stage_rc(int b, int& R, int& C) { const int st = b / 1024, sb = b % 1024, swz = sb ^ (((sb >> 9) & 1) << 5); R = (st >> 1) * 16 + swz / 64; C = (st & 1) * 32 + (swz % 64) / 2; }
__host__ __device__ __forceinline__ int perm32(int rho) { const int n = rho >> 4, i = rho & 15; return 8 * (i >> 2) + 4 * n + (i & 3); }

struct Unit { int pm, pn; };
struct Sched {
    int nM, nN, nwg, G, c;
    __device__ __forceinline__ void init(int nM_, int nN_, int G_, int c_) { nM = nM_; nN = nN_; nwg = nM * nN; G = G_; c = c_; }
    int head = 0, headM0 = 0;
    __device__ __forceinline__ bool next(int i, Unit& u) const {
        long L = (long)i * G + c;
        if (L < head) { u.pm = headM0 + (int)L / nN; u.pn = (int)L % nN; return true; }
        L -= head; if (L >= nwg) return false;
        int wgid = (int)L; { const int q = nwg / NXCD, r = nwg % NXCD, xcd = wgid % NXCD, off = wgid / NXCD; wgid = (xcd < r ? xcd * (q + 1) : r * (q + 1) + (xcd - r) * q) + off; }
        const int nig = WGM * nN, gid = wgid / nig, fm = gid * WGM, gsz = (nM - fm) < WGM ? (nM - fm) : WGM;
        u.pm = fm + ((wgid % nig) % gsz); u.pn = (wgid % nig) / gsz; return true;
    }
};
typedef f32x4 Acc[2][2][4][2];
#define PG8_NO_GATHER __device__ __forceinline__ int arow(const Unit&, int) const { return 0; }
#define PG8_NO_LITE static constexpr bool LITE = false; __device__ __forceinline__ bool lite(const Unit&) const { return false; }

template <class Op>
__device__ __forceinline__ void gemm_phase(LAS unsigned char* lds, const Op& op, const Sched& S, int tid) {
    asm volatile("" : "+v"(tid));
    const int wid = __builtin_amdgcn_readfirstlane(tid >> 6), lane = tid & 63, wr = wid >> 2, wc = wid & 3, fr = lane & 15, fq = lane >> 4;
    const int K = op.K, nt = K / BK, lda = op.lda, ldb = op.ldb;
    unsigned voffA[2], voffB[2]; int RA[2];
#pragma unroll
    for (int i = 0; i < 2; ++i) { int R, C; stage_rc(tid * 16 + i * 8192, R, C); const int Rb = Op::PERM ? ((R & ~31) + perm32(R & 31)) : R; RA[i] = R;
        voffA[i] = Op::GATHER ? (unsigned)C * 2u : (unsigned)(R * lda + C) * 2u; voffB[i] = (unsigned)(Rb * ldb + C) * 2u; }
    unsigned ga[2][2], gn[2][2];
#define PG8_GROWS(G, U) do { _Pragma("unroll") for (int _h = 0; _h < 2; ++_h) _Pragma("unroll") for (int _i = 0; _i < 2; ++_i) G[_h][_i] = (unsigned)op.arow(U, _h * HALF + RA[_i]) * (unsigned)(lda * 2); } while (0)
    const size_t kstep = (size_t)(BK * 2);
    const size_t hstepA = (size_t)HALF * lda * 2, hstepB = (size_t)HALF * ldb * 2;
    const unsigned ldsw = (unsigned)wid * 1024u;
    const int aoff = lds_byte(wr * 64 + fr, fq * 8), boff = lds_byte(wc * 32 + fr, fq * 8);
#define PG8_SA(b, h) (((b) * 2 + (h)) * HTB)
#define PG8_SB(b, h) ((4 + (b) * 2 + (h)) * HTB)
#define PG8_STAGE(bufoff, gbase, voff) do { _Pragma("unroll") for (int _i = 0; _i < 2; ++_i) \
        __builtin_amdgcn_global_load_lds((const unsigned*)((const char*)(gbase) + (voff)[_i]), (LAS unsigned*)(lds + (bufoff) + ldsw + _i * 8192), 16, 0, 0); } while (0)
#define PG8_STAGE_A(bufoff, sel, h, kb) do { _Pragma("unroll") for (int _i = 0; _i < 2; ++_i) { const char* _p; \
        if constexpr (Op::GATHER) _p = (const char*)op.A + (kb) + (size_t)(((sel) ? gn[h][_i] : ga[h][_i]) + voffA[_i]); \
        else _p = ((sel) ? nA : cA) + (size_t)(h) * hstepA + (kb) + voffA[_i]; \
        __builtin_amdgcn_global_load_lds((const unsigned*)_p, (LAS unsigned*)(lds + (bufoff) + ldsw + _i * 8192), 16, 0, 0); } } while (0)
#define PG8_LDA(dst, b, h) do { _Pragma("unroll") for (int m = 0; m < 4; ++m) _Pragma("unroll") for (int k = 0; k < 2; ++k) dst[m][k] = *(const LAS bf16x8*)(lds + PG8_SA(b, h) + aoff + m * 2048 + k * 1024); } while (0)
#define PG8_LDB(dst, b, h) do { _Pragma("unroll") for (int n = 0; n < 2; ++n) _Pragma("unroll") for (int k = 0; k < 2; ++k) dst[n][k] = *(const LAS bf16x8*)(lds + PG8_SB(b, h) + boff + n * 2048 + k * 1024); } while (0)
#define PG8_MMA(ai, bj, At, Bt) do { if (Op::LITE && lite && ((ai) == 1 || wr == 1)) break; __builtin_amdgcn_s_setprio(1); _Pragma("unroll") for (int m = 0; m < 4; ++m) _Pragma("unroll") for (int n = 0; n < 2; ++n) _Pragma("unroll") for (int k = 0; k < 2; ++k) \
        acc[ai][bj][m][n] = __builtin_amdgcn_mfma_f32_16x16x32_bf16(Bt[n][k], At[m][k], acc[ai][bj][m][n], 0, 0, 0); __builtin_amdgcn_s_setprio(0); } while (0)
#define PG8_WAIT_V(n) asm volatile("s_waitcnt vmcnt(" #n ")" ::: "memory")
#define PG8_WAIT_L(n) asm volatile("s_waitcnt lgkmcnt(" #n ")" ::: "memory")
#define PG8_BAR __builtin_amdgcn_s_barrier()
#define PG8_SCHED __builtin_amdgcn_sched_barrier(0)
    Unit cur, nxt; int ui = 0;
    if (!S.next(0, cur)) return;
    bool lite = Op::LITE ? op.lite(cur) : false;
    Acc acc;
#pragma unroll
    for (int a = 0; a < 2; ++a)
#pragma unroll
        for (int b = 0; b < 2; ++b)
#pragma unroll
            for (int m = 0; m < 4; ++m)
#pragma unroll
                for (int n = 0; n < 2; ++n) acc[a][b][m][n] = (f32x4){0.f, 0.f, 0.f, 0.f};
    bf16x8 At[4][2], B0[2][2], B1[2][2];
    const char* cA = (const char*)op.A + op.aoff(cur); const char* cB = (const char*)op.Bt + op.boff(cur); const char* nA = cA;
    if constexpr (Op::GATHER) { PG8_GROWS(ga, cur); if (S.next(1, nxt)) PG8_GROWS(gn, nxt); else PG8_GROWS(gn, cur);
        asm volatile("" :: "v"(ga[0][0]), "v"(ga[0][1]), "v"(ga[1][0]), "v"(ga[1][1]), "v"(gn[0][0]), "v"(gn[0][1]), "v"(gn[1][0]), "v"(gn[1][1])); }
    PG8_STAGE(PG8_SB(0, 0), cB, voffB); PG8_STAGE(PG8_SB(0, 1), cB + hstepB, voffB); PG8_STAGE_A(PG8_SA(0, 0), false, 0, 0); PG8_STAGE_A(PG8_SA(0, 1), false, 1, 0);
    if (wr == 1) PG8_BAR;
    PG8_WAIT_V(2); PG8_BAR;
    PG8_STAGE(PG8_SB(1, 0), cB + kstep, voffB); PG8_STAGE_A(PG8_SA(1, 0), false, 0, kstep); PG8_STAGE(PG8_SB(1, 1), cB + hstepB + kstep, voffB);
    PG8_WAIT_V(6); PG8_BAR;
    for (;;) {
        const bool has_next = S.next(ui + 1, nxt);
        nA = has_next ? (const char*)op.A + op.aoff(nxt) : cA; const char* nB = has_next ? (const char*)op.Bt + op.boff(nxt) : cB;
        for (int t = 0; t < nt; t += 2) {
            const bool last = (t == nt - 2), seln = last && has_next;
            const size_t k1 = (size_t)(t + 1) * kstep, k2 = last ? 0 : (size_t)(t + 2) * kstep, k3 = k2 + kstep;
            const char* b2 = last ? nB : cB + (size_t)(t + 2) * kstep; const char* b3 = b2 + kstep;
            PG8_LDB(B0, 0, 0); PG8_LDB(B1, 0, 1); PG8_SCHED; PG8_LDA(At, 0, 0); PG8_STAGE_A(PG8_SA(1, 1), false, 1, k1);
            PG8_WAIT_V(8); PG8_WAIT_L(0); PG8_BAR; PG8_MMA(0, 0, At, B0); PG8_MMA(0, 1, At, B1); PG8_BAR; PG8_SCHED;
            PG8_LDA(At, 0, 1); PG8_STAGE(PG8_SB(0, 0), b2, voffB); PG8_STAGE(PG8_SB(0, 1), b2 + hstepB, voffB); PG8_STAGE_A(PG8_SA(0, 0), seln, 0, k2);
            PG8_WAIT_V(8); PG8_WAIT_L(0); PG8_BAR; PG8_MMA(1, 0, At, B0); PG8_MMA(1, 1, At, B1); PG8_BAR; PG8_SCHED;
            PG8_LDB(B0, 1, 0); PG8_LDB(B1, 1, 1); PG8_SCHED; PG8_LDA(At, 1, 0); PG8_STAGE_A(PG8_SA(0, 1), seln, 1, k2);
            PG8_WAIT_V(8); PG8_WAIT_L(0); PG8_BAR; PG8_MMA(0, 0, At, B0); PG8_MMA(0, 1, At, B1); PG8_BAR; PG8_SCHED;
            PG8_LDA(At, 1, 1); PG8_STAGE(PG8_SB(1, 0), b3, voffB); PG8_STAGE(PG8_SB(1, 1), b3 + hstepB, voffB); PG8_STAGE_A(PG8_SA(1, 0), seln, 0, k3);
            PG8_WAIT_V(8); PG8_WAIT_L(0); PG8_BAR; PG8_MMA(1, 0, At, B0); PG8_MMA(1, 1, At, B1); PG8_BAR; PG8_SCHED;
        }
        if (wr == 0) PG8_BAR;
        op(acc, cur, wr, wc, fr, fq);
        if (!has_next) break;
#pragma unroll
        for (int a = 0; a < 2; ++a)
#pragma unroll
            for (int b = 0; b < 2; ++b)
#pragma unroll
                for (int m = 0; m < 4; ++m)
#pragma unroll
                    for (int n = 0; n < 2; ++n) acc[a][b][m][n] = (f32x4){0.f, 0.f, 0.f, 0.f};
        cur = nxt; cA = nA; cB = nB; ++ui; lite = Op::LITE ? op.lite(cur) : false;
        if constexpr (Op::GATHER) {
#pragma unroll
            for (int _h = 0; _h < 2; ++_h)
#pragma unroll
                for (int _i = 0; _i < 2; ++_i) ga[_h][_i] = gn[_h][_i];
            Unit n2; if (S.next(ui + 1, n2)) PG8_GROWS(gn, n2);
            asm volatile("" :: "v"(gn[0][0]), "v"(gn[0][1]), "v"(gn[1][0]), "v"(gn[1][1]));
        }
        if (wr == 1) PG8_BAR;
    }
    PG8_WAIT_V(0);
    PG8_BAR;
#undef PG8_SA
#undef PG8_SB
#undef PG8_STAGE
#undef PG8_STAGE_A
#undef PG8_GROWS
#undef PG8_LDA
#undef PG8_LDB
#undef PG8_MMA
#undef PG8_WAIT_V
#undef PG8_WAIT_L
#undef PG8_BAR
#undef PG8_SCHED
}

__device__ __forceinline__ u32x4 pack8(const f32x4 a, const f32x4 b) { u32x4 w; w.x = cvt_pk_bf16(a[0], a[1]); w.y = cvt_pk_bf16(a[2], a[3]); w.z = cvt_pk_bf16(b[0], b[1]); w.w = cvt_pk_bf16(b[2], b[3]); return w; }
__device__ __forceinline__ int moe_expert(int pm) { return pm < 256 ? (pm >> 4) : (pm - 256); }

template <bool MOE> struct OpStore {
    static constexpr bool PERM = true, GATHER = false; PG8_NO_GATHER static constexpr bool LITE = MOE; __device__ __forceinline__ bool lite(const Unit& u) const { return MOE && u.pm >= 256; }
    const bf16_t* A; const bf16_t* Bt; int lda, ldb, K; bf16_t* out; int ldc; const float* bias;
    __device__ __forceinline__ size_t aoff(const Unit& u) const { return (size_t)u.pm * 256 * lda * 2; }
    __device__ __forceinline__ size_t boff(const Unit& u) const { return MOE ? ((size_t)moe_expert(u.pm) * 2048 + (size_t)u.pn * 256) * ldb * 2 : (size_t)u.pn * 256 * ldb * 2; }
    __device__ __forceinline__ void operator()(const Acc& acc, const Unit& u, int wr, int wc, int fr, int fq) const {
        const int row0 = u.pm * 256 + wr * 64 + fr, col0 = u.pn * 256 + wc * 32 + 8 * fq;
#pragma unroll
        for (int ai = 0; ai < 2; ++ai)
#pragma unroll
            for (int m = 0; m < 4; ++m) { bf16_t* rowp = out + (size_t)(row0 + ai * 128 + m * 16) * ldc + col0;
#pragma unroll
                for (int bj = 0; bj < 2; ++bj) { f32x4 v0 = acc[ai][bj][m][0], v1 = acc[ai][bj][m][1];
                    if (bias) { v0 += *(const f32x4*)(bias + col0 + bj * 128); v1 += *(const f32x4*)(bias + col0 + bj * 128 + 4); }
                    *(u32x4*)(rowp + bj * 128) = pack8(v0, v1); } }
    }
};
struct OpWin {
    static constexpr bool PERM = true, GATHER = false; PG8_NO_GATHER PG8_NO_LITE
    const bf16_t* A; const bf16_t* Bt; int lda, ldb, K; bf16_t* a3; bf16_t* zf;
    __device__ __forceinline__ size_t aoff(const Unit& u) const { return (size_t)u.pm * 256 * lda * 2; }
    __device__ __forceinline__ size_t boff(const Unit& u) const { return (size_t)u.pn * 256 * ldb * 2; }
    __device__ __forceinline__ void operator()(const Acc& acc, const Unit& u, int wr, int wc, int fr, int fq) const {
        const int row0 = u.pm * 256 + wr * 64 + fr, col0 = u.pn * 256 + wc * 32 + 8 * fq;
#pragma unroll
        for (int ai = 0; ai < 2; ++ai)
#pragma unroll
            for (int m = 0; m < 4; ++m) { const int row = row0 + ai * 128 + m * 16;
#pragma unroll
                for (int bj = 0; bj < 2; ++bj) { const int c = col0 + bj * 128; const u32x4 w = pack8(acc[ai][bj][m][0], acc[ai][bj][m][1]);
                    if (u.pn < 4) { const int g = c >> 4; *(u32x4*)(a3 + ((size_t)(g * NCHP + (row >> 5)) * A3K + (row & 31) * 16 + (c & 15))) = w; }
                    else *(u32x4*)(zf + (size_t)row * 1024 + (c - 1024)) = w; } }
    }
};
struct OpL1 {
    static constexpr bool PERM = false, GATHER = false; PG8_NO_GATHER PG8_NO_LITE
    const bf16_t* A; const bf16_t* Bt; int lda, ldb, K; float* sum;
    __device__ __forceinline__ size_t aoff(const Unit& u) const { const int g = u.pm / 5, rt = u.pm % 5; return (size_t)(g * NCHP + rt * 256) * A3K * 2; }
    __device__ __forceinline__ size_t boff(const Unit& u) const { return (size_t)(u.pm / 5) * 256 * 512 * 2; }
    __device__ __forceinline__ void operator()(const Acc& acc, const Unit& u, int wr, int wc, int fr, int fq) const {
        const int g = u.pm / 5, rt = u.pm % 5, row0 = rt * 256 + wr * 64 + fr, col0 = wc * 32 + 4 * fq;
#pragma unroll
        for (int ai = 0; ai < 2; ++ai)
#pragma unroll
            for (int m = 0; m < 4; ++m) { float* rowp = sum + ((size_t)(g * NCHP + row0 + ai * 128 + m * 16)) * 256 + col0;
#pragma unroll
                for (int bj = 0; bj < 2; ++bj)
#pragma unroll
                    for (int n = 0; n < 2; ++n) *(f32x4*)(rowp + bj * 128 + n * 16) = acc[ai][bj][m][n]; }
    }
};
struct OpL3 {
    static constexpr bool PERM = true, GATHER = false; PG8_NO_GATHER PG8_NO_LITE
    const bf16_t* A; const bf16_t* Bt; int lda, ldb, K; bf16_t* gout;
    __device__ __forceinline__ size_t aoff(const Unit& u) const { const int g = u.pm / 5, rt = u.pm % 5; return (size_t)(g * NCHP + rt * 256) * A3K * 2; }
    __device__ __forceinline__ size_t boff(const Unit& u) const { return ((size_t)(u.pm / 5) * 512 + (size_t)u.pn * 256) * A3K * 2; }
    __device__ __forceinline__ void operator()(const Acc& acc, const Unit& u, int wr, int wc, int fr, int fq) const {
        const int g = u.pm / 5, rt = u.pm % 5, row0 = rt * 256 + wr * 64 + fr, col0 = u.pn * 256 + wc * 32 + 8 * fq;
#pragma unroll
        for (int ai = 0; ai < 2; ++ai)
#pragma unroll
            for (int m = 0; m < 4; ++m) { const int chunk = row0 + ai * 128 + m * 16;
                if (chunk < NCH) {
#pragma unroll
                    for (int bj = 0; bj < 2; ++bj) { const int c = col0 + bj * 128, t = c >> 4, co = c & 15; f32x4 v0 = acc[ai][bj][m][0], v1 = acc[ai][bj][m][1];
#pragma unroll
                        for (int i = 0; i < 4; ++i) { v0[i] = gelu_tanh(v0[i]); v1[i] = gelu_tanh(v1[i]); }
                        *(u32x4*)(gout + ((size_t)(chunk * 32 + t)) * 1024 + g * 16 + co) = pack8(v0, v1); } } }
    }
};
struct OpGlu {
    static constexpr bool PERM = true, GATHER = false; PG8_NO_GATHER PG8_NO_LITE
    const bf16_t* A; const bf16_t* Bt; int lda, ldb, K; const float* bias; bf16_t* cat;
    __device__ __forceinline__ size_t aoff(const Unit& u) const { return (size_t)u.pm * 256 * lda * 2; }
    __device__ __forceinline__ size_t boff(const Unit& u) const { return (size_t)u.pn * 256 * ldb * 2; }
    __device__ __forceinline__ void operator()(const Acc& acc, const Unit& u, int wr, int wc, int fr, int fq) const {
        const int row0 = u.pm * 256 + wr * 64 + fr, col0 = u.pn * 256 + wc * 32 + 8 * fq;
#pragma unroll
        for (int ai = 0; ai < 2; ++ai)
#pragma unroll
            for (int m = 0; m < 4; ++m) { const int row = row0 + ai * 128 + m * 16;
#pragma unroll
                for (int bj = 0; bj < 2; ++bj) { const int c = col0 + bj * 128;
                    const f32x4 b0 = *(const f32x4*)(bias + c), b1 = *(const f32x4*)(bias + c + 4);
                    const u32x4 gw = *(const u32x4*)(A + (size_t)row * 1024 + c);
                    f32x4 g0, g1; g0[0] = bf2f(gw.x & 0xffffu); g0[1] = bf2f(gw.x >> 16); g0[2] = bf2f(gw.y & 0xffffu); g0[3] = bf2f(gw.y >> 16);
                    g1[0] = bf2f(gw.z & 0xffffu); g1[1] = bf2f(gw.z >> 16); g1[2] = bf2f(gw.w & 0xffffu); g1[3] = bf2f(gw.w >> 16);
                    f32x4 v0 = acc[ai][bj][m][0] + b0, v1 = acc[ai][bj][m][1] + b1;
#pragma unroll
                    for (int i = 0; i < 4; ++i) { v0[i] = g0[i] * sigmoid_fast(v0[i]); v1[i] = g1[i] * sigmoid_fast(v1[i]); }
                    *(u32x4*)(cat + (size_t)row * 2048 + c) = pack8(v0, v1); } }
    }
};
struct OpFftA {
    static constexpr bool PERM = true, GATHER = false; PG8_NO_GATHER PG8_NO_LITE
    const bf16_t* A; const bf16_t* Bt; int lda, ldb, K; bf16_t* bt2;
    __device__ __forceinline__ size_t aoff(const Unit&) const { return 0; }
    __device__ __forceinline__ size_t boff(const Unit& u) const { return (size_t)u.pn * 256 * 128 * 2; }
    __device__ __forceinline__ void operator()(const Acc& acc, const Unit& u, int wr, int wc, int fr, int fq) const {
        const int l2b = wc * 32 + 8 * fq;
#pragma unroll
        for (int ai = 0; ai < 2; ++ai)
#pragma unroll
            for (int m = 0; m < 4; ++m) { const int k1 = wr * 64 + m * 16 + fr;
#pragma unroll
                for (int bj = 0; bj < 2; ++bj) { const int col = 2 * u.pn + bj;
                    *(u32x4*)(bt2 + ((size_t)(k1 * 2048 + col)) * 256 + ai * 128 + l2b) = pack8(acc[ai][bj][m][0], acc[ai][bj][m][1]); } }
    }
};
struct OpFftC {
    static constexpr bool PERM = true, GATHER = false; PG8_NO_GATHER PG8_NO_LITE
    const bf16_t* A; const bf16_t* Bt; int lda, ldb, K; bf16_t* pq;
    __device__ __forceinline__ size_t aoff(const Unit& u) const { return (size_t)(u.pn >> 3) * 256 * 256 * 2; }
    __device__ __forceinline__ size_t boff(const Unit& u) const { return (size_t)u.pn * 256 * 256 * 2; }
    __device__ __forceinline__ void operator()(const Acc& acc, const Unit& u, int wr, int wc, int fr, int fq) const {
        const int k1 = u.pn >> 3;
#pragma unroll
        for (int ai = 0; ai < 2; ++ai)
#pragma unroll
            for (int m = 0; m < 4; ++m) { const int k2 = wr * 64 + m * 16 + fr, k = k1 + 128 * k2;
#pragma unroll
                for (int bj = 0; bj < 2; ++bj) { const int colb = (u.pn & 7) * 256 + bj * 128 + wc * 32 + 8 * fq, b = colb >> 10, ch = colb & 1023, g = ch >> 8, c = ch & 255;
                    *(u32x4*)(pq + ((size_t)(b * RPB + CTX + k)) * 2048 + g * 512 + ai * 256 + c) = pack8(acc[ai][bj][m][0], acc[ai][bj][m][1]); } }
    }
};
struct OpCtxDft {
    static constexpr bool PERM = true, GATHER = false; PG8_NO_GATHER PG8_NO_LITE
    const bf16_t* A; const bf16_t* Bt; int lda, ldb, K; bf16_t* pq;
    __device__ __forceinline__ size_t aoff(const Unit& u) const { return (size_t)u.pm * 256 * 256 * 2; }
    __device__ __forceinline__ size_t boff(const Unit& u) const { return (size_t)u.pn * 256 * 256 * 2; }
    __device__ __forceinline__ void operator()(const Acc& acc, const Unit& u, int wr, int wc, int fr, int fq) const {
#pragma unroll
        for (int ai = 0; ai < 2; ++ai)
#pragma unroll
            for (int m = 0; m < 4; ++m) { const int k = ai * 128 + wr * 64 + m * 16 + fr;
#pragma unroll
                for (int bj = 0; bj < 2; ++bj) { const int colb = u.pn * 256 + bj * 128 + wc * 32 + 8 * fq, b = colb >> 10, ch = colb & 1023, g = ch >> 8, c = ch & 255;
                    *(u32x4*)(pq + ((size_t)(b * RPB + k)) * 2048 + g * 512 + u.pm * 256 + c) = pack8(acc[ai][bj][m][0], acc[ai][bj][m][1]); } }
    }
};
struct OpFnet {
    static constexpr bool PERM = true, GATHER = false; PG8_NO_GATHER PG8_NO_LITE
    const bf16_t* A; const bf16_t* Bt; int lda, ldb, K; const float* bias; bf16_t* cat;
    __device__ __forceinline__ size_t aoff(const Unit& u) const { return (size_t)u.pm * 256 * lda * 2 + (size_t)u.pn * 512 * 2; }
    __device__ __forceinline__ size_t boff(const Unit& u) const { return (size_t)u.pn * 256 * 512 * 2; }
    __device__ __forceinline__ void operator()(const Acc& acc, const Unit& u, int wr, int wc, int fr, int fq) const {
        const int row0 = u.pm * 256 + wr * 64 + fr, col0 = u.pn * 256 + wc * 32 + 8 * fq;
#pragma unroll
        for (int ai = 0; ai < 2; ++ai)
#pragma unroll
            for (int m = 0; m < 4; ++m) { const int row = row0 + ai * 128 + m * 16;
#pragma unroll
                for (int bj = 0; bj < 2; ++bj) { const int c = col0 + bj * 128;
                    const f32x4 v0 = acc[ai][bj][m][0] + *(const f32x4*)(bias + c), v1 = acc[ai][bj][m][1] + *(const f32x4*)(bias + c + 4);
                    *(u32x4*)(cat + (size_t)row * 2048 + 1024 + c) = pack8(v0, v1); } }
    }
};
struct OpM1 {
    static constexpr bool PERM = true, GATHER = true, LITE = true; __device__ __forceinline__ bool lite(const Unit& u) const { return u.pm >= 256; }
    const bf16_t* A; const bf16_t* Bt; int lda, ldb, K; bf16_t* hid; const int* idx;
    __device__ __forceinline__ size_t aoff(const Unit&) const { return 0; }
    __device__ __forceinline__ int arow(const Unit& u, int r) const { const int m = u.pm * 256 + r; const bool ok = m < NEXP * 4096 || ((m - NEXP * 4096) & 255) < 2 * CAP_C; return ok ? idx[m] : 0; }
    __device__ __forceinline__ size_t boff(const Unit& u) const { return ((size_t)moe_expert(u.pm) * 2048 + (size_t)u.pn * 256) * ldb * 2; }
    __device__ __forceinline__ void operator()(const Acc& acc, const Unit& u, int wr, int wc, int fr, int fq) const {
        const int row0 = u.pm * 256 + wr * 64 + fr, f0 = u.pn * 128 + wc * 16 + 4 * fq;
#pragma unroll
        for (int ai = 0; ai < 2; ++ai)
#pragma unroll
            for (int m = 0; m < 4; ++m) { bf16_t* rowp = hid + (size_t)(row0 + ai * 128 + m * 16) * EFF + f0;
#pragma unroll
                for (int bj = 0; bj < 2; ++bj) { const f32x4 gt = acc[ai][bj][m][0], up = acc[ai][bj][m][1]; f32x4 h;
#pragma unroll
                    for (int i = 0; i < 4; ++i) h[i] = gt[i] * sigmoid_fast(gt[i]) * up[i];
                    u32x2 w; w.x = cvt_pk_bf16(h[0], h[1]); w.y = cvt_pk_bf16(h[2], h[3]);
                    *(u32x2*)(rowp + bj * 64) = w; } }
    }
};
}
namespace att {
constexpr int D = 128, NW = 8, QBLK = 32, KVBLK = 64;
constexpr float SCALE = 0.088388347648318440f;
constexpr float THR = 8.f;
constexpr int LDQ = 3072, LDK = 3072, LDO = 2048;
constexpr size_t SHM_V = KVBLK * D * 2, SHM_K = KVBLK * D * 2, SHM_ATTN = 2 * SHM_V + 2 * SHM_K + NW * 64 * 4;
#define KSWZ(row, colB) ((row) * 256 + ((colB) ^ (((row) & 7) << 4)))
#define SBAR() __builtin_amdgcn_sched_barrier(0)
__device__ __forceinline__ int crow(int r, int hi) { return (r & 3) + 8 * (r >> 2) + 4 * hi; }
__device__ __forceinline__ unsigned cvtpk(float lo, float hi) { unsigned r; asm volatile("v_cvt_pk_bf16_f32 %0, %1, %2" : "=v"(r) : "v"(lo), "v"(hi)); return r; }

__device__ __forceinline__ void partialSM(f32x16& p0, f32x16& p1, float& m_reg, float& mn, float& alpha) {
  constexpr float C = SCALE * 1.4426950408889634f;
  float pmax = p0[0]; for (int r = 1; r < 16; ++r) pmax = fmaxf(pmax, p0[r]); for (int r = 0; r < 16; ++r) pmax = fmaxf(pmax, p1[r]);
  { auto rr = __builtin_amdgcn_permlane32_swap(__float_as_uint(pmax), __float_as_uint(pmax), false, false);
    pmax = fmaxf(__uint_as_float(rr[0]), __uint_as_float(rr[1])); }
  if (__builtin_expect(__all(pmax - m_reg <= THR / SCALE), 1)) { mn = m_reg; alpha = 1.f; }
  else { mn = fmaxf(m_reg, pmax); alpha = __builtin_amdgcn_exp2f((m_reg - mn) * C); m_reg = mn; }
  float mnC = -mn * C;
  for (int r = 0; r < 16; ++r) p0[r] = fmaf(p0[r], C, mnC); for (int r = 0; r < 16; ++r) p1[r] = fmaf(p1[r], C, mnC);
  for (int r = 0; r < 16; ++r) p0[r] = __builtin_amdgcn_exp2f(p0[r]);
}
__device__ __forceinline__ void partialSM_fix(f32x16& p0, f32x16& p1) {
  for (int r = 0; r < 16; ++r) p0[r] = __builtin_amdgcn_exp2f(p0[r]);
}
__device__ __forceinline__ void finishSM(f32x16& p0, f32x16& p1, float alpha, float& l_reg, bf16x8& pa0, bf16x8& pa1, bf16x8& pa2, bf16x8& pa3) {
  for (int r = 0; r < 16; ++r) p1[r] = __builtin_amdgcn_exp2f(p1[r]);
  float ps = 0; for (int r = 0; r < 16; ++r) ps += p0[r]; for (int r = 0; r < 16; ++r) ps += p1[r];
  { auto rr = __builtin_amdgcn_permlane32_swap(__float_as_uint(ps), __float_as_uint(ps), false, false);
    ps = __uint_as_float(rr[0]) + __uint_as_float(rr[1]); }
  l_reg = l_reg * alpha + ps;
#define PK4(P, BASE, OUT) do { unsigned a0 = cvtpk(P[BASE + 0], P[BASE + 1]), a1 = cvtpk(P[BASE + 2], P[BASE + 3]);   \
    unsigned b0 = cvtpk(P[BASE + 4], P[BASE + 5]), b1 = cvtpk(P[BASE + 6], P[BASE + 7]);                              \
    auto r0 = __builtin_amdgcn_permlane32_swap(a0, b0, false, false); auto r1 = __builtin_amdgcn_permlane32_swap(a1, b1, false, false); \
    u32x4 w = {r0[0], r1[0], r0[1], r1[1]}; OUT = *reinterpret_cast<bf16x8*>(&w); } while (0)
  PK4(p0, 0, pa0); PK4(p0, 8, pa1); PK4(p1, 0, pa2); PK4(p1, 8, pa3);
#undef PK4
}
__device__ __forceinline__ void partialSM_fix2(f32x16& p0, float& l_reg) {
  for (int r = 0; r < 16; ++r) { p0[r] = __builtin_amdgcn_exp2f(p0[r]); l_reg += p0[r]; }
}
__device__ __forceinline__ void finishSM2(f32x16& p0, f32x16& p1, float& l_reg, bf16x8& pa0, bf16x8& pa1, bf16x8& pa2, bf16x8& pa3) {
#define PK4(P, BASE, OUT) do { unsigned a0 = cvtpk(P[BASE + 0], P[BASE + 1]), a1 = cvtpk(P[BASE + 2], P[BASE + 3]);   \
    unsigned b0 = cvtpk(P[BASE + 4], P[BASE + 5]), b1 = cvtpk(P[BASE + 6], P[BASE + 7]);                              \
    u32x4 w = {a0, a1, b0, b1}; OUT = *reinterpret_cast<bf16x8*>(&w); } while (0)
  PK4(p0, 0, pa0); PK4(p0, 8, pa1);
  for (int r = 0; r < 8; ++r) { p1[r] = __builtin_amdgcn_exp2f(p1[r]); l_reg += p1[r]; }
  PK4(p1, 0, pa2);
  for (int r = 8; r < 16; ++r) { p1[r] = __builtin_amdgcn_exp2f(p1[r]); l_reg += p1[r]; }
  PK4(p1, 8, pa3);
#undef PK4
}
__device__ __forceinline__ void qkt(f32x16& p0, f32x16& p1, const bf16_t* Ks, const bf16x8* qr, int r32, int hi) {
  p0 = f32x16{}; p1 = f32x16{};
  for (int d0 = 0; d0 < 8; ++d0) { int cb = (d0 * 16 + hi * 8) * 2;
    bf16x8 b0 = *reinterpret_cast<const bf16x8*>((const char*)Ks + KSWZ(r32, cb));
    bf16x8 b1 = *reinterpret_cast<const bf16x8*>((const char*)Ks + KSWZ(32 + r32, cb));
    p0 = __builtin_amdgcn_mfma_f32_32x32x16_bf16(b0, qr[d0], p0, 0, 0, 0);
    p1 = __builtin_amdgcn_mfma_f32_32x32x16_bf16(b1, qr[d0], p1, 0, 0, 0); }
}
__device__ __forceinline__ int v_st(int k, int c) { const int kk = (k & ~0xC) | ((k & 4) << 1) | ((k & 8) >> 1); return ((kk >> 3) * 4 + (c >> 5)) * 512 + ((kk & 7) * 32 + (c & 31)) * 2; }
__device__ __forceinline__ int v_rd_base(int lane) { return ((lane & 3) << 3) | (((lane >> 2) & 3) << 6) | (((lane >> 4) & 1) << 5) | (((lane >> 5) & 1) << 8); }
constexpr int v_rd_off(int d0, int ks, int half) { return d0 * 512 + ks * 4096 + half * 2048; }
template <int OFF> __device__ __forceinline__ s16x4 tr_read(int vb) {
  s16x4 r; asm volatile("ds_read_b64_tr_b16 %0, %1 offset:%2" : "=&v"(r) : "v"(vb), "i"(OFF) : "memory"); return r;
}
template <int D0> __device__ __forceinline__ void pv_one(f32x16& od, int vb, bf16x8 pa0, bf16x8 pa1, bf16x8 pa2, bf16x8 pa3) {
  const s16x4 l0 = tr_read<v_rd_off(D0, 0, 0)>(vb), h0 = tr_read<v_rd_off(D0, 0, 1)>(vb), l1 = tr_read<v_rd_off(D0, 1, 0)>(vb), h1 = tr_read<v_rd_off(D0, 1, 1)>(vb);
  const s16x4 l2 = tr_read<v_rd_off(D0, 2, 0)>(vb), h2 = tr_read<v_rd_off(D0, 2, 1)>(vb), l3 = tr_read<v_rd_off(D0, 3, 0)>(vb), h3 = tr_read<v_rd_off(D0, 3, 1)>(vb);
  asm volatile("s_waitcnt lgkmcnt(0)" ::: "memory"); SBAR();
#define PK(L, H) (bf16x8){L[0], L[1], L[2], L[3], H[0], H[1], H[2], H[3]}
  od = __builtin_amdgcn_mfma_f32_32x32x16_bf16(pa0, PK(l0, h0), od, 0, 0, 0);
  od = __builtin_amdgcn_mfma_f32_32x32x16_bf16(pa1, PK(l1, h1), od, 0, 0, 0);
  od = __builtin_amdgcn_mfma_f32_32x32x16_bf16(pa2, PK(l2, h2), od, 0, 0, 0);
  od = __builtin_amdgcn_mfma_f32_32x32x16_bf16(pa3, PK(l3, h3), od, 0, 0, 0);
#undef PK
}
__device__ __forceinline__ void pv_d0(f32x16* o, int vb, bf16x8 pa0, bf16x8 pa1, bf16x8 pa2, bf16x8 pa3) {
  pv_one<0>(o[0], vb, pa0, pa1, pa2, pa3); pv_one<1>(o[1], vb, pa0, pa1, pa2, pa3); pv_one<2>(o[2], vb, pa0, pa1, pa2, pa3); pv_one<3>(o[3], vb, pa0, pa1, pa2, pa3);
}
template <bool FIXM>
__device__ __forceinline__ void attn_dense_body(const bf16_t* __restrict__ Qb, const bf16_t* __restrict__ Kh, const bf16_t* __restrict__ Vh,
                                                bf16_t* __restrict__ Ob, int seq, char* lds, int tid, float mfixC) {
  asm volatile("" : "+v"(tid));
  const int wid = tid >> 6, lane = tid & 63, r32 = lane & 31, hi = lane >> 5;
  bf16_t* V_lds = (bf16_t*)lds; bf16_t* K_lds = (bf16_t*)(lds + 2 * SHM_V);
  float* ws = (float*)(lds + 2 * SHM_V + 2 * SHM_K) + wid * 64; float* li_l = ws; float* al_l = ws + 32;
  float m_reg = -1e30f, l_reg = 0; f32x16 o[4] = {}; bf16x8 qr[8];
  const bf16_t* Qw = Qb + (long)(wid * QBLK + r32) * LDQ + hi * 8;
#pragma unroll
  for (int d0 = 0; d0 < 8; ++d0) qr[d0] = *reinterpret_cast<const bf16x8*>(Qw + d0 * 16);
  const int sr = tid >> 4, sc = (tid & 15) * 8, vst0 = v_st(sr, sc), vst1 = v_st(32 + sr, sc);
  const int vb0 = (int)(uintptr_t)V_lds + v_rd_base(lane);
  struct { bf16x8 vs0, vs1, ks0, ks1; } sr_[2];
#define SLOAD(i, k0) do { sr_[i].vs0 = *reinterpret_cast<const bf16x8*>(&Vh[(long)((k0) + sr) * LDK + sc]); sr_[i].vs1 = *reinterpret_cast<const bf16x8*>(&Vh[(long)((k0) + 32 + sr) * LDK + sc]); \
    sr_[i].ks0 = *reinterpret_cast<const bf16x8*>(&Kh[(long)((k0) + sr) * LDK + sc]); sr_[i].ks1 = *reinterpret_cast<const bf16x8*>(&Kh[(long)((k0) + 32 + sr) * LDK + sc]); } while (0)
#define SWRITE(b, i) do { *(bf16x8*)((char*)V_lds + (b) * SHM_V + vst0) = sr_[i].vs0;          \
    *(bf16x8*)((char*)V_lds + (b) * SHM_V + vst1) = sr_[i].vs1; int kc = sc * 2;               \
    *(bf16x8*)((char*)K_lds + (b) * SHM_K + KSWZ(sr, kc)) = sr_[i].ks0;                       \
    *(bf16x8*)((char*)K_lds + (b) * SHM_K + KSWZ(32 + sr, kc)) = sr_[i].ks1; } while (0)
#define SWAIT() asm volatile("s_waitcnt vmcnt(4)" ::: "memory")
#define PSM(P0, P1, MN, AL) do { if constexpr (FIXM) { SBAR(); partialSM_fix(P0, P1); AL = 1.f; SBAR(); } else partialSM(P0, P1, m_reg, MN, AL); } while (0)
#define RESC(a) do { if constexpr (!FIXM) if (__any((a) < 1.f)) { if (hi == 0) al_l[r32] = (a); asm volatile("s_waitcnt lgkmcnt(0)" ::: "memory"); \
    for (int d = 0; d < 4; ++d) for (int r = 0; r < 16; ++r) o[d][r] *= al_l[crow(r, hi)]; } } while (0)
  f32x16 pA0, pA1, pB0, pB1; float mnA, mnB, alA, alB; bf16x8 pa0, pa1, pa2, pa3; const int NT = seq / KVBLK;
  constexpr int SE = 0, SO = 1;
  SLOAD(SE, 0); asm volatile("s_waitcnt vmcnt(0)" ::: "memory"); SWRITE(0, SE); __syncthreads();
  qkt(pA0, pA1, K_lds, qr, r32, hi); PSM(pA0, pA1, mnA, alA);
  SLOAD(SO, KVBLK); SLOAD(SE, 2 * KVBLK);
  SWAIT(); SWRITE(1, SO); __syncthreads();
  for (int j = 1; j + 1 < NT; j += 2) {
    SBAR(); qkt(pB0, pB1, (bf16_t*)((char*)K_lds + SHM_K), qr, r32, hi);
    finishSM(pA0, pA1, alA, l_reg, pa0, pa1, pa2, pa3); SBAR();
    SLOAD(SO, (j + 2) * KVBLK); SBAR();
    pv_d0(o, vb0, pa0, pa1, pa2, pa3); PSM(pB0, pB1, mnB, alB);
    __syncthreads(); SWAIT(); SWRITE(0, SE);
    RESC(alB); __syncthreads();
    SBAR(); qkt(pA0, pA1, K_lds, qr, r32, hi);
    finishSM(pB0, pB1, alB, l_reg, pa0, pa1, pa2, pa3); SBAR();
    SLOAD(SE, (j + 3 < NT ? j + 3 : NT - 1) * KVBLK); SBAR();
    pv_d0(o, vb0 + (int)SHM_V, pa0, pa1, pa2, pa3); PSM(pA0, pA1, mnA, alA);
    __syncthreads(); SWAIT(); SWRITE(1, SO);
    RESC(alA); __syncthreads();
  }
  SBAR(); qkt(pB0, pB1, (bf16_t*)((char*)K_lds + SHM_K), qr, r32, hi);
  finishSM(pA0, pA1, alA, l_reg, pa0, pa1, pa2, pa3); SBAR();
  pv_d0(o, vb0, pa0, pa1, pa2, pa3); PSM(pB0, pB1, mnB, alB);
  __syncthreads(); RESC(alB);
  finishSM(pB0, pB1, alB, l_reg, pa0, pa1, pa2, pa3); SBAR();
  pv_d0(o, vb0 + (int)SHM_V, pa0, pa1, pa2, pa3);
  if (hi == 0) li_l[r32] = l_reg; asm volatile("s_waitcnt lgkmcnt(0)" ::: "memory");
  float rli[16];
#pragma unroll
  for (int r = 0; r < 16; ++r) rli[r] = __builtin_amdgcn_rcpf(li_l[crow(r, hi)]);
  bf16_t* Ow = Ob + (long)(wid * QBLK) * LDO;
#pragma unroll
  for (int r = 0; r < 16; ++r) { int orow = crow(r, hi);
    for (int d0 = 0; d0 < 4; ++d0) Ow[(long)orow * LDO + d0 * 32 + r32] = (bf16_t)f2bf(o[d0][r] * rli[r]); }
  asm volatile("s_waitcnt vmcnt(0) lgkmcnt(0)" ::: "memory"); __syncthreads();
#undef SLOAD
#undef SWRITE
#undef SWAIT
#undef RESC
#undef PSM
}

template <int NT>
__device__ __forceinline__ void attn_ring3_body(const bf16_t* __restrict__ Qb, const bf16_t* __restrict__ Kh, const bf16_t* __restrict__ Vh, bf16_t* __restrict__ Ob, char* lds, int tid) {
  static_assert(NT >= 8, "ring body: at least 8 key tiles");
  asm volatile("" : "+v"(tid));
  const int wid = tid >> 6, lane = tid & 63, r32 = lane & 31, hi = lane >> 5;
  constexpr int VB = (int)SHM_V, KB = (int)SHM_K;
  bf16_t* K_lds = (bf16_t*)lds; bf16_t* V_lds = (bf16_t*)(lds + 3 * KB);
  float* ws = (float*)(lds + 3 * VB + 3 * KB) + wid * 64; float* li_l = ws;
  float l_reg = 0; f32x16 o[4] = {}; bf16x8 qr[8];
  const bf16_t* Qw = Qb + (long)(wid * QBLK + r32) * LDQ + hi * 8;
#pragma unroll
  for (int d0 = 0; d0 < 8; ++d0) qr[d0] = __builtin_nontemporal_load(reinterpret_cast<const bf16x8*>(Qw + d0 * 16));
  const int sr = tid >> 4, sc = (tid & 15) * 8, srp = (sr & ~0xC) | ((sr & 4) << 1) | ((sr & 8) >> 1), vst0 = v_st(srp, sc), vst1 = v_st(32 + srp, sc);
  const int vb0 = (int)(uintptr_t)V_lds + v_rd_base(lane);
  struct { bf16x8 vs0, vs1, ks0, ks1; } sr_[2];
#define SLOAD(i, t) do { const long k0_ = (long)((t) < NT ? (t) : NT - 1) * KVBLK; sr_[i].vs0 = *reinterpret_cast<const bf16x8*>(&Vh[(k0_ + sr) * LDK + sc]); sr_[i].vs1 = *reinterpret_cast<const bf16x8*>(&Vh[(k0_ + 32 + sr) * LDK + sc]); \
    sr_[i].ks0 = *reinterpret_cast<const bf16x8*>(&Kh[(k0_ + sr) * LDK + sc]); sr_[i].ks1 = *reinterpret_cast<const bf16x8*>(&Kh[(k0_ + 32 + sr) * LDK + sc]); } while (0)
#define SWRITE(b, i) do { *(bf16x8*)((char*)V_lds + (b) * VB + vst0) = sr_[i].vs0; *(bf16x8*)((char*)V_lds + (b) * VB + vst1) = sr_[i].vs1; const int kc = sc * 2; \
    *(bf16x8*)((char*)K_lds + (b) * KB + KSWZ(sr, kc)) = sr_[i].ks0; *(bf16x8*)((char*)K_lds + (b) * KB + KSWZ(32 + sr, kc)) = sr_[i].ks1; } while (0)
#define SWAIT() asm volatile("s_waitcnt vmcnt(4)" ::: "memory")
  f32x16 pA0, pA1, pB0, pB1; bf16x8 pa0, pa1, pa2, pa3;
  unsigned ca0, ca1, cb0, cb1; bf16x8 ka0, ka1, kb0, kb1; s16x4 va[4];
#define KRD(D0, B0, B1) do { B0 = *reinterpret_cast<const bf16x8*>(Kp + KSWZ(r32, ((D0) * 16 + hi * 8) * 2)); B1 = *reinterpret_cast<const bf16x8*>(Kp + KSWZ(32 + r32, ((D0) * 16 + hi * 8) * 2)); } while (0)
#define MQ(ACC, KF, D0) ACC = __builtin_amdgcn_mfma_f32_32x32x16_bf16(KF, qr[D0], ACC, 0, 0, 0)
#define EX(P, R) P[R] = __builtin_amdgcn_exp2f(P[R])
#define AD(P, R) l_reg += P[R]
#define CV(P, I, A, B) do { A = cvtpk(P[I], P[(I) + 1]); B = cvtpk(P[(I) + 2], P[(I) + 3]); } while (0)
#define PM(OUT) do { u32x4 w_ = {ca0, ca1, cb0, cb1}; OUT = *reinterpret_cast<bf16x8*>(&w_); } while (0)
#define RV(ARR, I, D0, KS) do { ARR[I] = tr_read<v_rd_off(D0, KS, 0)>(vbp); ARR[(I) + 1] = tr_read<v_rd_off(D0, KS, 1)>(vbp); } while (0)
#define PKV(L, H) (bf16x8){L[0], L[1], L[2], L[3], H[0], H[1], H[2], H[3]}
#define MP(D0, PA, ARR, I) o[D0] = __builtin_amdgcn_mfma_f32_32x32x16_bf16(PKV(ARR[I], ARR[(I) + 1]), PA, o[D0], 0, 0, 0)
#define WL(N) do { asm volatile("s_waitcnt lgkmcnt(" #N ")" ::: "memory"); SBAR(); } while (0)
#define TROW(t) ((long)((t) < NT ? (t) : NT - 1) * KVBLK)
#define SLV0(i, t) sr_[i].vs0 = *reinterpret_cast<const bf16x8*>(&Vh[(TROW(t) + sr) * LDK + sc])
#define SLV1(i, t) sr_[i].vs1 = *reinterpret_cast<const bf16x8*>(&Vh[(TROW(t) + 32 + sr) * LDK + sc])
#define SLK0(i, t) sr_[i].ks0 = *reinterpret_cast<const bf16x8*>(&Kh[(TROW(t) + sr) * LDK + sc])
#define SLK1(i, t) sr_[i].ks1 = *reinterpret_cast<const bf16x8*>(&Kh[(TROW(t) + 32 + sr) * LDK + sc])
#define SWV0(b, i) *(bf16x8*)((char*)V_lds + (b) * VB + vst0) = sr_[i].vs0
#define SWV1(b, i) *(bf16x8*)((char*)V_lds + (b) * VB + vst1) = sr_[i].vs1
#define SWK0(b, i) *(bf16x8*)((char*)K_lds + (b) * KB + KSWZ(sr, sc * 2)) = sr_[i].ks0
#define SWK1(b, i) *(bf16x8*)((char*)K_lds + (b) * KB + KSWZ(32 + sr, sc * 2)) = sr_[i].ks1
#define STEP(J, Q0, Q1, P0, P1, BQ, BP, BW, SL, SW) do { const char* Kp = (const char*)K_lds + (BQ) * KB; const int vbp = vb0 + (BP) * VB; SBAR(); \
    KRD(0, ka0, ka1); Q0 = f32x16{}; Q1 = f32x16{};        \
    MQ(Q0, ka0, 0); KRD(1, kb0, kb1); EX(P1, 0); CV(P0, 0, ca0, ca1); SBAR(); \
    MQ(Q1, ka1, 0); EX(P1, 1); AD(P1, 0); CV(P0, 4, cb0, cb1); PM(pa0); SBAR(); \
    MQ(Q0, kb0, 1); KRD(2, ka0, ka1); EX(P1, 2); AD(P1, 1); CV(P0, 8, ca0, ca1); SBAR(); \
    MQ(Q1, kb1, 1); EX(P1, 3); AD(P1, 2); CV(P0, 12, cb0, cb1); PM(pa1); SBAR(); \
    MQ(Q0, ka0, 2); KRD(3, kb0, kb1); EX(P1, 4); AD(P1, 3); SBAR(); \
    MQ(Q1, ka1, 2); EX(P1, 5); AD(P1, 4); SLV0(SL, (J) + 2); SBAR(); \
    MQ(Q0, kb0, 3); KRD(4, ka0, ka1); EX(P1, 6); AD(P1, 5); SBAR(); \
    MQ(Q1, kb1, 3); EX(P1, 7); AD(P1, 6); SLV1(SL, (J) + 2); SBAR(); \
    MQ(Q0, ka0, 4); KRD(5, kb0, kb1); EX(P1, 8); AD(P1, 7); CV(P1, 0, ca0, ca1); SBAR(); \
    MQ(Q1, ka1, 4); EX(P1, 9); AD(P1, 8); CV(P1, 4, cb0, cb1); PM(pa2); SBAR(); \
    MQ(Q0, kb0, 5); KRD(6, ka0, ka1); EX(P1, 10); AD(P1, 9); SBAR(); \
    MQ(Q1, kb1, 5); EX(P1, 11); AD(P1, 10); SLK0(SL, (J) + 2); SBAR(); \
    MQ(Q0, ka0, 6); KRD(7, kb0, kb1); EX(P1, 12); AD(P1, 11); SBAR(); \
    MQ(Q1, ka1, 6); EX(P1, 13); AD(P1, 12); CV(P1, 8, ca0, ca1); SLK1(SL, (J) + 2); SBAR(); \
    MQ(Q0, kb0, 7); EX(P1, 14); AD(P1, 13); SBAR(); RV(va, 0, 0, 0); RV(va, 2, 1, 0); SBAR(); \
    MQ(Q1, kb1, 7); EX(P1, 15); AD(P1, 14); SBAR(); \
    WL(2); MP(0, pa0, va, 0); RV(va, 0, 0, 1); AD(P1, 15); CV(P1, 12, cb0, cb1); PM(pa3); EX(Q0, 0); SBAR(); \
    WL(2); MP(1, pa0, va, 2); RV(va, 2, 1, 1); EX(Q0, 1); AD(Q0, 0); SBAR(); \
    WL(2); MP(0, pa1, va, 0); RV(va, 0, 0, 2); EX(Q0, 2); AD(Q0, 1); SBAR(); \
    WL(2); MP(1, pa1, va, 2); RV(va, 2, 1, 2); EX(Q0, 3); AD(Q0, 2); SBAR(); \
    WL(2); MP(0, pa2, va, 0); RV(va, 0, 0, 3); EX(Q0, 4); AD(Q0, 3); SBAR(); \
    WL(2); MP(1, pa2, va, 2); RV(va, 2, 1, 3); EX(Q0, 5); AD(Q0, 4); SBAR(); \
    WL(2); MP(0, pa3, va, 0); RV(va, 0, 2, 0); EX(Q0, 6); AD(Q0, 5); SBAR(); \
    WL(2); MP(1, pa3, va, 2); RV(va, 2, 3, 0); EX(Q0, 7); AD(Q0, 6); SBAR(); \
    WL(2); MP(2, pa0, va, 0); RV(va, 0, 2, 1); EX(Q0, 8); AD(Q0, 7); SBAR(); \
    WL(2); MP(3, pa0, va, 2); RV(va, 2, 3, 1); EX(Q0, 9); AD(Q0, 8); SBAR(); \
    WL(2); MP(2, pa1, va, 0); RV(va, 0, 2, 2); EX(Q0, 10); AD(Q0, 9); SBAR(); \
    WL(2); MP(3, pa1, va, 2); RV(va, 2, 3, 2); EX(Q0, 11); AD(Q0, 10); SBAR(); \
    WL(2); MP(2, pa2, va, 0); RV(va, 0, 2, 3); SWAIT(); SWV0(BW, SW); EX(Q0, 12); AD(Q0, 11); SBAR(); \
    WL(3); MP(3, pa2, va, 2); RV(va, 2, 3, 3); SWV1(BW, SW); EX(Q0, 13); AD(Q0, 12); SBAR(); \
    WL(4); MP(2, pa3, va, 0); SWK0(BW, SW); EX(Q0, 14); AD(Q0, 13); SBAR(); \
    WL(2); MP(3, pa3, va, 2); SWK1(BW, SW); EX(Q0, 15); AD(Q0, 14); AD(Q0, 15); SBAR(); \
    __syncthreads(); } while (0)
  SLOAD(0, 0); asm volatile("s_waitcnt vmcnt(0)" ::: "memory"); SWRITE(0, 0); SLOAD(1, 1); SLOAD(0, 2); __syncthreads();
  qkt(pA0, pA1, K_lds, qr, r32, hi); partialSM_fix2(pA0, l_reg); SWAIT(); SWRITE(1, 1); __syncthreads();
  int jb = 1;
  for (; jb + 5 < NT; jb += 6) {
    STEP(jb,     pB0, pB1, pA0, pA1, 1, 0, 2, 1, 0);
    STEP(jb + 1, pA0, pA1, pB0, pB1, 2, 1, 0, 0, 1);
    STEP(jb + 2, pB0, pB1, pA0, pA1, 0, 2, 1, 1, 0);
    STEP(jb + 3, pA0, pA1, pB0, pB1, 1, 0, 2, 0, 1);
    STEP(jb + 4, pB0, pB1, pA0, pA1, 2, 1, 0, 1, 0);
    STEP(jb + 5, pA0, pA1, pB0, pB1, 0, 2, 1, 0, 1);
  }
  constexpr int REM = (NT - 1) % 6;
  if constexpr (REM > 0) STEP(jb,     pB0, pB1, pA0, pA1, 1, 0, 2, 1, 0);
  if constexpr (REM > 1) STEP(jb + 1, pA0, pA1, pB0, pB1, 2, 1, 0, 0, 1);
  if constexpr (REM > 2) STEP(jb + 2, pB0, pB1, pA0, pA1, 0, 2, 1, 1, 0);
  if constexpr (REM > 3) STEP(jb + 3, pA0, pA1, pB0, pB1, 1, 0, 2, 0, 1);
  if constexpr (REM > 4) STEP(jb + 4, pB0, pB1, pA0, pA1, 2, 1, 0, 1, 0);
  if constexpr ((NT - 1) & 1) finishSM2(pB0, pB1, l_reg, pa0, pa1, pa2, pa3); else finishSM2(pA0, pA1, l_reg, pa0, pa1, pa2, pa3);
  { auto rr = __builtin_amdgcn_permlane32_swap(__float_as_uint(l_reg), __float_as_uint(l_reg), false, false); l_reg = __uint_as_float(rr[0]) + __uint_as_float(rr[1]); }
  { const int vbp = vb0 + ((NT - 1) % 3) * VB; SBAR(); RV(va, 0, 0, 0); RV(va, 2, 1, 0); SBAR();
    WL(2); MP(0, pa0, va, 0); RV(va, 0, 0, 1); SBAR();
    WL(2); MP(1, pa0, va, 2); RV(va, 2, 1, 1); SBAR();
    WL(2); MP(0, pa1, va, 0); RV(va, 0, 0, 2); SBAR();
    WL(2); MP(1, pa1, va, 2); RV(va, 2, 1, 2); SBAR();
    WL(2); MP(0, pa2, va, 0); RV(va, 0, 0, 3); SBAR();
    WL(2); MP(1, pa2, va, 2); RV(va, 2, 1, 3); SBAR();
    WL(2); MP(0, pa3, va, 0); RV(va, 0, 2, 0); SBAR();
    WL(2); MP(1, pa3, va, 2); RV(va, 2, 3, 0); SBAR();
    WL(2); MP(2, pa0, va, 0); RV(va, 0, 2, 1); SBAR();
    WL(2); MP(3, pa0, va, 2); RV(va, 2, 3, 1); SBAR();
    WL(2); MP(2, pa1, va, 0); RV(va, 0, 2, 2); SBAR();
    WL(2); MP(3, pa1, va, 2); RV(va, 2, 3, 2); SBAR();
    WL(2); MP(2, pa2, va, 0); RV(va, 0, 2, 3); SBAR();
    WL(2); MP(3, pa2, va, 2); RV(va, 2, 3, 3); SBAR();
    WL(2); MP(2, pa3, va, 0); SBAR();
    WL(0); MP(3, pa3, va, 2); SBAR();
  }
  { const float rl = __builtin_amdgcn_rcpf(l_reg); bf16_t* Orow = Ob + (long)(wid * QBLK + r32) * LDO + hi * 8;
#pragma unroll
    for (int D0 = 0; D0 < 4; ++D0) {
#pragma unroll
      for (int gp = 0; gp < 2; ++gp) { const int k = D0 * 4 + 2 * gp;
        unsigned ax = cvtpk(o[D0][8 * gp + 0] * rl, o[D0][8 * gp + 1] * rl), ay = cvtpk(o[D0][8 * gp + 2] * rl, o[D0][8 * gp + 3] * rl);
        unsigned bx = cvtpk(o[D0][8 * gp + 4] * rl, o[D0][8 * gp + 5] * rl), by = cvtpk(o[D0][8 * gp + 6] * rl, o[D0][8 * gp + 7] * rl);
        auto sx = __builtin_amdgcn_permlane32_swap(ax, bx, false, false); auto sy = __builtin_amdgcn_permlane32_swap(ay, by, false, false);
        *(u32x4*)(Orow + 8 * k) = (u32x4){sx[0], sy[0], sx[1], sy[1]}; } } }
  asm volatile("s_waitcnt vmcnt(0) lgkmcnt(0)" ::: "memory"); __syncthreads();
#undef STEP
#undef TROW
#undef SLV0
#undef SLV1
#undef SLK0
#undef SLK1
#undef SWV0
#undef SWV1
#undef SWK0
#undef SWK1
#undef KRD
#undef MQ
#undef EX
#undef AD
#undef CV
#undef PM
#undef RV
#undef PKV
#undef MP
#undef WL
#undef SLOAD
#undef SWRITE
#undef SWAIT
}
}
struct Args { const float* in[32]; float* out; unsigned char* ws; int ph_lo, ph_hi, li, pad; };
constexpr int PTR_OFF = RING_BYTES + 512;
struct Ctx { LAS unsigned char* ldsb; unsigned char* ws;
    __device__ __forceinline__ const float* inp(int i) const { const u32x2 v = *(const LAS u32x2*)(ldsb + PTR_OFF + 8 * i);
        const unsigned long long p = ((unsigned long long)(unsigned)__builtin_amdgcn_readfirstlane((int)v.y) << 32) | (unsigned)__builtin_amdgcn_readfirstlane((int)v.x);
        return (const float*)(const GAS float*)p; }
    __device__ __forceinline__ float* outp() const { return (float*)inp(32); } };
enum { IN_X = 0, IN_C, IN_CTX, IN_CCTX, IN_MODW, IN_MODB, IN_LNMG, IN_LNMB, IN_LNFG, IN_LNFB, IN_WIN, IN_WOUT, IN_LAMRE, IN_LAMIM, IN_LOGSTEP, IN_BRE, IN_BIM, IN_CRE, IN_CIM,
       IN_S5D, IN_WGLU, IN_BGLU, IN_FNETW, IN_FNETB, IN_WQKV, IN_QGAIN, IN_KGAIN, IN_WO, IN_ROUTER, IN_WGATE, IN_WUP, IN_WDOWN };

struct RowV { f32x4 v[8]; };
__device__ __forceinline__ void row_load_f32(RowV& r, const float* p, int lane) {
#pragma unroll
    for (int j = 0; j < 8; ++j) r.v[j] = *(const f32x4*)(p + 4 * lane + 256 * j);
}
__device__ __forceinline__ void row_load_f32_nt(RowV& r, const float* p, int lane) {
#pragma unroll
    for (int j = 0; j < 8; ++j) r.v[j] = __builtin_nontemporal_load((const f32x4*)(p + 4 * lane + 256 * j));
}
__device__ __forceinline__ void row_store_f32(const RowV& r, float* p, int lane) {
#pragma unroll
    for (int j = 0; j < 8; ++j) *(f32x4*)(p + 4 * lane + 256 * j) = r.v[j];
}
__device__ __forceinline__ void row_store_f32_nt(const RowV& r, float* p, int lane) {
#pragma unroll
    for (int j = 0; j < 8; ++j) __builtin_nontemporal_store(r.v[j], (f32x4*)(p + 4 * lane + 256 * j));
}
__device__ __forceinline__ void row_load_bf16(RowV& r, const bf16_t* p, int lane) {
#pragma unroll
    for (int j = 0; j < 8; ++j) { const u32x2 w = *(const u32x2*)(p + 4 * lane + 256 * j);
        r.v[j] = (f32x4){bf2f(w.x & 0xffffu), bf2f(w.x >> 16), bf2f(w.y & 0xffffu), bf2f(w.y >> 16)}; }
}
__device__ __forceinline__ void row_store_bf16(const RowV& r, bf16_t* p, int lane) {
#pragma unroll
    for (int j = 0; j < 8; ++j) { u32x2 w; w.x = cvt_pk_bf16(r.v[j][0], r.v[j][1]); w.y = cvt_pk_bf16(r.v[j][2], r.v[j][3]); *(u32x2*)(p + 4 * lane + 256 * j) = w; }
}
__device__ __forceinline__ void row_normalize(RowV& r) {
    float s = 0.f;
#pragma unroll
    for (int j = 0; j < 8; ++j) s += (r.v[j][0] + r.v[j][1]) + (r.v[j][2] + r.v[j][3]);
    const float mean = wave_sum(s) * (1.f / DM); float q = 0.f;
#pragma unroll
    for (int j = 0; j < 8; ++j) { r.v[j] = r.v[j] - mean; q += (r.v[j][0] * r.v[j][0] + r.v[j][1] * r.v[j][1]) + (r.v[j][2] * r.v[j][2] + r.v[j][3] * r.v[j][3]); }
    const float rstd = 1.f / sqrtf(wave_sum(q) * (1.f / DM) + LN_EPS);
#pragma unroll
    for (int j = 0; j < 8; ++j) r.v[j] = r.v[j] * rstd;
}
__device__ __forceinline__ void row_modulate(RowV& r, const float* shift, const float* scale, int lane) {
#pragma unroll
    for (int j = 0; j < 8; ++j) { const f32x4 sc = *(const f32x4*)(scale + 4 * lane + 256 * j), sh = *(const f32x4*)(shift + 4 * lane + 256 * j); r.v[j] = r.v[j] * (sc + 1.f) + sh; }
}
__device__ __forceinline__ void row_affine(RowV& r, const float* gain, const float* bias, int lane) {
#pragma unroll
    for (int j = 0; j < 8; ++j) { const f32x4 g = *(const f32x4*)(gain + 4 * lane + 256 * j), b = *(const f32x4*)(bias + 4 * lane + 256 * j); r.v[j] = r.v[j] * g + b; }
}
__device__ __forceinline__ void row_decode(int r, int& b, bool& isctx, int& idx) { b = r / RPB; const int t = r - b * RPB; isctx = t < CTX; idx = isctx ? t : t - CTX; }
__device__ __forceinline__ const float* mod_ptr(const unsigned char* ws, int layer, int which, int k) { return (const float*)(ws + O_MOD) + ((size_t)((layer * 3 + which) * 6 + k)) * DM; }

template <int MODE>
__device__ __forceinline__ void transpose_item(const float* W, int K, int N, bf16_t* WT, LAS float* scrf, int item, int lane) {
    LAS unsigned* scr = (LAS unsigned*)scrf;
    const int nblk = N / 64, kb = item / nblk, nb = item % nblk, k0 = 64 * kb, n0 = 64 * nb;
    const float* src = W + (size_t)k0 * N + n0 + lane;
    float v[64];
#pragma unroll
    for (int i = 0; i < 64; ++i) v[i] = __builtin_nontemporal_load(src + (size_t)i * N);
#pragma unroll
    for (int i = 0; i < 32; ++i) scr[lane * 33 + i] = cvt_pk_bf16(v[2 * i], v[2 * i + 1]);
    LDS_WAIT(); asm volatile("" ::: "memory");
    const int c = lane & 7;
#pragma unroll
    for (int jj = 0; jj < 8; ++jj) { const int n = (lane >> 3) + 8 * jj; const LAS unsigned* s = scr + n * 33 + 4 * c;
        u32x4 o; o.x = s[0]; o.y = s[1]; o.z = s[2]; o.w = s[3];
        const int nn = n0 + n; const int orow = MODE == 0 ? nn : (8 * (nn >> 2) + (nn & 3) + (MODE == 2 ? 4 : 0));
        __builtin_nontemporal_store(o, (u32x4*)(WT + (size_t)orow * K + k0 + 8 * c)); }
    LDS_WAIT(); asm volatile("" ::: "memory");
}

__device__ __forceinline__ void p0_prologue(const Ctx& a, LAS unsigned char* lds, int tid, int lane, int wave) {
    unsigned char* ws = a.ws;
    LAS float* scr = (LAS float*)(lds + wave * 16384);
    const int gw = blockIdx.x * NWAVES + wave, NGW = gridDim.x * NWAVES;
    constexpr int I_SQ = 32 * 32, I_GLU = 16 * 16, I_QKV = 32 * 48;
    constexpr int PER_J = 2 * I_SQ + I_GLU + I_QKV + I_SQ;
    for (int it = gw; it < 2 * PER_J; it += NGW) {
        const int j = it / PER_J; int r = it % PER_J;
        if (r < I_SQ) { transpose_item<0>(a.inp(IN_WIN) + (size_t)j * DM * DM, DM, DM, (bf16_t*)(ws + O_WIN) + (size_t)j * DM * DM, scr, r, lane); continue; } r -= I_SQ;
        if (r < I_SQ) { transpose_item<0>(a.inp(IN_WOUT) + (size_t)j * DM * DM, DM, DM, (bf16_t*)(ws + O_WOUT) + (size_t)j * DM * DM, scr, r, lane); continue; } r -= I_SQ;
        if (r < I_GLU) { transpose_item<0>(a.inp(IN_WGLU) + (size_t)j * 1024 * 1024, 1024, 1024, (bf16_t*)(ws + O_WGLU) + (size_t)j * 1024 * 1024, scr, r, lane); continue; } r -= I_GLU;
        if (r < I_QKV) { transpose_item<0>(a.inp(IN_WQKV) + (size_t)j * DM * 3072, DM, 3072, (bf16_t*)(ws + O_WQKV) + (size_t)j * 3072 * DM, scr, r, lane); continue; } r -= I_QKV;
        transpose_item<0>(a.inp(IN_WO) + (size_t)j * DM * DM, DM, DM, (bf16_t*)(ws + O_WO) + (size_t)j * DM * DM, scr, r, lane);
    }
    __syncthreads();
    {
        LAS float* sl = (LAS float*)lds;
        LAS float* red = (LAS float*)(lds + 32768);
        for (int i = tid; i < 3 * DM; i += NTHREADS) { const int w = i / DM, k = i % DM; const float cv = w < 2 ? a.inp(IN_C)[w * DM + k] : a.inp(IN_CCTX)[k]; sl[i] = silu_f(cv); }
        __syncthreads();
        for (int wi = blockIdx.x; wi < 256; wi += gridDim.x) {
            const int layer = wi >> 6, col0 = (wi & 63) * 192;
            const float* W = a.inp(IN_MODW) + (size_t)layer * DM * 12288 + col0 + lane;
            float acc[3][3];
#pragma unroll
            for (int q = 0; q < 3; ++q)
#pragma unroll
                for (int r = 0; r < 3; ++r) acc[q][r] = 0.f;
#pragma unroll 16
            for (int k = wave * 256; k < wave * 256 + 256; ++k) {
                const float s0 = sl[k], s1 = sl[DM + k], s2 = sl[2 * DM + k];
#pragma unroll
                for (int q = 0; q < 3; ++q) { const float w = W[(size_t)k * 12288 + 64 * q]; acc[q][0] += w * s0; acc[q][1] += w * s1; acc[q][2] += w * s2; }
            }
#pragma unroll
            for (int q = 0; q < 3; ++q)
#pragma unroll
                for (int r = 0; r < 3; ++r) red[(wave * 9 + q * 3 + r) * 64 + lane] = acc[q][r];
            __syncthreads();
            for (int i = tid; i < 576; i += NTHREADS) { const int qr = i / 64, l = i % 64, q = qr / 3, r = qr % 3; float s = 0.f;
#pragma unroll
                for (int w = 0; w < 8; ++w) s += red[(w * 9 + qr) * 64 + l];
                const int n = col0 + 64 * q + l;
                ((float*)(ws + O_MOD))[((size_t)(layer * 3 + r)) * 12288 + n] = s + a.inp(IN_MODB)[layer * 12288 + n]; }
            __syncthreads();
        }
    }
    const int gt = blockIdx.x * NTHREADS + tid, NGT = gridDim.x * NTHREADS;
    const double INV_PI = 0.31830988618379067153776752674503;
    for (int i = gt; i < 256 * 32; i += NGT) { const int pos = i >> 5, f = i & 31; const float invf = (float)exp(-(double)f * (9.210340371976182736071965818737 / 32.0)); const float ang = (float)pos * invf;
        ((f32x2*)(ws + O_TRIG))[i] = (f32x2){(float)cospi((double)ang * INV_PI), (float)sinpi((double)ang * INV_PI)}; }
    for (int i = gt; i < 256 * 256; i += NGT) { const int r = i >> 8, k = i & 255;
        { float v = 0.f; if (k < 128) { float ss, cc; sincospif((float)(((r & 127) * k) & 127) * (1.f / 64.f), &ss, &cc); v = (r < 128 ? cc : -ss) * (1.f / 128.f); }
          ((bf16_t*)(ws + O_FA))[i] = (bf16_t)f2bf(v); }
    }
    for (int i8 = gt; i8 < 128 * 256 * 32; i8 += NGT) {
        const int k1 = i8 >> 13, r = (i8 >> 5) & 255, kc = (i8 & 31) * 8, k2 = r & 127; float v[8];
#pragma unroll
        for (int q = 0; q < 8; ++q) { const int k = kc + q, l2 = k & 127; float ss, cc; sincospif((float)((l2 * (k1 + 128 * k2)) & 16383) * (1.f / 8192.f), &ss, &cc);
            v[q] = r < 128 ? (k < 128 ? cc : ss) : (k < 128 ? ss : -cc); }
        u32x4 o; o.x = cvt_pk_bf16(v[0], v[1]); o.y = cvt_pk_bf16(v[2], v[3]); o.z = cvt_pk_bf16(v[4], v[5]); o.w = cvt_pk_bf16(v[6], v[7]);
        *(u32x4*)((bf16_t*)(ws + O_FC) + (size_t)i8 * 8) = o; }
    for (int i = gt; i < 512 * 256; i += NGT) { const int r = i >> 8, l = i & 255, k = r & 255; float ss, cc; sincospif((float)((k * l) & 255) * (1.f / 128.f), &ss, &cc);
        ((bf16_t*)(ws + O_F256))[i] = (bf16_t)f2bf((r < 256 ? cc : ss) * (1.f / 16.f)); }
    for (int i = gt; i < 2 * 2 * 64 * 64 * 33; i += NGT) { const int jdgp = i / 33, n = i - jdgp * 33;
        const double step = exp((double)a.inp(IN_LOGSTEP)[jdgp >> 6]), ar = (double)a.inp(IN_LAMRE)[jdgp] * step, ai = (double)a.inp(IN_LAMIM)[jdgp] * step * INV_PI;
        const double mag = exp(ar * n); ((f32x2*)(ws + O_POW))[i] = (f32x2){(float)(mag * cospi(ai * n)), (float)(mag * sinpi(ai * n))}; }
    for (int i = gt; i < 2 * 2 * 64 * 64 * 16; i += NGT) { const int jdgp = i >> 4;
        const double lre = a.inp(IN_LAMRE)[jdgp], lim = a.inp(IN_LAMIM)[jdgp], step = exp((double)a.inp(IN_LOGSTEP)[jdgp >> 6]);
        const double mag = exp(lre * step), ang = lim * step * INV_PI, br = mag * cospi(ang) - 1.0, bi = mag * sinpi(ang), den = lre * lre + lim * lim;
        const double qr = (br * lre + bi * lim) / den, qi = (bi * lre - br * lim) / den;
        const double xr = a.inp(IN_BRE)[i], xi = a.inp(IN_BIM)[i]; ((f32x2*)(ws + O_BBAR))[i] = (f32x2){(float)(qr * xr - qi * xi), (float)(qr * xi + qi * xr)}; }
    {
        __syncthreads();
        LAS float* ct = (LAS float*)lds; LAS float* st = ct + 256;
        if (tid < 256) { float ss, cc; sincospif((float)tid * (1.f / 128.f), &ss, &cc); ct[tid] = cc * (1.f / 16.f); st[tid] = -ss * (1.f / 16.f); }
        __syncthreads();
        for (int i = gt; i < 2 * 4 * 64 * 256; i += NGT) { const int e = i & 255, kb = (i >> 8) & 63, jg = i >> 14, c0 = (kb & 31) * 8; const LAS float* tb = kb < 32 ? ct : st;
            const float* w = a.inp(IN_FNETW) + (size_t)jg * 65536 + e; float s[8];
#pragma unroll
            for (int q = 0; q < 8; ++q) s[q] = 0.f;
#pragma unroll 4
            for (int m = 0; m < 256; ++m) { const float wv = w[m * 256];
#pragma unroll
                for (int q = 0; q < 8; ++q) s[q] += tb[(m * (c0 + q)) & 255] * wv; }
            u32x4 o; o.x = cvt_pk_bf16(s[0], s[1]); o.y = cvt_pk_bf16(s[2], s[3]); o.z = cvt_pk_bf16(s[4], s[5]); o.w = cvt_pk_bf16(s[6], s[7]);
            *(u32x4*)((bf16_t*)(ws + O_FNM) + ((size_t)jg * 256 + e) * 512 + kb * 8) = o; }
        __syncthreads();
    }
    if (gt < 128) ((bf16_t*)(ws + O_T1))[(size_t)2048 * 128 * 128 + gt] = 0;
}

__device__ __forceinline__ void p1_kf(const Ctx& a, LAS unsigned char* lds, int tid) {
    unsigned char* ws = a.ws;
    LAS f32x2* pw = (LAS f32x2*)lds;
    LAS f32x2* bb = pw + 64 * 33;
    LAS f32x2* cc = bb + 64 * 16;
    for (int jdg = blockIdx.x; jdg < 256; jdg += gridDim.x) {
        for (int i = tid; i < 64 * 33; i += NTHREADS) pw[i] = ((const f32x2*)(ws + O_POW))[(size_t)jdg * 64 * 33 + i];
        for (int i = tid; i < 64 * 16; i += NTHREADS) bb[i] = ((const f32x2*)(ws + O_BBAR))[(size_t)jdg * 64 * 16 + i];
        for (int i = tid; i < 16 * 64; i += NTHREADS) cc[(i >> 6) * 65 + (i & 63)] = (f32x2){a.inp(IN_CRE)[(size_t)jdg * 1024 + i], a.inp(IN_CIM)[(size_t)jdg * 1024 + i]};
        __syncthreads();
        const int tau = tid >> 4, co = tid & 15; float s[16];
#pragma unroll
        for (int ci = 0; ci < 16; ++ci) s[ci] = 0.f;
        for (int p = 0; p < 64; ++p) { const f32x2 w = pw[p * 33 + tau], c = cc[co * 65 + p]; const float xr = c.x * w.x - c.y * w.y, xi = c.x * w.y + c.y * w.x;
#pragma unroll
            for (int ci = 0; ci < 16; ++ci) { const f32x2 b = bb[p * 16 + ci]; s[ci] += xr * b.x - xi * b.y; } }
        float* out = (float*)(ws + O_KF) + ((size_t)jdg * 32 + tau) * 256 + co * 16;
#pragma unroll
        for (int q = 0; q < 4; ++q) *(f32x4*)(out + 4 * q) = (f32x4){s[4 * q], s[4 * q + 1], s[4 * q + 2], s[4 * q + 3]};
        __syncthreads();
    }
}
__device__ __forceinline__ u32x4 p2_bt1_item(const Ctx& a, int i) {
    unsigned char* ws = a.ws; const f32x2* POW = (const f32x2*)(ws + O_POW); const f32x2* BB = (const f32x2*)(ws + O_BBAR);
    const int k8 = i & 63, rr = (i >> 6) & 255, jg = i >> 14, j = jg >> 6, g = jg & 63;
    const int typ = rr >> 6, p = rr & 63, d = typ >> 1, t = k8 >> 1, ci0 = (k8 & 1) * 8, n = d == 0 ? (31 - t) : t;
    const size_t jdgp = ((size_t)((j * 2 + d) * 64 + g)) * 64 + p; const f32x2 w = POW[jdgp * 33 + n]; float v[8];
#pragma unroll
    for (int c = 0; c < 8; ++c) { const f32x2 b = BB[jdgp * 16 + ci0 + c]; v[c] = (typ & 1) ? (w.x * b.y + w.y * b.x) : (w.x * b.x - w.y * b.y); }
    u32x4 o; o.x = cvt_pk_bf16(v[0], v[1]); o.y = cvt_pk_bf16(v[2], v[3]); o.z = cvt_pk_bf16(v[4], v[5]); o.w = cvt_pk_bf16(v[6], v[7]); return o;
}
__device__ __forceinline__ u32x4 p2_bt3_item(const Ctx& a, int i) {
    unsigned char* ws = a.ws; const f32x2* POW = (const f32x2*)(ws + O_POW); const float* KF = (const float*)(ws + O_KF);
    const int k8 = i % 96, rr = (i / 96) & 511, jg = i / (96 * 512), j = jg >> 6, g = jg & 63;
    const int t = rr >> 4, co = rr & 15; float v[8];
    if (k8 < 64) { const int s = k8 >> 1, ci0 = (k8 & 1) * 8;
        f32x4 f0 = (f32x4){0.f, 0.f, 0.f, 0.f}, f1 = f0;
        if (s <= t) { const f32x4* p = (const f32x4*)(KF + ((((size_t)(j * 2 + 0) * 64 + g) * 32 + (t - s)) * 16 + co) * 16 + ci0); f0 += p[0]; f1 += p[1]; }
        if (s >= t) { const f32x4* p = (const f32x4*)(KF + ((((size_t)(j * 2 + 1) * 64 + g) * 32 + (s - t)) * 16 + co) * 16 + ci0); f0 += p[0]; f1 += p[1]; }
#pragma unroll
        for (int c = 0; c < 4; ++c) { v[c] = f0[c]; v[4 + c] = f1[c]; }
        if (s == t && (co >> 3) == (k8 & 1)) { const float dsk = a.inp(IN_S5D)[j * 1024 + g * 16 + co];
#pragma unroll
            for (int c = 0; c < 8; ++c) v[c] += (ci0 + c == co) ? dsk : 0.f; }
    } else { const int q0 = (k8 - 64) * 8, typ = q0 >> 6, d = typ >> 1, n = d == 0 ? (t + 1) : (32 - t);
        const size_t jdg = (size_t)(j * 2 + d) * 64 + g;
#pragma unroll
        for (int c = 0; c < 8; ++c) { const int p = (q0 & 63) + c; const f32x2 w = POW[(jdg * 64 + p) * 33 + n];
            const float cr = a.inp(IN_CRE)[(jdg * 16 + co) * 64 + p], ci = a.inp(IN_CIM)[(jdg * 16 + co) * 64 + p];
            v[c] = (typ & 1) ? -(cr * w.y + ci * w.x) : (cr * w.x - ci * w.y); } }
    u32x4 o; o.x = cvt_pk_bf16(v[0], v[1]); o.y = cvt_pk_bf16(v[2], v[3]); o.z = cvt_pk_bf16(v[4], v[5]); o.w = cvt_pk_bf16(v[6], v[7]); return o;
}
__device__ __forceinline__ void p2_s5mats(const Ctx& a, int tid) {
    unsigned char* ws = a.ws; const int gt = blockIdx.x * NTHREADS + tid, NGT = gridDim.x * NTHREADS;
    constexpr int N1 = 2 * 64 * 256 * 64, N3 = 2 * 64 * 512 * 96;
    for (int i = gt; i < N1; i += 4 * NGT) { u32x4 o[4];
#pragma unroll
        for (int q = 0; q < 4; ++q) { const int ii = i + q * NGT; o[q] = p2_bt1_item(a, ii < N1 ? ii : i); }
#pragma unroll
        for (int q = 0; q < 4; ++q) { const int ii = i + q * NGT; if (ii < N1) { const int k8 = ii & 63, rr = (ii >> 6) & 255, jg = ii >> 14;
            *(u32x4*)((bf16_t*)(ws + O_BT1) + ((size_t)jg * 256 + rr) * 512 + k8 * 8) = o[q]; } } }
    for (int i = gt; i < N3; i += 4 * NGT) { u32x4 o[4];
#pragma unroll
        for (int q = 0; q < 4; ++q) { const int ii = i + q * NGT; o[q] = p2_bt3_item(a, ii < N3 ? ii : i); }
#pragma unroll
        for (int q = 0; q < 4; ++q) { const int ii = i + q * NGT; if (ii < N3) { const int k8 = ii % 96, rr = (ii / 96) & 511, jg = ii / (96 * 512);
            *(u32x4*)((bf16_t*)(ws + O_BT3) + ((size_t)jg * 512 + rr) * 768 + k8 * 8) = o[q]; } } }
}
__device__ __forceinline__ void moe_weight_phase(const Ctx& a, int layer, int part, int tailwgs, LAS unsigned char* lds, int lane, int wave) {
    unsigned char* ws = a.ws; LAS float* scr = (LAS float*)(lds + wave * 16384);
    const int rank = (int)blockIdx.x - tailwgs, nact = (int)gridDim.x - tailwgs;
    if (rank >= 0) {
        const int gw = rank * NWAVES + wave, NGW = nact * NWAVES;
        constexpr int I_GU = 32 * 16, I_DN = 16 * 32, PER_E = 2 * I_GU + I_DN, HALF_ITEMS = 16 * PER_E / 2;
        for (int it = part * HALF_ITEMS + gw; it < (part + 1) * HALF_ITEMS; it += NGW) {
            const int e = it / PER_E; int r = it % PER_E;
            const size_t le = (size_t)layer * 16 + e;
            if (r < I_GU) { transpose_item<1>(a.inp(IN_WGATE) + le * DM * EFF, DM, EFF, (bf16_t*)(ws + O_WGU) + (size_t)e * 2048 * DM, scr, r, lane); continue; } r -= I_GU;
            if (r < I_GU) { transpose_item<2>(a.inp(IN_WUP) + le * DM * EFF, DM, EFF, (bf16_t*)(ws + O_WGU) + (size_t)e * 2048 * DM, scr, r, lane); continue; } r -= I_GU;
            transpose_item<0>(a.inp(IN_WDOWN) + le * EFF * DM, EFF, DM, (bf16_t*)(ws + O_WD) + (size_t)e * DM * EFF, scr, r, lane);
        }
    }
    __syncthreads();
}

__device__ __forceinline__ const float* r_xsrc0(const Ctx& a, int r) { int b, idx; bool isctx; row_decode(r, b, isctx, idx);
    return isctx ? a.inp(IN_CTX) + ((size_t)(b * CTX + idx)) * DM : a.inp(IN_X) + ((size_t)(b * SEQ + idx)) * DM; }
__device__ __forceinline__ void r0_phase(const Ctx& a, int lane, int wave) {
    unsigned char* ws = a.ws; const int gw = blockIdx.x * NWAVES + wave, NGW = gridDim.x * NWAVES;
    RowV xn;
    if (gw < NR) row_load_f32_nt(xn, r_xsrc0(a, gw), lane);
    for (int r = gw; r < NR; r += NGW) { int b, idx; bool isctx; row_decode(r, b, isctx, idx);
        const int which = isctx ? 2 : b; RowV x = xn;
        if (r + NGW < NR) row_load_f32_nt(xn, r_xsrc0(a, r + NGW), lane);
        row_normalize(x);
        row_modulate(x, mod_ptr(ws, 0, which, 0), mod_ptr(ws, 0, which, 1), lane);
        row_store_bf16(x, (bf16_t*)(ws + O_U) + (size_t)r * DM, lane); }
}
__device__ __forceinline__ void lds_vec_fill(LAS float* dst, const float* src, int tid) { for (int i = tid; i < DM / 4; i += NTHREADS) *(LAS f32x4*)(dst + 4 * i) = *(const f32x4*)(src + 4 * i); }
__device__ __forceinline__ f32x4 vld(const float* p, int lane, int j) { return *(const f32x4*)(p + 4 * lane + 256 * j); }
__device__ __forceinline__ f32x4 vld(const LAS float* p, int lane, int j) { return *(const LAS f32x4*)(p + 4 * lane + 256 * j); }
__device__ __forceinline__ const float* r_xsrc(const Ctx& a, int layer, int r) { int b, idx; bool isctx; row_decode(r, b, isctx, idx);
    if (layer == 0) return isctx ? a.inp(IN_CTX) + ((size_t)(b * CTX + idx)) * DM : a.inp(IN_X) + ((size_t)(b * SEQ + idx)) * DM;
    return isctx ? (const float*)(a.ws + O_XC) + ((size_t)(b * CTX + idx)) * DM : a.outp() + ((size_t)(b * SEQ + idx)) * DM; }
struct RowDeal { int b, i0, n_lat_wg, wave, nlat, gw, NGW;
    __device__ __forceinline__ void init(int wave_) { const int G = gridDim.x, nb = G >> 1, c = blockIdx.x; wave = wave_; gw = c * NWAVES + wave; NGW = G * NWAVES;
        if (nb > 0 && c < 2 * nb) { const int per = (SEQ + nb - 1) / nb; b = c / nb; i0 = (c % nb) * per; n_lat_wg = SEQ - i0 < per ? (SEQ - i0 > 0 ? SEQ - i0 : 0) : per; } else { b = 0; i0 = 0; n_lat_wg = 0; }
        nlat = n_lat_wg > wave ? (n_lat_wg - wave + NWAVES - 1) / NWAVES : 0; }
    bool with_ctx = true;
    __device__ __forceinline__ int row(int k) const { if (k < nlat) return b * RPB + CTX + i0 + wave + k * NWAVES;
        const int q = gw + (k - nlat) * NGW; if (!with_ctx || q >= NBATCH * CTX) return -1; return (q / CTX) * RPB + (q % CTX); } };
constexpr int RV_OFF = RING_BYTES + 1024;

template <bool FAST>
__device__ __forceinline__ void r1_row(const Ctx& a, int layer, int r, RowV& x, const LAS float* wl, const LAS float* lv, int lane, bool st) {
    unsigned char* ws = a.ws; int b, idx; bool isctx; row_decode(r, b, isctx, idx); const int which = isctx ? 2 : b;
    float* xs = isctx ? (float*)(ws + O_XC) + ((size_t)(b * CTX + idx)) * DM : a.outp() + ((size_t)(b * SEQ + idx)) * DM;
    row_normalize(x);
    row_affine(x, a.inp(IN_LNMG) + layer * DM, a.inp(IN_LNMB) + layer * DM, lane);
    if (st) row_store_f32_nt(x, xs, lane);
    row_normalize(x);
    if (FAST) {
#pragma unroll
        for (int j = 0; j < 8; ++j) x.v[j] = x.v[j] * (vld(lv + DM, lane, j) + 1.f) + vld(lv + 2 * DM, lane, j);
    } else row_modulate(x, mod_ptr(ws, layer, which, 3), mod_ptr(ws, layer, which, 4), lane);
    if (st) row_store_bf16(x, (bf16_t*)(ws + O_H2) + (size_t)r * DM, lane);
    float lg[16];
#pragma unroll
    for (int e = 0; e < 16; ++e) { float s0 = 0.f, s1 = 0.f, s2 = 0.f, s3 = 0.f;
#pragma unroll
        for (int j = 0; j < 8; ++j) { const f32x4 w = *(const LAS f32x4*)(wl + e * DM + 4 * lane + 256 * j);
            s0 = __builtin_fmaf(x.v[j][0], w[0], s0); s1 = __builtin_fmaf(x.v[j][1], w[1], s1); s2 = __builtin_fmaf(x.v[j][2], w[2], s2); s3 = __builtin_fmaf(x.v[j][3], w[3], s3); }
        lg[e] = wave_sum((s0 + s1) + (s2 + s3)); asm volatile("" ::: "memory"); }
    float mx = lg[0];
#pragma unroll
    for (int e = 1; e < 16; ++e) mx = fmaxf(mx, lg[e]);
    float den = 0.f;
#pragma unroll
    for (int e = 0; e < 16; ++e) { lg[e] = __builtin_amdgcn_exp2f((lg[e] - mx) * 1.4426950408889634f); den += lg[e]; }
    float mine = 0.f;
#pragma unroll
    for (int e = 0; e < 16; ++e) mine = (lane == e) ? lg[e] : mine;
    if (st && lane < 16) ((float*)(ws + O_AFF))[(size_t)r * 16 + lane] = mine / den;
}
__device__ __forceinline__ void r1_phase(const Ctx& a, int layer, LAS unsigned char* lds, int tid, int lane, int wave, bool st) {
    unsigned char* ws = a.ws;
    LAS float* wl = (LAS float*)lds;
    LAS float* lv = (LAS float*)(lds + RV_OFF);
    RowDeal rd; rd.init(wave); rd.with_ctx = layer + 1 < DEPTH;
    { const float* wr = a.inp(IN_ROUTER) + (size_t)layer * DM * 16;
      for (int i = tid; i < DM * 16; i += NTHREADS) wl[(i & 15) * DM + (i >> 4)] = wr[i];
      lds_vec_fill(lv, mod_ptr(ws, layer, rd.b, 2), tid); lds_vec_fill(lv + DM, mod_ptr(ws, layer, rd.b, 4), tid); lds_vec_fill(lv + 2 * DM, mod_ptr(ws, layer, rd.b, 3), tid); }
    __syncthreads();
    RowV xn; u32x2 on[8];
#define R1_FETCH(R) do { row_load_f32_nt(xn, r_xsrc(a, layer, (R)), lane); _Pragma("unroll") for (int j = 0; j < 8; ++j) on[j] = __builtin_nontemporal_load((const u32x2*)((const bf16_t*)(ws + O_O) + (size_t)(R) * DM + 4 * lane + 256 * j)); } while (0)
    int r = rd.row(0);
    if (r >= 0) R1_FETCH(r);
    int k = 0;
    for (; k < rd.nlat; ++k) {
        RowV x;
#pragma unroll
        for (int j = 0; j < 8; ++j) { const f32x4 o = (f32x4){bf2f(on[j].x & 0xffffu), bf2f(on[j].x >> 16), bf2f(on[j].y & 0xffffu), bf2f(on[j].y >> 16)}; x.v[j] = xn.v[j] * ALPHA + vld(lv, lane, j) * o; }
        const int rn = rd.row(k + 1);
        if (rn >= 0) R1_FETCH(rn);
        r1_row<true>(a, layer, r, x, wl, lv, lane, st);
        r = rn;
    }
    for (; r >= 0; ++k) {
        RowV x; { int b, idx; bool isctx; row_decode(r, b, isctx, idx); const float* g1 = mod_ptr(ws, layer, isctx ? 2 : b, 2);
#pragma unroll
          for (int j = 0; j < 8; ++j) { const f32x4 o = (f32x4){bf2f(on[j].x & 0xffffu), bf2f(on[j].x >> 16), bf2f(on[j].y & 0xffffu), bf2f(on[j].y >> 16)}; x.v[j] = xn.v[j] * ALPHA + vld(g1, lane, j) * o; } }
        const int rn = rd.row(k + 1);
        if (rn >= 0) R1_FETCH(rn);
        r1_row<false>(a, layer, r, x, wl, lv, lane, st);
        r = rn;
    }
#undef R1_FETCH
    __syncthreads();
}
__device__ __forceinline__ int moe_row(int e, int b, bool isctx, int slot) { return isctx ? (NEXP * 4096 + e * 256 + b * CAP_C + slot) : (e * 4096 + b * CAP_L + slot); }
template <bool FAST>
__device__ __forceinline__ void r2_row(const Ctx& a, int layer, int r, const RowV& xin, int selv, float affv, const LAS float* lv, int lane, bool st) {
    unsigned char* ws = a.ws; int b, idx; bool isctx; row_decode(r, b, isctx, idx); const int which = isctx ? 2 : b;
    const bf16_t* YE = (const bf16_t*)(ws + O_YE);
    float* xs = isctx ? (float*)(ws + O_XC) + ((size_t)(b * CTX + idx)) * DM : a.outp() + ((size_t)(b * SEQ + idx)) * DM;
    RowV x = xin, f;
    unsigned long long m = __ballot(selv >= 0);
    const int e0 = m ? __builtin_ctzll(m) : 0; unsigned long long m1 = m & (m - 1); const int e1 = m1 ? __builtin_ctzll(m1) : 0; unsigned long long m2 = m1 & (m1 - 1); const int e2 = m2 ? __builtin_ctzll(m2) : 0;
    u32x2 y0[8], y1[8], y2[8];
    if (m) { const bf16_t* p = YE + (size_t)moe_row(e0, b, isctx, __builtin_amdgcn_readlane(selv, e0)) * DM + 4 * lane;
#pragma unroll
        for (int j = 0; j < 8; ++j) y0[j] = __builtin_nontemporal_load((const u32x2*)(p + 256 * j)); }
    if (m1) { const bf16_t* p = YE + (size_t)moe_row(e1, b, isctx, __builtin_amdgcn_readlane(selv, e1)) * DM + 4 * lane;
#pragma unroll
        for (int j = 0; j < 8; ++j) y1[j] = __builtin_nontemporal_load((const u32x2*)(p + 256 * j)); }
    if (m2) { const bf16_t* p = YE + (size_t)moe_row(e2, b, isctx, __builtin_amdgcn_readlane(selv, e2)) * DM + 4 * lane;
#pragma unroll
        for (int j = 0; j < 8; ++j) y2[j] = __builtin_nontemporal_load((const u32x2*)(p + 256 * j)); }
#pragma unroll
    for (int j = 0; j < 8; ++j) f.v[j] = (f32x4){0.f, 0.f, 0.f, 0.f};
#define R2_ACC(Y, E) do { const float w_ = __uint_as_float(__builtin_amdgcn_readlane(__float_as_uint(affv), E)); _Pragma("unroll") for (int j = 0; j < 8; ++j) \
        f.v[j] += (f32x4){bf2f(Y[j].x & 0xffffu), bf2f(Y[j].x >> 16), bf2f(Y[j].y & 0xffffu), bf2f(Y[j].y >> 16)} * w_; } while (0)
    if (m) R2_ACC(y0, e0);
    if (m1) R2_ACC(y1, e1);
    if (m2) R2_ACC(y2, e2);
#undef R2_ACC
    unsigned long long mr = m2 & (m2 - 1);
    while (mr) { const int e = __builtin_ctzll(mr); mr &= mr - 1;
        const int s = __builtin_amdgcn_readlane(selv, e); const float w = __uint_as_float(__builtin_amdgcn_readlane(__float_as_uint(affv), e));
        RowV y; row_load_bf16(y, YE + (size_t)moe_row(e, b, isctx, s) * DM, lane);
#pragma unroll
        for (int j = 0; j < 8; ++j) f.v[j] += y.v[j] * w; }
    const float* g2 = mod_ptr(ws, layer, which, 5);
#pragma unroll
    for (int j = 0; j < 8; ++j) { const f32x4 g = FAST ? vld(lv, lane, j) : vld(g2, lane, j); x.v[j] = x.v[j] * ALPHA + g * f.v[j]; }
    row_normalize(x);
    if (FAST) {
#pragma unroll
        for (int j = 0; j < 8; ++j) x.v[j] = x.v[j] * vld(lv + DM, lane, j) + vld(lv + 2 * DM, lane, j);
    } else row_affine(x, a.inp(IN_LNFG) + layer * DM, a.inp(IN_LNFB) + layer * DM, lane);
    if (st) { if (layer + 1 < DEPTH) row_store_f32_nt(x, xs, lane); else row_store_f32(x, xs, lane); }
    if (layer + 1 < DEPTH) { row_normalize(x);
        if (FAST) {
#pragma unroll
            for (int j = 0; j < 8; ++j) x.v[j] = x.v[j] * (vld(lv + 4 * DM, lane, j) + 1.f) + vld(lv + 3 * DM, lane, j);
        } else row_modulate(x, mod_ptr(ws, layer + 1, which, 0), mod_ptr(ws, layer + 1, which, 1), lane);
        if (st) row_store_bf16(x, (bf16_t*)(ws + O_U) + (size_t)r * DM, lane); }
}
__device__ __forceinline__ void r2_phase(const Ctx& a, int layer, LAS unsigned char* lds, int tid, int lane, int wave, bool st) {
    unsigned char* ws = a.ws;
    const int* SEL = (const int*)(ws + O_SEL); const float* AFF = (const float*)(ws + O_AFF);
    LAS float* lv = (LAS float*)lds;
    RowDeal rd; rd.init(wave); rd.with_ctx = layer + 1 < DEPTH;
    lds_vec_fill(lv, mod_ptr(ws, layer, rd.b, 5), tid); lds_vec_fill(lv + DM, a.inp(IN_LNFG) + layer * DM, tid); lds_vec_fill(lv + 2 * DM, a.inp(IN_LNFB) + layer * DM, tid);
    if (layer + 1 < DEPTH) { lds_vec_fill(lv + 3 * DM, mod_ptr(ws, layer + 1, rd.b, 0), tid); lds_vec_fill(lv + 4 * DM, mod_ptr(ws, layer + 1, rd.b, 1), tid); }
    __syncthreads();
    RowV xn; int seln = -1; float affn = 0.f;
    int r = rd.row(0);
    if (r >= 0) { row_load_f32_nt(xn, r_xsrc(a, 1, r), lane); if (lane < 16) { seln = SEL[(size_t)r * 16 + lane]; affn = AFF[(size_t)r * 16 + lane]; } }
    for (int k = 0; r >= 0; ++k) {
        const RowV x = xn; const int selv = seln; const float affv = affn;
        const int rn = rd.row(k + 1);
        seln = -1; affn = 0.f;
        if (rn >= 0) { row_load_f32_nt(xn, r_xsrc(a, 1, rn), lane); if (lane < 16) { seln = SEL[(size_t)rn * 16 + lane]; affn = AFF[(size_t)rn * 16 + lane]; } }
        if (k < rd.nlat) r2_row<true>(a, layer, r, x, selv, affv, lv, lane, st);
        else r2_row<false>(a, layer, r, x, selv, affv, lv, lane, st);
        r = rn;
    }
    __syncthreads();
}
__device__ __forceinline__ int block_excl_scan(int v, LAS int* tmp, int lane, int wave, int& total) {
    int inc = v;
#pragma unroll
    for (int o = 1; o < 64; o <<= 1) { const int t = __builtin_amdgcn_ds_bpermute((lane >= o ? lane - o : lane) << 2, inc); if (lane >= o) inc += t; }
    if (lane == 63) tmp[wave] = inc;
    __syncthreads();
    int off = 0, tot = 0;
#pragma unroll
    for (int w = 0; w < 8; ++w) { const int t = tmp[w]; off += (w < wave) ? t : 0; tot += t; }
    __syncthreads();
    total = tot; return off + inc - v;
}
__device__ __forceinline__ void topk_phase(const Ctx& a, bool with_ctx, LAS unsigned char* lds, int tid, int lane, int wave) {
    unsigned char* ws = a.ws; const float* AFF = (const float*)(ws + O_AFF); int* SEL = (int*)(ws + O_SEL); int* IDX = (int*)(ws + O_IDX);
    LAS unsigned* val = (LAS unsigned*)lds;
    LAS unsigned* hist = (LAS unsigned*)(lds + 69632);
    LAS unsigned* bc = hist + 256;
    LAS int* tmp = (LAS int*)(hist + 272);
    for (int li = blockIdx.x; li < (with_ctx ? 64 : 32); li += gridDim.x) {
        const bool isctx = li >= 32; const int q = li & 31, b = q >> 4, e = q & 15;
        const int n = isctx ? CTX : SEQ, k = isctx ? CAP_C : CAP_L, row0 = b * RPB + (isctx ? 0 : CTX);
        for (int i = tid; i < n; i += NTHREADS) val[i + (i >> 5)] = __float_as_uint(AFF[(size_t)(row0 + i) * 16 + e]);
        __syncthreads();
        unsigned prefix = 0u, mask = 0u; int krem = k;
        for (int pass = 0; pass < 4; ++pass) { const int shift = 24 - 8 * pass;
            if (tid < 256) hist[tid] = 0u;
            __syncthreads();
            for (int i = tid; i < n; i += NTHREADS) { const unsigned v = val[i + (i >> 5)]; const bool in = (v & mask) == prefix; const unsigned bin = (v >> shift) & 255u;
                const unsigned long long act = __ballot(in);
                if (act) { const int first = (int)__builtin_ctzll(act); const unsigned lead = (unsigned)__builtin_amdgcn_readlane((int)bin, first);
                    const unsigned long long same = __ballot(in && bin == lead);
                    if (in && bin != lead) __hip_atomic_fetch_add(&hist[bin], 1u, __ATOMIC_RELAXED, __HIP_MEMORY_SCOPE_WORKGROUP);
                    if (lane == first) __hip_atomic_fetch_add(&hist[lead], (unsigned)__builtin_popcountll(same), __ATOMIC_RELAXED, __HIP_MEMORY_SCOPE_WORKGROUP); } }
            __syncthreads();
            if (wave == 0) { const int b0 = 255 - 4 * lane; const int c0 = (int)hist[b0], c1 = (int)hist[b0 - 1], c2 = (int)hist[b0 - 2], c3 = (int)hist[b0 - 3]; const int s = c0 + c1 + c2 + c3;
                int inc = s;
#pragma unroll
                for (int o = 1; o < 64; o <<= 1) { const int t = __builtin_amdgcn_ds_bpermute((lane >= o ? lane - o : lane) << 2, inc); if (lane >= o) inc += t; }
                const int exc = inc - s;
                if (exc < krem && krem <= inc) { int cum = exc, bin, before;
                    if (krem <= cum + c0) { bin = b0; before = cum; } else { cum += c0;
                    if (krem <= cum + c1) { bin = b0 - 1; before = cum; } else { cum += c1;
                    if (krem <= cum + c2) { bin = b0 - 2; before = cum; } else { cum += c2; bin = b0 - 3; before = cum; } } }
                    bc[0] = (unsigned)bin; bc[1] = (unsigned)(krem - before); } }
            __syncthreads();
            prefix |= bc[0] << shift; mask |= 0xffu << shift; krem = (int)bc[1];
        }
        const unsigned vstar = prefix; const int need = krem;
        const bool act = tid < (n >> 5); int cgt = 0, ceq = 0;
        if (act) for (int j = 0; j < 32; ++j) { const unsigned v = val[33 * tid + j]; cgt += v > vstar; ceq += v == vstar; }
        int tot; const int eqb = block_excl_scan(ceq, tmp, lane, wave, tot);
        int takeq = need - eqb; takeq = takeq < 0 ? 0 : (takeq > ceq ? ceq : takeq);
        const int slot0 = block_excl_scan(cgt + takeq, tmp, lane, wave, tot);
        if (act) { int eqr = eqb, slot = slot0;
            for (int j = 0; j < 32; ++j) { const int i = 32 * tid + j; const unsigned v = val[33 * tid + j]; const bool iseq = v == vstar; const bool take = v > vstar || (iseq && eqr < need); eqr += iseq;
                SEL[(size_t)(row0 + i) * 16 + e] = take ? slot : -1;
                if (take) { IDX[moe_row(e, b, isctx, slot)] = row0 + i; ++slot; } } }
        __syncthreads();
    }
}
__device__ __forceinline__ bool moe_row_valid(int m) { return m < NEXP * 4096 || ((m - NEXP * 4096) & 255) < 2 * CAP_C; }
__device__ __forceinline__ void gather_phase(const Ctx& a, int lane, int wave) {
    unsigned char* ws = a.ws; const int gw = blockIdx.x * NWAVES + wave, NGW = gridDim.x * NWAVES; const int* IDX = (const int*)(ws + O_IDX);
    for (int m0 = gw * 4; m0 < MOE_ROWS; m0 += NGW * 4) {
        const int mi = m0 + (lane & 3); const int tv = moe_row_valid(mi) ? IDX[mi] : -1;
        u32x4 t[4][4];
#pragma unroll
        for (int q = 0; q < 4; ++q) { const int tok = __builtin_amdgcn_readlane(tv, q);
            if (tok >= 0) { const u32x4* src = (const u32x4*)((const bf16_t*)(ws + O_H2) + (size_t)tok * DM);
#pragma unroll
                for (int j = 0; j < 4; ++j) t[q][j] = src[lane + 64 * j]; } }
#pragma unroll
        for (int q = 0; q < 4; ++q) { const int tok = __builtin_amdgcn_readlane(tv, q);
            if (tok >= 0) { u32x4* dst = (u32x4*)((bf16_t*)(ws + O_XE) + (size_t)(m0 + q) * DM);
#pragma unroll
                for (int j = 0; j < 4; ++j) dst[lane + 64 * j] = t[q][j]; } }
    }
}
__device__ __forceinline__ bool attn_fixed_form(const Ctx& a, int j, int lane) {
    const float* qg = a.inp(IN_QGAIN) + j * 128; const float* kg = a.inp(IN_KGAIN) + j * 128;
    const float gq = wave_max(fmaxf(fabsf(qg[lane]), fabsf(qg[lane + 64]))), gk = wave_max(fmaxf(fabsf(kg[lane]), fabsf(kg[lane + 64])));
    return 128.f * gq * gk * 1.03f * 0.088388347648318440f < 27.f;
}
__device__ __forceinline__ void qknorm_phase(const Ctx& a, int j, int lane, int wave, bool st) {
    unsigned char* ws = a.ws; const int gw = blockIdx.x * NWAVES + wave, NGW = gridDim.x * NWAVES;
    const f32x4* TRIG4 = (const f32x4*)(ws + O_TRIG);
    const int cidx = lane & 15, d0 = cidx * 8; const bool upper = (cidx & 4) != 0;
    const float* qg = a.inp(IN_QGAIN) + j * 128 + d0; const float* kg = a.inp(IN_KGAIN) + j * 128 + d0;
    const float qs = attn_fixed_form(a, j, lane) ? 0.088388347648318440f * 1.4426950408889634f : 1.f;
    const f32x4 gq0 = *(const f32x4*)qg * qs, gq1 = *(const f32x4*)(qg + 4) * qs, gk0 = *(const f32x4*)kg, gk1 = *(const f32x4*)(kg + 4);
    u32x4 nraw[5];
    if (gw < NR) { const bf16_t* zn = (const bf16_t*)(ws + O_Z) + (size_t)gw * 3072 + lane * 8;
#pragma unroll
        for (int it = 0; it < 5; ++it) nraw[it] = __builtin_nontemporal_load((const u32x4*)(zn + it * 512)); }
    for (int r = gw; r < NR; r += NGW) { int b, idx; bool isctx; row_decode(r, b, isctx, idx);
        float cs[8], sn[8];
#pragma unroll
        for (int i = 0; i < 8; ++i) { cs[i] = 1.f; sn[i] = 0.f; }
        if (!isctx) { const int pos = cidx < 8 ? (idx >> 6) : (idx & 63); const f32x4* tp = TRIG4 + pos * 16 + (cidx & 3) * 4;
#pragma unroll
            for (int q = 0; q < 4; ++q) { const f32x4 t = tp[q]; cs[2 * q] = t[0]; sn[2 * q] = t[1]; cs[2 * q + 1] = t[2]; sn[2 * q + 1] = t[3]; } }
        bf16_t* zr = (bf16_t*)(ws + O_Z) + (size_t)r * 3072 + lane * 8;
        u32x4 raw[5];
#pragma unroll
        for (int it = 0; it < 5; ++it) raw[it] = nraw[it];
        if (r + NGW < NR) { const bf16_t* zn = (const bf16_t*)(ws + O_Z) + (size_t)(r + NGW) * 3072 + lane * 8;
#pragma unroll
            for (int it = 0; it < 5; ++it) nraw[it] = __builtin_nontemporal_load((const u32x4*)(zn + it * 512)); }
#pragma unroll
        for (int it = 0; it < 5; ++it) {
            float x[8]; x[0] = bf2f(raw[it].x & 0xffffu); x[1] = bf2f(raw[it].x >> 16); x[2] = bf2f(raw[it].y & 0xffffu); x[3] = bf2f(raw[it].y >> 16);
            x[4] = bf2f(raw[it].z & 0xffffu); x[5] = bf2f(raw[it].z >> 16); x[6] = bf2f(raw[it].w & 0xffffu); x[7] = bf2f(raw[it].w >> 16);
            float ss = 0.f;
#pragma unroll
            for (int i = 0; i < 8; ++i) ss += x[i] * x[i];
            ss = row16_sum(ss);
            const float rinv = 1.f / sqrtf(ss * (1.f / 128.f) + QK_EPS);
            const f32x4 g0 = it < 4 ? gq0 : gk0, g1 = it < 4 ? gq1 : gk1;
            float y[8], o[8];
#pragma unroll
            for (int i = 0; i < 4; ++i) { y[i] = x[i] * rinv * g0[i]; y[4 + i] = x[4 + i] * rinv * g1[i]; }
#pragma unroll
            for (int i = 0; i < 8; ++i) { const float yp = __int_as_float(__builtin_amdgcn_ds_swizzle(__float_as_int(y[i]), 0x101F));     o[i] = upper ? (y[i] * cs[i] + yp * sn[i]) : (y[i] * cs[i] - yp * sn[i]); }
            u32x4 w; w.x = cvt_pk_bf16(o[0], o[1]); w.y = cvt_pk_bf16(o[2], o[3]); w.z = cvt_pk_bf16(o[4], o[5]); w.w = cvt_pk_bf16(o[6], o[7]);
            if (st) *(u32x4*)(zr + it * 512) = w; }
    }
}
__device__ __forceinline__ int s5_chunk_at(int b, int d, int q) { const int cb = b * 520; return d == 0 ? cb + q : (q < 8 ? cb + 7 - q : cb + 527 - q); }
__device__ __forceinline__ void s5_carry_phase(const Ctx& a, int j, LAS unsigned char* lds, int lane, int wave) {
    unsigned char* ws = a.ws; const float* SUM = (const float*)(ws + O_SUM); bf16_t* A3 = (bf16_t*)(ws + O_A3);
    LAS f32x2* ex = (LAS f32x2*)lds;
    for (int ui = blockIdx.x; ui < 256; ui += gridDim.x) {
        const int b = ui >> 7, g = (ui >> 1) & 63, d = ui & 1;
        const f32x2 l32 = ((const f32x2*)(ws + O_POW))[((size_t)((j * 2 + d) * 64 + g) * 64 + lane) * 33 + 32];
        const float* sb = SUM + (size_t)g * NCHP * 256 + d * 128 + lane;
        float hr = 0.f, hi = 0.f;
#pragma unroll 13
        for (int i = 0; i < 65; ++i) { const int ch = s5_chunk_at(b, d, wave * 65 + i); const float sr = sb[(size_t)ch * 256], si = sb[(size_t)ch * 256 + 64];
            const float nr = l32.x * hr - l32.y * hi + sr, ni = l32.x * hi + l32.y * hr + si; hr = nr; hi = ni; }
        ex[wave * 64 + lane] = (f32x2){hr, hi};
        __syncthreads();
        float pr = l32.x, pi = l32.y;
#pragma unroll
        for (int s = 0; s < 6; ++s) { const float nr = pr * pr - pi * pi, ni = 2.f * pr * pi; pr = nr; pi = ni; }
        { const float nr = pr * l32.x - pi * l32.y, ni = pr * l32.y + pi * l32.x; pr = nr; pi = ni; }
        float cr = 0.f, ci = 0.f;
        for (int w = 0; w < wave; ++w) { const f32x2 e = ex[w * 64 + lane]; const float nr = pr * cr - pi * ci + e.x, ni = pr * ci + pi * cr + e.y; cr = nr; ci = ni; }
        hr = cr; hi = ci;
        bf16_t* ab = A3 + (size_t)g * NCHP * A3K + 512 + d * 128 + lane;
#pragma unroll 13
        for (int i = 0; i < 65; ++i) { const int ch = s5_chunk_at(b, d, wave * 65 + i); const float sr = sb[(size_t)ch * 256], si = sb[(size_t)ch * 256 + 64];
            ab[(size_t)ch * A3K] = (bf16_t)f2bf(hr); ab[(size_t)ch * A3K + 64] = (bf16_t)f2bf(hi);
            const float nr = l32.x * hr - l32.y * hi + sr, ni = l32.x * hi + l32.y * hr + si; hr = nr; hi = ni; }
        __syncthreads();
    }
}
__device__ __forceinline__ void f1_transpose_phase(const Ctx& a, LAS unsigned char* lds, int lane, int wave) {
    unsigned char* ws = a.ws; const int gw = blockIdx.x * NWAVES + wave, NGW = gridDim.x * NWAVES;
    LAS bf16_t* scr = (LAS bf16_t*)(lds + wave * 16384);
    const bf16_t* ZF = (const bf16_t*)(ws + O_ZF);
    constexpr int N_LAT = 2 * 128 * 32, N_CTX = 2 * 2 * 32, P = 136;
    constexpr int N_SKEW = 3840, SK_WG = 64;
    const int nskw = ((int)gridDim.x - SK_WG) * NWAVES, gws = gw - SK_WG * NWAVES;
    const int n_mine_skew = (nskw > 0 && gws >= 0) ? (N_SKEW - gws + nskw - 1) / nskw : 0;
    const int skew0 = nskw > 0 ? N_SKEW : 0;
    const int n_mine_even = (N_LAT + N_CTX - skew0 - gw + NGW - 1) / NGW;
    for (int k = 0; k < n_mine_skew + (n_mine_even > 0 ? n_mine_even : 0); ++k) {
        const int it = k < n_mine_skew ? gws + k * nskw : skew0 + gw + (k - n_mine_skew) * NGW;
        size_t srow0, sstride; bf16_t* dst; size_t dpitch; int cb;
        if (it < N_LAT) { const int b = it >> 12, l2 = (it >> 5) & 127; cb = it & 31; srow0 = (size_t)b * RPB + CTX + l2; sstride = 128;
            dst = (bf16_t*)(ws + O_T1) + ((size_t)(b * 1024 + cb * 32) * 128 + l2) * 128; dpitch = 128 * 128; }
        else { const int q = it - N_LAT, b = q >> 6, tb = (q >> 5) & 1; cb = q & 31; srow0 = (size_t)b * RPB + tb * 128; sstride = 1;
            dst = (bf16_t*)(ws + O_T1C) + (size_t)(b * 1024 + cb * 32) * 256 + tb * 128; dpitch = 256; }
        const int c4 = lane & 3, rsub = lane >> 2;
        u32x4 v[8];
#pragma unroll
        for (int i = 0; i < 8; ++i) v[i] = __builtin_nontemporal_load((const u32x4*)(ZF + (srow0 + (size_t)(16 * i + rsub) * sstride) * 1024 + cb * 32 + c4 * 8));
#pragma unroll
        for (int i = 0; i < 8; ++i) { const int rr = 16 * i + rsub; LAS bf16_t* s = scr + (c4 * 8) * P + rr;
            s[0 * P] = (bf16_t)(v[i].x & 0xffffu); s[1 * P] = (bf16_t)(v[i].x >> 16); s[2 * P] = (bf16_t)(v[i].y & 0xffffu); s[3 * P] = (bf16_t)(v[i].y >> 16);
            s[4 * P] = (bf16_t)(v[i].z & 0xffffu); s[5 * P] = (bf16_t)(v[i].z >> 16); s[6 * P] = (bf16_t)(v[i].w & 0xffffu); s[7 * P] = (bf16_t)(v[i].w >> 16); }
        LDS_WAIT(); asm volatile("" ::: "memory");
        const int ch0 = lane >> 4, r0 = (lane & 15) * 8;
#pragma unroll
        for (int i = 0; i < 8; ++i) { const int ch = ch0 + 4 * i; const u32x4 o = *(const LAS u32x4*)(scr + ch * P + r0);
            *(u32x4*)(dst + (size_t)ch * dpitch + r0) = o; }
        LDS_WAIT(); asm volatile("" ::: "memory");
    }
    __syncthreads();
}
template <bool FIXM>
__device__ __forceinline__ void attn_units(const Ctx& a, int nunits, char* lds, int tid, float mfixC) {
    unsigned char* ws = a.ws; const bf16_t* Z = (const bf16_t*)(ws + O_Z); bf16_t* AO = (bf16_t*)(ws + O_AO);
    for (int L = blockIdx.x; L < nunits; L += gridDim.x) {
        int b, h, q0, seq;
        if (L < 2048) { b = L >> 10; const int kvh = (L >> 8) & 3, g = (L >> 6) & 3, qb = L & 63; h = kvh * 4 + g; q0 = b * RPB + CTX + qb * 256; seq = RPB; }
        else { const int q = L - 2048; b = q >> 4; h = q & 15; q0 = b * RPB; seq = CTX; }
        const int kvh = h >> 2; const size_t k0 = (size_t)b * RPB;
        if constexpr (FIXM) { if (L < 2048) { att::attn_ring3_body<RPB / 64>(Z + (size_t)q0 * 3072 + h * 128, Z + k0 * 3072 + 2048 + kvh * 128, Z + k0 * 3072 + 2560 + kvh * 128, AO + (size_t)q0 * 2048 + h * 128, lds, tid); continue; } }
        att::attn_dense_body<FIXM>(Z + (size_t)q0 * 3072 + h * 128, Z + k0 * 3072 + 2048 + kvh * 128, Z + k0 * 3072 + 2560 + kvh * 128, AO + (size_t)q0 * 2048 + h * 128, seq, lds, tid, mfixC);
    }
}
__device__ __forceinline__ void attn_phase(const Ctx& a, int j, bool need_ctx, char* lds, int tid) {
    unsigned char* ws = a.ws; const bf16_t* Z = (const bf16_t*)(ws + O_Z); bf16_t* AO = (bf16_t*)(ws + O_AO);
    const int nunits = 2048 + (need_ctx ? 32 : 0);
    const bool fixm = attn_fixed_form(a, j, tid & 63); const float mfixC = 0.f;
    if (fixm) attn_units<true>(a, nunits, lds, tid, mfixC); else attn_units<false>(a, nunits, lds, tid, 0.f);
}
constexpr int NPH = 3 + 12 * DEPTH;
#ifndef MK_N_LAUNCHES
#define MK_N_LAUNCHES 1
#endif
#ifndef REP_ATT
#define REP_ATT 1
#endif
#ifndef REP_MOE
#define REP_MOE 1
#endif
#ifndef REP_EVEN
#define REP_EVEN 1
#endif
#ifndef REP_ODDG
#define REP_ODDG 1
#endif
#ifndef REP_CONV
#define REP_CONV 1
#endif
#ifndef REP_GA
#define REP_GA 1
#endif
#ifndef REP_PRO
#define REP_PRO 1
#endif
#ifndef REP_ROW
#define REP_ROW 1
#endif
#ifndef REP_QK
#define REP_QK 1
#endif
#ifndef REP_P0
#define REP_P0 1
#endif
#ifndef REP_P1
#define REP_P1 1
#endif
#ifndef REP_P2
#define REP_P2 1
#endif
#ifndef REP_R1
#define REP_R1 1
#endif
#ifndef REP_R2
#define REP_R2 1
#endif
#ifndef REP_TK
#define REP_TK 1
#endif
#ifndef REP_GAT
#define REP_GAT 1
#endif
#ifndef REP_BAR
#define REP_BAR 1
#endif
#define REPEAT(N) _Pragma("unroll 1") for (int rep_ = 0; rep_ < (N); ++rep_)

__global__ void __launch_bounds__(NTHREADS, 2) mk_fwd(Args a0) {
    extern __shared__ __attribute__((aligned(16))) unsigned char lds_raw[];
    LAS unsigned char* lds = (LAS unsigned char*)lds_raw;
    volatile LAS unsigned* MISC = (volatile LAS unsigned*)(lds + MISC_OFF);
    if (threadIdx.x < 32) MISC[threadIdx.x] = 0u;
    if (threadIdx.x == 0) {
#pragma unroll
        for (int i = 0; i < 32; ++i) *(LAS unsigned long long*)(lds + PTR_OFF + 8 * i) = (unsigned long long)a0.in[i];
        *(LAS unsigned long long*)(lds + PTR_OFF + 8 * 32) = (unsigned long long)a0.out; }
    __syncthreads();
    const int wave0 = __builtin_amdgcn_readfirstlane(threadIdx.x >> 6);
    const int lo = a0.ph_lo, hi = a0.ph_hi; (void)lo; (void)hi;
    XcdBarrier bar = xcd_barrier_post((unsigned*)(a0.ws + O_CTL) + CW_BAR + a0.li * XCD_BAR_WORDS, MISC + 8);
#if MK_N_LAUNCHES == 1
#define IN(k) true
#else
#define IN(k) (lo <= (k) && (k) < hi)
#endif
#define PH int tid; asm volatile("v_mbcnt_lo_u32_b32 %0, -1, 0\n\tv_mbcnt_hi_u32_b32 %0, -1, %0" : "=v"(tid)); tid += wave0 * 64; asm volatile("" : "+v"(tid));     const int lane = tid & 63, wave = __builtin_amdgcn_readfirstlane(tid >> 6); (void)lane; (void)wave; size_t wz_ = 0; asm volatile("" : "+s"(wz_)); unsigned char* ws = a0.ws + wz_; const Ctx a{lds, ws};
#if MK_N_LAUNCHES == 1
#define SEAM(k) do { if ((k) + 1 < NPH) { REPEAT(REP_BAR) xcd_barrier(bar); } } while (0)
#else
#define SEAM(k) do { if ((k) + 1 < hi) { REPEAT(REP_BAR) xcd_barrier(bar); } } while (0)
#endif
    const int G = gridDim.x, cid = blockIdx.x;
    pg8::Sched S;

    if (IN(0)) { PH REPEAT(REP_P0) p0_prologue(a, lds, tid, lane, wave); SEAM(0); }
    if (IN(1)) { PH REPEAT(REP_P1) { p1_kf(a, lds, tid); r0_phase(a, lane, wave); } SEAM(1); }
    if (IN(2)) { PH REPEAT(REP_P2) p2_s5mats(a, tid); SEAM(2); }

    for (int layer = 0; layer < DEPTH; ++layer) {
        const int base = 3 + 12 * layer, j = layer >> 1;
        const bool need_ctx = layer < DEPTH - 1;
        if ((layer & 1) == 0) {
            if (IN(base + 0)) { PH
                moe_weight_phase(a, layer, 0, (NRT * 8) % G, lds, lane, wave);
                pg8::OpWin op{(const bf16_t*)(ws + O_U), (const bf16_t*)(ws + O_WIN) + (size_t)j * DM * DM, DM, DM, DM, (bf16_t*)(ws + O_A3), (bf16_t*)(ws + O_ZF)};
                S.init(NRT, 8, G, cid); REPEAT(REP_EVEN) pg8::gemm_phase(lds, op, S, tid);
                SEAM(base + 0);
            }
            if (IN(base + 1)) { PH
                { pg8::OpL1 op{(const bf16_t*)(ws + O_A3), (const bf16_t*)(ws + O_BT1) + (size_t)j * 64 * 256 * 512, A3K, 512, 512, (float*)(ws + O_SUM)};
                  S.init(320, 1, G, cid); REPEAT(REP_EVEN) pg8::gemm_phase(lds, op, S, tid); }
                REPEAT(REP_EVEN) f1_transpose_phase(a, lds, lane, wave);
                SEAM(base + 1);
            }
            if (IN(base + 2)) { PH
                REPEAT(REP_EVEN) s5_carry_phase(a, j, lds, lane, wave);
                { pg8::OpFftA op{(const bf16_t*)(ws + O_FA), (const bf16_t*)(ws + O_T1), 256, 128, 256, (bf16_t*)(ws + O_BT2)};
                  S.init(1, 1024, G, cid); REPEAT(REP_EVEN) pg8::gemm_phase(lds, op, S, tid); }
                { pg8::OpCtxDft op{(const bf16_t*)(ws + O_F256), (const bf16_t*)(ws + O_T1C), 256, 256, 256, (bf16_t*)(ws + O_PQ)};
                  S.init(2, 8, G, cid); REPEAT(REP_EVEN) pg8::gemm_phase(lds, op, S, tid); }
                SEAM(base + 2);
            }
            if (IN(base + 3)) { PH
                { pg8::OpL3 op{(const bf16_t*)(ws + O_A3), (const bf16_t*)(ws + O_BT3) + (size_t)j * 64 * 512 * 768, A3K, A3K, A3K, (bf16_t*)(ws + O_G)};
                  S.init(320, 2, G, cid); REPEAT(REP_EVEN) pg8::gemm_phase(lds, op, S, tid); }
                { pg8::OpFftC op{(const bf16_t*)(ws + O_FC), (const bf16_t*)(ws + O_BT2), 256, 256, 256, (bf16_t*)(ws + O_PQ)};
                  S.init(1, 1024, G, cid); REPEAT(REP_EVEN) pg8::gemm_phase(lds, op, S, tid); }
                SEAM(base + 3);
            }
            if (IN(base + 4)) { PH
                { pg8::OpGlu op{(const bf16_t*)(ws + O_G), (const bf16_t*)(ws + O_WGLU) + (size_t)j * 1024 * 1024, 1024, 1024, 1024, a.inp(IN_BGLU) + j * 1024, (bf16_t*)(ws + O_CAT)};
                  S.init(NRT, 4, G, cid); REPEAT(REP_EVEN) pg8::gemm_phase(lds, op, S, tid); }
                { pg8::OpFnet op{(const bf16_t*)(ws + O_PQ), (const bf16_t*)(ws + O_FNM) + (size_t)j * 4 * 256 * 512, DM, 512, 512, a.inp(IN_FNETB) + j * 1024, (bf16_t*)(ws + O_CAT)};
                  S.init(NRT, 4, G, (cid + G - (NRT * 4) % G) % G); REPEAT(REP_EVEN) pg8::gemm_phase(lds, op, S, tid); }
                SEAM(base + 4);
            }
            if (IN(base + 5)) { PH
                moe_weight_phase(a, layer, 1, (NRT * 8) % G, lds, lane, wave);
                pg8::OpStore<false> op{(const bf16_t*)(ws + O_CAT), (const bf16_t*)(ws + O_WOUT) + (size_t)j * DM * DM, DM, DM, DM, (bf16_t*)(ws + O_O), DM, nullptr};
                S.init(NRT, 8, G, cid); REPEAT(REP_EVEN) pg8::gemm_phase(lds, op, S, tid);
                SEAM(base + 5);
            }
        } else {
            if (IN(base + 0)) { PH
                moe_weight_phase(a, layer, 0, (NRT * 12) % G, lds, lane, wave);
                pg8::OpStore<false> op{(const bf16_t*)(ws + O_U), (const bf16_t*)(ws + O_WQKV) + (size_t)j * 3072 * DM, DM, DM, DM, (bf16_t*)(ws + O_Z), 3072, nullptr};
                S.init(NRT, 12, G, cid); REPEAT(REP_ODDG) pg8::gemm_phase(lds, op, S, tid);
                SEAM(base + 0);
            }
            if (IN(base + 1)) { PH REPEAT(REP_QK) qknorm_phase(a, j, lane, wave, rep_ == REP_QK - 1); SEAM(base + 1); }
            if (IN(base + 2)) { PH REPEAT(REP_ATT) attn_phase(a, j, need_ctx, (char*)lds_raw, tid); SEAM(base + 2); }
            if (IN(base + 3)) { PH
                moe_weight_phase(a, layer, 1, (NRT * 8) % G, lds, lane, wave);
                pg8::OpStore<false> op{(const bf16_t*)(ws + O_AO), (const bf16_t*)(ws + O_WO) + (size_t)j * DM * DM, DM, DM, DM, (bf16_t*)(ws + O_O), DM, nullptr};
                S.init(NRT, 8, G, cid); REPEAT(REP_ODDG) pg8::gemm_phase(lds, op, S, tid);
                SEAM(base + 3);
            }
        }
        if (IN(base + 6)) { PH REPEAT(REP_R1) r1_phase(a, layer, lds, tid, lane, wave, rep_ == REP_R1 - 1); SEAM(base + 6); }
        if (IN(base + 7)) { PH REPEAT(REP_TK) topk_phase(a, need_ctx, lds, tid, lane, wave); SEAM(base + 7); }
        if (IN(base + 9)) { PH
            pg8::OpM1 op{(const bf16_t*)(ws + O_H2), (const bf16_t*)(ws + O_WGU), DM, DM, DM, (bf16_t*)(ws + O_HID), (const int*)(ws + O_IDX)};
            S.init(256, 8, G, cid); S.head = need_ctx ? 128 : 0; S.headM0 = 256; REPEAT(REP_MOE) pg8::gemm_phase(lds, op, S, tid); S.head = 0;
            SEAM(base + 9);
        }
        if (IN(base + 10)) { PH
            pg8::OpStore<true> op{(const bf16_t*)(ws + O_HID), (const bf16_t*)(ws + O_WD), EFF, EFF, EFF, (bf16_t*)(ws + O_YE), DM, nullptr};
            S.init(256, 8, G, cid); S.head = need_ctx ? 128 : 0; S.headM0 = 256; REPEAT(REP_MOE) pg8::gemm_phase(lds, op, S, tid); S.head = 0;
            SEAM(base + 10);
        }
        if (IN(base + 11)) { PH REPEAT(REP_R2) r2_phase(a, layer, lds, tid, lane, wave, rep_ == REP_R2 - 1); SEAM(base + 11); }
    }
#undef IN
#undef SEAM
}

static bool phase_empty(int k) { if (k < 3) return false; const int l = (k - 3) / 12, s = (k - 3) % 12; return (l & 1) && (s == 4 || s == 5); }
extern "C" void kernel_launch(void* const* d_in, const int* in_sizes, int n_in, void* d_out, int out_size, void* d_ws, size_t ws_size, hipStream_t stream) {
    static int grid = 0;
    if (grid == 0) {
        if (n_in != 32 || out_size != NBATCH * SEQ * DM || ws_size < WS_NEED) { fprintf(stderr, "kernel_launch: bad shapes n_in %d out %d ws %zu (need %zu)\n", n_in, out_size, ws_size, (size_t)WS_NEED); grid = -1; return; }
        int dev = 0, cus = 0;
        if (hipGetDevice(&dev) != hipSuccess || hipDeviceGetAttribute(&cus, hipDeviceAttributeMultiprocessorCount, dev) != hipSuccess) { grid = -1; return; }
        if (hipFuncSetAttribute((const void*)mk_fwd, hipFuncAttributeMaxDynamicSharedMemorySize, LDS_BYTES) != hipSuccess) { fprintf(stderr, "kernel_launch: hipFuncSetAttribute failed\n"); grid = -1; return; }
        int per_cu = 0;
        if (hipOccupancyMaxActiveBlocksPerMultiprocessor(&per_cu, (const void*)mk_fwd, NTHREADS, LDS_BYTES) != hipSuccess || per_cu < 1) fprintf(stderr, "kernel_launch: occupancy query says %d\n", per_cu);
        (void)hipGetLastError();
        grid = cus;
    }
    if (grid < 0) return;
    (void)in_sizes;
    if (hipMemsetAsync((char*)d_ws + O_CTL, 0, CTL_BYTES, stream) != hipSuccess) return;
    Args a{};
    for (int i = 0; i < 32; ++i) a.in[i] = (const float*)d_in[i];
    a.out = (float*)d_out; a.ws = (unsigned char*)d_ws; a.pad = 0;
#if MK_N_LAUNCHES == 1
    a.ph_lo = 0; a.ph_hi = NPH; a.li = 0;
    hipLaunchKernelGGL(mk_fwd, dim3(grid), dim3(NTHREADS), LDS_BYTES, stream, a);
#else
    int li = 0;
    for (int k = 0; k < NPH; ++k) { if (phase_empty(k)) continue;
        a.ph_lo = k; a.ph_hi = k + 1; a.li = li++;
        hipLaunchKernelGGL(mk_fwd, dim3(grid), dim3(NTHREADS), LDS_BYTES, stream, a); }
#endif
    const hipError_t le = hipPeekAtLastError();
    if (le != hipSuccess) fprintf(stderr, "kernel_launch: launch failed: %s\n", hipGetErrorName(le));
}
```

```cpp
#include <hip/hip_runtime.h>
#include <cstdio>
#include <cstdint>

#define GAS __attribute__((address_space(1)))
#define LAS __attribute__((address_space(3)))
typedef unsigned short bf16_t;
typedef short bf16x8 __attribute__((ext_vector_type(8)));
typedef short s16x4 __attribute__((ext_vector_type(4)));
typedef float f32x4 __attribute__((ext_vector_type(4)));
typedef float f32x2 __attribute__((ext_vector_type(2)));
typedef float f32x16 __attribute__((ext_vector_type(16)));
typedef unsigned u32x4 __attribute__((ext_vector_type(4)));
typedef unsigned u32x2 __attribute__((ext_vector_type(2)));

constexpr int DM = 2048, NBATCH = 2, SEQ = 16384, CTX = 256, DEPTH = 4;
constexpr int RPB = SEQ + CTX;
constexpr int NR = NBATCH * RPB;
constexpr int NRT = NR / 256;
constexpr int NEXP = 16, EFF = 1024, CAP_L = 2048, CAP_C = 32;
constexpr int MOE_ROWS = NEXP * 4096 + NEXP * 256;
constexpr int MOE_RT = MOE_ROWS / 256;
constexpr int S5G = 64, S5P = 64, S5C = 16, S5T = 32;
constexpr int NCH = NR / S5T;
constexpr int NCHP = 1280;
constexpr int A3K = 768;
constexpr float LN_EPS = 1e-6f, QK_EPS = 1e-6f;
constexpr float ALPHA = 1.681792830507429f;
constexpr int NTHREADS = 512, NWAVES = 8;

constexpr size_t A256(size_t x) { return (x + 255) / 256 * 256; }
constexpr size_t O_CTL = 0, CTL_BYTES = 1u << 20;
constexpr size_t O_MOD = O_CTL + CTL_BYTES;
constexpr size_t O_TRIG = O_MOD + A256((size_t)4 * 3 * 6 * DM * 4);
constexpr size_t O_FA = O_TRIG + 256 * 32 * 8;
constexpr size_t O_FC = O_FA + 256 * 256 * 2;
constexpr size_t O_F256 = O_FC + (size_t)128 * 256 * 256 * 2;
constexpr size_t O_POW = O_F256 + 512 * 256 * 2;
constexpr size_t O_BBAR = O_POW + A256((size_t)2 * 2 * 64 * 64 * 33 * 8);
constexpr size_t O_KF = O_BBAR + (size_t)2 * 2 * 64 * 64 * 16 * 8;
constexpr size_t O_WIN = O_KF + (size_t)2 * 2 * 64 * 32 * 256 * 4;
constexpr size_t O_WOUT = O_WIN + (size_t)2 * DM * DM * 2;
constexpr size_t O_WGLU = O_WOUT + (size_t)2 * DM * DM * 2;
constexpr size_t O_FNM = O_WGLU + (size_t)2 * 1024 * 1024 * 2;
constexpr size_t O_BT1 = O_FNM + (size_t)2 * 4 * 256 * 512 * 2;
constexpr size_t O_BT3 = O_BT1 + (size_t)2 * 64 * 256 * 512 * 2;
constexpr size_t O_WQKV = O_BT3 + (size_t)2 * 64 * 512 * 768 * 2;
constexpr size_t O_WO = O_WQKV + (size_t)2 * 3072 * DM * 2;
constexpr size_t O_WGU = O_WO + (size_t)2 * DM * DM * 2;
constexpr size_t O_WD = O_WGU + (size_t)NEXP * 2048 * DM * 2;
constexpr size_t O_XC = O_WD + (size_t)NEXP * DM * EFF * 2;
constexpr size_t O_AFF = O_XC + (size_t)512 * DM * 4;
constexpr size_t O_SEL = O_AFF + (size_t)NR * 16 * 4;
constexpr size_t O_IDX = O_SEL + (size_t)NR * 16 * 4;
constexpr size_t O_U = O_IDX + A256((size_t)MOE_ROWS * 4);
constexpr size_t O_H2 = O_U + (size_t)NR * DM * 2;
constexpr size_t O_O = O_H2 + (size_t)NR * DM * 2;
constexpr size_t O_S = O_O + (size_t)NR * DM * 2;
constexpr size_t O_A3 = O_S;
constexpr size_t O_SUM = O_A3 + (size_t)S5G * NCHP * A3K * 2;
constexpr size_t O_ZF = O_SUM + (size_t)S5G * NCHP * 256 * 4;
constexpr size_t O_T1 = O_ZF + (size_t)NR * 1024 * 2;
constexpr size_t O_T1C = O_T1 + (size_t)2048 * 128 * 128 * 2 + 256;
constexpr size_t O_BT2 = O_T1C + (size_t)2048 * 256 * 2;
constexpr size_t O_PQ = O_BT2 + (size_t)128 * 2048 * 256 * 2;
constexpr size_t O_G = O_PQ + (size_t)NR * DM * 2;
constexpr size_t O_CAT = O_G + (size_t)NR * 1024 * 2;
constexpr size_t O_EVEN_END = O_CAT + (size_t)NR * DM * 2;
constexpr size_t O_Z = O_S;
constexpr size_t O_AO = O_Z + (size_t)NR * 3072 * 2;
constexpr size_t O_ODD_END = O_AO + (size_t)NR * DM * 2;
constexpr size_t O_XE = O_S;
constexpr size_t O_HID = O_XE + (size_t)MOE_ROWS * DM * 2;
constexpr size_t O_YE = O_HID + (size_t)MOE_ROWS * EFF * 2;
constexpr size_t O_MOE_END = O_YE + (size_t)MOE_ROWS * DM * 2;
constexpr size_t WS_NEED = O_EVEN_END > O_MOE_END ? (O_EVEN_END > O_ODD_END ? O_EVEN_END : O_ODD_END) : (O_MOE_END > O_ODD_END ? O_MOE_END : O_ODD_END);
static_assert(WS_NEED < (size_t)2300 * 1024 * 1024, "workspace budget");
constexpr int CW_BAR = 4096;
constexpr int CW_DIAG = 16384;

constexpr int RING_BYTES = 131072;
constexpr int MISC_OFF = RING_BYTES;
constexpr int EPI_OFF = RING_BYTES + 256;
constexpr int LDS_BYTES = 163840;

#define LDS_WAIT() asm volatile("s_waitcnt lgkmcnt(0)" ::: "memory")
#define VM_WAIT() asm volatile("s_waitcnt vmcnt(0)" ::: "memory")
__device__ __forceinline__ float bf2f(unsigned b) { return __uint_as_float(b << 16); }
__device__ __forceinline__ unsigned f2bf(float f) { unsigned u = __float_as_uint(f); return (u + 0x7fffu + ((u >> 16) & 1u)) >> 16; }
__device__ __forceinline__ unsigned cvt_pk_bf16(float lo, float hi) { unsigned r; asm volatile("v_cvt_pk_bf16_f32 %0, %1, %2" : "=v"(r) : "v"(lo), "v"(hi)); return r; }
template <int CTRL> __device__ __forceinline__ float dpp_mov(float v) { return __int_as_float(__builtin_amdgcn_update_dpp(0, __float_as_int(v), CTRL, 0xf, 0xf, true)); }
__device__ __forceinline__ float row16_sum(float v) {
    v += dpp_mov<0xB1>(v);
    v += dpp_mov<0x4E>(v);
    v += dpp_mov<0x141>(v);
    v += dpp_mov<0x140>(v);
    return v;
}
__device__ __forceinline__ float wave_sum(float v) {
    v = row16_sum(v);
    { auto rr = __builtin_amdgcn_permlane16_swap(__float_as_uint(v), __float_as_uint(v), false, false); v = __uint_as_float(rr[0]) + __uint_as_float(rr[1]); }
    { auto rr = __builtin_amdgcn_permlane32_swap(__float_as_uint(v), __float_as_uint(v), false, false); v = __uint_as_float(rr[0]) + __uint_as_float(rr[1]); }
    return v;
}
__device__ __forceinline__ float wave_max(float v) {
    v = fmaxf(v, dpp_mov<0xB1>(v)); v = fmaxf(v, dpp_mov<0x4E>(v)); v = fmaxf(v, dpp_mov<0x141>(v)); v = fmaxf(v, dpp_mov<0x140>(v));
    { auto rr = __builtin_amdgcn_permlane16_swap(__float_as_uint(v), __float_as_uint(v), false, false); v = fmaxf(__uint_as_float(rr[0]), __uint_as_float(rr[1])); }
    { auto rr = __builtin_amdgcn_permlane32_swap(__float_as_uint(v), __float_as_uint(v), false, false); v = fmaxf(__uint_as_float(rr[0]), __uint_as_float(rr[1])); }
    return v;
}
__device__ __forceinline__ float sigmoid_fast(float x) { return __builtin_amdgcn_rcpf(1.f + __builtin_amdgcn_exp2f(-1.4426950408889634f * x)); }
__device__ __forceinline__ float silu_f(float x) { return x / (1.f + __expf(-x)); }
__device__ __forceinline__ float gelu_tanh(float x) {
    const float u = 0.7978845608028654f * (x + 0.044715f * x * x * x);
    const float t = 1.f - 2.f * sigmoid_fast(-2.f * u);
    return 0.5f * x * (1.f + t);
}

#define XB_TMO      128
#define XB_XCNT(j)  (256  + 64 * (j))
#define XB_XSUB(j)  (1280 + 64 * (j))
#define XB_XGEN(j)  (2304 + 64 * (j))
#define XB_TOP      3328
#define XB_TOPGEN   3392
#define XCD_BAR_WORDS 3456
#define XB_SPIN_CAP (1u << 18)

__device__ __forceinline__ unsigned xb_ld(unsigned* p)              { return __hip_atomic_load(p, __ATOMIC_RELAXED, __HIP_MEMORY_SCOPE_AGENT); }
__device__ __forceinline__ unsigned xb_add(unsigned* p, unsigned v) { return __hip_atomic_fetch_add(p, v, __ATOMIC_RELAXED, __HIP_MEMORY_SCOPE_AGENT); }
__device__ __forceinline__ unsigned xb_xcc_id() { return (unsigned)__builtin_amdgcn_s_getreg((3 << 11) | 20) & 0xFu; }
#define XB_SPIN(cond, bar) do { unsigned _sp = 0; while (cond) { __builtin_amdgcn_s_sleep(1); \
    if ((++_sp & 255u) == 0u) { if (xb_ld(&(bar)[XB_TMO])) break; if (_sp > XB_SPIN_CAP) { atomicAdd(&(bar)[XB_TMO], 1u); break; } } } } while (0)

struct XcdBarrier { unsigned* bar; unsigned x; volatile LAS unsigned* st; };

__device__ __forceinline__ XcdBarrier xcd_barrier_post(unsigned* bar, volatile LAS unsigned* st) {
    XcdBarrier b; b.bar = bar; b.x = xb_xcc_id(); b.st = st;
    if (threadIdx.x == 0) (void)xb_add(&bar[XB_XCNT(b.x)], 1u);
    return b;
}
__device__ __forceinline__ void xcd_barrier_complete(unsigned* bar, unsigned x, unsigned& nloc, unsigned& nx) {
    const unsigned G = gridDim.x * gridDim.y * gridDim.z;
    unsigned sum, cnt, mine, sp = 0u;
    for (;;) {
        sum = 0u; cnt = 0u; mine = 0u;
#pragma unroll
        for (unsigned j = 0; j < 16; ++j) { const unsigned c = xb_ld(&bar[XB_XCNT(j)]); sum += c; cnt += (c > 0u) ? 1u : 0u; mine = (j == x) ? c : mine; }
        if (sum == G) break;
        __builtin_amdgcn_s_sleep(1);
        if ((++sp & 255u) == 0u) { if (xb_ld(&bar[XB_TMO])) break; if (sp > XB_SPIN_CAP) { atomicAdd(&bar[XB_TMO], 1u); break; } }
    }
    nloc = mine > 0u ? mine : 1u; nx = cnt > 0u ? cnt : 1u;
}
__device__ __forceinline__ void xcd_barrier(const XcdBarrier& b) {
    asm volatile("s_waitcnt vmcnt(0)" ::: "memory");
    __syncthreads();
    if (threadIdx.x == 0) {
        unsigned* bar = b.bar;
        __builtin_amdgcn_s_waitcnt(0);
        unsigned nloc = b.st[0], nx = b.st[1];
        if (nloc == 0u) { xcd_barrier_complete(bar, b.x, nloc, nx); b.st[0] = nloc; b.st[1] = nx; }
        const unsigned old = xb_add(&bar[XB_XSUB(b.x)], 1u);
        const unsigned gen = old / nloc;
        if (old + 1u == (gen + 1u) * nloc) {
            __builtin_amdgcn_fence(__ATOMIC_RELEASE, "agent");
            asm volatile("s_waitcnt vmcnt(0)" ::: "memory");
            const unsigned og = xb_add(&bar[XB_TOP], 1u);
            const unsigned tg = og / nx;
            if (og + 1u == (tg + 1u) * nx) xb_add(&bar[XB_TOPGEN], 1u);
            else XB_SPIN(xb_ld(&bar[XB_TOPGEN]) == tg, bar);
            __builtin_amdgcn_fence(__ATOMIC_ACQUIRE, "agent");
            xb_add(&bar[XB_XGEN(b.x)], 1u);
            asm volatile("s_waitcnt vmcnt(0)" ::: "memory");
        } else {
            XB_SPIN(xb_ld(&bar[XB_XGEN(b.x)]) == gen, bar);
            __builtin_amdgcn_fence(__ATOMIC_ACQUIRE, "agent");
            asm volatile("s_waitcnt vmcnt(0)" ::: "memory");
        }
    }
    __syncthreads();
}
namespace pg8 {
constexpr int BM = 256, BK = 64, HALF = 128, HTB = HALF * BK * 2, STAGE_BYTES = 8 * HTB, NXCD = 8, WGM = 8;
__host__ __device__ __forceinline__ int lds_byte(int r, int c) { const int st = (r >> 4) * 2 + (c >> 5), rr = r & 15, cc = c & 31, ob = rr * 64 + cc * 2; return st * 1024 + (ob ^ (((ob >> 9) & 1) << 5)); }
__host__ __device__ __forceinline__ void stage_rc(int b, int& R, int& C) { const int st = b / 1024, sb = b % 1024, swz = sb ^ (((sb >> 9) & 1) << 5); R = (st >> 1) * 16 + swz / 64; C = (st & 1) * 32 + (swz % 64) / 2; }
__host__ __device__ __forceinline__ int perm32(int rho) { const int n = rho >> 4, i = rho & 15; return 8 * (i >> 2) + 4 * n + (i & 3); }

struct Unit { int pm, pn; };
struct Sched {
    int nM, nN, nwg, G, c;
    __device__ __forceinline__ void init(int nM_, int nN_, int G_, int c_) { nM = nM_; nN = nN_; nwg = nM * nN; G = G_; c = c_; }
    int head = 0, headM0 = 0;
    __device__ __forceinline__ bool next(int i, Unit& u) const {
        long L = (long)i * G + c;
        if (L < head) { u.pm = headM0 + (int)L / nN; u.pn = (int)L % nN; return true; }
        L -= head; if (L >= nwg) return false;
        int wgid = (int)L; { const int q = nwg / NXCD, r = nwg % NXCD, xcd = wgid % NXCD, off = wgid / NXCD; wgid = (xcd < r ? xcd * (q + 1) : r * (q + 1) + (xcd - r) * q) + off; }
        const int nig = WGM * nN, gid = wgid / nig, fm = gid * WGM, gsz = (nM - fm) < WGM ? (nM - fm) : WGM;
        u.pm = fm + ((wgid % nig) % gsz); u.pn = (wgid % nig) / gsz; return true;
    }
};
typedef f32x4 Acc[2][2][4][2];
#define PG8_NO_GATHER __device__ __forceinline__ int arow(const Unit&, int) const { return 0; }
#define PG8_NO_LITE static constexpr bool LITE = false; __device__ __forceinline__ bool lite(const Unit&) const { return false; }

template <class Op>
__device__ __forceinline__ void gemm_phase(LAS unsigned char* lds, const Op& op, const Sched& S, int tid) {
    asm volatile("" : "+v"(tid));
    const int wid = __builtin_amdgcn_readfirstlane(tid >> 6), lane = tid & 63, wr = wid >> 2, wc = wid & 3, fr = lane & 15, fq = lane >> 4;
    const int K = op.K, nt = K / BK, lda = op.lda, ldb = op.ldb;
    unsigned voffA[2], voffB[2]; int RA[2];
#pragma unroll
    for (int i = 0; i < 2; ++i) { int R, C; stage_rc(tid * 16 + i * 8192, R, C); const int Rb = Op::PERM ? ((R & ~31) + perm32(R & 31)) : R; RA[i] = R;
        voffA[i] = Op::GATHER ? (unsigned)C * 2u : (unsigned)(R * lda + C) * 2u; voffB[i] = (unsigned)(Rb * ldb + C) * 2u; }
    unsigned ga[2][2], gn[2][2];
#define PG8_GROWS(G, U) do { _Pragma("unroll") for (int _h = 0; _h < 2; ++_h) _Pragma("unroll") for (int _i = 0; _i < 2; ++_i) G[_h][_i] = (unsigned)op.arow(U, _h * HALF + RA[_i]) * (unsigned)(lda * 2); } while (0)
    const size_t kstep = (size_t)(BK * 2);
    const size_t hstepA = (size_t)HALF * lda * 2, hstepB = (size_t)HALF * ldb * 2;
    const unsigned ldsw = (unsigned)wid * 1024u;
    const int aoff = lds_byte(wr * 64 + fr, fq * 8), boff = lds_byte(wc * 32 + fr, fq * 8);
#define PG8_SA(b, h) (((b) * 2 + (h)) * HTB)
#define PG8_SB(b, h) ((4 + (b) * 2 + (h)) * HTB)
#define PG8_STAGE(bufoff, gbase, voff) do { _Pragma("unroll") for (int _i = 0; _i < 2; ++_i) \
        __builtin_amdgcn_global_load_lds((const unsigned*)((const char*)(gbase) + (voff)[_i]), (LAS unsigned*)(lds + (bufoff) + ldsw + _i * 8192), 16, 0, 0); } while (0)
#define PG8_STAGE_A(bufoff, sel, h, kb) do { _Pragma("unroll") for (int _i = 0; _i < 2; ++_i) { const char* _p; \
        if constexpr (Op::GATHER) _p = (const char*)op.A + (kb) + (size_t)(((sel) ? gn[h][_i] : ga[h][_i]) + voffA[_i]); \
        else _p = ((sel) ? nA : cA) + (size_t)(h) * hstepA + (kb) + voffA[_i]; \
        __builtin_amdgcn_global_load_lds((const unsigned*)_p, (LAS unsigned*)(lds + (bufoff) + ldsw + _i * 8192), 16, 0, 0); } } while (0)
#define PG8_LDA(dst, b, h) do { _Pragma("unroll") for (int m = 0; m < 4; ++m) _Pragma("unroll") for (int k = 0; k < 2; ++k) dst[m][k] = *(const LAS bf16x8*)(lds + PG8_SA(b, h) + aoff + m * 2048 + k * 1024); } while (0)
#define PG8_LDB(dst, b, h) do { _Pragma("unroll") for (int n = 0; n < 2; ++n) _Pragma("unroll") for (int k = 0; k < 2; ++k) dst[n][k] = *(const LAS bf16x8*)(lds + PG8_SB(b, h) + boff + n * 2048 + k * 1024); } while (0)
#define PG8_MMA(ai, bj, At, Bt) do { if (Op::LITE && lite && ((ai) == 1 || wr == 1)) break; __builtin_amdgcn_s_setprio(1); _Pragma("unroll") for (int m = 0; m < 4; ++m) _Pragma("unroll") for (int n = 0; n < 2; ++n) _Pragma("unroll") for (int k = 0; k < 2; ++k) \
        acc[ai][bj][m][n] = __builtin_amdgcn_mfma_f32_16x16x32_bf16(Bt[n][k], At[m][k], acc[ai][bj][m][n], 0, 0, 0); __builtin_amdgcn_s_setprio(0); } while (0)
#define PG8_WAIT_V(n) asm volatile("s_waitcnt vmcnt(" #n ")" ::: "memory")
#define PG8_WAIT_L(n) asm volatile("s_waitcnt lgkmcnt(" #n ")" ::: "memory")
#define PG8_BAR __builtin_amdgcn_s_barrier()
#define PG8_SCHED __builtin_amdgcn_sched_barrier(0)
    Unit cur, nxt; int ui = 0;
    if (!S.next(0, cur)) return;
    bool lite = Op::LITE ? op.lite(cur) : false;
    Acc acc;
#pragma unroll
    for (int a = 0; a < 2; ++a)
#pragma unroll
        for (int b = 0; b < 2; ++b)
#pragma unroll
            for (int m = 0; m < 4; ++m)
#pragma unroll
                for (int n = 0; n < 2; ++n) acc[a][b][m][n] = (f32x4){0.f, 0.f, 0.f, 0.f};
    bf16x8 At[4][2], B0[2][2], B1[2][2];
    const char* cA = (const char*)op.A + op.aoff(cur); const char* cB = (const char*)op.Bt + op.boff(cur); const char* nA = cA;
    if constexpr (Op::GATHER) { PG8_GROWS(ga, cur); if (S.next(1, nxt)) PG8_GROWS(gn, nxt); else PG8_GROWS(gn, cur);
        asm volatile("" :: "v"(ga[0][0]), "v"(ga[0][1]), "v"(ga[1][0]), "v"(ga[1][1]), "v"(gn[0][0]), "v"(gn[0][1]), "v"(gn[1][0]), "v"(gn[1][1])); }
    PG8_STAGE(PG8_SB(0, 0), cB, voffB); PG8_STAGE(PG8_SB(0, 1), cB + hstepB, voffB); PG8_STAGE_A(PG8_SA(0, 0), false, 0, 0); PG8_STAGE_A(PG8_SA(0, 1), false, 1, 0);
    if (wr == 1) PG8_BAR;
    PG8_WAIT_V(2); PG8_BAR;
    PG8_STAGE(PG8_SB(1, 0), cB + kstep, voffB); PG8_STAGE_A(PG8_SA(1, 0), false, 0, kstep); PG8_STAGE(PG8_SB(1, 1), cB + hstepB + kstep, voffB);
    PG8_WAIT_V(6); PG8_BAR;
    for (;;) {
        const bool has_next = S.next(ui + 1, nxt);
        nA = has_next ? (const char*)op.A + op.aoff(nxt) : cA; const char* nB = has_next ? (const char*)op.Bt + op.boff(nxt) : cB;
        for (int t = 0; t < nt; t += 2) {
            const bool last = (t == nt - 2), seln = last && has_next;
            const size_t k1 = (size_t)(t + 1) * kstep, k2 = last ? 0 : (size_t)(t + 2) * kstep, k3 = k2 + kstep;
            const char* b2 = last ? nB : cB + (size_t)(t + 2) * kstep; const char* b3 = b2 + kstep;
            PG8_LDB(B0, 0, 0); PG8_LDB(B1, 0, 1); PG8_SCHED; PG8_LDA(At, 0, 0); PG8_STAGE_A(PG8_SA(1, 1), false, 1, k1);
            PG8_WAIT_V(8); PG8_WAIT_L(0); PG8_BAR; PG8_MMA(0, 0, At, B0); PG8_MMA(0, 1, At, B1); PG8_BAR; PG8_SCHED;
            PG8_LDA(At, 0, 1); PG8_STAGE(PG8_SB(0, 0), b2, voffB); PG8_STAGE(PG8_SB(0, 1), b2 + hstepB, voffB); PG8_STAGE_A(PG8_SA(0, 0), seln, 0, k2);
            PG8_WAIT_V(8); PG8_WAIT_L(0); PG8_BAR; PG8_MMA(1, 0, At, B0); PG8_MMA(1, 1, At, B1); PG8_BAR; PG8_SCHED;
            PG8_LDB(B0, 1, 0); PG8_LDB(B1, 1, 1); PG8_SCHED; PG8_LDA(At, 1, 0); PG8_STAGE_A(PG8_SA(0, 1), seln, 1, k2);
            PG8_WAIT_V(8); PG8_WAIT_L(0); PG8_BAR; PG8_MMA(0, 0, At, B0); PG8_MMA(0, 1, At, B1); PG8_BAR; PG8_SCHED;
            PG8_LDA(At, 1, 1); PG8_STAGE(PG8_SB(1, 0), b3, voffB); PG8_STAGE(PG8_SB(1, 1), b3 + hstepB, voffB); PG8_STAGE_A(PG8_SA(1, 0), seln, 0, k3);
            PG8_WAIT_V(8); PG8_WAIT_L(0); PG8_BAR; PG8_MMA(1, 0, At, B0); PG8_MMA(1, 1, At, B1); PG8_BAR; PG8_SCHED;
        }
        if (wr == 0) PG8_BAR;
        op(acc, cur, wr, wc, fr, fq);
        if (!has_next) break;
#pragma unroll
        for (int a = 0; a < 2; ++a)
#pragma unroll
            for (int b = 0; b < 2; ++b)
#pragma unroll
                for (int m = 0; m < 4; ++m)
#pragma unroll
                    for (int n = 0; n < 2; ++n) acc[a][b][m][n] = (f32x4){0.f, 0.f, 0.f, 0.f};
        cur = nxt; cA = nA; cB = nB; ++ui; lite = Op::LITE ? op.lite(cur) : false;
        if constexpr (Op::GATHER) {
#pragma unroll
            for (int _h = 0; _h < 2; ++_h)
#pragma unroll
                for (int _i = 0; _i < 2; ++_i) ga[_h][_i] = gn[_h][_i];
            Unit n2; if (S.next(ui + 1, n2)) PG8_GROWS(gn, n2);
            asm volatile("" :: "v"(gn[0][0]), "v"(gn[0][1]), "v"(gn[1][0]), "v"(gn[1][1]));
        }
        if (wr == 1) PG8_BAR;
    }
    PG8_WAIT_V(0);
    PG8_BAR;
#undef PG8_SA
#undef PG8_SB
#undef PG8_STAGE
#undef PG8_STAGE_A
#undef PG8_GROWS
#undef PG8_LDA
#undef PG8_LDB
#undef PG8_MMA
#undef PG8_WAIT_V
#undef PG8_WAIT_L
#undef PG8_BAR
#undef PG8_SCHED
}

__device__ __forceinline__ u32x4 pack8(const f32x4 a, const f32x4 b) { u32x4 w; w.x = cvt_pk_bf16(a[0], a[1]); w.y = cvt_pk_bf16(a[2], a[3]); w.z = cvt_pk_bf16(b[0], b[1]); w.w = cvt_pk_bf16(b[2], b[3]); return w; }
__device__ __forceinline__ int moe_expert(int pm) { return pm < 256 ? (pm >> 4) : (pm - 256); }

template <bool MOE> struct OpStore {
    static constexpr bool PERM = true, GATHER = false; PG8_NO_GATHER static constexpr bool LITE = MOE; __device__ __forceinline__ bool lite(const Unit& u) const { return MOE && u.pm >= 256; }
    const bf16_t* A; const bf16_t* Bt; int lda, ldb, K; bf16_t* out; int ldc; const float* bias;
    __device__ __forceinline__ size_t aoff(const Unit& u) const { return (size_t)u.pm * 256 * lda * 2; }
    __device__ __forceinline__ size_t boff(const Unit& u) const { return MOE ? ((size_t)moe_expert(u.pm) * 2048 + (size_t)u.pn * 256) * ldb * 2 : (size_t)u.pn * 256 * ldb * 2; }
    __device__ __forceinline__ void operator()(const Acc& acc, const Unit& u, int wr, int wc, int fr, int fq) const {
        const int row0 = u.pm * 256 + wr * 64 + fr, col0 = u.pn * 256 + wc * 32 + 8 * fq;
#pragma unroll
        for (int ai = 0; ai < 2; ++ai)
#pragma unroll
            for (int m = 0; m < 4; ++m) { bf16_t* rowp = out + (size_t)(row0 + ai * 128 + m * 16) * ldc + col0;
#pragma unroll
                for (int bj = 0; bj < 2; ++bj) { f32x4 v0 = acc[ai][bj][m][0], v1 = acc[ai][bj][m][1];
                    if (bias) { v0 += *(const f32x4*)(bias + col0 + bj * 128); v1 += *(const f32x4*)(bias + col0 + bj * 128 + 4); }
                    *(u32x4*)(rowp + bj * 128) = pack8(v0, v1); } }
    }
};
struct OpWin {
    static constexpr bool PERM = true, GATHER = false; PG8_NO_GATHER PG8_NO_LITE
    const bf16_t* A; const bf16_t* Bt; int lda, ldb, K; bf16_t* a3; bf16_t* zf;
    __device__ __forceinline__ size_t aoff(const Unit& u) const { return (size_t)u.pm * 256 * lda * 2; }
    __device__ __forceinline__ size_t boff(const Unit& u) const { return (size_t)u.pn * 256 * ldb * 2; }
    __device__ __forceinline__ void operator()(const Acc& acc, const Unit& u, int wr, int wc, int fr, int fq) const {
        const int row0 = u.pm * 256 + wr * 64 + fr, col0 = u.pn * 256 + wc * 32 + 8 * fq;
#pragma unroll
        for (int ai = 0; ai < 2; ++ai)
#pragma unroll
            for (int m = 0; m < 4; ++m) { const int row = row0 + ai * 128 + m * 16;
#pragma unroll
                for (int bj = 0; bj < 2; ++bj) { const int c = col0 + bj * 128; const u32x4 w = pack8(acc[ai][bj][m][0], acc[ai][bj][m][1]);
                    if (u.pn < 4) { const int g = c >> 4; *(u32x4*)(a3 + ((size_t)(g * NCHP + (row >> 5)) * A3K + (row & 31) * 16 + (c & 15))) = w; }
                    else *(u32x4*)(zf + (size_t)row * 1024 + (c - 1024)) = w; } }
    }
};
struct OpL1 {
    static constexpr bool PERM = false, GATHER = false; PG8_NO_GATHER PG8_NO_LITE
    const bf16_t* A; const bf16_t* Bt; int lda, ldb, K; float* sum;
    __device__ __forceinline__ size_t aoff(const Unit& u) const { const int g = u.pm / 5, rt = u.pm % 5; return (size_t)(g * NCHP + rt * 256) * A3K * 2; }
    __device__ __forceinline__ size_t boff(const Unit& u) const { return (size_t)(u.pm / 5) * 256 * 512 * 2; }
    __device__ __forceinline__ void operator()(const Acc& acc, const Unit& u, int wr, int wc, int fr, int fq) const {
        const int g = u.pm / 5, rt = u.pm % 5, row0 = rt * 256 + wr * 64 + fr, col0 = wc * 32 + 4 * fq;
#pragma unroll
        for (int ai = 0; ai < 2; ++ai)
#pragma unroll
            for (int m = 0; m < 4; ++m) { float* rowp = sum + ((size_t)(g * NCHP + row0 + ai * 128 + m * 16)) * 256 + col0;
#pragma unroll
                for (int bj = 0; bj < 2; ++bj)
#pragma unroll
                    for (int n = 0; n < 2; ++n) *(f32x4*)(rowp + bj * 128 + n * 16) = acc[ai][bj][m][n]; }
    }
};
struct OpL3 {
    static constexpr bool PERM = true, GATHER = false; PG8_NO_GATHER PG8_NO_LITE
    const bf16_t* A; const bf16_t* Bt; int lda, ldb, K; bf16_t* gout;
    __device__ __forceinline__ size_t aoff(const Unit& u) const { const int g = u.pm / 5, rt = u.pm % 5; return (size_t)(g * NCHP + rt * 256) * A3K * 2; }
    __device__ __forceinline__ size_t boff(const Unit& u) const { return ((size_t)(u.pm / 5) * 512 + (size_t)u.pn * 256) * A3K * 2; }
    __device__ __forceinline__ void operator()(const Acc& acc, const Unit& u, int wr, int wc, int fr, int fq) const {
        const int g = u.pm / 5, rt = u.pm % 5, row0 = rt * 256 + wr * 64 + fr, col0 = u.pn * 256 + wc * 32 + 8 * fq;
#pragma unroll
        for (int ai = 0; ai < 2; ++ai)
#pragma unroll
            for (int m = 0; m < 4; ++m) { const int chunk = row0 + ai * 128 + m * 16;
                if (chunk < NCH) {
#pragma unroll
                    for (int bj = 0; bj < 2; ++bj) { const int c = col0 + bj * 128, t = c >> 4, co = c & 15; f32x4 v0 = acc[ai][bj][m][0], v1 = acc[ai][bj][m][1];
#pragma unroll
                        for (int i = 0; i < 4; ++i) { v0[i] = gelu_tanh(v0[i]); v1[i] = gelu_tanh(v1[i]); }
                        *(u32x4*)(gout + ((size_t)(chunk * 32 + t)) * 1024 + g * 16 + co) = pack8(v0, v1); } } }
    }
};
struct OpGlu {
    static constexpr bool PERM = true, GATHER = false; PG8_NO_GATHER PG8_NO_LITE
    const bf16_t* A; const bf16_t* Bt; int lda, ldb, K; const float* bias; bf16_t* cat;
    __device__ __forceinline__ size_t aoff(const Unit& u) const { return (size_t)u.pm * 256 * lda * 2; }
    __device__ __forceinline__ size_t boff(const Unit& u) const { return (size_t)u.pn * 256 * ldb * 2; }
    __device__ __forceinline__ void operator()(const Acc& acc, const Unit& u, int wr, int wc, int fr, int fq) const {
        const int row0 = u.pm * 256 + wr * 64 + fr, col0 = u.pn * 256 + wc * 32 + 8 * fq;
#pragma unroll
        for (int ai = 0; ai < 2; ++ai)
#pragma unroll
            for (int m = 0; m < 4; ++m) { const int row = row0 + ai * 128 + m * 16;
#pragma unroll
                for (int bj = 0; bj < 2; ++bj) { const int c = col0 + bj * 128;
                    const f32x4 b0 = *(const f32x4*)(bias + c), b1 = *(const f32x4*)(bias + c + 4);
                    const u32x4 gw = *(const u32x4*)(A + (size_t)row * 1024 + c);
                    f32x4 g0, g1; g0[0] = bf2f(gw.x & 0xffffu); g0[1] = bf2f(gw.x >> 16); g0[2] = bf2f(gw.y & 0xffffu); g0[3] = bf2f(gw.y >> 16);
                    g1[0] = bf2f(gw.z & 0xffffu); g1[1] = bf2f(gw.z >> 16); g1[2] = bf2f(gw.w & 0xffffu); g1[3] = bf2f(gw.w >> 16);
                    f32x4 v0 = acc[ai][bj][m][0] + b0, v1 = acc[ai][bj][m][1] + b1;
#pragma unroll
                    for (int i = 0; i < 4; ++i) { v0[i] = g0[i] * sigmoid_fast(v0[i]); v1[i] = g1[i] * sigmoid_fast(v1[i]); }
                    *(u32x4*)(cat + (size_t)row * 2048 + c) = pack8(v0, v1); } }
    }
};
struct OpFftA {
    static constexpr bool PERM = true, GATHER = false; PG8_NO_GATHER PG8_NO_LITE
    const bf16_t* A; const bf16_t* Bt; int lda, ldb, K; bf16_t* bt2;
    __device__ __forceinline__ size_t aoff(const Unit&) const { return 0; }
    __device__ __forceinline__ size_t boff(const Unit& u) const { return (size_t)u.pn * 256 * 128 * 2; }
    __device__ __forceinline__ void operator()(const Acc& acc, const Unit& u, int wr, int wc, int fr, int fq) const {
        const int l2b = wc * 32 + 8 * fq;
#pragma unroll
        for (int ai = 0; ai < 2; ++ai)
#pragma unroll
            for (int m = 0; m < 4; ++m) { const int k1 = wr * 64 + m * 16 + fr;
#pragma unroll
                for (int bj = 0; bj < 2; ++bj) { const int col = 2 * u.pn + bj;
                    *(u32x4*)(bt2 + ((size_t)(k1 * 2048 + col)) * 256 + ai * 128 + l2b) = pack8(acc[ai][bj][m][0], acc[ai][bj][m][1]); } }
    }
};
struct OpFftC {
    static constexpr bool PERM = true, GATHER = false; PG8_NO_GATHER PG8_NO_LITE
    const bf16_t* A; const bf16_t* Bt; int lda, ldb, K; bf16_t* pq;
    __device__ __forceinline__ size_t aoff(const Unit& u) const { return (size_t)(u.pn >> 3) * 256 * 256 * 2; }
    __device__ __forceinline__ size_t boff(const Unit& u) const { return (size_t)u.pn * 256 * 256 * 2; }
    __device__ __forceinline__ void operator()(const Acc& acc, const Unit& u, int wr, int wc, int fr, int fq) const {
        const int k1 = u.pn >> 3;
#pragma unroll
        for (int ai = 0; ai < 2; ++ai)
#pragma unroll
            for (int m = 0; m < 4; ++m) { const int k2 = wr * 64 + m * 16 + fr, k = k1 + 128 * k2;
#pragma unroll
                for (int bj = 0; bj < 2; ++bj) { const int colb = (u.pn & 7) * 256 + bj * 128 + wc * 32 + 8 * fq, b = colb >> 10, ch = colb & 1023, g = ch >> 8, c = ch & 255;
                    *(u32x4*)(pq + ((size_t)(b * RPB + CTX + k)) * 2048 + g * 512 + ai * 256 + c) = pack8(acc[ai][bj][m][0], acc[ai][bj][m][1]); } }
    }
};
struct OpCtxDft {
    static constexpr bool PERM = true, GATHER = false; PG8_NO_GATHER PG8_NO_LITE
    const bf16_t* A; const bf16_t* Bt; int lda, ldb, K; bf16_t* pq;
    __device__ __forceinline__ size_t aoff(const Unit& u) const { return (size_t)u.pm * 256 * 256 * 2; }
    __device__ __forceinline__ size_t boff(const Unit& u) const { return (size_t)u.pn * 256 * 256 * 2; }
    __device__ __forceinline__ void operator()(const Acc& acc, const Unit& u, int wr, int wc, int fr, int fq) const {
#pragma unroll
        for (int ai = 0; ai < 2; ++ai)
#pragma unroll
            for (int m = 0; m < 4; ++m) { const int k = ai * 128 + wr * 64 + m * 16 + fr;
#pragma unroll
                for (int bj = 0; bj < 2; ++bj) { const int colb = u.pn * 256 + bj * 128 + wc * 32 + 8 * fq, b = colb >> 10, ch = colb & 1023, g = ch >> 8, c = ch & 255;
                    *(u32x4*)(pq + ((size_t)(b * RPB + k)) * 2048 + g * 512 + u.pm * 256 + c) = pack8(acc[ai][bj][m][0], acc[ai][bj][m][1]); } }
    }
};
struct OpFnet {
    static constexpr bool PERM = true, GATHER = false; PG8_NO_GATHER PG8_NO_LITE
    const bf16_t* A; const bf16_t* Bt; int lda, ldb, K; const float* bias; bf16_t* cat;
    __device__ __forceinline__ size_t aoff(const Unit& u) const { return (size_t)u.pm * 256 * lda * 2 + (size_t)u.pn * 512 * 2; }
    __device__ __forceinline__ size_t boff(const Unit& u) const { return (size_t)u.pn * 256 * 512 * 2; }
    __device__ __forceinline__ void operator()(const Acc& acc, const Unit& u, int wr, int wc, int fr, int fq) const {
        const int row0 = u.pm * 256 + wr * 64 + fr, col0 = u.pn * 256 + wc * 32 + 8 * fq;
#pragma unroll
        for (int ai = 0; ai < 2; ++ai)
#pragma unroll
            for (int m = 0; m < 4; ++m) { const int row = row0 + ai * 128 + m * 16;
#pragma unroll
                for (int bj = 0; bj < 2; ++bj) { const int c = col0 + bj * 128;
                    const f32x4 v0 = acc[ai][bj][m][0] + *(const f32x4*)(bias + c), v1 = acc[ai][bj][m][1] + *(const f32x4*)(bias + c + 4);
                    *(u32x4*)(cat + (size_t)row * 2048 + 1024 + c) = pack8(v0, v1); } }
    }
};
struct OpM1 {
    static constexpr bool PERM = true, GATHER = true, LITE = true; __device__ __forceinline__ bool lite(const Unit& u) const { return u.pm >= 256; }
    const bf16_t* A; const bf16_t* Bt; int lda, ldb, K; bf16_t* hid; const int* idx;
    __device__ __forceinline__ size_t aoff(const Unit&) const { return 0; }
    __device__ __forceinline__ int arow(const Unit& u, int r) const { const int m = u.pm * 256 + r; const bool ok = m < NEXP * 4096 || ((m - NEXP * 4096) & 255) < 2 * CAP_C; return ok ? idx[m] : 0; }
    __device__ __forceinline__ size_t boff(const Unit& u) const { return ((size_t)moe_expert(u.pm) * 2048 + (size_t)u.pn * 256) * ldb * 2; }
    __device__ __forceinline__ void operator()(const Acc& acc, const Unit& u, int wr, int wc, int fr, int fq) const {
        const int row0 = u.pm * 256 + wr * 64 + fr, f0 = u.pn * 128 + wc * 16 + 4 * fq;
#pragma unroll
        for (int ai = 0; ai < 2; ++ai)
#pragma unroll
            for (int m = 0; m < 4; ++m) { bf16_t* rowp = hid + (size_t)(row0 + ai * 128 + m * 16) * EFF + f0;
#pragma unroll
                for (int bj = 0; bj < 2; ++bj) { const f32x4 gt = acc[ai][bj][m][0], up = acc[ai][bj][m][1]; f32x4 h;
#pragma unroll
                    for (int i = 0; i < 4; ++i) h[i] = gt[i] * sigmoid_fast(gt[i]) * up[i];
                    u32x2 w; w.x = cvt_pk_bf16(h[0], h[1]); w.y = cvt_pk_bf16(h[2], h[3]);
                    *(u32x2*)(rowp + bj * 64) = w; } }
    }
};
}
namespace att {
constexpr int D = 128, NW = 8, QBLK = 32, KVBLK = 64;
constexpr float SCALE = 0.088388347648318440f;
constexpr float THR = 8.f;
constexpr int LDQ = 3072, LDK = 3072, LDO = 2048;
constexpr size_t SHM_V = KVBLK * D * 2, SHM_K = KVBLK * D * 2, SHM_ATTN = 2 * SHM_V + 2 * SHM_K + NW * 64 * 4;
#define KSWZ(row, colB) ((row) * 256 + ((colB) ^ (((row) & 7) << 4)))
#define SBAR() __builtin_amdgcn_sched_barrier(0)
__device__ __forceinline__ int crow(int r, int hi) { return (r & 3) + 8 * (r >> 2) + 4 * hi; }
__device__ __forceinline__ unsigned cvtpk(float lo, float hi) { unsigned r; asm volatile("v_cvt_pk_bf16_f32 %0, %1, %2" : "=v"(r) : "v"(lo), "v"(hi)); return r; }

__device__ __forceinline__ void partialSM(f32x16& p0, f32x16& p1, float& m_reg, float& mn, float& alpha) {
  constexpr float C = SCALE * 1.4426950408889634f;
  float pmax = p0[0]; for (int r = 1; r < 16; ++r) pmax = fmaxf(pmax, p0[r]); for (int r = 0; r < 16; ++r) pmax = fmaxf(pmax, p1[r]);
  { auto rr = __builtin_amdgcn_permlane32_swap(__float_as_uint(pmax), __float_as_uint(pmax), false, false);
    pmax = fmaxf(__uint_as_float(rr[0]), __uint_as_float(rr[1])); }
  if (__builtin_expect(__all(pmax - m_reg <= THR / SCALE), 1)) { mn = m_reg; alpha = 1.f; }
  else { mn = fmaxf(m_reg, pmax); alpha = __builtin_amdgcn_exp2f((m_reg - mn) * C); m_reg = mn; }
  float mnC = -mn * C;
  for (int r = 0; r < 16; ++r) p0[r] = fmaf(p0[r], C, mnC); for (int r = 0; r < 16; ++r) p1[r] = fmaf(p1[r], C, mnC);
  for (int r = 0; r < 16; ++r) p0[r] = __builtin_amdgcn_exp2f(p0[r]);
}
__device__ __forceinline__ void partialSM_fix(f32x16& p0, f32x16& p1) {
  for (int r = 0; r < 16; ++r) p0[r] = __builtin_amdgcn_exp2f(p0[r]);
}
__device__ __forceinline__ void finishSM(f32x16& p0, f32x16& p1, float alpha, float& l_reg, bf16x8& pa0, bf16x8& pa1, bf16x8& pa2, bf16x8& pa3) {
  for (int r = 0; r < 16; ++r) p1[r] = __builtin_amdgcn_exp2f(p1[r]);
  float ps = 0; for (int r = 0; r < 16; ++r) ps += p0[r]; for (int r = 0; r < 16; ++r) ps += p1[r];
  { auto rr = __builtin_amdgcn_permlane32_swap(__float_as_uint(ps), __float_as_uint(ps), false, false);
    ps = __uint_as_float(rr[0]) + __uint_as_float(rr[1]); }
  l_reg = l_reg * alpha + ps;
#define PK4(P, BASE, OUT) do { unsigned a0 = cvtpk(P[BASE + 0], P[BASE + 1]), a1 = cvtpk(P[BASE + 2], P[BASE + 3]);   \
    unsigned b0 = cvtpk(P[BASE + 4], P[BASE + 5]), b1 = cvtpk(P[BASE + 6], P[BASE + 7]);                              \
    auto r0 = __builtin_amdgcn_permlane32_swap(a0, b0, false, false); auto r1 = __builtin_amdgcn_permlane32_swap(a1, b1, false, false); \
    u32x4 w = {r0[0], r1[0], r0[1], r1[1]}; OUT = *reinterpret_cast<bf16x8*>(&w); } while (0)
  PK4(p0, 0, pa0); PK4(p0, 8, pa1); PK4(p1, 0, pa2); PK4(p1, 8, pa3);
#undef PK4
}
__device__ __forceinline__ void partialSM_fix2(f32x16& p0, float& l_reg) {
  for (int r = 0; r < 16; ++r) { p0[r] = __builtin_amdgcn_exp2f(p0[r]); l_reg += p0[r]; }
}
__device__ __forceinline__ void finishSM2(f32x16& p0, f32x16& p1, float& l_reg, bf16x8& pa0, bf16x8& pa1, bf16x8& pa2, bf16x8& pa3) {
#define PK4(P, BASE, OUT) do { unsigned a0 = cvtpk(P[BASE + 0], P[BASE + 1]), a1 = cvtpk(P[BASE + 2], P[BASE + 3]);   \
    unsigned b0 = cvtpk(P[BASE + 4], P[BASE + 5]), b1 = cvtpk(P[BASE + 6], P[BASE + 7]);                              \
    u32x4 w = {a0, a1, b0, b1}; OUT = *reinterpret_cast<bf16x8*>(&w); } while (0)
  PK4(p0, 0, pa0); PK4(p0, 8, pa1);
  for (int r = 0; r < 8; ++r) { p1[r] = __builtin_amdgcn_exp2f(p1[r]); l_reg += p1[r]; }
  PK4(p1, 0, pa2);
  for (int r = 8; r < 16; ++r) { p1[r] = __builtin_amdgcn_exp2f(p1[r]); l_reg += p1[r]; }
  PK4(p1, 8, pa3);
#undef PK4
}
__device__ __forceinline__ void qkt(f32x16& p0, f32x16& p1, const bf16_t* Ks, const bf16x8* qr, int r32, int hi) {
  p0 = f32x16{}; p1 = f32x16{};
  for (int d0 = 0; d0 < 8; ++d0) { int cb = (d0 * 16 + hi * 8) * 2;
    bf16x8 b0 = *reinterpret_cast<const bf16x8*>((const char*)Ks + KSWZ(r32, cb));
    bf16x8 b1 = *reinterpret_cast<const bf16x8*>((const char*)Ks + KSWZ(32 + r32, cb));
    p0 = __builtin_amdgcn_mfma_f32_32x32x16_bf16(b0, qr[d0], p0, 0, 0, 0);
    p1 = __builtin_amdgcn_mfma_f32_32x32x16_bf16(b1, qr[d0], p1, 0, 0, 0); }
}
__device__ __forceinline__ int v_st(int k, int c) { const int kk = (k & ~0xC) | ((k & 4) << 1) | ((k & 8) >> 1); return ((kk >> 3) * 4 + (c >> 5)) * 512 + ((kk & 7) * 32 + (c & 31)) * 2; }
__device__ __forceinline__ int v_rd_base(int lane) { return ((lane & 3) << 3) | (((lane >> 2) & 3) << 6) | (((lane >> 4) & 1) << 5) | (((lane >> 5) & 1) << 8); }
constexpr int v_rd_off(int d0, int ks, int half) { return d0 * 512 + ks * 4096 + half * 2048; }
template <int OFF> __device__ __forceinline__ s16x4 tr_read(int vb) {
  s16x4 r; asm volatile("ds_read_b64_tr_b16 %0, %1 offset:%2" : "=&v"(r) : "v"(vb), "i"(OFF) : "memory"); return r;
}
template <int D0> __device__ __forceinline__ void pv_one(f32x16& od, int vb, bf16x8 pa0, bf16x8 pa1, bf16x8 pa2, bf16x8 pa3) {
  const s16x4 l0 = tr_read<v_rd_off(D0, 0, 0)>(vb), h0 = tr_read<v_rd_off(D0, 0, 1)>(vb), l1 = tr_read<v_rd_off(D0, 1, 0)>(vb), h1 = tr_read<v_rd_off(D0, 1, 1)>(vb);
  const s16x4 l2 = tr_read<v_rd_off(D0, 2, 0)>(vb), h2 = tr_read<v_rd_off(D0, 2, 1)>(vb), l3 = tr_read<v_rd_off(D0, 3, 0)>(vb), h3 = tr_read<v_rd_off(D0, 3, 1)>(vb);
  asm volatile("s_waitcnt lgkmcnt(0)" ::: "memory"); SBAR();
#define PK(L, H) (bf16x8){L[0], L[1], L[2], L[3], H[0], H[1], H[2], H[3]}
  od = __builtin_amdgcn_mfma_f32_32x32x16_bf16(pa0, PK(l0, h0), od, 0, 0, 0);
  od = __builtin_amdgcn_mfma_f32_32x32x16_bf16(pa1, PK(l1, h1), od, 0, 0, 0);
  od = __builtin_amdgcn_mfma_f32_32x32x16_bf16(pa2, PK(l2, h2), od, 0, 0, 0);
  od = __builtin_amdgcn_mfma_f32_32x32x16_bf16(pa3, PK(l3, h3), od, 0, 0, 0);
#undef PK
}
__device__ __forceinline__ void pv_d0(f32x16* o, int vb, bf16x8 pa0, bf16x8 pa1, bf16x8 pa2, bf16x8 pa3) {
  pv_one<0>(o[0], vb, pa0, pa1, pa2, pa3); pv_one<1>(o[1], vb, pa0, pa1, pa2, pa3); pv_one<2>(o[2], vb, pa0, pa1, pa2, pa3); pv_one<3>(o[3], vb, pa0, pa1, pa2, pa3);
}
template <bool FIXM>
__device__ __forceinline__ void attn_dense_body(const bf16_t* __restrict__ Qb, const bf16_t* __restrict__ Kh, const bf16_t* __restrict__ Vh,
                                                bf16_t* __restrict__ Ob, int seq, char* lds, int tid, float mfixC) {
  asm volatile("" : "+v"(tid));
  const int wid = tid >> 6, lane = tid & 63, r32 = lane & 31, hi = lane >> 5;
  bf16_t* V_lds = (bf16_t*)lds; bf16_t* K_lds = (bf16_t*)(lds + 2 * SHM_V);
  float* ws = (float*)(lds + 2 * SHM_V + 2 * SHM_K) + wid * 64; float* li_l = ws; float* al_l = ws + 32;
  float m_reg = -1e30f, l_reg = 0; f32x16 o[4] = {}; bf16x8 qr[8];
  const bf16_t* Qw = Qb + (long)(wid * QBLK + r32) * LDQ + hi * 8;
#pragma unroll
  for (int d0 = 0; d0 < 8; ++d0) qr[d0] = *reinterpret_cast<const bf16x8*>(Qw + d0 * 16);
  const int sr = tid >> 4, sc = (tid & 15) * 8, vst0 = v_st(sr, sc), vst1 = v_st(32 + sr, sc);
  const int vb0 = (int)(uintptr_t)V_lds + v_rd_base(lane);
  struct { bf16x8 vs0, vs1, ks0, ks1; } sr_[2];
#define SLOAD(i, k0) do { sr_[i].vs0 = *reinterpret_cast<const bf16x8*>(&Vh[(long)((k0) + sr) * LDK + sc]); sr_[i].vs1 = *reinterpret_cast<const bf16x8*>(&Vh[(long)((k0) + 32 + sr) * LDK + sc]); \
    sr_[i].ks0 = *reinterpret_cast<const bf16x8*>(&Kh[(long)((k0) + sr) * LDK + sc]); sr_[i].ks1 = *reinterpret_cast<const bf16x8*>(&Kh[(long)((k0) + 32 + sr) * LDK + sc]); } while (0)
#define SWRITE(b, i) do { *(bf16x8*)((char*)V_lds + (b) * SHM_V + vst0) = sr_[i].vs0;          \
    *(bf16x8*)((char*)V_lds + (b) * SHM_V + vst1) = sr_[i].vs1; int kc = sc * 2;               \
    *(bf16x8*)((char*)K_lds + (b) * SHM_K + KSWZ(sr, kc)) = sr_[i].ks0;                       \
    *(bf16x8*)((char*)K_lds + (b) * SHM_K + KSWZ(32 + sr, kc)) = sr_[i].ks1; } while (0)
#define SWAIT() asm volatile("s_waitcnt vmcnt(4)" ::: "memory")
#define PSM(P0, P1, MN, AL) do { if constexpr (FIXM) { SBAR(); partialSM_fix(P0, P1); AL = 1.f; SBAR(); } else partialSM(P0, P1, m_reg, MN, AL); } while (0)
#define RESC(a) do { if constexpr (!FIXM) if (__any((a) < 1.f)) { if (hi == 0) al_l[r32] = (a); asm volatile("s_waitcnt lgkmcnt(0)" ::: "memory"); \
    for (int d = 0; d < 4; ++d) for (int r = 0; r < 16; ++r) o[d][r] *= al_l[crow(r, hi)]; } } while (0)
  f32x16 pA0, pA1, pB0, pB1; float mnA, mnB, alA, alB; bf16x8 pa0, pa1, pa2, pa3; const int NT = seq / KVBLK;
  constexpr int SE = 0, SO = 1;
  SLOAD(SE, 0); asm volatile("s_waitcnt vmcnt(0)" ::: "memory"); SWRITE(0, SE); __syncthreads();
  qkt(pA0, pA1, K_lds, qr, r32, hi); PSM(pA0, pA1, mnA, alA);
  SLOAD(SO, KVBLK); SLOAD(SE, 2 * KVBLK);
  SWAIT(); SWRITE(1, SO); __syncthreads();
  for (int j = 1; j + 1 < NT; j += 2) {
    SBAR(); qkt(pB0, pB1, (bf16_t*)((char*)K_lds + SHM_K), qr, r32, hi);
    finishSM(pA0, pA1, alA, l_reg, pa0, pa1, pa2, pa3); SBAR();
    SLOAD(SO, (j + 2) * KVBLK); SBAR();
    pv_d0(o, vb0, pa0, pa1, pa2, pa3); PSM(pB0, pB1, mnB, alB);
    __syncthreads(); SWAIT(); SWRITE(0, SE);
    RESC(alB); __syncthreads();
    SBAR(); qkt(pA0, pA1, K_lds, qr, r32, hi);
    finishSM(pB0, pB1, alB, l_reg, pa0, pa1, pa2, pa3); SBAR();
    SLOAD(SE, (j + 3 < NT ? j + 3 : NT - 1) * KVBLK); SBAR();
    pv_d0(o, vb0 + (int)SHM_V, pa0, pa1, pa2, pa3); PSM(pA0, pA1, mnA, alA);
    __syncthreads(); SWAIT(); SWRITE(1, SO);
    RESC(alA); __syncthreads();
  }
  SBAR(); qkt(pB0, pB1, (bf16_t*)((char*)K_lds + SHM_K), qr, r32, hi);
  finishSM(pA0, pA1, alA, l_reg, pa0, pa1, pa2, pa3); SBAR();
  pv_d0(o, vb0, pa0, pa1, pa2, pa3); PSM(pB0, pB1, mnB, alB);
  __syncthreads(); RESC(alB);
  finishSM(pB0, pB1, alB, l_reg, pa0, pa1, pa2, pa3); SBAR();
  pv_d0(o, vb0 + (int)SHM_V, pa0, pa1, pa2, pa3);
  if (hi == 0) li_l[r32] = l_reg; asm volatile("s_waitcnt lgkmcnt(0)" ::: "memory");
  float rli[16];
#pragma unroll
  for (int r = 0; r < 16; ++r) rli[r] = __builtin_amdgcn_rcpf(li_l[crow(r, hi)]);
  bf16_t* Ow = Ob + (long)(wid * QBLK) * LDO;
#pragma unroll
  for (int r = 0; r < 16; ++r) { int orow = crow(r, hi);
    for (int d0 = 0; d0 < 4; ++d0) Ow[(long)orow * LDO + d0 * 32 + r32] = (bf16_t)f2bf(o[d0][r] * rli[r]); }
  asm volatile("s_waitcnt vmcnt(0) lgkmcnt(0)" ::: "memory"); __syncthreads();
#undef SLOAD
#undef SWRITE
#undef SWAIT
#undef RESC
#undef PSM
}

template <int NT>
__device__ __forceinline__ void attn_ring3_body(const bf16_t* __restrict__ Qb, const bf16_t* __restrict__ Kh, const bf16_t* __restrict__ Vh, bf16_t* __restrict__ Ob, char* lds, int tid) {
  static_assert(NT >= 8, "ring body: at least 8 key tiles");
  asm volatile("" : "+v"(tid));
  const int wid = tid >> 6, lane = tid & 63, r32 = lane & 31, hi = lane >> 5;
  constexpr int VB = (int)SHM_V, KB = (int)SHM_K;
  bf16_t* K_lds = (bf16_t*)lds; bf16_t* V_lds = (bf16_t*)(lds + 3 * KB);
  float* ws = (float*)(lds + 3 * VB + 3 * KB) + wid * 64; float* li_l = ws;
  float l_reg = 0; f32x16 o[4] = {}; bf16x8 qr[8];
  const bf16_t* Qw = Qb + (long)(wid * QBLK + r32) * LDQ + hi * 8;
#pragma unroll
  for (int d0 = 0; d0 < 8; ++d0) qr[d0] = __builtin_nontemporal_load(reinterpret_cast<const bf16x8*>(Qw + d0 * 16));
  const int sr = tid >> 4, sc = (tid & 15) * 8, srp = (sr & ~0xC) | ((sr & 4) << 1) | ((sr & 8) >> 1), vst0 = v_st(srp, sc), vst1 = v_st(32 + srp, sc);
  const int vb0 = (int)(uintptr_t)V_lds + v_rd_base(lane);
  struct { bf16x8 vs0, vs1, ks0, ks1; } sr_[2];
#define SLOAD(i, t) do { const long k0_ = (long)((t) < NT ? (t) : NT - 1) * KVBLK; sr_[i].vs0 = *reinterpret_cast<const bf16x8*>(&Vh[(k0_ + sr) * LDK + sc]); sr_[i].vs1 = *reinterpret_cast<const bf16x8*>(&Vh[(k0_ + 32 + sr) * LDK + sc]); \
    sr_[i].ks0 = *reinterpret_cast<const bf16x8*>(&Kh[(k0_ + sr) * LDK + sc]); sr_[i].ks1 = *reinterpret_cast<const bf16x8*>(&Kh[(k0_ + 32 + sr) * LDK + sc]); } while (0)
#define SWRITE(b, i) do { *(bf16x8*)((char*)V_lds + (b) * VB + vst0) = sr_[i].vs0; *(bf16x8*)((char*)V_lds + (b) * VB + vst1) = sr_[i].vs1; const int kc = sc * 2; \
    *(bf16x8*)((char*)K_lds + (b) * KB + KSWZ(sr, kc)) = sr_[i].ks0; *(bf16x8*)((char*)K_lds + (b) * KB + KSWZ(32 + sr, kc)) = sr_[i].ks1; } while (0)
#define SWAIT() asm volatile("s_waitcnt vmcnt(4)" ::: "memory")
  f32x16 pA0, pA1, pB0, pB1; bf16x8 pa0, pa1, pa2, pa3;
  unsigned ca0, ca1, cb0, cb1; bf16x8 ka0, ka1, kb0, kb1; s16x4 va[4];
#define KRD(D0, B0, B1) do { B0 = *reinterpret_cast<const bf16x8*>(Kp + KSWZ(r32, ((D0) * 16 + hi * 8) * 2)); B1 = *reinterpret_cast<const bf16x8*>(Kp + KSWZ(32 + r32, ((D0) * 16 + hi * 8) * 2)); } while (0)
#define MQ(ACC, KF, D0) ACC = __builtin_amdgcn_mfma_f32_32x32x16_bf16(KF, qr[D0], ACC, 0, 0, 0)
#define EX(P, R) P[R] = __builtin_amdgcn_exp2f(P[R])
#define AD(P, R) l_reg += P[R]
#define CV(P, I, A, B) do { A = cvtpk(P[I], P[(I) + 1]); B = cvtpk(P[(I) + 2], P[(I) + 3]); } while (0)
#define PM(OUT) do { u32x4 w_ = {ca0, ca1, cb0, cb1}; OUT = *reinterpret_cast<bf16x8*>(&w_); } while (0)
#define RV(ARR, I, D0, KS) do { ARR[I] = tr_read<v_rd_off(D0, KS, 0)>(vbp); ARR[(I) + 1] = tr_read<v_rd_off(D0, KS, 1)>(vbp); } while (0)
#define PKV(L, H) (bf16x8){L[0], L[1], L[2], L[3], H[0], H[1], H[2], H[3]}
#define MP(D0, PA, ARR, I) o[D0] = __builtin_amdgcn_mfma_f32_32x32x16_bf16(PKV(ARR[I], ARR[(I) + 1]), PA, o[D0], 0, 0, 0)
#define WL(N) do { asm volatile("s_waitcnt lgkmcnt(" #N ")" ::: "memory"); SBAR(); } while (0)
#define TROW(t) ((long)((t) < NT ? (t) : NT - 1) * KVBLK)
#define SLV0(i, t) sr_[i].vs0 = *reinterpret_cast<const bf16x8*>(&Vh[(TROW(t) + sr) * LDK + sc])
#define SLV1(i, t) sr_[i].vs1 = *reinterpret_cast<const bf16x8*>(&Vh[(TROW(t) + 32 + sr) * LDK + sc])
#define SLK0(i, t) sr_[i].ks0 = *reinterpret_cast<const bf16x8*>(&Kh[(TROW(t) + sr) * LDK + sc])
#define SLK1(i, t) sr_[i].ks1 = *reinterpret_cast<const bf16x8*>(&Kh[(TROW(t) + 32 + sr) * LDK + sc])
#define SWV0(b, i) *(bf16x8*)((char*)V_lds + (b) * VB + vst0) = sr_[i].vs0
#define SWV1(b, i) *(bf16x8*)((char*)V_lds + (b) * VB + vst1) = sr_[i].vs1
#define SWK0(b, i) *(bf16x8*)((char*)K_lds + (b) * KB + KSWZ(sr, sc * 2)) = sr_[i].ks0
#define SWK1(b, i) *(bf16x8*)((char*)K_lds + (b) * KB + KSWZ(32 + sr, sc * 2)) = sr_[i].ks1
#define STEP(J, Q0, Q1, P0, P1, BQ, BP, BW, SL, SW) do { const char* Kp = (const char*)K_lds + (BQ) * KB; const int vbp = vb0 + (BP) * VB; SBAR(); \
    KRD(0, ka0, ka1); Q0 = f32x16{}; Q1 = f32x16{};        \
    MQ(Q0, ka0, 0); KRD(1, kb0, kb1); EX(P1, 0); CV(P0, 0, ca0, ca1); SBAR(); \
    MQ(Q1, ka1, 0); EX(P1, 1); AD(P1, 0); CV(P0, 4, cb0, cb1); PM(pa0); SBAR(); \
    MQ(Q0, kb0, 1); KRD(2, ka0, ka1); EX(P1, 2); AD(P1, 1); CV(P0, 8, ca0, ca1); SBAR(); \
    MQ(Q1, kb1, 1); EX(P1, 3); AD(P1, 2); CV(P0, 12, cb0, cb1); PM(pa1); SBAR(); \
    MQ(Q0, ka0, 2); KRD(3, kb0, kb1); EX(P1, 4); AD(P1, 3); SBAR(); \
    MQ(Q1, ka1, 2); EX(P1, 5); AD(P1, 4); SLV0(SL, (J) + 2); SBAR(); \
    MQ(Q0, kb0, 3); KRD(4, ka0, ka1); EX(P1, 6); AD(P1, 5); SBAR(); \
    MQ(Q1, kb1, 3); EX(P1, 7); AD(P1, 6); SLV1(SL, (J) + 2); SBAR(); \
    MQ(Q0, ka0, 4); KRD(5, kb0, kb1); EX(P1, 8); AD(P1, 7); CV(P1, 0, ca0, ca1); SBAR(); \
    MQ(Q1, ka1, 4); EX(P1, 9); AD(P1, 8); CV(P1, 4, cb0, cb1); PM(pa2); SBAR(); \
    MQ(Q0, kb0, 5); KRD(6, ka0, ka1); EX(P1, 10); AD(P1, 9); SBAR(); \
    MQ(Q1, kb1, 5); EX(P1, 11); AD(P1, 10); SLK0(SL, (J) + 2); SBAR(); \
    MQ(Q0, ka0, 6); KRD(7, kb0, kb1); EX(P1, 12); AD(P1, 11); SBAR(); \
    MQ(Q1, ka1, 6); EX(P1, 13); AD(P1, 12); CV(P1, 8, ca0, ca1); SLK1(SL, (J) + 2); SBAR(); \
    MQ(Q0, kb0, 7); EX(P1, 14); AD(P1, 13); SBAR(); RV(va, 0, 0, 0); RV(va, 2, 1, 0); SBAR(); \
    MQ(Q1, kb1, 7); EX(P1, 15); AD(P1, 14); SBAR(); \
    WL(2); MP(0, pa0, va, 0); RV(va, 0, 0, 1); AD(P1, 15); CV(P1, 12, cb0, cb1); PM(pa3); EX(Q0, 0); SBAR(); \
    WL(2); MP(1, pa0, va, 2); RV(va, 2, 1, 1); EX(Q0, 1); AD(Q0, 0); SBAR(); \
    WL(2); MP(0, pa1, va, 0); RV(va, 0, 0, 2); EX(Q0, 2); AD(Q0, 1); SBAR(); \
    WL(2); MP(1, pa1, va, 2); RV(va, 2, 1, 2); EX(Q0, 3); AD(Q0, 2); SBAR(); \
    WL(2); MP(0, pa2, va, 0); RV(va, 0, 0, 3); EX(Q0, 4); AD(Q0, 3); SBAR(); \
    WL(2); MP(1, pa2, va, 2); RV(va, 2, 1, 3); EX(Q0, 5); AD(Q0, 4); SBAR(); \
    WL(2); MP(0, pa3, va, 0); RV(va, 0, 2, 0); EX(Q0, 6); AD(Q0, 5); SBAR(); \
    WL(2); MP(1, pa3, va, 2); RV(va, 2, 3, 0); EX(Q0, 7); AD(Q0, 6); SBAR(); \
    WL(2); MP(2, pa0, va, 0); RV(va, 0, 2, 1); EX(Q0, 8); AD(Q0, 7); SBAR(); \
    WL(2); MP(3, pa0, va, 2); RV(va, 2, 3, 1); EX(Q0, 9); AD(Q0, 8); SBAR(); \
    WL(2); MP(2, pa1, va, 0); RV(va, 0, 2, 2); EX(Q0, 10); AD(Q0, 9); SBAR(); \
    WL(2); MP(3, pa1, va, 2); RV(va, 2, 3, 2); EX(Q0, 11); AD(Q0, 10); SBAR(); \
    WL(2); MP(2, pa2, va, 0); RV(va, 0, 2, 3); SWAIT(); SWV0(BW, SW); EX(Q0, 12); AD(Q0, 11); SBAR(); \
    WL(3); MP(3, pa2, va, 2); RV(va, 2, 3, 3); SWV1(BW, SW); EX(Q0, 13); AD(Q0, 12); SBAR(); \
    WL(4); MP(2, pa3, va, 0); SWK0(BW, SW); EX(Q0, 14); AD(Q0, 13); SBAR(); \
    WL(2); MP(3, pa3, va, 2); SWK1(BW, SW); EX(Q0, 15); AD(Q0, 14); AD(Q0, 15); SBAR(); \
    __syncthreads(); } while (0)
  SLOAD(0, 0); asm volatile("s_waitcnt vmcnt(0)" ::: "memory"); SWRITE(0, 0); SLOAD(1, 1); SLOAD(0, 2); __syncthreads();
  qkt(pA0, pA1, K_lds, qr, r32, hi); partialSM_fix2(pA0, l_reg); SWAIT(); SWRITE(1, 1); __syncthreads();
  int jb = 1;
  for (; jb + 5 < NT; jb += 6) {
    STEP(jb,     pB0, pB1, pA0, pA1, 1, 0, 2, 1, 0);
    STEP(jb + 1, pA0, pA1, pB0, pB1, 2, 1, 0, 0, 1);
    STEP(jb + 2, pB0, pB1, pA0, pA1, 0, 2, 1, 1, 0);
    STEP(jb + 3, pA0, pA1, pB0, pB1, 1, 0, 2, 0, 1);
    STEP(jb + 4, pB0, pB1, pA0, pA1, 2, 1, 0, 1, 0);
    STEP(jb + 5, pA0, pA1, pB0, pB1, 0, 2, 1, 0, 1);
  }
  constexpr int REM = (NT - 1) % 6;
  if constexpr (REM > 0) STEP(jb,     pB0, pB1, pA0, pA1, 1, 0, 2, 1, 0);
  if constexpr (REM > 1) STEP(jb + 1, pA0, pA1, pB0, pB1, 2, 1, 0, 0, 1);
  if constexpr (REM > 2) STEP(jb + 2, pB0, pB1, pA0, pA1, 0, 2, 1, 1, 0);
  if constexpr (REM > 3) STEP(jb + 3, pA0, pA1, pB0, pB1, 1, 0, 2, 0, 1);
  if constexpr (REM > 4) STEP(jb + 4, pB0, pB1, pA0, pA1, 2, 1, 0, 1, 0);
  if constexpr ((NT - 1) & 1) finishSM2(pB0, pB1, l_reg, pa0, pa1, pa2, pa3); else finishSM2(pA0, pA1, l_reg, pa0, pa1, pa2, pa3);
  { auto rr = __builtin_amdgcn_permlane32_swap(__float_as_uint(l_reg), __float_as_uint(l_reg), false, false); l_reg = __uint_as_float(rr[0]) + __uint_as_float(rr[1]); }
  { const int vbp = vb0 + ((NT - 1) % 3) * VB; SBAR(); RV(va, 0, 0, 0); RV(va, 2, 1, 0); SBAR();
    WL(2); MP(0, pa0, va, 0); RV(va, 0, 0, 1); SBAR();
    WL(2); MP(1, pa0, va, 2); RV(va, 2, 1, 1); SBAR();
    WL(2); MP(0, pa1, va, 0); RV(va, 0, 0, 2); SBAR();
    WL(2); MP(1, pa1, va, 2); RV(va, 2, 1, 2); SBAR();
    WL(2); MP(0, pa2, va, 0); RV(va, 0, 0, 3); SBAR();
    WL(2); MP(1, pa2, va, 2); RV(va, 2, 1, 3); SBAR();
    WL(2); MP(0, pa3, va, 0); RV(va, 0, 2, 0); SBAR();
    WL(2); MP(1, pa3, va, 2); RV(va, 2, 3, 0); SBAR();
    WL(2); MP(2, pa0, va, 0); RV(va, 0, 2, 1); SBAR();
    WL(2); MP(3, pa0, va, 2); RV(va, 2, 3, 1); SBAR();
    WL(2); MP(2, pa1, va, 0); RV(va, 0, 2, 2); SBAR();
    WL(2); MP(3, pa1, va, 2); RV(va, 2, 3, 2); SBAR();
    WL(2); MP(2, pa2, va, 0); RV(va, 0, 2, 3); SBAR();
    WL(2); MP(3, pa2, va, 2); RV(va, 2, 3, 3); SBAR();
    WL(2); MP(2, pa3, va, 0); SBAR();
    WL(0); MP(3, pa3, va, 2); SBAR();
  }
  { const float rl = __builtin_amdgcn_rcpf(l_reg); bf16_t* Orow = Ob + (long)(wid * QBLK + r32) * LDO + hi * 8;
#pragma unroll
    for (int D0 = 0; D0 < 4; ++D0) {
#pragma unroll
      for (int gp = 0; gp < 2; ++gp) { const int k = D0 * 4 + 2 * gp;
        unsigned ax = cvtpk(o[D0][8 * gp + 0] * rl, o[D0][8 * gp + 1] * rl), ay = cvtpk(o[D0][8 * gp + 2] * rl, o[D0][8 * gp + 3] * rl);
        unsigned bx = cvtpk(o[D0][8 * gp + 4] * rl, o[D0][8 * gp + 5] * rl), by = cvtpk(o[D0][8 * gp + 6] * rl, o[D0][8 * gp + 7] * rl);
        auto sx = __builtin_amdgcn_permlane32_swap(ax, bx, false, false); auto sy = __builtin_amdgcn_permlane32_swap(ay, by, false, false);
        *(u32x4*)(Orow + 8 * k) = (u32x4){sx[0], sy[0], sx[1], sy[1]}; } } }
  asm volatile("s_waitcnt vmcnt(0) lgkmcnt(0)" ::: "memory"); __syncthreads();
#undef STEP
#undef TROW
#undef SLV0
#undef SLV1
#undef SLK0
#undef SLK1
#undef SWV0
#undef SWV1
#undef SWK0
#undef SWK1
#undef KRD
#undef MQ
#undef EX
#undef AD
#undef CV
#undef PM
#undef RV
#undef PKV
#undef MP
#undef WL
#undef SLOAD
#undef SWRITE
#undef SWAIT
}
}
struct Args { const float* in[32]; float* out; unsigned char* ws; int ph_lo, ph_hi, li, pad; };
constexpr int PTR_OFF = RING_BYTES + 512;
struct Ctx { LAS unsigned char* ldsb; unsigned char* ws;
    __device__ __forceinline__ const float* inp(int i) const { const u32x2 v = *(const LAS u32x2*)(ldsb + PTR_OFF + 8 * i);
        const unsigned long long p = ((unsigned long long)(unsigned)__builtin_amdgcn_readfirstlane((int)v.y) << 32) | (unsigned)__builtin_amdgcn_readfirstlane((int)v.x);
        return (const float*)(const GAS float*)p; }
    __device__ __forceinline__ float* outp() const { return (float*)inp(32); } };
enum { IN_X = 0, IN_C, IN_CTX, IN_CCTX, IN_MODW, IN_MODB, IN_LNMG, IN_LNMB, IN_LNFG, IN_LNFB, IN_WIN, IN_WOUT, IN_LAMRE, IN_LAMIM, IN_LOGSTEP, IN_BRE, IN_BIM, IN_CRE, IN_CIM,
       IN_S5D, IN_WGLU, IN_BGLU, IN_FNETW, IN_FNETB, IN_WQKV, IN_QGAIN, IN_KGAIN, IN_WO, IN_ROUTER, IN_WGATE, IN_WUP, IN_WDOWN };

struct RowV { f32x4 v[8]; };
__device__ __forceinline__ void row_load_f32(RowV& r, const float* p, int lane) {
#pragma unroll
    for (int j = 0; j < 8; ++j) r.v[j] = *(const f32x4*)(p + 4 * lane + 256 * j);
}
__device__ __forceinline__ void row_load_f32_nt(RowV& r, const float* p, int lane) {
#pragma unroll
    for (int j = 0; j < 8; ++j) r.v[j] = __builtin_nontemporal_load((const f32x4*)(p + 4 * lane + 256 * j));
}
__device__ __forceinline__ void row_store_f32(const RowV& r, float* p, int lane) {
#pragma unroll
    for (int j = 0; j < 8; ++j) *(f32x4*)(p + 4 * lane + 256 * j) = r.v[j];
}
__device__ __forceinline__ void row_store_f32_nt(const RowV& r, float* p, int lane) {
#pragma unroll
    for (int j = 0; j < 8; ++j) __builtin_nontemporal_store(r.v[j], (f32x4*)(p + 4 * lane + 256 * j));
}
__device__ __forceinline__ void row_load_bf16(RowV& r, const bf16_t* p, int lane) {
#pragma unroll
    for (int j = 0; j < 8; ++j) { const u32x2 w = *(const u32x2*)(p + 4 * lane + 256 * j);
        r.v[j] = (f32x4){bf2f(w.x & 0xffffu), bf2f(w.x >> 16), bf2f(w.y & 0xffffu), bf2f(w.y >> 16)}; }
}
__device__ __forceinline__ void row_store_bf16(const RowV& r, bf16_t* p, int lane) {
#pragma unroll
    for (int j = 0; j < 8; ++j) { u32x2 w; w.x = cvt_pk_bf16(r.v[j][0], r.v[j][1]); w.y = cvt_pk_bf16(r.v[j][2], r.v[j][3]); *(u32x2*)(p + 4 * lane + 256 * j) = w; }
}
__device__ __forceinline__ void row_normalize(RowV& r) {
    float s = 0.f;
#pragma unroll
    for (int j = 0; j < 8; ++j) s += (r.v[j][0] + r.v[j][1]) + (r.v[j][2] + r.v[j][3]);
    const float mean = wave_sum(s) * (1.f / DM); float q = 0.f;
#pragma unroll
    for (int j = 0; j < 8; ++j) { r.v[j] = r.v[j] - mean; q += (r.v[j][0] * r.v[j][0] + r.v[j][1] * r.v[j][1]) + (r.v[j][2] * r.v[j][2] + r.v[j][3] * r.v[j][3]); }
    const float rstd = 1.f / sqrtf(wave_sum(q) * (1.f / DM) + LN_EPS);
#pragma unroll
    for (int j = 0; j < 8; ++j) r.v[j] = r.v[j] * rstd;
}
__device__ __forceinline__ void row_modulate(RowV& r, const float* shift, const float* scale, int lane) {
#pragma unroll
    for (int j = 0; j < 8; ++j) { const f32x4 sc = *(const f32x4*)(scale + 4 * lane + 256 * j), sh = *(const f32x4*)(shift + 4 * lane + 256 * j); r.v[j] = r.v[j] * (sc + 1.f) + sh; }
}
__device__ __forceinline__ void row_affine(RowV& r, const float* gain, const float* bias, int lane) {
#pragma unroll
    for (int j = 0; j < 8; ++j) { const f32x4 g = *(const f32x4*)(gain + 4 * lane + 256 * j), b = *(const f32x4*)(bias + 4 * lane + 256 * j); r.v[j] = r.v[j] * g + b; }
}
__device__ __forceinline__ void row_decode(int r, int& b, bool& isctx, int& idx) { b = r / RPB; const int t = r - b * RPB; isctx = t < CTX; idx = isctx ? t : t - CTX; }
__device__ __forceinline__ const float* mod_ptr(const unsigned char* ws, int layer, int which, int k) { return (const float*)(ws + O_MOD) + ((size_t)((layer * 3 + which) * 6 + k)) * DM; }

template <int MODE>
__device__ __forceinline__ void transpose_item(const float* W, int K, int N, bf16_t* WT, LAS float* scrf, int item, int lane) {
    LAS unsigned* scr = (LAS unsigned*)scrf;
    const int nblk = N / 64, kb = item / nblk, nb = item % nblk, k0 = 64 * kb, n0 = 64 * nb;
    const float* src = W + (size_t)k0 * N + n0 + lane;
    float v[64];
#pragma unroll
    for (int i = 0; i < 64; ++i) v[i] = __builtin_nontemporal_load(src + (size_t)i * N);
#pragma unroll
    for (int i = 0; i < 32; ++i) scr[lane * 33 + i] = cvt_pk_bf16(v[2 * i], v[2 * i + 1]);
    LDS_WAIT(); asm volatile("" ::: "memory");
    const int c = lane & 7;
#pragma unroll
    for (int jj = 0; jj < 8; ++jj) { const int n = (lane >> 3) + 8 * jj; const LAS unsigned* s = scr + n * 33 + 4 * c;
        u32x4 o; o.x = s[0]; o.y = s[1]; o.z = s[2]; o.w = s[3];
        const int nn = n0 + n; const int orow = MODE == 0 ? nn : (8 * (nn >> 2) + (nn & 3) + (MODE == 2 ? 4 : 0));
        __builtin_nontemporal_store(o, (u32x4*)(WT + (size_t)orow * K + k0 + 8 * c)); }
    LDS_WAIT(); asm volatile("" ::: "memory");
}

__device__ __forceinline__ void p0_prologue(const Ctx& a, LAS unsigned char* lds, int tid, int lane, int wave) {
    unsigned char* ws = a.ws;
    LAS float* scr = (LAS float*)(lds + wave * 16384);
    const int gw = blockIdx.x * NWAVES + wave, NGW = gridDim.x * NWAVES;
    constexpr int I_SQ = 32 * 32, I_GLU = 16 * 16, I_QKV = 32 * 48;
    constexpr int PER_J = 2 * I_SQ + I_GLU + I_QKV + I_SQ;
    for (int it = gw; it < 2 * PER_J; it += NGW) {
        const int j = it / PER_J; int r = it % PER_J;
        if (r < I_SQ) { transpose_item<0>(a.inp(IN_WIN) + (size_t)j * DM * DM, DM, DM, (bf16_t*)(ws + O_WIN) + (size_t)j * DM * DM, scr, r, lane); continue; } r -= I_SQ;
        if (r < I_SQ) { transpose_item<0>(a.inp(IN_WOUT) + (size_t)j * DM * DM, DM, DM, (bf16_t*)(ws + O_WOUT) + (size_t)j * DM * DM, scr, r, lane); continue; } r -= I_SQ;
        if (r < I_GLU) { transpose_item<0>(a.inp(IN_WGLU) + (size_t)j * 1024 * 1024, 1024, 1024, (bf16_t*)(ws + O_WGLU) + (size_t)j * 1024 * 1024, scr, r, lane); continue; } r -= I_GLU;
        if (r < I_QKV) { transpose_item<0>(a.inp(IN_WQKV) + (size_t)j * DM * 3072, DM, 3072, (bf16_t*)(ws + O_WQKV) + (size_t)j * 3072 * DM, scr, r, lane); continue; } r -= I_QKV;
        transpose_item<0>(a.inp(IN_WO) + (size_t)j * DM * DM, DM, DM, (bf16_t*)(ws + O_WO) + (size_t)j * DM * DM, scr, r, lane);
    }
    __syncthreads();
    {
        LAS float* sl = (LAS float*)lds;
        LAS float* red = (LAS float*)(lds + 32768);
        for (int i = tid; i < 3 * DM; i += NTHREADS) { const int w = i / DM, k = i % DM; const float cv = w < 2 ? a.inp(IN_C)[w * DM + k] : a.inp(IN_CCTX)[k]; sl[i] = silu_f(cv); }
        __syncthreads();
        for (int wi = blockIdx.x; wi < 256; wi += gridDim.x) {
            const int layer = wi >> 6, col0 = (wi & 63) * 192;
            const float* W = a.inp(IN_MODW) + (size_t)layer * DM * 12288 + col0 + lane;
            float acc[3][3];
#pragma unroll
            for (int q = 0; q < 3; ++q)
#pragma unroll
                for (int r = 0; r < 3; ++r) acc[q][r] = 0.f;
#pragma unroll 16
            for (int k = wave * 256; k < wave * 256 + 256; ++k) {
                const float s0 = sl[k], s1 = sl[DM + k], s2 = sl[2 * DM + k];
#pragma unroll
                for (int q = 0; q < 3; ++q) { const float w = W[(size_t)k * 12288 + 64 * q]; acc[q][0] += w * s0; acc[q][1] += w * s1; acc[q][2] += w * s2; }
            }
#pragma unroll
            for (int q = 0; q < 3; ++q)
#pragma unroll
                for (int r = 0; r < 3; ++r) red[(wave * 9 + q * 3 + r) * 64 + lane] = acc[q][r];
            __syncthreads();
            for (int i = tid; i < 576; i += NTHREADS) { const int qr = i / 64, l = i % 64, q = qr / 3, r = qr % 3; float s = 0.f;
#pragma unroll
                for (int w = 0; w < 8; ++w) s += red[(w * 9 + qr) * 64 + l];
                const int n = col0 + 64 * q + l;
                ((float*)(ws + O_MOD))[((size_t)(layer * 3 + r)) * 12288 + n] = s + a.inp(IN_MODB)[layer * 12288 + n]; }
            __syncthreads();
        }
    }
    const int gt = blockIdx.x * NTHREADS + tid, NGT = gridDim.x * NTHREADS;
    const double INV_PI = 0.31830988618379067153776752674503;
    for (int i = gt; i < 256 * 32; i += NGT) { const int pos = i >> 5, f = i & 31; const float invf = (float)exp(-(double)f * (9.210340371976182736071965818737 / 32.0)); const float ang = (float)pos * invf;
        ((f32x2*)(ws + O_TRIG))[i] = (f32x2){(float)cospi((double)ang * INV_PI), (float)sinpi((double)ang * INV_PI)}; }
    for (int i = gt; i < 256 * 256; i += NGT) { const int r = i >> 8, k = i & 255;
        { float v = 0.f; if (k < 128) { float ss, cc; sincospif((float)(((r & 127) * k) & 127) * (1.f / 64.f), &ss, &cc); v = (r < 128 ? cc : -ss) * (1.f / 128.f); }
          ((bf16_t*)(ws + O_FA))[i] = (bf16_t)f2bf(v); }
    }
    for (int i8 = gt; i8 < 128 * 256 * 32; i8 += NGT) {
        const int k1 = i8 >> 13, r = (i8 >> 5) & 255, kc = (i8 & 31) * 8, k2 = r & 127; float v[8];
#pragma unroll
        for (int q = 0; q < 8; ++q) { const int k = kc + q, l2 = k & 127; float ss, cc; sincospif((float)((l2 * (k1 + 128 * k2)) & 16383) * (1.f / 8192.f), &ss, &cc);
            v[q] = r < 128 ? (k < 128 ? cc : ss) : (k < 128 ? ss : -cc); }
        u32x4 o; o.x = cvt_pk_bf16(v[0], v[1]); o.y = cvt_pk_bf16(v[2], v[3]); o.z = cvt_pk_bf16(v[4], v[5]); o.w = cvt_pk_bf16(v[6], v[7]);
        *(u32x4*)((bf16_t*)(ws + O_FC) + (size_t)i8 * 8) = o; }
    for (int i = gt; i < 512 * 256; i += NGT) { const int r = i >> 8, l = i & 255, k = r & 255; float ss, cc; sincospif((float)((k * l) & 255) * (1.f / 128.f), &ss, &cc);
        ((bf16_t*)(ws + O_F256))[i] = (bf16_t)f2bf((r < 256 ? cc : ss) * (1.f / 16.f)); }
    for (int i = gt; i < 2 * 2 * 64 * 64 * 33; i += NGT) { const int jdgp = i / 33, n = i - jdgp * 33;
        const double step = exp((double)a.inp(IN_LOGSTEP)[jdgp >> 6]), ar = (double)a.inp(IN_LAMRE)[jdgp] * step, ai = (double)a.inp(IN_LAMIM)[jdgp] * step * INV_PI;
        const double mag = exp(ar * n); ((f32x2*)(ws + O_POW))[i] = (f32x2){(float)(mag * cospi(ai * n)), (float)(mag * sinpi(ai * n))}; }
    for (int i = gt; i < 2 * 2 * 64 * 64 * 16; i += NGT) { const int jdgp = i >> 4;
        const double lre = a.inp(IN_LAMRE)[jdgp], lim = a.inp(IN_LAMIM)[jdgp], step = exp((double)a.inp(IN_LOGSTEP)[jdgp >> 6]);
        const double mag = exp(lre * step), ang = lim * step * INV_PI, br = mag * cospi(ang) - 1.0, bi = mag * sinpi(ang), den = lre * lre + lim * lim;
        const double qr = (br * lre + bi * lim) / den, qi = (bi * lre - br * lim) / den;
        const double xr = a.inp(IN_BRE)[i], xi = a.inp(IN_BIM)[i]; ((f32x2*)(ws + O_BBAR))[i] = (f32x2){(float)(qr * xr - qi * xi), (float)(qr * xi + qi * xr)}; }
    {
        __syncthreads();
        LAS float* ct = (LAS float*)lds; LAS float* st = ct + 256;
        if (tid < 256) { float ss, cc; sincospif((float)tid * (1.f / 128.f), &ss, &cc); ct[tid] = cc * (1.f / 16.f); st[tid] = -ss * (1.f / 16.f); }
        __syncthreads();
        for (int i = gt; i < 2 * 4 * 64 * 256; i += NGT) { const int e = i & 255, kb = (i >> 8) & 63, jg = i >> 14, c0 = (kb & 31) * 8; const LAS float* tb = kb < 32 ? ct : st;
            const float* w = a.inp(IN_FNETW) + (size_t)jg * 65536 + e; float s[8];
#pragma unroll
            for (int q = 0; q < 8; ++q) s[q] = 0.f;
#pragma unroll 4
            for (int m = 0; m < 256; ++m) { const float wv = w[m * 256];
#pragma unroll
                for (int q = 0; q < 8; ++q) s[q] += tb[(m * (c0 + q)) & 255] * wv; }
            u32x4 o; o.x = cvt_pk_bf16(s[0], s[1]); o.y = cvt_pk_bf16(s[2], s[3]); o.z = cvt_pk_bf16(s[4], s[5]); o.w = cvt_pk_bf16(s[6], s[7]);
            *(u32x4*)((bf16_t*)(ws + O_FNM) + ((size_t)jg * 256 + e) * 512 + kb * 8) = o; }
        __syncthreads();
    }
    if (gt < 128) ((bf16_t*)(ws + O_T1))[(size_t)2048 * 128 * 128 + gt] = 0;
}

__device__ __forceinline__ void p1_kf(const Ctx& a, LAS unsigned char* lds, int tid) {
    unsigned char* ws = a.ws;
    LAS f32x2* pw = (LAS f32x2*)lds;
    LAS f32x2* bb = pw + 64 * 33;
    LAS f32x2* cc = bb + 64 * 16;
    for (int jdg = blockIdx.x; jdg < 256; jdg += gridDim.x) {
        for (int i = tid; i < 64 * 33; i += NTHREADS) pw[i] = ((const f32x2*)(ws + O_POW))[(size_t)jdg * 64 * 33 + i];
        for (int i = tid; i < 64 * 16; i += NTHREADS) bb[i] = ((const f32x2*)(ws + O_BBAR))[(size_t)jdg * 64 * 16 + i];
        for (int i = tid; i < 16 * 64; i += NTHREADS) cc[(i >> 6) * 65 + (i & 63)] = (f32x2){a.inp(IN_CRE)[(size_t)jdg * 1024 + i], a.inp(IN_CIM)[(size_t)jdg * 1024 + i]};
        __syncthreads();
        const int tau = tid >> 4, co = tid & 15; float s[16];
#pragma unroll
        for (int ci = 0; ci < 16; ++ci) s[ci] = 0.f;
        for (int p = 0; p < 64; ++p) { const f32x2 w = pw[p * 33 + tau], c = cc[co * 65 + p]; const float xr = c.x * w.x - c.y * w.y, xi = c.x * w.y + c.y * w.x;
#pragma unroll
            for (int ci = 0; ci < 16; ++ci) { const f32x2 b = bb[p * 16 + ci]; s[ci] += xr * b.x - xi * b.y; } }
        float* out = (float*)(ws + O_KF) + ((size_t)jdg * 32 + tau) * 256 + co * 16;
#pragma unroll
        for (int q = 0; q < 4; ++q) *(f32x4*)(out + 4 * q) = (f32x4){s[4 * q], s[4 * q + 1], s[4 * q + 2], s[4 * q + 3]};
        __syncthreads();
    }
}
__device__ __forceinline__ u32x4 p2_bt1_item(const Ctx& a, int i) {
    unsigned char* ws = a.ws; const f32x2* POW = (const f32x2*)(ws + O_POW); const f32x2* BB = (const f32x2*)(ws + O_BBAR);
    const int k8 = i & 63, rr = (i >> 6) & 255, jg = i >> 14, j = jg >> 6, g = jg & 63;
    const int typ = rr >> 6, p = rr & 63, d = typ >> 1, t = k8 >> 1, ci0 = (k8 & 1) * 8, n = d == 0 ? (31 - t) : t;
    const size_t jdgp = ((size_t)((j * 2 + d) * 64 + g)) * 64 + p; const f32x2 w = POW[jdgp * 33 + n]; float v[8];
#pragma unroll
    for (int c = 0; c < 8; ++c) { const f32x2 b = BB[jdgp * 16 + ci0 + c]; v[c] = (typ & 1) ? (w.x * b.y + w.y * b.x) : (w.x * b.x - w.y * b.y); }
    u32x4 o; o.x = cvt_pk_bf16(v[0], v[1]); o.y = cvt_pk_bf16(v[2], v[3]); o.z = cvt_pk_bf16(v[4], v[5]); o.w = cvt_pk_bf16(v[6], v[7]); return o;
}
__device__ __forceinline__ u32x4 p2_bt3_item(const Ctx& a, int i) {
    unsigned char* ws = a.ws; const f32x2* POW = (const f32x2*)(ws + O_POW); const float* KF = (const float*)(ws + O_KF);
    const int k8 = i % 96, rr = (i / 96) & 511, jg = i / (96 * 512), j = jg >> 6, g = jg & 63;
    const int t = rr >> 4, co = rr & 15; float v[8];
    if (k8 < 64) { const int s = k8 >> 1, ci0 = (k8 & 1) * 8;
        f32x4 f0 = (f32x4){0.f, 0.f, 0.f, 0.f}, f1 = f0;
        if (s <= t) { const f32x4* p = (const f32x4*)(KF + ((((size_t)(j * 2 + 0) * 64 + g) * 32 + (t - s)) * 16 + co) * 16 + ci0); f0 += p[0]; f1 += p[1]; }
        if (s >= t) { const f32x4* p = (const f32x4*)(KF + ((((size_t)(j * 2 + 1) * 64 + g) * 32 + (s - t)) * 16 + co) * 16 + ci0); f0 += p[0]; f1 += p[1]; }
#pragma unroll
        for (int c = 0; c < 4; ++c) { v[c] = f0[c]; v[4 + c] = f1[c]; }
        if (s == t && (co >> 3) == (k8 & 1)) { const float dsk = a.inp(IN_S5D)[j * 1024 + g * 16 + co];
#pragma unroll
            for (int c = 0; c < 8; ++c) v[c] += (ci0 + c == co) ? dsk : 0.f; }
    } else { const int q0 = (k8 - 64) * 8, typ = q0 >> 6, d = typ >> 1, n = d == 0 ? (t + 1) : (32 - t);
        const size_t jdg = (size_t)(j * 2 + d) * 64 + g;
#pragma unroll
        for (int c = 0; c < 8; ++c) { const int p = (q0 & 63) + c; const f32x2 w = POW[(jdg * 64 + p) * 33 + n];
            const float cr = a.inp(IN_CRE)[(jdg * 16 + co) * 64 + p], ci = a.inp(IN_CIM)[(jdg * 16 + co) * 64 + p];
            v[c] = (typ & 1) ? -(cr * w.y + ci * w.x) : (cr * w.x - ci * w.y); } }
    u32x4 o; o.x = cvt_pk_bf16(v[0], v[1]); o.y = cvt_pk_bf16(v[2], v[3]); o.z = cvt_pk_bf16(v[4], v[5]); o.w = cvt_pk_bf16(v[6], v[7]); return o;
}
__device__ __forceinline__ void p2_s5mats(const Ctx& a, int tid) {
    unsigned char* ws = a.ws; const int gt = blockIdx.x * NTHREADS + tid, NGT = gridDim.x * NTHREADS;
    constexpr int N1 = 2 * 64 * 256 * 64, N3 = 2 * 64 * 512 * 96;
    for (int i = gt; i < N1; i += 4 * NGT) { u32x4 o[4];
#pragma unroll
        for (int q = 0; q < 4; ++q) { const int ii = i + q * NGT; o[q] = p2_bt1_item(a, ii < N1 ? ii : i); }
#pragma unroll
        for (int q = 0; q < 4; ++q) { const int ii = i + q * NGT; if (ii < N1) { const int k8 = ii & 63, rr = (ii >> 6) & 255, jg = ii >> 14;
            __builtin_nontemporal_store(o[q], (u32x4*)((bf16_t*)(ws + O_BT1) + ((size_t)jg * 256 + rr) * 512 + k8 * 8)); } } }
    for (int i = gt; i < N3; i += 4 * NGT) { u32x4 o[4];
#pragma unroll
        for (int q = 0; q < 4; ++q) { const int ii = i + q * NGT; o[q] = p2_bt3_item(a, ii < N3 ? ii : i); }
#pragma unroll
        for (int q = 0; q < 4; ++q) { const int ii = i + q * NGT; if (ii < N3) { const int k8 = ii % 96, rr = (ii / 96) & 511, jg = ii / (96 * 512);
            __builtin_nontemporal_store(o[q], (u32x4*)((bf16_t*)(ws + O_BT3) + ((size_t)jg * 512 + rr) * 768 + k8 * 8)); } } }
}
__device__ __forceinline__ void moe_weight_phase(const Ctx& a, int layer, int part, int tailwgs, LAS unsigned char* lds, int lane, int wave) {
    unsigned char* ws = a.ws; LAS float* scr = (LAS float*)(lds + wave * 16384);
    const int rank = (int)blockIdx.x - tailwgs, nact = (int)gridDim.x - tailwgs;
    if (rank >= 0) {
        const int gw = rank * NWAVES + wave, NGW = nact * NWAVES;
        constexpr int I_GU = 32 * 16, I_DN = 16 * 32, PER_E = 2 * I_GU + I_DN, HALF_ITEMS = 16 * PER_E / 2;
        for (int it = part * HALF_ITEMS + gw; it < (part + 1) * HALF_ITEMS; it += NGW) {
            const int e = it / PER_E; int r = it % PER_E;
            const size_t le = (size_t)layer * 16 + e;
            if (r < I_GU) { transpose_item<1>(a.inp(IN_WGATE) + le * DM * EFF, DM, EFF, (bf16_t*)(ws + O_WGU) + (size_t)e * 2048 * DM, scr, r, lane); continue; } r -= I_GU;
            if (r < I_GU) { transpose_item<2>(a.inp(IN_WUP) + le * DM * EFF, DM, EFF, (bf16_t*)(ws + O_WGU) + (size_t)e * 2048 * DM, scr, r, lane); continue; } r -= I_GU;
            transpose_item<0>(a.inp(IN_WDOWN) + le * EFF * DM, EFF, DM, (bf16_t*)(ws + O_WD) + (size_t)e * DM * EFF, scr, r, lane);
        }
    }
    __syncthreads();
}

__device__ __forceinline__ const float* r_xsrc0(const Ctx& a, int r) { int b, idx; bool isctx; row_decode(r, b, isctx, idx);
    return isctx ? a.inp(IN_CTX) + ((size_t)(b * CTX + idx)) * DM : a.inp(IN_X) + ((size_t)(b * SEQ + idx)) * DM; }
__device__ __forceinline__ void r0_phase(const Ctx& a, int lane, int wave) {
    unsigned char* ws = a.ws; const int gw = blockIdx.x * NWAVES + wave, NGW = gridDim.x * NWAVES;
    RowV xn;
    if (gw < NR) row_load_f32_nt(xn, r_xsrc0(a, gw), lane);
    for (int r = gw; r < NR; r += NGW) { int b, idx; bool isctx; row_decode(r, b, isctx, idx);
        const int which = isctx ? 2 : b; RowV x = xn;
        if (r + NGW < NR) row_load_f32_nt(xn, r_xsrc0(a, r + NGW), lane);
        row_normalize(x);
        row_modulate(x, mod_ptr(ws, 0, which, 0), mod_ptr(ws, 0, which, 1), lane);
        row_store_bf16(x, (bf16_t*)(ws + O_U) + (size_t)r * DM, lane); }
}
__device__ __forceinline__ void lds_vec_fill(LAS float* dst, const float* src, int tid) { for (int i = tid; i < DM / 4; i += NTHREADS) *(LAS f32x4*)(dst + 4 * i) = *(const f32x4*)(src + 4 * i); }
__device__ __forceinline__ f32x4 vld(const float* p, int lane, int j) { return *(const f32x4*)(p + 4 * lane + 256 * j); }
__device__ __forceinline__ f32x4 vld(const LAS float* p, int lane, int j) { return *(const LAS f32x4*)(p + 4 * lane + 256 * j); }
__device__ __forceinline__ const float* r_xsrc(const Ctx& a, int layer, int r) { int b, idx; bool isctx; row_decode(r, b, isctx, idx);
    if (layer == 0) return isctx ? a.inp(IN_CTX) + ((size_t)(b * CTX + idx)) * DM : a.inp(IN_X) + ((size_t)(b * SEQ + idx)) * DM;
    return isctx ? (const float*)(a.ws + O_XC) + ((size_t)(b * CTX + idx)) * DM : a.outp() + ((size_t)(b * SEQ + idx)) * DM; }
struct RowDeal { int b, i0, n_lat_wg, wave, nlat, gw, NGW;
    __device__ __forceinline__ void init(int wave_) { const int G = gridDim.x, nb = G >> 1, c = blockIdx.x; wave = wave_; gw = c * NWAVES + wave; NGW = G * NWAVES;
        if (nb > 0 && c < 2 * nb) { const int per = (SEQ + nb - 1) / nb; b = c / nb; i0 = (c % nb) * per; n_lat_wg = SEQ - i0 < per ? (SEQ - i0 > 0 ? SEQ - i0 : 0) : per; } else { b = 0; i0 = 0; n_lat_wg = 0; }
        nlat = n_lat_wg > wave ? (n_lat_wg - wave + NWAVES - 1) / NWAVES : 0; }
    bool with_ctx = true;
    __device__ __forceinline__ int row(int k) const { if (k < nlat) return b * RPB + CTX + i0 + wave + k * NWAVES;
        const int q = gw + (k - nlat) * NGW; if (!with_ctx || q >= NBATCH * CTX) return -1; return (q / CTX) * RPB + (q % CTX); } };
constexpr int RV_OFF = RING_BYTES + 1024;

template <bool FAST>
__device__ __forceinline__ void r1_row(const Ctx& a, int layer, int r, RowV& x, const LAS float* wl, const LAS float* lv, int lane, bool st) {
    unsigned char* ws = a.ws; int b, idx; bool isctx; row_decode(r, b, isctx, idx); const int which = isctx ? 2 : b;
    float* xs = isctx ? (float*)(ws + O_XC) + ((size_t)(b * CTX + idx)) * DM : a.outp() + ((size_t)(b * SEQ + idx)) * DM;
    row_normalize(x);
    row_affine(x, a.inp(IN_LNMG) + layer * DM, a.inp(IN_LNMB) + layer * DM, lane);
    if (st) row_store_f32_nt(x, xs, lane);
    row_normalize(x);
    if (FAST) {
#pragma unroll
        for (int j = 0; j < 8; ++j) x.v[j] = x.v[j] * (vld(lv + DM, lane, j) + 1.f) + vld(lv + 2 * DM, lane, j);
    } else row_modulate(x, mod_ptr(ws, layer, which, 3), mod_ptr(ws, layer, which, 4), lane);
    if (st) row_store_bf16(x, (bf16_t*)(ws + O_H2) + (size_t)r * DM, lane);
    float lg[16];
#pragma unroll
    for (int e = 0; e < 16; ++e) { float s0 = 0.f, s1 = 0.f, s2 = 0.f, s3 = 0.f;
#pragma unroll
        for (int j = 0; j < 8; ++j) { const f32x4 w = *(const LAS f32x4*)(wl + e * DM + 4 * lane + 256 * j);
            s0 = __builtin_fmaf(x.v[j][0], w[0], s0); s1 = __builtin_fmaf(x.v[j][1], w[1], s1); s2 = __builtin_fmaf(x.v[j][2], w[2], s2); s3 = __builtin_fmaf(x.v[j][3], w[3], s3); }
        lg[e] = wave_sum((s0 + s1) + (s2 + s3)); asm volatile("" ::: "memory"); }
    float mx = lg[0];
#pragma unroll
    for (int e = 1; e < 16; ++e) mx = fmaxf(mx, lg[e]);
    float den = 0.f;
#pragma unroll
    for (int e = 0; e < 16; ++e) { lg[e] = __builtin_amdgcn_exp2f((lg[e] - mx) * 1.4426950408889634f); den += lg[e]; }
    float mine = 0.f;
#pragma unroll
    for (int e = 0; e < 16; ++e) mine = (lane == e) ? lg[e] : mine;
    if (st && lane < 16) ((float*)(ws + O_AFF))[(size_t)r * 16 + lane] = mine / den;
}
__device__ __forceinline__ void r1_phase(const Ctx& a, int layer, LAS unsigned char* lds, int tid, int lane, int wave, bool st) {
    unsigned char* ws = a.ws;
    LAS float* wl = (LAS float*)lds;
    LAS float* lv = (LAS float*)(lds + RV_OFF);
    RowDeal rd; rd.init(wave); rd.with_ctx = layer + 1 < DEPTH;
    { const float* wr = a.inp(IN_ROUTER) + (size_t)layer * DM * 16;
      for (int i = tid; i < DM * 16; i += NTHREADS) wl[(i & 15) * DM + (i >> 4)] = wr[i];
      lds_vec_fill(lv, mod_ptr(ws, layer, rd.b, 2), tid); lds_vec_fill(lv + DM, mod_ptr(ws, layer, rd.b, 4), tid); lds_vec_fill(lv + 2 * DM, mod_ptr(ws, layer, rd.b, 3), tid); }
    __syncthreads();
    RowV xn; u32x2 on[8];
#define R1_FETCH(R) do { row_load_f32_nt(xn, r_xsrc(a, layer, (R)), lane); _Pragma("unroll") for (int j = 0; j < 8; ++j) on[j] = __builtin_nontemporal_load((const u32x2*)((const bf16_t*)(ws + O_O) + (size_t)(R) * DM + 4 * lane + 256 * j)); } while (0)
    int r = rd.row(0);
    if (r >= 0) R1_FETCH(r);
    int k = 0;
    for (; k < rd.nlat; ++k) {
        RowV x;
#pragma unroll
        for (int j = 0; j < 8; ++j) { const f32x4 o = (f32x4){bf2f(on[j].x & 0xffffu), bf2f(on[j].x >> 16), bf2f(on[j].y & 0xffffu), bf2f(on[j].y >> 16)}; x.v[j] = xn.v[j] * ALPHA + vld(lv, lane, j) * o; }
        const int rn = rd.row(k + 1);
        if (rn >= 0) R1_FETCH(rn);
        r1_row<true>(a, layer, r, x, wl, lv, lane, st);
        r = rn;
    }
    for (; r >= 0; ++k) {
        RowV x; { int b, idx; bool isctx; row_decode(r, b, isctx, idx); const float* g1 = mod_ptr(ws, layer, isctx ? 2 : b, 2);
#pragma unroll
          for (int j = 0; j < 8; ++j) { const f32x4 o = (f32x4){bf2f(on[j].x & 0xffffu), bf2f(on[j].x >> 16), bf2f(on[j].y & 0xffffu), bf2f(on[j].y >> 16)}; x.v[j] = xn.v[j] * ALPHA + vld(g1, lane, j) * o; } }
        const int rn = rd.row(k + 1);
        if (rn >= 0) R1_FETCH(rn);
        r1_row<false>(a, layer, r, x, wl, lv, lane, st);
        r = rn;
    }
#undef R1_FETCH
    __syncthreads();
}
__device__ __forceinline__ int moe_row(int e, int b, bool isctx, int slot) { return isctx ? (NEXP * 4096 + e * 256 + b * CAP_C + slot) : (e * 4096 + b * CAP_L + slot); }
template <bool FAST>
__device__ __forceinline__ void r2_row(const Ctx& a, int layer, int r, const RowV& xin, int selv, float affv, const LAS float* lv, int lane, bool st) {
    unsigned char* ws = a.ws; int b, idx; bool isctx; row_decode(r, b, isctx, idx); const int which = isctx ? 2 : b;
    const bf16_t* YE = (const bf16_t*)(ws + O_YE);
    float* xs = isctx ? (float*)(ws + O_XC) + ((size_t)(b * CTX + idx)) * DM : a.outp() + ((size_t)(b * SEQ + idx)) * DM;
    RowV x = xin, f;
    unsigned long long m = __ballot(selv >= 0);
    const int e0 = m ? __builtin_ctzll(m) : 0; unsigned long long m1 = m & (m - 1); const int e1 = m1 ? __builtin_ctzll(m1) : 0; unsigned long long m2 = m1 & (m1 - 1); const int e2 = m2 ? __builtin_ctzll(m2) : 0;
    u32x2 y0[8], y1[8], y2[8];
    if (m) { const bf16_t* p = YE + (size_t)moe_row(e0, b, isctx, __builtin_amdgcn_readlane(selv, e0)) * DM + 4 * lane;
#pragma unroll
        for (int j = 0; j < 8; ++j) y0[j] = __builtin_nontemporal_load((const u32x2*)(p + 256 * j)); }
    if (m1) { const bf16_t* p = YE + (size_t)moe_row(e1, b, isctx, __builtin_amdgcn_readlane(selv, e1)) * DM + 4 * lane;
#pragma unroll
        for (int j = 0; j < 8; ++j) y1[j] = __builtin_nontemporal_load((const u32x2*)(p + 256 * j)); }
    if (m2) { const bf16_t* p = YE + (size_t)moe_row(e2, b, isctx, __builtin_amdgcn_readlane(selv, e2)) * DM + 4 * lane;
#pragma unroll
        for (int j = 0; j < 8; ++j) y2[j] = __builtin_nontemporal_load((const u32x2*)(p + 256 * j)); }
#pragma unroll
    for (int j = 0; j < 8; ++j) f.v[j] = (f32x4){0.f, 0.f, 0.f, 0.f};
#define R2_ACC(Y, E) do { const float w_ = __uint_as_float(__builtin_amdgcn_readlane(__float_as_uint(affv), E)); _Pragma("unroll") for (int j = 0; j < 8; ++j) \
        f.v[j] += (f32x4){bf2f(Y[j].x & 0xffffu), bf2f(Y[j].x >> 16), bf2f(Y[j].y & 0xffffu), bf2f(Y[j].y >> 16)} * w_; } while (0)
    if (m) R2_ACC(y0, e0);
    if (m1) R2_ACC(y1, e1);
    if (m2) R2_ACC(y2, e2);
#undef R2_ACC
    unsigned long long mr = m2 & (m2 - 1);
    while (mr) { const int e = __builtin_ctzll(mr); mr &= mr - 1;
        const int s = __builtin_amdgcn_readlane(selv, e); const float w = __uint_as_float(__builtin_amdgcn_readlane(__float_as_uint(affv), e));
        RowV y; row_load_bf16(y, YE + (size_t)moe_row(e, b, isctx, s) * DM, lane);
#pragma unroll
        for (int j = 0; j < 8; ++j) f.v[j] += y.v[j] * w; }
    const float* g2 = mod_ptr(ws, layer, which, 5);
#pragma unroll
    for (int j = 0; j < 8; ++j) { const f32x4 g = FAST ? vld(lv, lane, j) : vld(g2, lane, j); x.v[j] = x.v[j] * ALPHA + g * f.v[j]; }
    row_normalize(x);
    if (FAST) {
#pragma unroll
        for (int j = 0; j < 8; ++j) x.v[j] = x.v[j] * vld(lv + DM, lane, j) + vld(lv + 2 * DM, lane, j);
    } else row_affine(x, a.inp(IN_LNFG) + layer * DM, a.inp(IN_LNFB) + layer * DM, lane);
    if (st) row_store_f32_nt(x, xs, lane);
    if (layer + 1 < DEPTH) { row_normalize(x);
        if (FAST) {
#pragma unroll
            for (int j = 0; j < 8; ++j) x.v[j] = x.v[j] * (vld(lv + 4 * DM, lane, j) + 1.f) + vld(lv + 3 * DM, lane, j);
        } else row_modulate(x, mod_ptr(ws, layer + 1, which, 0), mod_ptr(ws, layer + 1, which, 1), lane);
        if (st) row_store_bf16(x, (bf16_t*)(ws + O_U) + (size_t)r * DM, lane); }
}
__device__ __forceinline__ void r2_phase(const Ctx& a, int layer, LAS unsigned char* lds, int tid, int lane, int wave, bool st) {
    unsigned char* ws = a.ws;
    const int* SEL = (const int*)(ws + O_SEL); const float* AFF = (const float*)(ws + O_AFF);
    LAS float* lv = (LAS float*)lds;
    RowDeal rd; rd.init(wave); rd.with_ctx = layer + 1 < DEPTH;
    lds_vec_fill(lv, mod_ptr(ws, layer, rd.b, 5), tid); lds_vec_fill(lv + DM, a.inp(IN_LNFG) + layer * DM, tid); lds_vec_fill(lv + 2 * DM, a.inp(IN_LNFB) + layer * DM, tid);
    if (layer + 1 < DEPTH) { lds_vec_fill(lv + 3 * DM, mod_ptr(ws, layer + 1, rd.b, 0), tid); lds_vec_fill(lv + 4 * DM, mod_ptr(ws, layer + 1, rd.b, 1), tid); }
    __syncthreads();
    RowV xn; int seln = -1; float affn = 0.f;
    int r = rd.row(0);
    if (r >= 0) { row_load_f32_nt(xn, r_xsrc(a, 1, r), lane); if (lane < 16) { seln = SEL[(size_t)r * 16 + lane]; affn = AFF[(size_t)r * 16 + lane]; } }
    for (int k = 0; r >= 0; ++k) {
        const RowV x = xn; const int selv = seln; const float affv = affn;
        const int rn = rd.row(k + 1);
        seln = -1; affn = 0.f;
        if (rn >= 0) { row_load_f32_nt(xn, r_xsrc(a, 1, rn), lane); if (lane < 16) { seln = SEL[(size_t)rn * 16 + lane]; affn = AFF[(size_t)rn * 16 + lane]; } }
        if (k < rd.nlat) r2_row<true>(a, layer, r, x, selv, affv, lv, lane, st);
        else r2_row<false>(a, layer, r, x, selv, affv, lv, lane, st);
        r = rn;
    }
    __syncthreads();
}
__device__ __forceinline__ int block_excl_scan(int v, LAS int* tmp, int lane, int wave, int& total) {
    int inc = v;
#pragma unroll
    for (int o = 1; o < 64; o <<= 1) { const int t = __builtin_amdgcn_ds_bpermute((lane >= o ? lane - o : lane) << 2, inc); if (lane >= o) inc += t; }
    if (lane == 63) tmp[wave] = inc;
    __syncthreads();
    int off = 0, tot = 0;
#pragma unroll
    for (int w = 0; w < 8; ++w) { const int t = tmp[w]; off += (w < wave) ? t : 0; tot += t; }
    __syncthreads();
    total = tot; return off + inc - v;
}
__device__ __forceinline__ void topk_phase(const Ctx& a, bool with_ctx, LAS unsigned char* lds, int tid, int lane, int wave) {
    unsigned char* ws = a.ws; const float* AFF = (const float*)(ws + O_AFF); int* SEL = (int*)(ws + O_SEL); int* IDX = (int*)(ws + O_IDX);
    LAS unsigned* val = (LAS unsigned*)lds;
    LAS unsigned* hist = (LAS unsigned*)(lds + 69632);
    LAS unsigned* bc = hist + 256;
    LAS int* tmp = (LAS int*)(hist + 272);
    for (int li = blockIdx.x; li < (with_ctx ? 64 : 32); li += gridDim.x) {
        const bool isctx = li >= 32; const int q = li & 31, b = q >> 4, e = q & 15;
        const int n = isctx ? CTX : SEQ, k = isctx ? CAP_C : CAP_L, row0 = b * RPB + (isctx ? 0 : CTX);
        for (int i = tid; i < n; i += NTHREADS) val[i + (i >> 5)] = __float_as_uint(AFF[(size_t)(row0 + i) * 16 + e]);
        __syncthreads();
        unsigned prefix = 0u, mask = 0u; int krem = k;
        for (int pass = 0; pass < 4; ++pass) { const int shift = 24 - 8 * pass;
            if (tid < 256) hist[tid] = 0u;
            __syncthreads();
            for (int i = tid; i < n; i += NTHREADS) { const unsigned v = val[i + (i >> 5)]; const bool in = (v & mask) == prefix; const unsigned bin = (v >> shift) & 255u;
                const unsigned long long act = __ballot(in);
                if (act) { const int first = (int)__builtin_ctzll(act); const unsigned lead = (unsigned)__builtin_amdgcn_readlane((int)bin, first);
                    const unsigned long long same = __ballot(in && bin == lead);
                    if (in && bin != lead) __hip_atomic_fetch_add(&hist[bin], 1u, __ATOMIC_RELAXED, __HIP_MEMORY_SCOPE_WORKGROUP);
                    if (lane == first) __hip_atomic_fetch_add(&hist[lead], (unsigned)__builtin_popcountll(same), __ATOMIC_RELAXED, __HIP_MEMORY_SCOPE_WORKGROUP); } }
            __syncthreads();
            if (wave == 0) { const int b0 = 255 - 4 * lane; const int c0 = (int)hist[b0], c1 = (int)hist[b0 - 1], c2 = (int)hist[b0 - 2], c3 = (int)hist[b0 - 3]; const int s = c0 + c1 + c2 + c3;
                int inc = s;
#pragma unroll
                for (int o = 1; o < 64; o <<= 1) { const int t = __builtin_amdgcn_ds_bpermute((lane >= o ? lane - o : lane) << 2, inc); if (lane >= o) inc += t; }
                const int exc = inc - s;
                if (exc < krem && krem <= inc) { int cum = exc, bin, before;
                    if (krem <= cum + c0) { bin = b0; before = cum; } else { cum += c0;
                    if (krem <= cum + c1) { bin = b0 - 1; before = cum; } else { cum += c1;
                    if (krem <= cum + c2) { bin = b0 - 2; before = cum; } else { cum += c2; bin = b0 - 3; before = cum; } } }
                    bc[0] = (unsigned)bin; bc[1] = (unsigned)(krem - before); } }
            __syncthreads();
            prefix |= bc[0] << shift; mask |= 0xffu << shift; krem = (int)bc[1];
        }
        const unsigned vstar = prefix; const int need = krem;
        const bool act = tid < (n >> 5); int cgt = 0, ceq = 0;
        if (act) for (int j = 0; j < 32; ++j) { const unsigned v = val[33 * tid + j]; cgt += v > vstar; ceq += v == vstar; }
        int tot; const int eqb = block_excl_scan(ceq, tmp, lane, wave, tot);
        int takeq = need - eqb; takeq = takeq < 0 ? 0 : (takeq > ceq ? ceq : takeq);
        const int slot0 = block_excl_scan(cgt + takeq, tmp, lane, wave, tot);
        if (act) { int eqr = eqb, slot = slot0;
            for (int j = 0; j < 32; ++j) { const int i = 32 * tid + j; const unsigned v = val[33 * tid + j]; const bool iseq = v == vstar; const bool take = v > vstar || (iseq && eqr < need); eqr += iseq;
                SEL[(size_t)(row0 + i) * 16 + e] = take ? slot : -1;
                if (take) { IDX[moe_row(e, b, isctx, slot)] = row0 + i; ++slot; } } }
        __syncthreads();
    }
}
__device__ __forceinline__ bool moe_row_valid(int m) { return m < NEXP * 4096 || ((m - NEXP * 4096) & 255) < 2 * CAP_C; }
__device__ __forceinline__ void gather_phase(const Ctx& a, int lane, int wave) {
    unsigned char* ws = a.ws; const int gw = blockIdx.x * NWAVES + wave, NGW = gridDim.x * NWAVES; const int* IDX = (const int*)(ws + O_IDX);
    for (int m0 = gw * 4; m0 < MOE_ROWS; m0 += NGW * 4) {
        const int mi = m0 + (lane & 3); const int tv = moe_row_valid(mi) ? IDX[mi] : -1;
        u32x4 t[4][4];
#pragma unroll
        for (int q = 0; q < 4; ++q) { const int tok = __builtin_amdgcn_readlane(tv, q);
            if (tok >= 0) { const u32x4* src = (const u32x4*)((const bf16_t*)(ws + O_H2) + (size_t)tok * DM);
#pragma unroll
                for (int j = 0; j < 4; ++j) t[q][j] = src[lane + 64 * j]; } }
#pragma unroll
        for (int q = 0; q < 4; ++q) { const int tok = __builtin_amdgcn_readlane(tv, q);
            if (tok >= 0) { u32x4* dst = (u32x4*)((bf16_t*)(ws + O_XE) + (size_t)(m0 + q) * DM);
#pragma unroll
                for (int j = 0; j < 4; ++j) dst[lane + 64 * j] = t[q][j]; } }
    }
}
__device__ __forceinline__ bool attn_fixed_form(const Ctx& a, int j, int lane) {
    const float* qg = a.inp(IN_QGAIN) + j * 128; const float* kg = a.inp(IN_KGAIN) + j * 128;
    const float gq = wave_max(fmaxf(fabsf(qg[lane]), fabsf(qg[lane + 64]))), gk = wave_max(fmaxf(fabsf(kg[lane]), fabsf(kg[lane + 64])));
    return 128.f * gq * gk * 1.03f * 0.088388347648318440f < 27.f;
}
__device__ __forceinline__ void qknorm_phase(const Ctx& a, int j, int lane, int wave, bool st) {
    unsigned char* ws = a.ws; const int gw = blockIdx.x * NWAVES + wave, NGW = gridDim.x * NWAVES;
    const f32x4* TRIG4 = (const f32x4*)(ws + O_TRIG);
    const int cidx = lane & 15, d0 = cidx * 8; const bool upper = (cidx & 4) != 0;
    const float* qg = a.inp(IN_QGAIN) + j * 128 + d0; const float* kg = a.inp(IN_KGAIN) + j * 128 + d0;
    const float qs = attn_fixed_form(a, j, lane) ? 0.088388347648318440f * 1.4426950408889634f : 1.f;
    const f32x4 gq0 = *(const f32x4*)qg * qs, gq1 = *(const f32x4*)(qg + 4) * qs, gk0 = *(const f32x4*)kg, gk1 = *(const f32x4*)(kg + 4);
    u32x4 nraw[5];
    if (gw < NR) { const bf16_t* zn = (const bf16_t*)(ws + O_Z) + (size_t)gw * 3072 + lane * 8;
#pragma unroll
        for (int it = 0; it < 5; ++it) nraw[it] = __builtin_nontemporal_load((const u32x4*)(zn + it * 512)); }
    for (int r = gw; r < NR; r += NGW) { int b, idx; bool isctx; row_decode(r, b, isctx, idx);
        float cs[8], sn[8];
#pragma unroll
        for (int i = 0; i < 8; ++i) { cs[i] = 1.f; sn[i] = 0.f; }
        if (!isctx) { const int pos = cidx < 8 ? (idx >> 6) : (idx & 63); const f32x4* tp = TRIG4 + pos * 16 + (cidx & 3) * 4;
#pragma unroll
            for (int q = 0; q < 4; ++q) { const f32x4 t = tp[q]; cs[2 * q] = t[0]; sn[2 * q] = t[1]; cs[2 * q + 1] = t[2]; sn[2 * q + 1] = t[3]; } }
        bf16_t* zr = (bf16_t*)(ws + O_Z) + (size_t)r * 3072 + lane * 8;
        u32x4 raw[5];
#pragma unroll
        for (int it = 0; it < 5; ++it) raw[it] = nraw[it];
        if (r + NGW < NR) { const bf16_t* zn = (const bf16_t*)(ws + O_Z) + (size_t)(r + NGW) * 3072 + lane * 8;
#pragma unroll
            for (int it = 0; it < 5; ++it) nraw[it] = __builtin_nontemporal_load((const u32x4*)(zn + it * 512)); }
#pragma unroll
        for (int it = 0; it < 5; ++it) {
            float x[8]; x[0] = bf2f(raw[it].x & 0xffffu); x[1] = bf2f(raw[it].x >> 16); x[2] = bf2f(raw[it].y & 0xffffu); x[3] = bf2f(raw[it].y >> 16);
            x[4] = bf2f(raw[it].z & 0xffffu); x[5] = bf2f(raw[it].z >> 16); x[6] = bf2f(raw[it].w & 0xffffu); x[7] = bf2f(raw[it].w >> 16);
            float ss = 0.f;
#pragma unroll
            for (int i = 0; i < 8; ++i) ss += x[i] * x[i];
            ss = row16_sum(ss);
            const float rinv = 1.f / sqrtf(ss * (1.f / 128.f) + QK_EPS);
            const f32x4 g0 = it < 4 ? gq0 : gk0, g1 = it < 4 ? gq1 : gk1;
            float y[8], o[8];
#pragma unroll
            for (int i = 0; i < 4; ++i) { y[i] = x[i] * rinv * g0[i]; y[4 + i] = x[4 + i] * rinv * g1[i]; }
#pragma unroll
            for (int i = 0; i < 8; ++i) { const float yp = __int_as_float(__builtin_amdgcn_ds_swizzle(__float_as_int(y[i]), 0x101F));     o[i] = upper ? (y[i] * cs[i] + yp * sn[i]) : (y[i] * cs[i] - yp * sn[i]); }
            u32x4 w; w.x = cvt_pk_bf16(o[0], o[1]); w.y = cvt_pk_bf16(o[2], o[3]); w.z = cvt_pk_bf16(o[4], o[5]); w.w = cvt_pk_bf16(o[6], o[7]);
            if (st) *(u32x4*)(zr + it * 512) = w; }
    }
}
__device__ __forceinline__ int s5_chunk_at(int b, int d, int q) { const int cb = b * 520; return d == 0 ? cb + q : (q < 8 ? cb + 7 - q : cb + 527 - q); }
__device__ __forceinline__ void s5_carry_phase(const Ctx& a, int j, LAS unsigned char* lds, int lane, int wave) {
    unsigned char* ws = a.ws; const float* SUM = (const float*)(ws + O_SUM); bf16_t* A3 = (bf16_t*)(ws + O_A3);
    LAS f32x2* ex = (LAS f32x2*)lds;
    for (int ui = blockIdx.x; ui < 256; ui += gridDim.x) {
        const int b = ui >> 7, g = (ui >> 1) & 63, d = ui & 1;
        const f32x2 l32 = ((const f32x2*)(ws + O_POW))[((size_t)((j * 2 + d) * 64 + g) * 64 + lane) * 33 + 32];
        const float* sb = SUM + (size_t)g * NCHP * 256 + d * 128 + lane;
        float hr = 0.f, hi = 0.f;
#pragma unroll 13
        for (int i = 0; i < 65; ++i) { const int ch = s5_chunk_at(b, d, wave * 65 + i); const float sr = sb[(size_t)ch * 256], si = sb[(size_t)ch * 256 + 64];
            const float nr = l32.x * hr - l32.y * hi + sr, ni = l32.x * hi + l32.y * hr + si; hr = nr; hi = ni; }
        ex[wave * 64 + lane] = (f32x2){hr, hi};
        __syncthreads();
        float pr = l32.x, pi = l32.y;
#pragma unroll
        for (int s = 0; s < 6; ++s) { const float nr = pr * pr - pi * pi, ni = 2.f * pr * pi; pr = nr; pi = ni; }
        { const float nr = pr * l32.x - pi * l32.y, ni = pr * l32.y + pi * l32.x; pr = nr; pi = ni; }
        float cr = 0.f, ci = 0.f;
        for (int w = 0; w < wave; ++w) { const f32x2 e = ex[w * 64 + lane]; const float nr = pr * cr - pi * ci + e.x, ni = pr * ci + pi * cr + e.y; cr = nr; ci = ni; }
        hr = cr; hi = ci;
        bf16_t* ab = A3 + (size_t)g * NCHP * A3K + 512 + d * 128 + lane;
#pragma unroll 13
        for (int i = 0; i < 65; ++i) { const int ch = s5_chunk_at(b, d, wave * 65 + i); const float sr = sb[(size_t)ch * 256], si = sb[(size_t)ch * 256 + 64];
            ab[(size_t)ch * A3K] = (bf16_t)f2bf(hr); ab[(size_t)ch * A3K + 64] = (bf16_t)f2bf(hi);
            const float nr = l32.x * hr - l32.y * hi + sr, ni = l32.x * hi + l32.y * hr + si; hr = nr; hi = ni; }
        __syncthreads();
    }
}
__device__ __forceinline__ void f1_transpose_phase(const Ctx& a, LAS unsigned char* lds, int lane, int wave) {
    unsigned char* ws = a.ws; const int gw = blockIdx.x * NWAVES + wave, NGW = gridDim.x * NWAVES;
    LAS bf16_t* scr = (LAS bf16_t*)(lds + wave * 16384);
    const bf16_t* ZF = (const bf16_t*)(ws + O_ZF);
    constexpr int N_LAT = 2 * 128 * 32, N_CTX = 2 * 2 * 32, P = 136;
    constexpr int N_SKEW = 3840, SK_WG = 64;
    const int nskw = ((int)gridDim.x - SK_WG) * NWAVES, gws = gw - SK_WG * NWAVES;
    const int n_mine_skew = (nskw > 0 && gws >= 0) ? (N_SKEW - gws + nskw - 1) / nskw : 0;
    const int skew0 = nskw > 0 ? N_SKEW : 0;
    const int n_mine_even = (N_LAT + N_CTX - skew0 - gw + NGW - 1) / NGW;
    for (int k = 0; k < n_mine_skew + (n_mine_even > 0 ? n_mine_even : 0); ++k) {
        const int it = k < n_mine_skew ? gws + k * nskw : skew0 + gw + (k - n_mine_skew) * NGW;
        size_t srow0, sstride; bf16_t* dst; size_t dpitch; int cb;
        if (it < N_LAT) { const int b = it >> 12, l2 = (it >> 5) & 127; cb = it & 31; srow0 = (size_t)b * RPB + CTX + l2; sstride = 128;
            dst = (bf16_t*)(ws + O_T1) + ((size_t)(b * 1024 + cb * 32) * 128 + l2) * 128; dpitch = 128 * 128; }
        else { const int q = it - N_LAT, b = q >> 6, tb = (q >> 5) & 1; cb = q & 31; srow0 = (size_t)b * RPB + tb * 128; sstride = 1;
            dst = (bf16_t*)(ws + O_T1C) + (size_t)(b * 1024 + cb * 32) * 256 + tb * 128; dpitch = 256; }
        const int c4 = lane & 3, rsub = lane >> 2;
        u32x4 v[8];
#pragma unroll
        for (int i = 0; i < 8; ++i) v[i] = __builtin_nontemporal_load((const u32x4*)(ZF + (srow0 + (size_t)(16 * i + rsub) * sstride) * 1024 + cb * 32 + c4 * 8));
#pragma unroll
        for (int i = 0; i < 8; ++i) { const int rr = 16 * i + rsub; LAS bf16_t* s = scr + (c4 * 8) * P + rr;
            s[0 * P] = (bf16_t)(v[i].x & 0xffffu); s[1 * P] = (bf16_t)(v[i].x >> 16); s[2 * P] = (bf16_t)(v[i].y & 0xffffu); s[3 * P] = (bf16_t)(v[i].y >> 16);
            s[4 * P] = (bf16_t)(v[i].z & 0xffffu); s[5 * P] = (bf16_t)(v[i].z >> 16); s[6 * P] = (bf16_t)(v[i].w & 0xffffu); s[7 * P] = (bf16_t)(v[i].w >> 16); }
        LDS_WAIT(); asm volatile("" ::: "memory");
        const int ch0 = lane >> 4, r0 = (lane & 15) * 8;
#pragma unroll
        for (int i = 0; i < 8; ++i) { const int ch = ch0 + 4 * i; const u32x4 o = *(const LAS u32x4*)(scr + ch * P + r0);
            *(u32x4*)(dst + (size_t)ch * dpitch + r0) = o; }
        LDS_WAIT(); asm volatile("" ::: "memory");
    }
    __syncthreads();
}
template <bool FIXM>
__device__ __forceinline__ void attn_units(const Ctx& a, int nunits, char* lds, int tid, float mfixC) {
    unsigned char* ws = a.ws; const bf16_t* Z = (const bf16_t*)(ws + O_Z); bf16_t* AO = (bf16_t*)(ws + O_AO);
    for (int L = blockIdx.x; L < nunits; L += gridDim.x) {
        int b, h, q0, seq;
        if (L < 2048) { b = L >> 10; const int kvh = (L >> 8) & 3, g = (L >> 6) & 3, qb = L & 63; h = kvh * 4 + g; q0 = b * RPB + CTX + qb * 256; seq = RPB; }
        else { const int q = L - 2048; b = q >> 4; h = q & 15; q0 = b * RPB; seq = CTX; }
        const int kvh = h >> 2; const size_t k0 = (size_t)b * RPB;
        if constexpr (FIXM) { if (L < 2048) { att::attn_ring3_body<RPB / 64>(Z + (size_t)q0 * 3072 + h * 128, Z + k0 * 3072 + 2048 + kvh * 128, Z + k0 * 3072 + 2560 + kvh * 128, AO + (size_t)q0 * 2048 + h * 128, lds, tid); continue; } }
        att::attn_dense_body<FIXM>(Z + (size_t)q0 * 3072 + h * 128, Z + k0 * 3072 + 2048 + kvh * 128, Z + k0 * 3072 + 2560 + kvh * 128, AO + (size_t)q0 * 2048 + h * 128, seq, lds, tid, mfixC);
    }
}
__device__ __forceinline__ void attn_phase(const Ctx& a, int j, bool need_ctx, char* lds, int tid) {
    unsigned char* ws = a.ws; const bf16_t* Z = (const bf16_t*)(ws + O_Z); bf16_t* AO = (bf16_t*)(ws + O_AO);
    const int nunits = 2048 + (need_ctx ? 32 : 0);
    const bool fixm = attn_fixed_form(a, j, tid & 63); const float mfixC = 0.f;
    if (fixm) attn_units<true>(a, nunits, lds, tid, mfixC); else attn_units<false>(a, nunits, lds, tid, 0.f);
}
constexpr int NPH = 3 + 12 * DEPTH;
#ifndef MK_N_LAUNCHES
#define MK_N_LAUNCHES 1
#endif
#ifndef REP_ATT
#define REP_ATT 1
#endif
#ifndef REP_MOE
#define REP_MOE 1
#endif
#ifndef REP_EVEN
#define REP_EVEN 1
#endif
#ifndef REP_ODDG
#define REP_ODDG 1
#endif
#ifndef REP_CONV
#define REP_CONV 1
#endif
#ifndef REP_GA
#define REP_GA 1
#endif
#ifndef REP_PRO
#define REP_PRO 1
#endif
#ifndef REP_ROW
#define REP_ROW 1
#endif
#ifndef REP_QK
#define REP_QK 1
#endif
#ifndef REP_P0
#define REP_P0 1
#endif
#ifndef REP_P1
#define REP_P1 1
#endif
#ifndef REP_P2
#define REP_P2 1
#endif
#ifndef REP_R1
#define REP_R1 1
#endif
#ifndef REP_R2
#define REP_R2 1
#endif
#ifndef REP_TK
#define REP_TK 1
#endif
#ifndef REP_GAT
#define REP_GAT 1
#endif
#ifndef REP_BAR
#define REP_BAR 1
#endif
#define REPEAT(N) _Pragma("unroll 1") for (int rep_ = 0; rep_ < (N); ++rep_)

__global__ void __launch_bounds__(NTHREADS, 2) mk_fwd(Args a0) {
    extern __shared__ __attribute__((aligned(16))) unsigned char lds_raw[];
    LAS unsigned char* lds = (LAS unsigned char*)lds_raw;
    volatile LAS unsigned* MISC = (volatile LAS unsigned*)(lds + MISC_OFF);
    if (threadIdx.x < 32) MISC[threadIdx.x] = 0u;
    if (threadIdx.x == 0) {
#pragma unroll
        for (int i = 0; i < 32; ++i) *(LAS unsigned long long*)(lds + PTR_OFF + 8 * i) = (unsigned long long)a0.in[i];
        *(LAS unsigned long long*)(lds + PTR_OFF + 8 * 32) = (unsigned long long)a0.out; }
    __syncthreads();
    const int wave0 = __builtin_amdgcn_readfirstlane(threadIdx.x >> 6);
    const int lo = a0.ph_lo, hi = a0.ph_hi; (void)lo; (void)hi;
    XcdBarrier bar = xcd_barrier_post((unsigned*)(a0.ws + O_CTL) + CW_BAR + a0.li * XCD_BAR_WORDS, MISC + 8);
#if MK_N_LAUNCHES == 1
#define IN(k) true
#else
#define IN(k) (lo <= (k) && (k) < hi)
#endif
#define PH int tid; asm volatile("v_mbcnt_lo_u32_b32 %0, -1, 0\n\tv_mbcnt_hi_u32_b32 %0, -1, %0" : "=v"(tid)); tid += wave0 * 64; asm volatile("" : "+v"(tid));     const int lane = tid & 63, wave = __builtin_amdgcn_readfirstlane(tid >> 6); (void)lane; (void)wave; size_t wz_ = 0; asm volatile("" : "+s"(wz_)); unsigned char* ws = a0.ws + wz_; const Ctx a{lds, ws};
#if MK_N_LAUNCHES == 1
#define SEAM(k) do { if ((k) + 1 < NPH) { REPEAT(REP_BAR) xcd_barrier(bar); } } while (0)
#else
#define SEAM(k) do { if ((k) + 1 < hi) { REPEAT(REP_BAR) xcd_barrier(bar); } } while (0)
#endif
    const int G = gridDim.x, cid = blockIdx.x;
    pg8::Sched S;

    if (IN(0)) { PH REPEAT(REP_P0) p0_prologue(a, lds, tid, lane, wave); SEAM(0); }
    if (IN(1)) { PH REPEAT(REP_P1) { p1_kf(a, lds, tid); r0_phase(a, lane, wave); } SEAM(1); }
    if (IN(2)) { PH REPEAT(REP_P2) p2_s5mats(a, tid); SEAM(2); }

    for (int layer = 0; layer < DEPTH; ++layer) {
        const int base = 3 + 12 * layer, j = layer >> 1;
        const bool need_ctx = layer < DEPTH - 1;
        if ((layer & 1) == 0) {
            if (IN(base + 0)) { PH
                moe_weight_phase(a, layer, 0, (NRT * 8) % G, lds, lane, wave);
                pg8::OpWin op{(const bf16_t*)(ws + O_U), (const bf16_t*)(ws + O_WIN) + (size_t)j * DM * DM, DM, DM, DM, (bf16_t*)(ws + O_A3), (bf16_t*)(ws + O_ZF)};
                S.init(NRT, 8, G, cid); REPEAT(REP_EVEN) pg8::gemm_phase(lds, op, S, tid);
                SEAM(base + 0);
            }
            if (IN(base + 1)) { PH
                { pg8::OpL1 op{(const bf16_t*)(ws + O_A3), (const bf16_t*)(ws + O_BT1) + (size_t)j * 64 * 256 * 512, A3K, 512, 512, (float*)(ws + O_SUM)};
                  S.init(320, 1, G, cid); REPEAT(REP_EVEN) pg8::gemm_phase(lds, op, S, tid); }
                REPEAT(REP_EVEN) f1_transpose_phase(a, lds, lane, wave);
                SEAM(base + 1);
            }
            if (IN(base + 2)) { PH
                REPEAT(REP_EVEN) s5_carry_phase(a, j, lds, lane, wave);
                { pg8::OpFftA op{(const bf16_t*)(ws + O_FA), (const bf16_t*)(ws + O_T1), 256, 128, 256, (bf16_t*)(ws + O_BT2)};
                  S.init(1, 1024, G, cid); REPEAT(REP_EVEN) pg8::gemm_phase(lds, op, S, tid); }
                { pg8::OpCtxDft op{(const bf16_t*)(ws + O_F256), (const bf16_t*)(ws + O_T1C), 256, 256, 256, (bf16_t*)(ws + O_PQ)};
                  S.init(2, 8, G, cid); REPEAT(REP_EVEN) pg8::gemm_phase(lds, op, S, tid); }
                SEAM(base + 2);
            }
            if (IN(base + 3)) { PH
                { pg8::OpL3 op{(const bf16_t*)(ws + O_A3), (const bf16_t*)(ws + O_BT3) + (size_t)j * 64 * 512 * 768, A3K, A3K, A3K, (bf16_t*)(ws + O_G)};
                  S.init(320, 2, G, cid); REPEAT(REP_EVEN) pg8::gemm_phase(lds, op, S, tid); }
                { pg8::OpFftC op{(const bf16_t*)(ws + O_FC), (const bf16_t*)(ws + O_BT2), 256, 256, 256, (bf16_t*)(ws + O_PQ)};
                  S.init(1, 1024, G, cid); REPEAT(REP_EVEN) pg8::gemm_phase(lds, op, S, tid); }
                SEAM(base + 3);
            }
            if (IN(base + 4)) { PH
                { pg8::OpGlu op{(const bf16_t*)(ws + O_G), (const bf16_t*)(ws + O_WGLU) + (size_t)j * 1024 * 1024, 1024, 1024, 1024, a.inp(IN_BGLU) + j * 1024, (bf16_t*)(ws + O_CAT)};
                  S.init(NRT, 4, G, cid); REPEAT(REP_EVEN) pg8::gemm_phase(lds, op, S, tid); }
                { pg8::OpFnet op{(const bf16_t*)(ws + O_PQ), (const bf16_t*)(ws + O_FNM) + (size_t)j * 4 * 256 * 512, DM, 512, 512, a.inp(IN_FNETB) + j * 1024, (bf16_t*)(ws + O_CAT)};
                  S.init(NRT, 4, G, (cid + G - (NRT * 4) % G) % G); REPEAT(REP_EVEN) pg8::gemm_phase(lds, op, S, tid); }
                SEAM(base + 4);
            }
            if (IN(base + 5)) { PH
                moe_weight_phase(a, layer, 1, (NRT * 8) % G, lds, lane, wave);
                pg8::OpStore<false> op{(const bf16_t*)(ws + O_CAT), (const bf16_t*)(ws + O_WOUT) + (size_t)j * DM * DM, DM, DM, DM, (bf16_t*)(ws + O_O), DM, nullptr};
                S.init(NRT, 8, G, cid); REPEAT(REP_EVEN) pg8::gemm_phase(lds, op, S, tid);
                SEAM(base + 5);
            }
        } else {
            if (IN(base + 0)) { PH
                moe_weight_phase(a, layer, 0, (NRT * 12) % G, lds, lane, wave);
                pg8::OpStore<false> op{(const bf16_t*)(ws + O_U), (const bf16_t*)(ws + O_WQKV) + (size_t)j * 3072 * DM, DM, DM, DM, (bf16_t*)(ws + O_Z), 3072, nullptr};
                S.init(NRT, 12, G, cid); REPEAT(REP_ODDG) pg8::gemm_phase(lds, op, S, tid);
                SEAM(base + 0);
            }
            if (IN(base + 1)) { PH REPEAT(REP_QK) qknorm_phase(a, j, lane, wave, rep_ == REP_QK - 1); SEAM(base + 1); }
            if (IN(base + 2)) { PH REPEAT(REP_ATT) attn_phase(a, j, need_ctx, (char*)lds_raw, tid); SEAM(base + 2); }
            if (IN(base + 3)) { PH
                moe_weight_phase(a, layer, 1, (NRT * 8) % G, lds, lane, wave);
                pg8::OpStore<false> op{(const bf16_t*)(ws + O_AO), (const bf16_t*)(ws + O_WO) + (size_t)j * DM * DM, DM, DM, DM, (bf16_t*)(ws + O_O), DM, nullptr};
                S.init(NRT, 8, G, cid); REPEAT(REP_ODDG) pg8::gemm_phase(lds, op, S, tid);
                SEAM(base + 3);
            }
        }
        if (IN(base + 6)) { PH REPEAT(REP_R1) r1_phase(a, layer, lds, tid, lane, wave, rep_ == REP_R1 - 1); SEAM(base + 6); }
        if (IN(base + 7)) { PH REPEAT(REP_TK) topk_phase(a, need_ctx, lds, tid, lane, wave); SEAM(base + 7); }
        if (IN(base + 9)) { PH
            pg8::OpM1 op{(const bf16_t*)(ws + O_H2), (const bf16_t*)(ws + O_WGU), DM, DM, DM, (bf16_t*)(ws + O_HID), (const int*)(ws + O_IDX)};
            S.init(256, 8, G, cid); S.head = need_ctx ? 128 : 0; S.headM0 = 256; REPEAT(REP_MOE) pg8::gemm_phase(lds, op, S, tid); S.head = 0;
            SEAM(base + 9);
        }
        if (IN(base + 10)) { PH
            pg8::OpStore<true> op{(const bf16_t*)(ws + O_HID), (const bf16_t*)(ws + O_WD), EFF, EFF, EFF, (bf16_t*)(ws + O_YE), DM, nullptr};
            S.init(256, 8, G, cid); S.head = need_ctx ? 128 : 0; S.headM0 = 256; REPEAT(REP_MOE) pg8::gemm_phase(lds, op, S, tid); S.head = 0;
            SEAM(base + 10);
        }
        if (IN(base + 11)) { PH REPEAT(REP_R2) r2_phase(a, layer, lds, tid, lane, wave, rep_ == REP_R2 - 1); SEAM(base + 11); }
    }
#undef IN
#undef SEAM
}

static bool phase_empty(int k) { if (k < 3) return false; const int l = (k - 3) / 12, s = (k - 3) % 12; return (l & 1) && (s == 4 || s == 5); }
extern "C" void kernel_launch(void* const* d_in, const int* in_sizes, int n_in, void* d_out, int out_size, void* d_ws, size_t ws_size, hipStream_t stream) {
    static int grid = 0;
    if (grid == 0) {
        if (n_in != 32 || out_size != NBATCH * SEQ * DM || ws_size < WS_NEED) { fprintf(stderr, "kernel_launch: bad shapes n_in %d out %d ws %zu (need %zu)\n", n_in, out_size, ws_size, (size_t)WS_NEED); grid = -1; return; }
        int dev = 0, cus = 0;
        if (hipGetDevice(&dev) != hipSuccess || hipDeviceGetAttribute(&cus, hipDeviceAttributeMultiprocessorCount, dev) != hipSuccess) { grid = -1; return; }
        if (hipFuncSetAttribute((const void*)mk_fwd, hipFuncAttributeMaxDynamicSharedMemorySize, LDS_BYTES) != hipSuccess) { fprintf(stderr, "kernel_launch: hipFuncSetAttribute failed\n"); grid = -1; return; }
        int per_cu = 0;
        if (hipOccupancyMaxActiveBlocksPerMultiprocessor(&per_cu, (const void*)mk_fwd, NTHREADS, LDS_BYTES) != hipSuccess || per_cu < 1) fprintf(stderr, "kernel_launch: occupancy query says %d\n", per_cu);
        (void)hipGetLastError();
        grid = cus;
    }
    if (grid < 0) return;
    (void)in_sizes;
    if (hipMemsetAsync((char*)d_ws + O_CTL, 0, CTL_BYTES, stream) != hipSuccess) return;
    Args a{};
    for (int i = 0; i < 32; ++i) a.in[i] = (const float*)d_in[i];
    a.out = (float*)d_out; a.ws = (unsigned char*)d_ws; a.pad = 0;
#if MK_N_LAUNCHES == 1
    a.ph_lo = 0; a.ph_hi = NPH; a.li = 0;
    hipLaunchKernelGGL(mk_fwd, dim3(grid), dim3(NTHREADS), LDS_BYTES, stream, a);
#else
    int li = 0;
    for (int k = 0; k < NPH; ++k) { if (phase_empty(k)) continue;
        a.ph_lo = k; a.ph_hi = k + 1; a.li = li++;
        hipLaunchKernelGGL(mk_fwd, dim3(grid), dim3(NTHREADS), LDS_BYTES, stream, a); }
#endif
    const hipError_t le = hipPeekAtLastError();
    if (le != hipSuccess) fprintf(stderr, "kernel_launch: launch failed: %s\n", hipGetErrorName(le));
}
```
